# Optimizing an MI355X kernel written in HIP

```python
import math
import jax, jax.numpy as jnp
from jax import lax
import numpy as np

D_MODEL = 1024
BATCH = 1
SEQ = 16384
DEPTH = 2
DEC_BATCH = 32
DEC_SEQ = 64
PAST_LEN = 4096

CHUNK = 64
CONV_WIDTH = 4
HEAD_DIM = 64
GDN_WIDTH = D_MODEL // 4
GDN_HEADS = GDN_WIDTH // HEAD_DIM
SSM_WIDTH = D_MODEL // 2
SSM_HEADS = SSM_WIDTH // HEAD_DIM
SSM_GROUPS = 2
SSM_STATE = 128
RWKV_WIDTH = D_MODEL - GDN_WIDTH - SSM_WIDTH
RWKV_HEADS = RWKV_WIDTH // HEAD_DIM
RWKV_DECAY_LORA = 64
RWKV_ICLR_LORA = 64
RWKV_GATE_LORA = 128
MIX_WIDTH = GDN_WIDTH + SSM_WIDTH + RWKV_WIDTH
FFN_HIDDEN = -(-8 * D_MODEL // (3 * 256)) * 256
GDN_CONV_CH = 3 * GDN_WIDTH
GDN_COLS = GDN_CONV_CH + GDN_WIDTH + 2 * GDN_HEADS
SSM_BC = SSM_GROUPS * SSM_STATE
SSM_CONV_CH = SSM_WIDTH + 2 * SSM_BC
SSM_COLS = SSM_WIDTH + SSM_CONV_CH + SSM_HEADS
RWKV_COLS = 3 * RWKV_WIDTH + RWKV_DECAY_LORA + RWKV_ICLR_LORA + RWKV_GATE_LORA
IN_COLS = GDN_COLS + SSM_COLS + RWKV_COLS
NORM_EPS = 1e-6
RWKV_GN_EPS = 64e-5

kernel_name = 'hybrid_gdn_ssd_rwkv7_stream_step'


def rms_norm(x, w):
    xf = x.astype(jnp.float32)
    y = xf * lax.rsqrt(jnp.mean(xf * xf, axis=-1, keepdims=True) + NORM_EPS)
    return (y * w.astype(jnp.float32)).astype(x.dtype)


def l2_normalize(x):
    return x * lax.rsqrt(jnp.sum(x * x, axis=-1, keepdims=True) + NORM_EPS)


def causal_conv(x, prev, w):
    t = x.shape[1]
    xp = jnp.concatenate([prev.astype(x.dtype), x], axis=1)
    w = w.astype(x.dtype)
    y = xp[:, 0:t] * w[0]
    for j in range(1, CONV_WIDTH):
        y = y + xp[:, j:j + t] * w[j]
    return y, xp[:, t:]


def gated_delta_chunked(q, k, v, g, beta, s0, chunk):
    bsz, t, h, _ = q.shape
    dv = v.shape[-1]
    n = t // chunk

    def blocks(a):
        return jnp.moveaxis(a.reshape((bsz, n, chunk, h) + a.shape[3:]), 3, 2)

    qc, kc, vc = blocks(q), blocks(k), blocks(v)
    gc, bc = blocks(g), blocks(beta)
    gcum = jnp.cumsum(gc, axis=-1)
    causal = jnp.tril(jnp.ones((chunk, chunk), dtype=bool))
    strict = jnp.tril(jnp.ones((chunk, chunk), dtype=bool), -1)
    diff = gcum[..., :, None] - gcum[..., None, :]
    decay = jnp.where(causal, jnp.exp(jnp.where(causal, diff, 0.0)), 0.0)
    k_beta = kc * bc[..., None]
    v_beta = vc * bc[..., None]
    lower = jnp.where(strict, jnp.einsum('bnhik,bnhjk->bnhij', k_beta, kc) * decay, 0.0)
    unit_lower = lower + jnp.eye(chunk, dtype=lower.dtype)
    u = lax.linalg.triangular_solve(unit_lower, v_beta, left_side=True, lower=True)
    w = lax.linalg.triangular_solve(unit_lower, k_beta * jnp.exp(gcum)[..., None],
                                    left_side=True, lower=True)
    attn = jnp.where(causal, jnp.einsum('bnhik,bnhjk->bnhij', qc, kc) * decay, 0.0)
    q_dec = qc * jnp.exp(gcum)[..., None]
    k_dec = kc * jnp.exp(gcum[..., -1:] - gcum)[..., None]
    blk_dec = jnp.exp(gcum[..., -1])

    def step(s, inp):
        u_i, w_i, a_i, qd_i, kd_i, bd_i = inp
        v_new = u_i - jnp.einsum('bhck,bhkv->bhcv', w_i, s)
        o_i = jnp.einsum('bhck,bhkv->bhcv', qd_i, s) + jnp.einsum('bhcj,bhjv->bhcv', a_i, v_new)
        s = s * bd_i[..., None, None] + jnp.einsum('bhck,bhcv->bhkv', kd_i, v_new)
        return s, o_i

    xs = tuple(jnp.moveaxis(a, 1, 0) for a in (u, w, attn, q_dec, k_dec, blk_dec))
    s_final, o = lax.scan(step, s0, xs)
    o = jnp.transpose(o, (1, 0, 3, 2, 4)).reshape(bsz, t, h, dv)
    return o, s_final


def ssd_chunked(xdt, adt, bm, cm, s0, chunk):
    bsz, t, h, p = xdt.shape
    nst = bm.shape[-1]
    nc = t // chunk
    xc = xdt.reshape(bsz, nc, chunk, h, p)
    bc = bm.reshape(bsz, nc, chunk, h, nst)
    cc = cm.reshape(bsz, nc, chunk, h, nst)
    ac = jnp.moveaxis(adt.reshape(bsz, nc, chunk, h), 3, 2)
    acum = jnp.cumsum(ac, axis=-1)
    causal = jnp.tril(jnp.ones((chunk, chunk), dtype=bool))
    seg = acum[..., :, None] - acum[..., None, :]
    lmat = jnp.where(causal, jnp.exp(jnp.where(causal, seg, 0.0)), 0.0)
    scores = jnp.einsum('bclhn,bcshn->bchls', cc, bc) * lmat
    y_diag = jnp.einsum('bchls,bcshp->bclhp', scores, xc)
    decay_to_end = jnp.exp(acum[..., -1:] - acum)
    chunk_states = jnp.einsum('bclhn,bchl,bclhp->bchpn', bc, decay_to_end, xc)
    chunk_decay = jnp.exp(acum[..., -1])

    def step(s, inp):
        cs, cd = inp
        return s * cd[..., None, None] + cs, s

    s_final, s_in = lax.scan(step, s0, (jnp.moveaxis(chunk_states, 1, 0),
                                        jnp.moveaxis(chunk_decay, 1, 0)))
    s_in = jnp.moveaxis(s_in, 0, 1)
    y_off = jnp.einsum('bclhn,bchpn,bchl->bclhp', cc, s_in, jnp.exp(acum))
    return (y_diag + y_off).reshape(bsz, t, h, p), s_final


def rwkv7_scan(r, w, k, v, a, b, s0):
    def step(s, inp):
        r_t, w_t, k_t, v_t, a_t, b_t = inp
        sa = jnp.einsum('bhvk,bhk->bhv', s, a_t)
        s = s * w_t[:, :, None, :] + sa[..., None] * b_t[:, :, None, :] + v_t[..., None] * k_t[:, :, None, :]
        return s, jnp.einsum('bhvk,bhk->bhv', s, r_t)

    xs = tuple(jnp.moveaxis(z, 1, 0) for z in (r, w, k, v, a, b))
    s_final, ys = lax.scan(step, s0, xs)
    return jnp.moveaxis(ys, 0, 1), s_final


def gdn_mixer(p, s0, conv_prev, lp, chunk):
    bsz, t, _ = p.shape
    h, d = GDN_HEADS, HEAD_DIM
    c0 = GDN_CONV_CH
    c1 = c0 + GDN_WIDTH
    c2 = c1 + GDN_HEADS
    qkv, conv_new = causal_conv(p[..., :c0], conv_prev, lp['gdn_conv_w'])
    qkv = jax.nn.silu(qkv).reshape(bsz, t, 3, h, d)
    q = l2_normalize(qkv[:, :, 0]) * (d ** -0.5)
    k = l2_normalize(qkv[:, :, 1])
    v = qkv[:, :, 2]
    z = p[..., c0:c1].reshape(bsz, t, h, d)
    g = -jnp.exp(lp['gdn_A_log'].astype(jnp.float32)) * jax.nn.softplus(p[..., c1:c2] + lp['gdn_dt_bias'])
    beta = jax.nn.sigmoid(p[..., c2:c2 + h])
    o, s = gated_delta_chunked(q, k, v, g, beta, s0.astype(jnp.float32), chunk)
    o = rms_norm(o, lp['gdn_norm_w']) * jax.nn.silu(z)
    return o.reshape(bsz, t, GDN_WIDTH), s, conv_new


def ssd_mixer(p, s0, conv_prev, lp, chunk):
    bsz, t, _ = p.shape
    h, d, g, n = SSM_HEADS, HEAD_DIM, SSM_GROUPS, SSM_STATE
    c0 = SSM_WIDTH
    c1 = c0 + SSM_CONV_CH
    z = p[..., :c0]
    xbc, conv_new = causal_conv(p[..., c0:c1], conv_prev, lp['ssm_conv_w'])
    xbc = jax.nn.silu(xbc + lp['ssm_conv_b'])
    xs = xbc[..., :SSM_WIDTH].reshape(bsz, t, h, d)
    bm = jnp.repeat(xbc[..., SSM_WIDTH:SSM_WIDTH + SSM_BC].reshape(bsz, t, g, n), h // g, axis=2)
    cm = jnp.repeat(xbc[..., SSM_WIDTH + SSM_BC:].reshape(bsz, t, g, n), h // g, axis=2)
    dt = jax.nn.softplus(p[..., c1:c1 + h] + lp['ssm_dt_bias'])
    a = -jnp.exp(lp['ssm_A_log'].astype(jnp.float32))
    y, s = ssd_chunked(xs * dt[..., None], dt * a, bm, cm, s0.astype(jnp.float32), chunk)
    y = y + lp['ssm_D'].astype(jnp.float32)[:, None] * xs
    y = y.reshape(bsz, t, SSM_WIDTH) * jax.nn.silu(z)
    yg = y.reshape(bsz, t, g, SSM_WIDTH // g)
    yg = yg * lax.rsqrt(jnp.mean(yg * yg, axis=-1, keepdims=True) + NORM_EPS)
    y = yg.reshape(bsz, t, SSM_WIDTH) * lp['ssm_norm_w'].astype(jnp.float32)
    return y, s, conv_new


def rwkv7_mixer(p, s0, shift_prev, lp):
    bsz, t, _ = p.shape
    h, d, wd = RWKV_HEADS, HEAD_DIM, RWKV_WIDTH
    prev = jnp.concatenate([shift_prev.astype(p.dtype), p[:, :-1]], axis=1)
    xm = p + (prev - p) * lp['rwkv_mu']
    c0 = 3 * wd
    c1 = c0 + RWKV_DECAY_LORA
    c2 = c1 + RWKV_ICLR_LORA
    r = xm[..., :wd]
    k = xm[..., wd:2 * wd]
    v = xm[..., 2 * wd:c0]
    w_log = -jax.nn.softplus(-(lp['rwkv_w0'] + jnp.matmul(jnp.tanh(xm[..., c0:c1]), lp['rwkv_w_up']))) - 0.5
    decay = jnp.exp(-jnp.exp(w_log))
    iclr = jax.nn.sigmoid(lp['rwkv_a0'] + jnp.matmul(xm[..., c1:c2], lp['rwkv_a_up']))
    gate = jnp.matmul(jax.nn.sigmoid(xm[..., c2:]), lp['rwkv_g_up'])

    def heads(z):
        return z.reshape(bsz, t, h, d)

    kk = l2_normalize(heads(k * lp['rwkv_k_k']))
    k = k * (1.0 + (iclr - 1.0) * lp['rwkv_k_a'])
    r_h, k_h, v_h = heads(r), heads(k), heads(v)
    y, s = rwkv7_scan(r_h, heads(decay), k_h, v_h, -kk, kk * heads(iclr), s0.astype(jnp.float32))
    mean = jnp.mean(y, axis=-1, keepdims=True)
    var = jnp.mean(jnp.square(y - mean), axis=-1, keepdims=True)
    y = ((y - mean) * lax.rsqrt(var + RWKV_GN_EPS)).reshape(bsz, t, wd)
    y = y * lp['rwkv_ln_w'] + lp['rwkv_ln_b']
    bonus = jnp.sum(r_h * k_h * lp['rwkv_r_k'], axis=-1, keepdims=True) * v_h
    y = (y + bonus.reshape(bsz, t, wd)) * gate
    return y, s, p[:, -1:]


def layer(x, st, lp):
    gdn_s, gdn_conv, ssm_s, ssm_conv, rwkv_s, rwkv_shift = st
    chunk = min(CHUNK, x.shape[1])
    hn = rms_norm(x, lp['norm1_w'])
    proj = jnp.matmul(hn, lp['w_in']).astype(jnp.float32)
    pa = proj[..., :GDN_COLS]
    pb = proj[..., GDN_COLS:GDN_COLS + SSM_COLS]
    pc = proj[..., GDN_COLS + SSM_COLS:]
    ya, gdn_s_new, gdn_conv_new = gdn_mixer(pa, gdn_s, gdn_conv, lp, chunk)
    yb, ssm_s_new, ssm_conv_new = ssd_mixer(pb, ssm_s, ssm_conv, lp, chunk)
    yc, rwkv_s_new, rwkv_shift_new = rwkv7_mixer(pc, rwkv_s, rwkv_shift, lp)
    mix = jnp.concatenate([ya, yb, yc], axis=-1).astype(x.dtype)
    x = x + jnp.matmul(mix, lp['w_out'])
    h2 = rms_norm(x, lp['norm2_w'])
    ff = jax.nn.silu(jnp.matmul(h2, lp['ffn_w_gate'])) * jnp.matmul(h2, lp['ffn_w_up'])
    x = x + jnp.matmul(ff, lp['ffn_w_down'])
    return x, (gdn_s_new, gdn_conv_new, ssm_s_new, ssm_conv_new, rwkv_s_new, rwkv_shift_new)


def trunk(x, states, params, final_norm_w):
    outs = [[] for _ in states]
    for l in range(DEPTH):
        lp = {name: w[l] for name, w in params.items()}
        x, new = layer(x, tuple(s[l] for s in states), lp)
        for o, nw in zip(outs, new):
            o.append(nw.astype(x.dtype))
    y = rms_norm(x, final_norm_w)
    return y, tuple(jnp.stack(o) for o in outs)


def setup_inputs(seed: int = 0) -> dict:
    key = jax.random.key(seed)
    ks = iter(jax.random.split(key, 48))

    def nrm(shape, scale):
        return scale * jax.random.normal(next(ks), shape, jnp.float32)

    def unif(shape, lo, hi):
        return jax.random.uniform(next(ks), shape, jnp.float32, lo, hi)

    def dt_bias(shape):
        dt = jnp.exp(unif(shape, math.log(1e-3), math.log(1e-1)))
        return dt + jnp.log(-jnp.expm1(-dt))

    L, D, W1 = DEPTH, D_MODEL, CONV_WIDTH - 1
    return {
        'x_prompt': nrm((BATCH, SEQ, D), 1.0),
        'x_sample': nrm((DEC_BATCH, DEC_SEQ, D), 1.0),
        'state_gdn': nrm((L, DEC_BATCH, GDN_HEADS, HEAD_DIM, HEAD_DIM), 0.3),
        'state_gdn_conv': nrm((L, DEC_BATCH, W1, GDN_CONV_CH), 1.0),
        'state_ssm': nrm((L, DEC_BATCH, SSM_HEADS, HEAD_DIM, SSM_STATE), 0.3),
        'state_ssm_conv': nrm((L, DEC_BATCH, W1, SSM_CONV_CH), 1.0),
        'state_rwkv': nrm((L, DEC_BATCH, RWKV_HEADS, HEAD_DIM, HEAD_DIM), 0.3),
        'state_rwkv_shift': nrm((L, DEC_BATCH, 1, RWKV_COLS), 1.0),
        'norm1_w': 1.0 + nrm((L, D), 0.02),
        'w_in': nrm((L, D, IN_COLS), D ** -0.5),
        'gdn_conv_w': nrm((L, CONV_WIDTH, GDN_CONV_CH), CONV_WIDTH ** -0.5),
        'gdn_A_log': jnp.log(unif((L, GDN_HEADS), 1.0, 16.0)),
        'gdn_dt_bias': dt_bias((L, GDN_HEADS)),
        'gdn_norm_w': 1.0 + nrm((L, HEAD_DIM), 0.02),
        'ssm_conv_w': nrm((L, CONV_WIDTH, SSM_CONV_CH), CONV_WIDTH ** -0.5),
        'ssm_conv_b': nrm((L, SSM_CONV_CH), 0.02),
        'ssm_A_log': jnp.log(unif((L, SSM_HEADS), 1.0, 16.0)),
        'ssm_dt_bias': dt_bias((L, SSM_HEADS)),
        'ssm_D': 1.0 + nrm((L, SSM_HEADS), 0.1),
        'ssm_norm_w': 1.0 + nrm((L, SSM_WIDTH), 0.02),
        'rwkv_mu': unif((L, RWKV_COLS), 0.0, 1.0),
        'rwkv_w0': unif((L, RWKV_WIDTH), -6.5, -1.5),
        'rwkv_w_up': nrm((L, RWKV_DECAY_LORA, RWKV_WIDTH), 0.5 * RWKV_DECAY_LORA ** -0.5),
        'rwkv_a0': nrm((L, RWKV_WIDTH), 0.1),
        'rwkv_a_up': nrm((L, RWKV_ICLR_LORA, RWKV_WIDTH), 0.5 * RWKV_ICLR_LORA ** -0.5),
        'rwkv_g_up': nrm((L, RWKV_GATE_LORA, RWKV_WIDTH), RWKV_GATE_LORA ** -0.5),
        'rwkv_k_k': 0.85 + nrm((L, RWKV_WIDTH), 0.02),
        'rwkv_k_a': 1.0 + nrm((L, RWKV_WIDTH), 0.02),
        'rwkv_r_k': nrm((L, RWKV_HEADS, HEAD_DIM), 0.1),
        'rwkv_ln_w': 1.0 + nrm((L, RWKV_WIDTH), 0.02),
        'rwkv_ln_b': nrm((L, RWKV_WIDTH), 0.02),
        'w_out': nrm((L, MIX_WIDTH, D), MIX_WIDTH ** -0.5),
        'norm2_w': 1.0 + nrm((L, D), 0.02),
        'ffn_w_gate': nrm((L, D, FFN_HIDDEN), D ** -0.5),
        'ffn_w_up': nrm((L, D, FFN_HIDDEN), D ** -0.5),
        'ffn_w_down': nrm((L, FFN_HIDDEN, D), FFN_HIDDEN ** -0.5),
        'final_norm_w': 1.0 + nrm((D,), 0.02),
    }


def reference(x_prompt, x_sample, state_gdn, state_gdn_conv, state_ssm, state_ssm_conv,
              state_rwkv, state_rwkv_shift,
              norm1_w, w_in, gdn_conv_w, gdn_A_log, gdn_dt_bias, gdn_norm_w,
              ssm_conv_w, ssm_conv_b, ssm_A_log, ssm_dt_bias, ssm_D, ssm_norm_w,
              rwkv_mu, rwkv_w0, rwkv_w_up, rwkv_a0, rwkv_a_up, rwkv_g_up,
              rwkv_k_k, rwkv_k_a, rwkv_r_k, rwkv_ln_w, rwkv_ln_b,
              w_out, norm2_w, ffn_w_gate, ffn_w_up, ffn_w_down, final_norm_w):
    params = {
        'norm1_w': norm1_w, 'w_in': w_in,
        'gdn_conv_w': gdn_conv_w, 'gdn_A_log': gdn_A_log, 'gdn_dt_bias': gdn_dt_bias,
        'gdn_norm_w': gdn_norm_w,
        'ssm_conv_w': ssm_conv_w, 'ssm_conv_b': ssm_conv_b, 'ssm_A_log': ssm_A_log,
        'ssm_dt_bias': ssm_dt_bias, 'ssm_D': ssm_D, 'ssm_norm_w': ssm_norm_w,
        'rwkv_mu': rwkv_mu, 'rwkv_w0': rwkv_w0, 'rwkv_w_up': rwkv_w_up, 'rwkv_a0': rwkv_a0,
        'rwkv_a_up': rwkv_a_up, 'rwkv_g_up': rwkv_g_up, 'rwkv_k_k': rwkv_k_k,
        'rwkv_k_a': rwkv_k_a, 'rwkv_r_k': rwkv_r_k, 'rwkv_ln_w': rwkv_ln_w, 'rwkv_ln_b': rwkv_ln_b,
        'w_out': w_out, 'norm2_w': norm2_w,
        'ffn_w_gate': ffn_w_gate, 'ffn_w_up': ffn_w_up, 'ffn_w_down': ffn_w_down,
    }
    nb = x_prompt.shape[0]
    f32 = jnp.float32
    zero_states = (
        jnp.zeros((DEPTH, nb, GDN_HEADS, HEAD_DIM, HEAD_DIM), f32),
        jnp.zeros((DEPTH, nb, CONV_WIDTH - 1, GDN_CONV_CH), f32),
        jnp.zeros((DEPTH, nb, SSM_HEADS, HEAD_DIM, SSM_STATE), f32),
        jnp.zeros((DEPTH, nb, CONV_WIDTH - 1, SSM_CONV_CH), f32),
        jnp.zeros((DEPTH, nb, RWKV_HEADS, HEAD_DIM, HEAD_DIM), f32),
        jnp.zeros((DEPTH, nb, 1, RWKV_COLS), f32),
    )
    y_prompt, p_states = trunk(x_prompt, zero_states, params, final_norm_w)
    p_gdn, p_gdn_conv, p_ssm, p_ssm_conv, p_rwkv, p_rwkv_shift = p_states
    cache_states = (state_gdn, state_gdn_conv, state_ssm, state_ssm_conv, state_rwkv, state_rwkv_shift)
    y_sample, s_states = trunk(x_sample, cache_states, params, final_norm_w)
    s_gdn, s_gdn_conv, s_ssm, s_ssm_conv, s_rwkv, s_rwkv_shift = s_states
    return (y_prompt, y_sample,
            p_gdn, p_gdn_conv, p_ssm, p_ssm_conv, p_rwkv, p_rwkv_shift,
            s_gdn, s_gdn_conv, s_ssm, s_ssm_conv, s_rwkv, s_rwkv_shift)
```

```cpp
#include <hip/hip_runtime.h>
#include <cstdio>
#include <cstdint>

#ifndef MK_N_LAUNCHES
#define MK_N_LAUNCHES 0
#endif

#define LAS __attribute__((address_space(3)))
typedef unsigned short bf16_t;
typedef short bf16x8 __attribute__((ext_vector_type(8)));
typedef float f32x4 __attribute__((ext_vector_type(4)));
typedef float f32x2 __attribute__((ext_vector_type(2)));
typedef unsigned u32x4 __attribute__((ext_vector_type(4)));
typedef unsigned u32x2 __attribute__((ext_vector_type(2)));

constexpr int DM = 1024, TP = 16384, NB = 32, T = 18432, NCH = 288, NSEQ = 33;
constexpr int PW = 3584;
constexpr int NIN = 3840;
constexpr int FF = 2816, NGU = 5632;
constexpr float EPS = 1e-6f;
constexpr int PC_ZG = 0, PC_ZS = 256, PC_R = 768, PC_GQ = 1024, PC_GK = 1280, PC_GV = 1536, PC_SX = 1792, PC_SB = 2304, PC_SC = 2560,
              PC_RK = 2816, PC_RV = 3072, PC_RL = 3328;
constexpr size_t O_Y = 0;
constexpr size_t O_P_GDN = (size_t)T * DM;
constexpr size_t O_P_GDNC = O_P_GDN + 2 * 1 * 4 * 64 * 64;
constexpr size_t O_P_SSM = O_P_GDNC + 2 * 1 * 3 * 768;
constexpr size_t O_P_SSMC = O_P_SSM + 2 * 1 * 8 * 64 * 128;
constexpr size_t O_P_RWKV = O_P_SSMC + 2 * 1 * 3 * 1024;
constexpr size_t O_P_SHIFT = O_P_RWKV + 2 * 1 * 4 * 64 * 64;
constexpr size_t O_S_GDN = O_P_SHIFT + 2 * 1 * 1024;
constexpr size_t O_S_GDNC = O_S_GDN + (size_t)2 * 32 * 4 * 64 * 64;
constexpr size_t O_S_SSM = O_S_GDNC + (size_t)2 * 32 * 3 * 768;
constexpr size_t O_S_SSMC = O_S_SSM + (size_t)2 * 32 * 8 * 64 * 128;
constexpr size_t O_S_RWKV = O_S_SSMC + (size_t)2 * 32 * 3 * 1024;
constexpr size_t O_S_SHIFT = O_S_RWKV + (size_t)2 * 32 * 4 * 64 * 64;
constexpr size_t O_END = O_S_SHIFT + (size_t)2 * 32 * 1024;
static_assert(O_END == 25784832, "output size");

constexpr size_t WS_CTL = 0, CTL_BYTES = 1u << 20;
constexpr size_t W_IN_B = (size_t)NIN * DM * 2, W_OUT_B = (size_t)DM * DM * 2, W_GU_B = (size_t)NGU * DM * 2, W_DN_B = (size_t)DM * FF * 2;
constexpr size_t W_LAYER_B = W_IN_B + W_OUT_B + W_GU_B + W_DN_B;
constexpr size_t WS_W = WS_CTL + CTL_BYTES;
constexpr size_t WS_R1 = WS_W + 2 * W_LAYER_B;
constexpr size_t R_BYTES = (size_t)T * DM * 2;
constexpr size_t WS_R2 = WS_R1 + R_BYTES;
constexpr size_t WS_PROJ = WS_R2 + R_BYTES;
constexpr size_t PROJ_BYTES = (size_t)T * PW * 2;
constexpr size_t WS_SSQA = WS_PROJ + PROJ_BYTES;
constexpr size_t SSQ_BYTES = (size_t)T * 16 * 4;
constexpr size_t WS_SSQD = WS_SSQA + SSQ_BYTES;
constexpr size_t WS_END = WS_SSQD + SSQ_BYTES;
static_assert(WS_END <= 268435456, "d_ws map exceeds 256 MiB");
static_assert((size_t)T * FF * 2 <= PROJ_BYTES, "ff overlays proj");
constexpr size_t R2_SCAL = 0;
constexpr size_t R2_HCONV = R2_SCAL + (size_t)T * 16 * 4;
constexpr size_t R2_HSHIFT = R2_HCONV + (size_t)NCH * 3 * 1792 * 2;
static_assert(R2_HSHIFT + (size_t)NCH * 1024 * 2 <= R_BYTES, "R2 map");
constexpr size_t R1_RW = 0;
constexpr size_t R1_RKK = R1_RW + (size_t)T * 256 * 4;
constexpr size_t R1_RB = R1_RKK + (size_t)T * 256 * 2;
static_assert(R1_RB + (size_t)T * 256 * 2 <= R_BYTES, "R1 map");
constexpr int CW_BAR = 4096;

constexpr int RING_BYTES = 131072;
constexpr int LDSCTL_OFF = 143360, MISC_OFF = LDSCTL_OFF + 320;
constexpr int LDS_BYTES = 147456;

__device__ __forceinline__ unsigned cvt_pk_bf16(float lo, float hi) { unsigned r; asm volatile("v_cvt_pk_bf16_f32 %0, %1, %2" : "=v"(r) : "v"(lo), "v"(hi)); return r; }
__device__ __forceinline__ float bf_lo(unsigned w) { return __uint_as_float(w << 16); }
__device__ __forceinline__ float bf_hi(unsigned w) { return __uint_as_float(w & 0xffff0000u); }
__device__ __forceinline__ float bf2f(bf16_t h) { return __uint_as_float(((unsigned)h) << 16); }
__device__ __forceinline__ bf16_t f2bf(float f) { return (bf16_t)(cvt_pk_bf16(f, 0.f) & 0xffffu); }
__device__ __forceinline__ void unpack8(u32x4 w, float (&o)[8]) {
    o[0] = bf_lo(w.x); o[1] = bf_hi(w.x); o[2] = bf_lo(w.y); o[3] = bf_hi(w.y); o[4] = bf_lo(w.z); o[5] = bf_hi(w.z); o[6] = bf_lo(w.w); o[7] = bf_hi(w.w); }
__device__ __forceinline__ u32x4 pack8(const float (&v)[8]) { u32x4 w; w.x = cvt_pk_bf16(v[0], v[1]); w.y = cvt_pk_bf16(v[2], v[3]); w.z = cvt_pk_bf16(v[4], v[5]); w.w = cvt_pk_bf16(v[6], v[7]); return w; }
__device__ __forceinline__ float wave_sum(float v) {
#pragma unroll
    for (int o = 1; o < 64; o <<= 1) v += __shfl_xor(v, o);
    return v;
}
__device__ __forceinline__ float sigmoidf_(float x) { return 1.f / (1.f + __expf(-x)); }
__device__ __forceinline__ float siluf_(float x) { return x / (1.f + __expf(-x)); }
__device__ __forceinline__ float softplusf_(float x) { return fmaxf(x, 0.f) + log1pf(__expf(-fabsf(x))); }

namespace pg8 {
constexpr int BM = 256, BK = 64, HALF = 128, HTB = HALF * BK * 2, STAGE_BYTES = 8 * HTB, NXCD = 8, WGM = 8;
__host__ __device__ __forceinline__ int lds_byte(int r, int c) { const int st = (r >> 4) * 2 + (c >> 5), rr = r & 15, cc = c & 31, ob = rr * 64 + cc * 2; return st * 1024 + (ob ^ (((ob >> 9) & 1) << 5)); }
__host__ __device__ __forceinline__ void stage_rc(int b, int& R, int& C) { const int st = b / 1024, sb = b % 1024, swz = sb ^ (((sb >> 9) & 1) << 5); R = (st >> 1) * 16 + swz / 64; C = (st & 1) * 32 + (swz % 64) / 2; }
__host__ __device__ __forceinline__ int perm32(int rho) { const int n = rho >> 4, i = rho & 15; return 8 * (i >> 2) + 4 * n + (i & 3); }
struct Unit { int pm, pn; };
struct Gemm { const bf16_t* A; const bf16_t* Bt; int M, N, K, lda; };
struct StaticOrder {
    int nM, nN, nwg, G, c;
    __host__ __device__ void init(int M, int N, int G_, int c_) { nM = M / BM; nN = N / BM; nwg = nM * nN; G = G_; c = c_; }
    __host__ __device__ bool next(int i, Unit& u) const {
        const long L = (long)i * G + c; if (L >= nwg) return false;
        int wgid = (int)L; { const int q = nwg / NXCD, r = nwg % NXCD, xcd = wgid % NXCD, off = wgid / NXCD; wgid = (xcd < r ? xcd * (q + 1) : r * (q + 1) + (xcd - r) * q) + off; }
        const int nig = WGM * nN, gid = wgid / nig, fm = gid * WGM, gsz = (nM - fm) < WGM ? (nM - fm) : WGM;
        u.pm = fm + ((wgid % nig) % gsz); u.pn = (wgid % nig) / gsz; return true;
    }
};
template <class Epi, bool ALIGN_EPI>
__device__ __forceinline__ void gemm_phase(LAS unsigned char* lds, const Gemm g, const StaticOrder& S, const Epi& E) {
    int tid_ = threadIdx.x; asm volatile("" : "+v"(tid_));
    const int tid = tid_, wid = __builtin_amdgcn_readfirstlane(tid >> 6), lane = tid & 63, wr = wid >> 2, wc = wid & 3, fr = lane & 15, fq = lane >> 4;
    const int K = g.K, nt = K / BK, lda = g.lda;
    unsigned voffA[2], voffB[2];
#pragma unroll
    for (int i = 0; i < 2; ++i) { int R, C; stage_rc(tid * 16 + i * 8192, R, C); const int Rb = Epi::PERM ? ((R & ~31) + perm32(R & 31)) : R;
        voffA[i] = (unsigned)(R * lda + C) * 2u; voffB[i] = (unsigned)(Rb * K + C) * 2u; }
    const size_t kstep = (size_t)(BK * 2);
    const size_t hstepA = (size_t)HALF * lda * 2, hstepB = (size_t)HALF * K * 2;
    const size_t tstepA = 2 * hstepA, tstepB = 2 * hstepB;
    const unsigned ldsw = (unsigned)wid * 1024u;
    const int aoff = lds_byte(wr * 64 + fr, fq * 8), boff = lds_byte(wc * 32 + fr, fq * 8);
#define PG8_SA(b, h) (((b) * 2 + (h)) * HTB)
#define PG8_SB(b, h) ((4 + (b) * 2 + (h)) * HTB)
#define PG8_STAGE(bufoff, gbase, voff) do { _Pragma("unroll") for (int _i = 0; _i < 2; ++_i) \
        __builtin_amdgcn_global_load_lds((const unsigned*)((const char*)(gbase) + (voff)[_i]), (LAS unsigned*)(lds + (bufoff) + ldsw + _i * 8192), 16, 0, 0); } while (0)
#define PG8_LDA(dst, b, h) do { _Pragma("unroll") for (int m = 0; m < 4; ++m) _Pragma("unroll") for (int k = 0; k < 2; ++k) dst[m][k] = *(const LAS bf16x8*)(lds + PG8_SA(b, h) + aoff + m * 2048 + k * 1024); } while (0)
#define PG8_LDB(dst, b, h) do { _Pragma("unroll") for (int n = 0; n < 2; ++n) _Pragma("unroll") for (int k = 0; k < 2; ++k) dst[n][k] = *(const LAS bf16x8*)(lds + PG8_SB(b, h) + boff + n * 2048 + k * 1024); } while (0)
#define PG8_MMA(ai, bj, At, Bt) do { __builtin_amdgcn_s_setprio(1); _Pragma("unroll") for (int m = 0; m < 4; ++m) _Pragma("unroll") for (int n = 0; n < 2; ++n) _Pragma("unroll") for (int k = 0; k < 2; ++k) \
        acc[ai][bj][m][n] = __builtin_amdgcn_mfma_f32_16x16x32_bf16(Bt[n][k], At[m][k], acc[ai][bj][m][n], 0, 0, 0); __builtin_amdgcn_s_setprio(0); } while (0)
#define PG8_WAIT_V(n) asm volatile("s_waitcnt vmcnt(" #n ")" ::: "memory")
#define PG8_WAIT_L(n) asm volatile("s_waitcnt lgkmcnt(" #n ")" ::: "memory")
#define PG8_BAR __builtin_amdgcn_s_barrier()
#define PG8_SCHED __builtin_amdgcn_sched_barrier(0)
    Unit cur, nxt; int ui = 0;
    if (!S.next(0, cur)) return;
    f32x4 acc[2][2][4][2];
#pragma unroll
    for (int a = 0; a < 2; ++a)
#pragma unroll
        for (int b = 0; b < 2; ++b)
#pragma unroll
            for (int m = 0; m < 4; ++m)
#pragma unroll
                for (int n = 0; n < 2; ++n) acc[a][b][m][n] = (f32x4){0.f, 0.f, 0.f, 0.f};
    bf16x8 At[4][2], B0[2][2], B1[2][2];
    const char* cA = (const char*)g.A + (size_t)cur.pm * tstepA; const char* cB = (const char*)g.Bt + (size_t)cur.pn * tstepB;
    PG8_STAGE(PG8_SB(0, 0), cB, voffB); PG8_STAGE(PG8_SB(0, 1), cB + hstepB, voffB); PG8_STAGE(PG8_SA(0, 0), cA, voffA); PG8_STAGE(PG8_SA(0, 1), cA + hstepA, voffA);
    if (wr == 1) PG8_BAR;
    PG8_WAIT_V(2); PG8_BAR;
    PG8_STAGE(PG8_SB(1, 0), cB + kstep, voffB); PG8_STAGE(PG8_SA(1, 0), cA + kstep, voffA); PG8_STAGE(PG8_SB(1, 1), cB + hstepB + kstep, voffB);
    PG8_WAIT_V(6); PG8_BAR;
    for (;;) {
        const bool has_next = S.next(ui + 1, nxt);
        const char* nA = has_next ? (const char*)g.A + (size_t)nxt.pm * tstepA : cA; const char* nB = has_next ? (const char*)g.Bt + (size_t)nxt.pn * tstepB : cB;
        for (int t = 0; t < nt; t += 2) {
            const bool last = (t == nt - 2);
            const char* a1 = cA + (size_t)(t + 1) * kstep;
            const char* a2 = last ? nA : cA + (size_t)(t + 2) * kstep; const char* b2 = last ? nB : cB + (size_t)(t + 2) * kstep;
            const char* a3 = a2 + kstep; const char* b3 = b2 + kstep;
            PG8_LDB(B0, 0, 0); PG8_LDB(B1, 0, 1); PG8_SCHED; PG8_LDA(At, 0, 0); PG8_STAGE(PG8_SA(1, 1), a1 + hstepA, voffA);
            PG8_WAIT_V(8); PG8_WAIT_L(0); PG8_BAR; PG8_MMA(0, 0, At, B0); PG8_MMA(0, 1, At, B1); PG8_BAR; PG8_SCHED;
            PG8_LDA(At, 0, 1); PG8_STAGE(PG8_SB(0, 0), b2, voffB); PG8_STAGE(PG8_SB(0, 1), b2 + hstepB, voffB); PG8_STAGE(PG8_SA(0, 0), a2, voffA);
            PG8_WAIT_V(8); PG8_WAIT_L(0); PG8_BAR; PG8_MMA(1, 0, At, B0); PG8_MMA(1, 1, At, B1); PG8_BAR; PG8_SCHED;
            PG8_LDB(B0, 1, 0); PG8_LDB(B1, 1, 1); PG8_SCHED; PG8_LDA(At, 1, 0); PG8_STAGE(PG8_SA(0, 1), a2 + hstepA, voffA);
            PG8_WAIT_V(8); PG8_WAIT_L(0); PG8_BAR; PG8_MMA(0, 0, At, B0); PG8_MMA(0, 1, At, B1); PG8_BAR; PG8_SCHED;
            PG8_LDA(At, 1, 1); PG8_STAGE(PG8_SB(1, 0), b3, voffB); PG8_STAGE(PG8_SB(1, 1), b3 + hstepB, voffB); PG8_STAGE(PG8_SA(1, 0), a3, voffA);
            PG8_WAIT_V(8); PG8_WAIT_L(0); PG8_BAR; PG8_MMA(1, 0, At, B0); PG8_MMA(1, 1, At, B1); PG8_BAR; PG8_SCHED;
        }
        if constexpr (ALIGN_EPI) { if (wr == 0) PG8_BAR; }
        E(acc, cur, wr, wc, fr, fq);
        if (!has_next) break;
#pragma unroll
        for (int a = 0; a < 2; ++a)
#pragma unroll
            for (int b = 0; b < 2; ++b)
#pragma unroll
                for (int m = 0; m < 4; ++m)
#pragma unroll
                    for (int n = 0; n < 2; ++n) acc[a][b][m][n] = (f32x4){0.f, 0.f, 0.f, 0.f};
        cur = nxt; cA = nA; cB = nB; ++ui;
        if constexpr (ALIGN_EPI) { if (wr == 1) PG8_BAR; }
    }
    PG8_WAIT_V(0);
    if constexpr (!ALIGN_EPI) { if (wr == 0) PG8_BAR; }
    PG8_BAR;
#undef PG8_SA
#undef PG8_SB
#undef PG8_STAGE
#undef PG8_LDA
#undef PG8_LDB
#undef PG8_MMA
#undef PG8_WAIT_V
#undef PG8_WAIT_L
#undef PG8_BAR
#undef PG8_SCHED
}

__device__ __forceinline__ float row_rstd(const float* ssq, int row, int fq) {
    const f32x4 p = *(const f32x4*)(ssq + (size_t)row * 16 + 4 * fq);
    float s = (p.x + p.y) + (p.z + p.w);
    s += __shfl_xor(s, 16); s += __shfl_xor(s, 32);
    return rsqrtf(s * (1.0f / 1024.0f) + EPS);
}

struct EpiInProj {
    static constexpr bool PERM = true;
    bf16_t* proj; float* scal; const float* ssq; bf16_t* hconv; bf16_t* hshift; float* out; int layer;
    __device__ __forceinline__ void operator()(const f32x4 (&acc)[2][2][4][2], const Unit& u, int wr, int wc, int fr, int fq) const {
        const int pn = u.pn;
#pragma unroll
        for (int ai = 0; ai < 2; ++ai)
#pragma unroll
            for (int m = 0; m < 4; ++m) {
                const int row = u.pm * BM + ai * HALF + wr * 64 + m * 16 + fr;
                const float rs = row_rstd(ssq, row, fq);
                if (pn < 14) {
#pragma unroll
                    for (int bj = 0; bj < 2; ++bj) {
                        const int c0 = pn * BM + bj * HALF + wc * 32 + 8 * fq;
                        const f32x4 v0 = acc[ai][bj][m][0] * rs, v1 = acc[ai][bj][m][1] * rs;
                        u32x4 w; w.x = cvt_pk_bf16(v0[0], v0[1]); w.y = cvt_pk_bf16(v0[2], v0[3]); w.z = cvt_pk_bf16(v1[0], v1[1]); w.w = cvt_pk_bf16(v1[2], v1[3]);
                        *(u32x4*)(proj + (size_t)row * PW + c0) = w;
                        if (m == 3) {
                            const int chunk = row >> 6;
                            if (fr >= 13 && pn >= 4 && pn < 11) {
                                const int j = fr - 13;
                                *(u32x4*)(hconv + ((size_t)chunk * 3 + j) * 1792 + (c0 - 1024)) = w;
                                if (chunk >= 255) {
                                    float* o;
                                    if (c0 < PC_SX) o = out + (chunk == 255 ? O_P_GDNC + ((size_t)layer * 3 + j) * 768 : O_S_GDNC + (((size_t)layer * 32 + (chunk - 256)) * 3 + j) * 768) + (c0 - PC_GQ);
                                    else o = out + (chunk == 255 ? O_P_SSMC + ((size_t)layer * 3 + j) * 1024 : O_S_SSMC + (((size_t)layer * 32 + (chunk - 256)) * 3 + j) * 1024) + (c0 - PC_SX);
                                    *(f32x4*)o = v0; *(f32x4*)(o + 4) = v1;
                                }
                            }
                            if (fr == 15 && (pn == 3 || pn >= 11)) {
                                const int oc = (pn == 3) ? (c0 - PC_R) : (c0 - 2560);
                                *(u32x4*)(hshift + (size_t)chunk * 1024 + oc) = w;
                                if (chunk >= 255) {
                                    float* o = out + (chunk == 255 ? O_P_SHIFT + (size_t)layer * 1024 : O_S_SHIFT + ((size_t)layer * 32 + (chunk - 256)) * 1024) + oc;
                                    *(f32x4*)o = v0; *(f32x4*)(o + 4) = v1;
                                }
                            }
                        }
                    }
                } else {
                    if (wc == 0 && fq < 2) {
                        const f32x4 v0 = acc[ai][0][m][0] * rs, v1 = acc[ai][0][m][1] * rs;
                        float* o = scal + (size_t)row * 16 + 8 * fq;
                        *(f32x4*)o = v0; *(f32x4*)(o + 4) = v1;
                    }
                }
            }
    }
};
struct EpiResid {
    static constexpr bool PERM = false;
    const float* base_p; const float* base_s; float* xres; bf16_t* xb; float* ssq;
    __device__ __forceinline__ void operator()(const f32x4 (&acc)[2][2][4][2], const Unit& u, int wr, int wc, int fr, int fq) const {
        const int col0 = u.pn * BM + wc * 32 + 4 * fq;
#pragma unroll
        for (int ai = 0; ai < 2; ++ai)
#pragma unroll
            for (int m = 0; m < 4; ++m) {
                const int row = u.pm * BM + ai * HALF + wr * 64 + m * 16 + fr;
                const float* bp = (row < TP) ? base_p + (size_t)row * DM : base_s + (size_t)(row - TP) * DM;
                float ss = 0.f;
#pragma unroll
                for (int bj = 0; bj < 2; ++bj)
#pragma unroll
                    for (int n = 0; n < 2; ++n) {
                        const int c = col0 + bj * HALF + n * 16;
                        const f32x4 x = *(const f32x4*)(bp + c) + acc[ai][bj][m][n];
                        *(f32x4*)(xres + (size_t)row * DM + c) = x;
                        u32x2 w; w.x = cvt_pk_bf16(x[0], x[1]); w.y = cvt_pk_bf16(x[2], x[3]);
                        *(u32x2*)(xb + (size_t)row * DM + c) = w;
                        ss += (x[0] * x[0] + x[1] * x[1]) + (x[2] * x[2] + x[3] * x[3]);
                    }
                ss += __shfl_xor(ss, 16); ss += __shfl_xor(ss, 32);
                if (fq == 0) ssq[(size_t)row * 16 + u.pn * 4 + wc] = ss;
            }
    }
};
struct EpiGateUp {
    static constexpr bool PERM = true;
    bf16_t* ff; const float* ssq;
    __device__ __forceinline__ void operator()(const f32x4 (&acc)[2][2][4][2], const Unit& u, int wr, int wc, int fr, int fq) const {
        const int c0 = u.pn * HALF + wc * 32 + 8 * fq;
#pragma unroll
        for (int ai = 0; ai < 2; ++ai)
#pragma unroll
            for (int m = 0; m < 4; ++m) {
                const int row = u.pm * BM + ai * HALF + wr * 64 + m * 16 + fr;
                const float rs = row_rstd(ssq, row, fq);
                float f[8];
#pragma unroll
                for (int n = 0; n < 2; ++n)
#pragma unroll
                    for (int i = 0; i < 4; ++i) { const float gg = acc[ai][0][m][n][i] * rs, uu = acc[ai][1][m][n][i] * rs; f[n * 4 + i] = siluf_(gg) * uu; }
                *(u32x4*)(ff + (size_t)row * FF + c0) = pack8(f);
            }
    }
};
}

#define XB_TMO      128
#define XB_XCNT(j)  (256  + 64 * (j))
#define XB_XSUB(j)  (1280 + 64 * (j))
#define XB_XGEN(j)  (2304 + 64 * (j))
#define XB_TOP      3328
#define XB_TOPGEN   3392
#define XCD_BAR_WORDS 3456
#define XB_SPIN_CAP (1u << 18)
__device__ __forceinline__ unsigned xb_ld(unsigned* p)              { return __hip_atomic_load(p, __ATOMIC_RELAXED, __HIP_MEMORY_SCOPE_AGENT); }
__device__ __forceinline__ unsigned xb_add(unsigned* p, unsigned v) { return __hip_atomic_fetch_add(p, v, __ATOMIC_RELAXED, __HIP_MEMORY_SCOPE_AGENT); }
__device__ __forceinline__ unsigned xb_xcc_id() { return (unsigned)__builtin_amdgcn_s_getreg((3 << 11) | 20) & 0xFu; }
#define XB_SPIN(cond, bar) do { unsigned _sp = 0; while (cond) { __builtin_amdgcn_s_sleep(1); \
    if ((++_sp & 255u) == 0u) { if (xb_ld(&(bar)[XB_TMO])) break; if (_sp > XB_SPIN_CAP) { atomicAdd(&(bar)[XB_TMO], 1u); break; } } } } while (0)
struct XcdBarrier { unsigned* bar; unsigned x; volatile LAS unsigned* st; };
__device__ __forceinline__ XcdBarrier xcd_barrier_post(unsigned* bar, volatile LAS unsigned* st) {
    XcdBarrier b; b.bar = bar; b.x = xb_xcc_id(); b.st = st;
    if (threadIdx.x == 0) (void)xb_add(&bar[XB_XCNT(b.x)], 1u);
    return b;
}
__device__ __forceinline__ void xcd_barrier_complete(unsigned* bar, unsigned x, unsigned& nloc, unsigned& nx) {
    const unsigned G = gridDim.x * gridDim.y * gridDim.z;
    unsigned sum, cnt, mine, sp = 0u;
    for (;;) {
        sum = 0u; cnt = 0u; mine = 0u;
#pragma unroll
        for (unsigned j = 0; j < 16; ++j) { const unsigned c = xb_ld(&bar[XB_XCNT(j)]); sum += c; cnt += (c > 0u) ? 1u : 0u; mine = (j == x) ? c : mine; }
        if (sum == G) break;
        __builtin_amdgcn_s_sleep(1);
        if ((++sp & 255u) == 0u) { if (xb_ld(&bar[XB_TMO])) break; if (sp > XB_SPIN_CAP) { atomicAdd(&bar[XB_TMO], 1u); break; } }
    }
    nloc = mine > 0u ? mine : 1u; nx = cnt > 0u ? cnt : 1u;
}
__device__ __forceinline__ void xcd_barrier(const XcdBarrier& b) {
    asm volatile("s_waitcnt vmcnt(0)" ::: "memory");
    __syncthreads();
    if (threadIdx.x == 0) {
        unsigned* bar = b.bar;
        __builtin_amdgcn_s_waitcnt(0);
        unsigned nloc = b.st[0], nx = b.st[1];
        if (nloc == 0u) { xcd_barrier_complete(bar, b.x, nloc, nx); b.st[0] = nloc; b.st[1] = nx; }
        const unsigned old = xb_add(&bar[XB_XSUB(b.x)], 1u);
        const unsigned gen = old / nloc;
        if (old + 1u == (gen + 1u) * nloc) {
            __builtin_amdgcn_fence(__ATOMIC_RELEASE, "agent");
            asm volatile("s_waitcnt vmcnt(0)" ::: "memory");
            const unsigned og = xb_add(&bar[XB_TOP], 1u);
            const unsigned tg = og / nx;
            if (og + 1u == (tg + 1u) * nx) xb_add(&bar[XB_TOPGEN], 1u);
            else XB_SPIN(xb_ld(&bar[XB_TOPGEN]) == tg, bar);
            __builtin_amdgcn_fence(__ATOMIC_ACQUIRE, "agent");
            xb_add(&bar[XB_XGEN(b.x)], 1u);
            asm volatile("s_waitcnt vmcnt(0)" ::: "memory");
        } else {
            XB_SPIN(xb_ld(&bar[XB_XGEN(b.x)]) == gen, bar);
            __builtin_amdgcn_fence(__ATOMIC_ACQUIRE, "agent");
            asm volatile("s_waitcnt vmcnt(0)" ::: "memory");
        }
    }
    __syncthreads();
}

struct Args { const float* in[37]; float* out; unsigned char* ws; int ph_lo, ph_hi; };
enum { I_XP = 0, I_XS, I_SGDN, I_SGDNC, I_SSSM, I_SSSMC, I_SRWKV, I_SSHIFT, I_NORM1, I_WIN, I_GCONVW, I_GALOG, I_GDTB, I_GNORMW,
       I_SCONVW, I_SCONVB, I_SALOG, I_SDTB, I_SD, I_SNORMW, I_RMU, I_RW0, I_RWUP, I_RA0, I_RAUP, I_RGUP, I_RKK, I_RKA, I_RRK, I_RLNW, I_RLNB,
       I_WOUT, I_NORM2, I_WG, I_WU, I_WD, I_FNORM };

struct Frame {
    LAS unsigned char* lds;
    int tid, lane, wave, vcu, G;
    const float* const* in; float* out; unsigned char* ws;
};
#define F_R1     ((bf16_t*)(F.ws + WS_R1))
#define F_R2     ((bf16_t*)(F.ws + WS_R2))
#define F_PROJ   ((bf16_t*)(F.ws + WS_PROJ))
#define F_SSQA   ((float*)(F.ws + WS_SSQA))
#define F_SSQD   ((float*)(F.ws + WS_SSQD))
#define F_SCAL   ((float*)(F.ws + WS_R2 + R2_SCAL))
#define F_HCONV  ((bf16_t*)(F.ws + WS_R2 + R2_HCONV))
#define F_HSHIFT ((bf16_t*)(F.ws + WS_R2 + R2_HSHIFT))
#define F_RW     ((float*)(F.ws + WS_R1 + R1_RW))
#define F_RKK    ((bf16_t*)(F.ws + WS_R1 + R1_RKK))
#define F_RB     ((bf16_t*)(F.ws + WS_R1 + R1_RB))
__device__ __forceinline__ bf16_t* w_in(const Frame& F, int l) { return (bf16_t*)(F.ws + WS_W + (size_t)l * W_LAYER_B); }
__device__ __forceinline__ bf16_t* w_out(const Frame& F, int l) { return (bf16_t*)(F.ws + WS_W + (size_t)l * W_LAYER_B + W_IN_B); }
__device__ __forceinline__ bf16_t* w_gu(const Frame& F, int l) { return (bf16_t*)(F.ws + WS_W + (size_t)l * W_LAYER_B + W_IN_B + W_OUT_B); }
__device__ __forceinline__ bf16_t* w_dn(const Frame& F, int l) { return (bf16_t*)(F.ws + WS_W + (size_t)l * W_LAYER_B + W_IN_B + W_OUT_B + W_GU_B); }

__device__ __forceinline__ int opaque_tid() { int t = threadIdx.x; asm volatile("" : "+v"(t)); return t; }
#define PHASE_IDS(F) do { (F).tid = opaque_tid(); (F).lane = (F).tid & 63; (F).wave = __builtin_amdgcn_readfirstlane((F).tid >> 6); } while (0)
__device__ __forceinline__ int inproj_dst(int n) {
    if (n < 768) return PC_GQ + n;
    if (n < 1024) return PC_ZG + (n - 768);
    if (n < 1032) return 3584 + (n - 1024);
    if (n < 1544) return PC_ZS + (n - 1032);
    if (n < 2568) return PC_SX + (n - 1544);
    if (n < 2576) return 3592 + (n - 2568);
    if (n < 2832) return PC_R + (n - 2576);
    if (n < 3344) return PC_RK + (n - 2832);
    return PC_RL + (n - 3344);
}
template <int MODE>
__device__ __forceinline__ void p0_transpose_item(const float* W, int K, int N, bf16_t* WT, const float* kscale, LAS float* scr, int item, int lane) {
    const int nblk = (N + 31) / 32, kb = item / nblk, nb = item % nblk, k0 = 64 * kb, n0 = 32 * nb;
    const int nn = n0 + (lane & 31);
#pragma unroll 8
    for (int i = 0; i < 32; ++i) { const int kk = 2 * i + (lane >> 5); scr[kk * 33 + (lane & 31)] = (nn < N) ? W[(size_t)(k0 + kk) * N + nn] : 0.f; }
    asm volatile("s_waitcnt lgkmcnt(0)" ::: "memory");
    const int c = lane & 7;
    float ks[8];
#pragma unroll
    for (int i = 0; i < 8; ++i) ks[i] = kscale ? kscale[k0 + 8 * c + i] : 1.f;
#pragma unroll
    for (int j = 0; j < 4; ++j) { const int nl = (lane >> 3) + 8 * j; const int n = n0 + nl; const LAS float* s = scr + (8 * c) * 33 + nl;
        u32x4 o; o.x = cvt_pk_bf16(s[0 * 33] * ks[0], s[1 * 33] * ks[1]); o.y = cvt_pk_bf16(s[2 * 33] * ks[2], s[3 * 33] * ks[3]);
        o.z = cvt_pk_bf16(s[4 * 33] * ks[4], s[5 * 33] * ks[5]); o.w = cvt_pk_bf16(s[6 * 33] * ks[6], s[7 * 33] * ks[7]);
        if (n < N) {
            int d;
            if (MODE == 0) d = n; else if (MODE == 1) d = inproj_dst(n); else if (MODE == 2) d = 256 * (n >> 7) + (n & 127); else d = 256 * (n >> 7) + 128 + (n & 127);
            *(u32x4*)(WT + (size_t)d * K + k0 + 8 * c) = o; } }
    asm volatile("s_waitcnt lgkmcnt(0)" ::: "memory");
}
__device__ __forceinline__ void p0_prologue(Frame& F) {
    PHASE_IDS(F);
    LAS float* scr = (LAS float*)(F.lds + F.wave * 16384);
    const int gw = F.vcu * 8 + F.wave, NGW = F.G * 8;
    constexpr int I_IN = 16 * 113, I_OUT = 16 * 32, I_G = 16 * 88, I_D = 44 * 32;
    constexpr int PER_L = I_IN + I_OUT + 2 * I_G + I_D;
    for (int it = gw; it < 2 * PER_L; it += NGW) {
        const int l = it / PER_L; int r = it % PER_L;
        if (r < I_IN) { p0_transpose_item<1>(F.in[I_WIN] + (size_t)l * DM * 3600, DM, 3600, w_in(F, l), F.in[I_NORM1] + l * DM, scr, r, F.lane); continue; } r -= I_IN;
        if (r < I_OUT) { p0_transpose_item<0>(F.in[I_WOUT] + (size_t)l * DM * DM, DM, DM, w_out(F, l), nullptr, scr, r, F.lane); continue; } r -= I_OUT;
        if (r < I_G) { p0_transpose_item<2>(F.in[I_WG] + (size_t)l * DM * FF, DM, FF, w_gu(F, l), F.in[I_NORM2] + l * DM, scr, r, F.lane); continue; } r -= I_G;
        if (r < I_G) { p0_transpose_item<3>(F.in[I_WU] + (size_t)l * DM * FF, DM, FF, w_gu(F, l), F.in[I_NORM2] + l * DM, scr, r, F.lane); continue; } r -= I_G;
        p0_transpose_item<0>(F.in[I_WD] + (size_t)l * FF * DM, FF, DM, w_dn(F, l), nullptr, scr, r, F.lane);
    }
    for (int m = gw; m < T; m += NGW) {
        const float* xr = (m < TP) ? F.in[I_XP] + (size_t)m * DM : F.in[I_XS] + (size_t)(m - TP) * DM;
        f32x4 v[4]; float s = 0.f;
#pragma unroll
        for (int j = 0; j < 4; ++j) { v[j] = *((const f32x4*)xr + F.lane + 64 * j); s += (v[j].x * v[j].x + v[j].y * v[j].y) + (v[j].z * v[j].z + v[j].w * v[j].w); }
        s = wave_sum(s);
#pragma unroll
        for (int j = 0; j < 4; ++j) { u32x2 w; w.x = cvt_pk_bf16(v[j].x, v[j].y); w.y = cvt_pk_bf16(v[j].z, v[j].w); *((u32x2*)(F_R1 + (size_t)m * DM) + F.lane + 64 * j) = w; }
        if (F.lane < 16) F_SSQA[(size_t)m * 16 + F.lane] = (F.lane == 0) ? s : 0.f;
    }
}

__device__ __forceinline__ void act_chunk(Frame& F, int l, int c) {
    PHASE_IDS(F);
    const int tid = F.tid;
    const size_t row0 = (size_t)c * 64;
    const bool prompt = c < 256; const int b = c - 256;
    bf16_t* const proj = F_PROJ;
    LAS float* inT = (LAS float*)F.lds;
    LAS bf16_t* kx = (LAS bf16_t*)(F.lds + 256 * 68 * 4);
    if (tid < 224) {
        const int col = 1024 + tid * 8;
        const bool gdn = tid < 96;
        const int cc = gdn ? (col - PC_GQ) : (col - PC_SX);
        const int C = gdn ? 768 : 1024;
        const float* cw = gdn ? F.in[I_GCONVW] + (size_t)l * 4 * 768 : F.in[I_SCONVW] + (size_t)l * 4 * 1024;
        float w[4][8], bias[8], p3[8], p2[8], p1[8];
#pragma unroll
        for (int j = 0; j < 4; ++j)
#pragma unroll
            for (int i = 0; i < 8; ++i) w[j][i] = cw[j * C + cc + i];
#pragma unroll
        for (int i = 0; i < 8; ++i) bias[i] = gdn ? 0.f : F.in[I_SCONVB][l * 1024 + cc + i];
        if (prompt) {
            if (c == 0) {
#pragma unroll
                for (int i = 0; i < 8; ++i) { p3[i] = 0.f; p2[i] = 0.f; p1[i] = 0.f; }
            } else {
                const bf16_t* h = F_HCONV + (size_t)(c - 1) * 3 * 1792 + (col - 1024);
                unpack8(*(const u32x4*)(h), p3); unpack8(*(const u32x4*)(h + 1792), p2); unpack8(*(const u32x4*)(h + 2 * 1792), p1);
            }
        } else {
            const float* st = gdn ? F.in[I_SGDNC] + ((size_t)l * 32 + b) * 3 * 768 + cc : F.in[I_SSSMC] + ((size_t)l * 32 + b) * 3 * 1024 + cc;
#pragma unroll
            for (int i = 0; i < 8; ++i) { p3[i] = st[i]; p2[i] = st[C + i]; p1[i] = st[2 * C + i]; }
        }
        const int kind = gdn ? (tid >> 5) : 3;
        for (int t = 0; t < 64; ++t) {
            bf16_t* p = proj + (row0 + t) * PW + col;
            float x[8], y[8];
            unpack8(*(const u32x4*)p, x);
#pragma unroll
            for (int i = 0; i < 8; ++i) { float a = w[0][i] * p3[i] + w[1][i] * p2[i] + w[2][i] * p1[i] + w[3][i] * x[i] + bias[i]; y[i] = siluf_(a); p3[i] = p2[i]; p2[i] = p1[i]; p1[i] = x[i]; }
            if (tid < 64) {
                float ss = 0.f;
#pragma unroll
                for (int i = 0; i < 8; ++i) ss += y[i] * y[i];
                ss += __shfl_xor(ss, 1); ss += __shfl_xor(ss, 2); ss += __shfl_xor(ss, 4);
                const float sc = rsqrtf(ss + EPS) * (kind == 0 ? 0.125f : 1.f);
#pragma unroll
                for (int i = 0; i < 8; ++i) y[i] *= sc;
            }
            *(u32x4*)p = pack8(y);
        }
    } else if (tid >= 256 && tid < 384) {
        const int o = 8 * (tid - 256);
        const int col = o < 256 ? PC_R + o : 2560 + o;
        float mu[8], prev[8];
#pragma unroll
        for (int i = 0; i < 8; ++i) mu[i] = F.in[I_RMU][l * 1024 + o + i];
        if (prompt) {
            if (c == 0) {
#pragma unroll
                for (int i = 0; i < 8; ++i) prev[i] = 0.f;
            } else unpack8(*(const u32x4*)(F_HSHIFT + (size_t)(c - 1) * 1024 + o), prev);
        } else {
            const float* st = F.in[I_SSHIFT] + ((size_t)l * 32 + b) * 1024 + o;
#pragma unroll
            for (int i = 0; i < 8; ++i) prev[i] = st[i];
        }
        for (int t = 0; t < 64; ++t) {
            bf16_t* p = proj + (row0 + t) * PW + col;
            float x[8], y[8];
            unpack8(*(const u32x4*)p, x);
#pragma unroll
            for (int i = 0; i < 8; ++i) { y[i] = x[i] + (prev[i] - x[i]) * mu[i]; prev[i] = x[i]; }
            if (o < 768) {
                const u32x4 pk = pack8(y);
                *(u32x4*)p = pk;
                if (o >= 256 && o < 512) *(LAS u32x4*)(kx + t * 256 + (o - 256)) = pk;
            } else {
                const int i0 = o - 768;
#pragma unroll
                for (int i = 0; i < 8; ++i) { const int ii = i0 + i; float v = y[i]; if (ii < 64) v = tanhf(v); else if (ii >= 128) v = sigmoidf_(v); inT[ii * 68 + t] = v; }
            }
        }
    }
    __syncthreads();
    {
        const int j = tid & 255, th = tid >> 8, t0 = 32 * th;
        float acc[32], iclr[32];
#pragma unroll
        for (int t = 0; t < 32; ++t) acc[t] = 0.f;
        { const float* wu = F.in[I_RWUP] + (size_t)l * 64 * 256 + j;
          for (int i = 0; i < 64; ++i) { const float wv = wu[i * 256];
#pragma unroll
              for (int q = 0; q < 8; ++q) { const f32x4 x = *(const LAS f32x4*)(inT + i * 68 + t0 + 4 * q); acc[4 * q] += x[0] * wv; acc[4 * q + 1] += x[1] * wv; acc[4 * q + 2] += x[2] * wv; acc[4 * q + 3] += x[3] * wv; } } }
        { const float w0 = F.in[I_RW0][l * 256 + j];
#pragma unroll
          for (int t = 0; t < 32; ++t) { const float wl = -softplusf_(-(w0 + acc[t])) - 0.5f; F_RW[(row0 + t0 + t) * 256 + j] = __expf(-__expf(wl)); } }
#pragma unroll
        for (int t = 0; t < 32; ++t) acc[t] = 0.f;
        { const float* wu = F.in[I_RAUP] + (size_t)l * 64 * 256 + j;
          for (int i = 0; i < 64; ++i) { const float wv = wu[i * 256];
#pragma unroll
              for (int q = 0; q < 8; ++q) { const f32x4 x = *(const LAS f32x4*)(inT + (64 + i) * 68 + t0 + 4 * q); acc[4 * q] += x[0] * wv; acc[4 * q + 1] += x[1] * wv; acc[4 * q + 2] += x[2] * wv; acc[4 * q + 3] += x[3] * wv; } } }
        { const float a0 = F.in[I_RA0][l * 256 + j];
#pragma unroll
          for (int t = 0; t < 32; ++t) iclr[t] = sigmoidf_(a0 + acc[t]); }
#pragma unroll
        for (int t = 0; t < 32; ++t) acc[t] = 0.f;
        { const float* wu = F.in[I_RGUP] + (size_t)l * 128 * 256 + j;
          for (int i = 0; i < 128; ++i) { const float wv = wu[i * 256];
#pragma unroll
              for (int q = 0; q < 8; ++q) { const f32x4 x = *(const LAS f32x4*)(inT + (128 + i) * 68 + t0 + 4 * q); acc[4 * q] += x[0] * wv; acc[4 * q + 1] += x[1] * wv; acc[4 * q + 2] += x[2] * wv; acc[4 * q + 3] += x[3] * wv; } } }
        const float kkw = F.in[I_RKK][l * 256 + j], kaw = F.in[I_RKA][l * 256 + j];
#pragma unroll
        for (int t = 0; t < 32; ++t) {
            const size_t row = row0 + t0 + t;
            proj[row * PW + PC_RL + j] = f2bf(acc[t]);
            const float k = bf2f(kx[(t0 + t) * 256 + j]);
            const float kq = k * kkw;
            const float ss = wave_sum(kq * kq);
            const float kk = kq * rsqrtf(ss + EPS);
            F_RKK[row * 256 + j] = f2bf(kk);
            F_RB[row * 256 + j] = f2bf(kk * iclr[t]);
            proj[row * PW + PC_RK + j] = f2bf(k * (1.f + (iclr[t] - 1.f) * kaw));
        }
    }
    for (int e = tid; e < 64 * 16; e += 512) {
        const int t = e >> 4, q = e & 15;
        float* p = F_SCAL + (row0 + t) * 16 + q;
        const float v = *p; float r;
        if (q < 4) r = -__expf(F.in[I_GALOG][l * 4 + q]) * softplusf_(v + F.in[I_GDTB][l * 4 + q]);
        else if (q < 8) r = sigmoidf_(v);
        else r = softplusf_(v + F.in[I_SDTB][l * 8 + (q - 8)]);
        *p = r;
    }
    __syncthreads();
}

__device__ __forceinline__ void stage_tile_f32(LAS float* dst, const bf16_t* src, int ld, int tid) {
    const int t = tid >> 3, d8 = (tid & 7) * 8;
    float v[8]; unpack8(*(const u32x4*)(src + (size_t)t * ld + d8), v);
    *(LAS f32x4*)(dst + t * 64 + d8) = (f32x4){v[0], v[1], v[2], v[3]}; *(LAS f32x4*)(dst + t * 64 + d8 + 4) = (f32x4){v[4], v[5], v[6], v[7]};
}
__device__ __forceinline__ void scan_gdn(Frame& F, int l, int s, int h) {
    const int tid = F.tid, lane = F.lane;
    const int nch = (s == 0) ? 256 : 1, c0 = (s == 0) ? 0 : 255 + s, b = s - 1;
    LAS float* qs = (LAS float*)F.lds; LAS float* ks = qs + 4096; LAS float* vs = ks + 4096; LAS float* zs = vs + 4096; LAS float* gs = zs + 4096; LAS float* bs = gs + 64;
    float S[64];
    if (s == 0) {
#pragma unroll
        for (int k = 0; k < 64; ++k) S[k] = 0.f;
    } else {
        const float* st = F.in[I_SGDN] + (((size_t)l * 32 + b) * 4 + h) * 4096 + lane;
#pragma unroll
        for (int k = 0; k < 64; ++k) S[k] = st[k * 64];
    }
    const float nw = F.in[I_GNORMW][l * 64 + lane];
    for (int ci = 0; ci < nch; ++ci) {
        const size_t row0 = (size_t)(c0 + ci) * 64;
        stage_tile_f32(qs, F_PROJ + row0 * PW + PC_GQ + h * 64, PW, tid);
        stage_tile_f32(ks, F_PROJ + row0 * PW + PC_GK + h * 64, PW, tid);
        stage_tile_f32(vs, F_PROJ + row0 * PW + PC_GV + h * 64, PW, tid);
        stage_tile_f32(zs, F_PROJ + row0 * PW + PC_ZG + h * 64, PW, tid);
        if (tid < 64) { gs[tid] = F_SCAL[(row0 + tid) * 16 + h]; bs[tid] = F_SCAL[(row0 + tid) * 16 + 4 + h]; }
        __syncthreads();
        if (F.wave == 0) {
            for (int t = 0; t < 64; ++t) {
                const float eg = __expf(gs[t]), beta = bs[t];
                float kS = 0.f;
#pragma unroll
                for (int q = 0; q < 16; ++q) { const f32x4 kv = *(const LAS f32x4*)(ks + t * 64 + 4 * q); kS += S[4 * q] * kv[0] + S[4 * q + 1] * kv[1] + S[4 * q + 2] * kv[2] + S[4 * q + 3] * kv[3]; }
                const float delta = beta * (vs[t * 64 + lane] - eg * kS);
                float o = 0.f;
#pragma unroll
                for (int q = 0; q < 16; ++q) { const f32x4 kv = *(const LAS f32x4*)(ks + t * 64 + 4 * q); const f32x4 qv = *(const LAS f32x4*)(qs + t * 64 + 4 * q);
#pragma unroll
                    for (int i = 0; i < 4; ++i) { S[4 * q + i] = S[4 * q + i] * eg + kv[i] * delta; o += S[4 * q + i] * qv[i]; } }
                const float ss = wave_sum(o * o);
                const float y = o * rsqrtf(ss * (1.f / 64.f) + EPS) * nw * siluf_(zs[t * 64 + lane]);
                F_PROJ[(row0 + t) * PW + PC_ZG + h * 64 + lane] = f2bf(y);
            }
        }
        __syncthreads();
    }
    if (F.wave == 0) {
        float* o = F.out + (s == 0 ? O_P_GDN + ((size_t)l * 4 + h) * 4096 : O_S_GDN + (((size_t)l * 32 + b) * 4 + h) * 4096) + lane;
#pragma unroll
        for (int k = 0; k < 64; ++k) o[k * 64] = S[k];
    }
}
__device__ __forceinline__ void scan_rwkv(Frame& F, int l, int s, int h) {
    const int tid = F.tid, lane = F.lane;
    const int nch = (s == 0) ? 256 : 1, c0 = (s == 0) ? 0 : 255 + s, b = s - 1;
    LAS float* rs = (LAS float*)F.lds; LAS float* wsd = rs + 4096; LAS float* ks = wsd + 4096; LAS float* as = ks + 4096; LAS float* bs = as + 4096; LAS float* vs = bs + 4096; LAS float* gs = vs + 4096;
    float S[64];
    if (s == 0) {
#pragma unroll
        for (int k = 0; k < 64; ++k) S[k] = 0.f;
    } else {
        const float* st = F.in[I_SRWKV] + (((size_t)l * 32 + b) * 4 + h) * 4096 + lane * 64;
#pragma unroll
        for (int k = 0; k < 64; ++k) S[k] = st[k];
    }
    const float lnw = F.in[I_RLNW][l * 256 + h * 64 + lane], lnb = F.in[I_RLNB][l * 256 + h * 64 + lane], rk = F.in[I_RRK][l * 256 + h * 64 + lane];
    for (int ci = 0; ci < nch; ++ci) {
        const size_t row0 = (size_t)(c0 + ci) * 64;
        stage_tile_f32(rs, F_PROJ + row0 * PW + PC_R + h * 64, PW, tid);
        stage_tile_f32(ks, F_PROJ + row0 * PW + PC_RK + h * 64, PW, tid);
        stage_tile_f32(vs, F_PROJ + row0 * PW + PC_RV + h * 64, PW, tid);
        stage_tile_f32(gs, F_PROJ + row0 * PW + PC_RL + h * 64, PW, tid);
        stage_tile_f32(as, F_RKK + row0 * 256 + h * 64, 256, tid);
        stage_tile_f32(bs, F_RB + row0 * 256 + h * 64, 256, tid);
        { const int t = tid >> 3, d8 = (tid & 7) * 8; const float* p = F_RW + (row0 + t) * 256 + h * 64 + d8;
          *(LAS f32x4*)(wsd + t * 64 + d8) = *(const f32x4*)p; *(LAS f32x4*)(wsd + t * 64 + d8 + 4) = *(const f32x4*)(p + 4); }
        __syncthreads();
        if (F.wave == 0) {
            for (int t = 0; t < 64; ++t) {
                float sa = 0.f;
#pragma unroll
                for (int q = 0; q < 16; ++q) { const f32x4 av = *(const LAS f32x4*)(as + t * 64 + 4 * q); sa += S[4 * q] * av[0] + S[4 * q + 1] * av[1] + S[4 * q + 2] * av[2] + S[4 * q + 3] * av[3]; }
                sa = -sa;
                const float vv = vs[t * 64 + lane];
                float y = 0.f;
#pragma unroll
                for (int q = 0; q < 16; ++q) {
                    const f32x4 wv = *(const LAS f32x4*)(wsd + t * 64 + 4 * q), bv = *(const LAS f32x4*)(bs + t * 64 + 4 * q), kv = *(const LAS f32x4*)(ks + t * 64 + 4 * q), rv = *(const LAS f32x4*)(rs + t * 64 + 4 * q);
#pragma unroll
                    for (int i = 0; i < 4; ++i) { S[4 * q + i] = S[4 * q + i] * wv[i] + sa * bv[i] + vv * kv[i]; y += S[4 * q + i] * rv[i]; } }
                const float mean = wave_sum(y) * (1.f / 64.f);
                const float d = y - mean;
                const float var = wave_sum(d * d) * (1.f / 64.f);
                const float yn = d * rsqrtf(var + 64e-5f) * lnw + lnb;
                const float bonus = wave_sum(rs[t * 64 + lane] * ks[t * 64 + lane] * rk) * vv;
                F_PROJ[(row0 + t) * PW + PC_R + h * 64 + lane] = f2bf((yn + bonus) * gs[t * 64 + lane]);
            }
        }
        __syncthreads();
    }
    if (F.wave == 0) {
        float* o = F.out + (s == 0 ? O_P_RWKV + ((size_t)l * 4 + h) * 4096 : O_S_RWKV + (((size_t)l * 32 + b) * 4 + h) * 4096) + lane * 64;
#pragma unroll
        for (int k = 0; k < 64; ++k) o[k] = S[k];
    }
}
__device__ __forceinline__ void scan_ssd(Frame& F, int l, int s, int g) {
    const int tid = F.tid, lane = F.lane, w = F.wave;
    const int nch = (s == 0) ? 256 : 1, c0 = (s == 0) ? 0 : 255 + s, b = s - 1;
    LAS float* Bs = (LAS float*)F.lds; LAS float* Cs = Bs + 8192;
    LAS bf16_t* xs = (LAS bf16_t*)(F.lds + 65536); LAS bf16_t* zs = xs + 16384;
    LAS float* ssn = (LAS float*)(F.lds + 131072); LAS float* dts = ssn + 256;
    const int head = 4 * g + (w & 3);
    float hst[128];
    if (w < 4) {
        if (s == 0) {
#pragma unroll
            for (int n = 0; n < 128; ++n) hst[n] = 0.f;
        } else {
            const float* st = F.in[I_SSSM] + ((((size_t)l * 32 + b) * 8 + head) * 64 + lane) * 128;
#pragma unroll
            for (int n = 0; n < 128; n += 4) { const f32x4 v = *(const f32x4*)(st + n); hst[n] = v[0]; hst[n + 1] = v[1]; hst[n + 2] = v[2]; hst[n + 3] = v[3]; }
        }
    }
    const float Aneg = -__expf(F.in[I_SALOG][l * 8 + head]), Dh = F.in[I_SD][l * 8 + head];
    for (int ci = 0; ci < nch; ++ci) {
        const size_t row0 = (size_t)(c0 + ci) * 64;
        { const int t = tid >> 3, n16 = (tid & 7) * 16;
          const bf16_t* pb = F_PROJ + (row0 + t) * PW + PC_SB + g * 128 + n16; const bf16_t* pc = F_PROJ + (row0 + t) * PW + PC_SC + g * 128 + n16;
          float v[8];
#pragma unroll
          for (int q = 0; q < 2; ++q) {
              unpack8(*(const u32x4*)(pb + 8 * q), v); *(LAS f32x4*)(Bs + t * 128 + n16 + 8 * q) = (f32x4){v[0], v[1], v[2], v[3]}; *(LAS f32x4*)(Bs + t * 128 + n16 + 8 * q + 4) = (f32x4){v[4], v[5], v[6], v[7]};
              unpack8(*(const u32x4*)(pc + 8 * q), v); *(LAS f32x4*)(Cs + t * 128 + n16 + 8 * q) = (f32x4){v[0], v[1], v[2], v[3]}; *(LAS f32x4*)(Cs + t * 128 + n16 + 8 * q + 4) = (f32x4){v[4], v[5], v[6], v[7]}; }
          const int c32 = (tid & 7) * 32;
          const bf16_t* px = F_PROJ + (row0 + t) * PW + PC_SX + g * 256 + c32; const bf16_t* pz = F_PROJ + (row0 + t) * PW + PC_ZS + g * 256 + c32;
#pragma unroll
          for (int q = 0; q < 4; ++q) { *(LAS u32x4*)(xs + t * 256 + c32 + 8 * q) = *(const u32x4*)(px + 8 * q); *(LAS u32x4*)(zs + t * 256 + c32 + 8 * q) = *(const u32x4*)(pz + 8 * q); }
          if (tid < 256) dts[tid] = F_SCAL[(row0 + (tid >> 2)) * 16 + 8 + g * 4 + (tid & 3)]; }
        __syncthreads();
        if (w < 4) {
            for (int t = 0; t < 64; ++t) {
                const float dtv = dts[t * 4 + w], dA = __expf(dtv * Aneg);
                const float x = bf2f(xs[t * 256 + w * 64 + lane]), xdt = x * dtv;
                float y = 0.f;
#pragma unroll
                for (int q = 0; q < 32; ++q) { const f32x4 bv = *(const LAS f32x4*)(Bs + t * 128 + 4 * q), cv = *(const LAS f32x4*)(Cs + t * 128 + 4 * q);
#pragma unroll
                    for (int i = 0; i < 4; ++i) { hst[4 * q + i] = hst[4 * q + i] * dA + xdt * bv[i]; y += hst[4 * q + i] * cv[i]; } }
                y += Dh * x;
                y *= siluf_(bf2f(zs[t * 256 + w * 64 + lane]));
                const float ss = wave_sum(y * y);
                if (lane == 0) ssn[t * 4 + w] = ss;
                const unsigned yb = __float_as_uint(y);
                zs[t * 256 + w * 64 + lane] = (bf16_t)(yb >> 16); xs[t * 256 + w * 64 + lane] = (bf16_t)(yb & 0xffffu);
            }
        }
        __syncthreads();
        { const int t = tid >> 3, c32 = (tid & 7) * 32;
          const f32x4 sv = *(const LAS f32x4*)(ssn + t * 4);
          const float sc = rsqrtf(((sv[0] + sv[1]) + (sv[2] + sv[3])) * (1.f / 256.f) + EPS);
          const float* nw = F.in[I_SNORMW] + l * 512 + g * 256 + c32;
#pragma unroll
          for (int q = 0; q < 4; ++q) { float o[8];
#pragma unroll
              for (int i = 0; i < 8; ++i) { const int cidx = t * 256 + c32 + 8 * q + i; const float y = __uint_as_float(((unsigned)zs[cidx] << 16) | (unsigned)xs[cidx]); o[i] = y * sc * nw[8 * q + i]; }
              *(u32x4*)(F_PROJ + (row0 + t) * PW + PC_ZS + g * 256 + c32 + 8 * q) = pack8(o); } }
        __syncthreads();
    }
    if (w < 4) {
        float* o = F.out + (s == 0 ? O_P_SSM + (((size_t)l * 8 + head) * 64 + lane) * 128 : O_S_SSM + ((((size_t)l * 32 + b) * 8 + head) * 64 + lane) * 128);
#pragma unroll
        for (int n = 0; n < 128; n += 4) *(f32x4*)(o + n) = (f32x4){hst[n], hst[n + 1], hst[n + 2], hst[n + 3]};
    }
}
__device__ __forceinline__ void scan_phase(Frame& F, int l) {
    PHASE_IDS(F);
    for (int it = F.vcu; it < 330; it += F.G) {
        if (it < 4) scan_gdn(F, l, 0, it);
        else if (it < 6) scan_ssd(F, l, 0, it - 4);
        else if (it < 10) scan_rwkv(F, l, 0, it - 6);
        else { const int r = it - 10;
            if (r < 128) scan_gdn(F, l, 1 + (r >> 2), r & 3);
            else if (r < 192) scan_ssd(F, l, 1 + ((r - 128) >> 1), (r - 128) & 1);
            else scan_rwkv(F, l, 1 + ((r - 192) >> 2), (r - 192) & 3); }
        __syncthreads();
    }
}
__device__ __forceinline__ void final_norm(Frame& F) {
    PHASE_IDS(F);
    const int gw = F.vcu * 8 + F.wave, NGW = F.G * 8;
    const float* fw = F.in[I_FNORM];
    f32x4 wv[4];
#pragma unroll
    for (int j = 0; j < 4; ++j) wv[j] = *((const f32x4*)fw + F.lane + 64 * j);
    for (int m = gw; m < T; m += NGW) {
        float s = (F.lane < 16) ? F_SSQA[(size_t)m * 16 + F.lane] : 0.f;
        s = wave_sum(s);
        const float rs = rsqrtf(s * (1.f / 1024.f) + EPS);
        f32x4* xr = (f32x4*)(F.out + (size_t)m * DM);
#pragma unroll
        for (int j = 0; j < 4; ++j) { f32x4 v = xr[F.lane + 64 * j]; v = v * rs * wv[j]; xr[F.lane + 64 * j] = v; }
    }
}

constexpr int N_PHASES = 14;
__global__ void __launch_bounds__(512, 2) mk_fwd(Args args) {
    extern __shared__ __attribute__((aligned(16))) unsigned char lds[];
    Frame F;
    F.lds = (LAS unsigned char*)lds;
    F.tid = threadIdx.x; F.lane = F.tid & 63; F.wave = __builtin_amdgcn_readfirstlane(F.tid >> 6);
    F.G = gridDim.x; { const int bx = blockIdx.x; F.vcu = (F.G % 8 == 0) ? (bx % 8) * (F.G / 8) + bx / 8 : bx; }
    F.in = args.in; F.out = args.out; F.ws = args.ws;
    volatile LAS unsigned* MISC = (volatile LAS unsigned*)(F.lds + MISC_OFF);
    for (int u = F.tid; u < (LDS_BYTES - LDSCTL_OFF) / 4; u += 512) ((LAS unsigned*)(F.lds + LDSCTL_OFF))[u] = 0u;
    __syncthreads();
    XcdBarrier bar; bar.bar = (unsigned*)(args.ws + WS_CTL) + CW_BAR; bar.x = 0; bar.st = nullptr;
    const int lo = args.ph_lo, hi = args.ph_hi;
    if (hi - lo > 1) bar = xcd_barrier_post((unsigned*)(args.ws + WS_CTL) + CW_BAR, MISC + 8);
#define IN(k) (lo <= (k) && (k) < hi)
#define SEAM(k) do { if (IN(k) && IN((k) + 1)) xcd_barrier(bar); } while (0)

    if (IN(0)) { p0_prologue(F); SEAM(0); }
    for (int l = 0; l < 2; ++l) {
        const int pb = 1 + 6 * l;
        if (IN(pb)) {
            pg8::Gemm g{F_R1, w_in(F, l), T, NIN, DM, DM}; pg8::StaticOrder S; S.init(T, NIN, F.G, (int)blockIdx.x);
            pg8::EpiInProj E{F_PROJ, F_SCAL, F_SSQA, F_HCONV, F_HSHIFT, F.out, l};
            pg8::gemm_phase<pg8::EpiInProj, true>(F.lds, g, S, E);
            SEAM(pb);
        }
        if (IN(pb + 1)) {
            for (int c = F.vcu; c < NCH; c += F.G) act_chunk(F, l, c);
            SEAM(pb + 1);
        }
        if (IN(pb + 2)) {
            scan_phase(F, l);
            SEAM(pb + 2);
        }
        if (IN(pb + 3)) {
            pg8::Gemm g{F_PROJ, w_out(F, l), T, DM, DM, PW}; pg8::StaticOrder S; S.init(T, DM, F.G, (int)blockIdx.x);
            const float* bp = l == 0 ? F.in[I_XP] : F.out; const float* bs = l == 0 ? F.in[I_XS] : F.out + (size_t)TP * DM;
            pg8::EpiResid E{bp, bs, F.out, F_R2, F_SSQD};
            pg8::gemm_phase<pg8::EpiResid, true>(F.lds, g, S, E);
            SEAM(pb + 3);
        }
        if (IN(pb + 4)) {
            pg8::Gemm g{F_R2, w_gu(F, l), T, NGU, DM, DM}; pg8::StaticOrder S; S.init(T, NGU, F.G, (int)blockIdx.x);
            pg8::EpiGateUp E{F_PROJ, F_SSQD};
            pg8::gemm_phase<pg8::EpiGateUp, true>(F.lds, g, S, E);
            SEAM(pb + 4);
        }
        if (IN(pb + 5)) {
            pg8::Gemm g{F_PROJ, w_dn(F, l), T, DM, FF, FF}; pg8::StaticOrder S; S.init(T, DM, F.G, (int)blockIdx.x);
            pg8::EpiResid E{F.out, F.out + (size_t)TP * DM, F.out, F_R1, F_SSQA};
            pg8::gemm_phase<pg8::EpiResid, true>(F.lds, g, S, E);
            SEAM(pb + 5);
        }
    }
    if (IN(13)) final_norm(F);
#undef IN
#undef SEAM
}

extern "C" void kernel_launch(void* const* d_in, const int* in_sizes, int n_in, void* d_out, int out_size, void* d_ws, size_t ws_size, hipStream_t stream) {
    static int grid = 0;
    if (grid == 0) {
        if (n_in != 37 || out_size != (int)O_END || ws_size < WS_END) { fprintf(stderr, "kernel_launch: unexpected shapes: n_in %d out %d ws %zu\n", n_in, out_size, ws_size); grid = -1; return; }
        int dev = 0, cus = 0;
        if (hipGetDevice(&dev) != hipSuccess || hipDeviceGetAttribute(&cus, hipDeviceAttributeMultiprocessorCount, dev) != hipSuccess) { grid = -1; return; }
        if (hipFuncSetAttribute((const void*)mk_fwd, hipFuncAttributeMaxDynamicSharedMemorySize, LDS_BYTES) != hipSuccess) { fprintf(stderr, "kernel_launch: hipFuncSetAttribute failed\n"); grid = -1; return; }
        int per_cu = 0;
        if (hipOccupancyMaxActiveBlocksPerMultiprocessor(&per_cu, (const void*)mk_fwd, 512, LDS_BYTES) != hipSuccess || per_cu < 1)
            fprintf(stderr, "kernel_launch: occupancy query reports %d workgroups per CU\n", per_cu);
        (void)hipGetLastError();
        grid = cus;
    }
    if (grid < 0) return;
    (void)hipMemsetAsync((char*)d_ws + WS_CTL, 0, 65536, stream);
    Args a{};
    for (int i = 0; i < 37; ++i) a.in[i] = (const float*)d_in[i];
    a.out = (float*)d_out; a.ws = (unsigned char*)d_ws;
#if MK_N_LAUNCHES == 1
    a.ph_lo = 0; a.ph_hi = N_PHASES;
    hipLaunchKernelGGL(mk_fwd, dim3(grid), dim3(512), LDS_BYTES, stream, a);
#else
    for (int p = 0; p < N_PHASES; ++p) { a.ph_lo = p; a.ph_hi = p + 1; hipLaunchKernelGGL(mk_fwd, dim3(grid), dim3(512), LDS_BYTES, stream, a); }
#endif
}
```

```cpp
#include <hip/hip_runtime.h>
#include <cstdio>
#include <cstdint>

#ifndef MK_N_LAUNCHES
#define MK_N_LAUNCHES 1
#endif

#define LAS __attribute__((address_space(3)))
typedef unsigned short bf16_t;
typedef short bf16x8 __attribute__((ext_vector_type(8)));
typedef float f32x4 __attribute__((ext_vector_type(4)));
typedef float f32x2 __attribute__((ext_vector_type(2)));
typedef unsigned u32x4 __attribute__((ext_vector_type(4)));
typedef unsigned u32x2 __attribute__((ext_vector_type(2)));

constexpr int DM = 1024, TP = 16384, NB = 32, T = 18432, NCH = 288, NSEQ = 33;
constexpr int PW = 3584;
constexpr int NIN = 3840;
constexpr int FF = 2816, NGU = 5632;
constexpr float EPS = 1e-6f;
constexpr int PC_ZG = 0, PC_ZS = 256, PC_R = 768, PC_GQ = 1024, PC_GK = 1280, PC_GV = 1536, PC_SX = 1792, PC_SB = 2304, PC_SC = 2560,
              PC_RK = 2816, PC_RV = 3072, PC_RL = 3328;
constexpr size_t O_Y = 0;
constexpr size_t O_P_GDN = (size_t)T * DM;
constexpr size_t O_P_GDNC = O_P_GDN + 2 * 1 * 4 * 64 * 64;
constexpr size_t O_P_SSM = O_P_GDNC + 2 * 1 * 3 * 768;
constexpr size_t O_P_SSMC = O_P_SSM + 2 * 1 * 8 * 64 * 128;
constexpr size_t O_P_RWKV = O_P_SSMC + 2 * 1 * 3 * 1024;
constexpr size_t O_P_SHIFT = O_P_RWKV + 2 * 1 * 4 * 64 * 64;
constexpr size_t O_S_GDN = O_P_SHIFT + 2 * 1 * 1024;
constexpr size_t O_S_GDNC = O_S_GDN + (size_t)2 * 32 * 4 * 64 * 64;
constexpr size_t O_S_SSM = O_S_GDNC + (size_t)2 * 32 * 3 * 768;
constexpr size_t O_S_SSMC = O_S_SSM + (size_t)2 * 32 * 8 * 64 * 128;
constexpr size_t O_S_RWKV = O_S_SSMC + (size_t)2 * 32 * 3 * 1024;
constexpr size_t O_S_SHIFT = O_S_RWKV + (size_t)2 * 32 * 4 * 64 * 64;
constexpr size_t O_END = O_S_SHIFT + (size_t)2 * 32 * 1024;
static_assert(O_END == 25784832, "output size");

constexpr size_t WS_CTL = 0, CTL_BYTES = 1u << 20;
constexpr size_t W_IN_B = (size_t)NIN * DM * 2, W_OUT_B = (size_t)DM * DM * 2, W_GU_B = (size_t)NGU * DM * 2, W_DN_B = (size_t)DM * FF * 2;
constexpr size_t W_LAYER_B = W_IN_B + W_OUT_B + W_GU_B + W_DN_B;
constexpr size_t WS_W = WS_CTL + CTL_BYTES;
constexpr size_t WS_R1 = WS_W + 2 * W_LAYER_B;
constexpr size_t R_BYTES = (size_t)T * DM * 2;
constexpr size_t WS_R2 = WS_R1 + R_BYTES;
constexpr size_t WS_PROJ = WS_R2 + R_BYTES;
constexpr size_t PROJ_BYTES = (size_t)T * PW * 2;
constexpr size_t WS_SSQA = WS_PROJ + PROJ_BYTES;
constexpr size_t SSQ_BYTES = (size_t)T * 16 * 4;
constexpr size_t WS_SSQD = WS_SSQA + SSQ_BYTES;
constexpr size_t WS_END = WS_SSQD + SSQ_BYTES;
static_assert(WS_END <= 268435456, "d_ws map exceeds 256 MiB");
static_assert((size_t)T * FF * 2 <= PROJ_BYTES, "ff overlays proj");
constexpr size_t R2_SCAL = 0;
constexpr size_t R2_HCONV = R2_SCAL + (size_t)T * 16 * 4;
constexpr size_t R2_HSHIFT = R2_HCONV + (size_t)NCH * 3 * 1792 * 2;
static_assert(R2_HSHIFT + (size_t)NCH * 1024 * 2 <= R_BYTES, "R2 map");
constexpr size_t R1_RW = 0;
constexpr size_t R1_RKK = R1_RW + (size_t)T * 256 * 4;
constexpr size_t R1_RB = R1_RKK + (size_t)T * 256 * 2;
static_assert(R1_RB + (size_t)T * 256 * 2 <= R_BYTES, "R1 map");
constexpr int CW_BAR = 4096;

constexpr int RING_BYTES = 131072;
constexpr int LDSCTL_OFF = 143360, MISC_OFF = LDSCTL_OFF + 320;
constexpr int LDS_BYTES = 147456;

__device__ __forceinline__ unsigned cvt_pk_bf16(float lo, float hi) { unsigned r; asm volatile("v_cvt_pk_bf16_f32 %0, %1, %2" : "=v"(r) : "v"(lo), "v"(hi)); return r; }
__device__ __forceinline__ float bf_lo(unsigned w) { return __uint_as_float(w << 16); }
__device__ __forceinline__ float bf_hi(unsigned w) { return __uint_as_float(w & 0xffff0000u); }
__device__ __forceinline__ float bf2f(bf16_t h) { return __uint_as_float(((unsigned)h) << 16); }
__device__ __forceinline__ bf16_t f2bf(float f) { return (bf16_t)(cvt_pk_bf16(f, 0.f) & 0xffffu); }
__device__ __forceinline__ void unpack8(u32x4 w, float (&o)[8]) {
    o[0] = bf_lo(w.x); o[1] = bf_hi(w.x); o[2] = bf_lo(w.y); o[3] = bf_hi(w.y); o[4] = bf_lo(w.z); o[5] = bf_hi(w.z); o[6] = bf_lo(w.w); o[7] = bf_hi(w.w); }
__device__ __forceinline__ u32x4 pack8(const float (&v)[8]) { u32x4 w; w.x = cvt_pk_bf16(v[0], v[1]); w.y = cvt_pk_bf16(v[2], v[3]); w.z = cvt_pk_bf16(v[4], v[5]); w.w = cvt_pk_bf16(v[6], v[7]); return w; }
__device__ __forceinline__ float wave_sum(float v) {
#pragma unroll
    for (int o = 1; o < 64; o <<= 1) v += __shfl_xor(v, o);
    return v;
}
__device__ __forceinline__ float sigmoidf_(float x) { return 1.f / (1.f + __expf(-x)); }
__device__ __forceinline__ float siluf_(float x) { return x / (1.f + __expf(-x)); }
__device__ __forceinline__ float softplusf_(float x) { return fmaxf(x, 0.f) + log1pf(__expf(-fabsf(x))); }

namespace pg8 {
constexpr int BM = 256, BK = 64, HALF = 128, HTB = HALF * BK * 2, STAGE_BYTES = 8 * HTB, NXCD = 8, WGM = 8;
__host__ __device__ __forceinline__ int lds_byte(int r, int c) { const int st = (r >> 4) * 2 + (c >> 5), rr = r & 15, cc = c & 31, ob = rr * 64 + cc * 2; return st * 1024 + (ob ^ (((ob >> 9) & 1) << 5)); }
__host__ __device__ __forceinline__ void stage_rc(int b, int& R, int& C) { const int st = b / 1024, sb = b % 1024, swz = sb ^ (((sb >> 9) & 1) << 5); R = (st >> 1) * 16 + swz / 64; C = (st & 1) * 32 + (swz % 64) / 2; }
__host__ __device__ __forceinline__ int perm32(int rho) { const int n = rho >> 4, i = rho & 15; return 8 * (i >> 2) + 4 * n + (i & 3); }
struct Unit { int pm, pn; };
struct Gemm { const bf16_t* A; const bf16_t* Bt; int M, N, K, lda; };
struct StaticOrder {
    int nM, nN, nwg, G, c;
    __host__ __device__ void init(int M, int N, int G_, int c_) { nM = M / BM; nN = N / BM; nwg = nM * nN; G = G_; c = c_; }
    __host__ __device__ bool next(int i, Unit& u) const {
        const long L = (long)i * G + c; if (L >= nwg) return false;
        int wgid = (int)L; { const int q = nwg / NXCD, r = nwg % NXCD, xcd = wgid % NXCD, off = wgid / NXCD; wgid = (xcd < r ? xcd * (q + 1) : r * (q + 1) + (xcd - r) * q) + off; }
        const int nig = WGM * nN, gid = wgid / nig, fm = gid * WGM, gsz = (nM - fm) < WGM ? (nM - fm) : WGM;
        u.pm = fm + ((wgid % nig) % gsz); u.pn = (wgid % nig) / gsz; return true;
    }
};
template <class Epi, bool ALIGN_EPI>
__device__ __forceinline__ void gemm_phase(LAS unsigned char* lds, const Gemm g, const StaticOrder& S, const Epi& E) {
    int tid_ = threadIdx.x; asm volatile("" : "+v"(tid_));
    const int tid = tid_, wid = __builtin_amdgcn_readfirstlane(tid >> 6), lane = tid & 63, wr = wid >> 2, wc = wid & 3, fr = lane & 15, fq = lane >> 4;
    const int K = g.K, nt = K / BK, lda = g.lda;
    unsigned voffA[2], voffB[2];
#pragma unroll
    for (int i = 0; i < 2; ++i) { int R, C; stage_rc(tid * 16 + i * 8192, R, C); const int Rb = Epi::PERM ? ((R & ~31) + perm32(R & 31)) : R;
        voffA[i] = (unsigned)(R * lda + C) * 2u; voffB[i] = (unsigned)(Rb * K + C) * 2u; }
    const size_t kstep = (size_t)(BK * 2);
    const size_t hstepA = (size_t)HALF * lda * 2, hstepB = (size_t)HALF * K * 2;
    const size_t tstepA = 2 * hstepA, tstepB = 2 * hstepB;
    const unsigned ldsw = (unsigned)wid * 1024u;
    const int aoff = lds_byte(wr * 64 + fr, fq * 8), boff = lds_byte(wc * 32 + fr, fq * 8);
#define PG8_SA(b, h) (((b) * 2 + (h)) * HTB)
#define PG8_SB(b, h) ((4 + (b) * 2 + (h)) * HTB)
#define PG8_STAGE(bufoff, gbase, voff) do { _Pragma("unroll") for (int _i = 0; _i < 2; ++_i) \
        __builtin_amdgcn_global_load_lds((const unsigned*)((const char*)(gbase) + (voff)[_i]), (LAS unsigned*)(lds + (bufoff) + ldsw + _i * 8192), 16, 0, 0); } while (0)
#define PG8_LDA(dst, b, h) do { _Pragma("unroll") for (int m = 0; m < 4; ++m) _Pragma("unroll") for (int k = 0; k < 2; ++k) dst[m][k] = *(const LAS bf16x8*)(lds + PG8_SA(b, h) + aoff + m * 2048 + k * 1024); } while (0)
#define PG8_LDB(dst, b, h) do { _Pragma("unroll") for (int n = 0; n < 2; ++n) _Pragma("unroll") for (int k = 0; k < 2; ++k) dst[n][k] = *(const LAS bf16x8*)(lds + PG8_SB(b, h) + boff + n * 2048 + k * 1024); } while (0)
#define PG8_MMA(ai, bj, At, Bt) do { __builtin_amdgcn_s_setprio(1); _Pragma("unroll") for (int m = 0; m < 4; ++m) _Pragma("unroll") for (int n = 0; n < 2; ++n) _Pragma("unroll") for (int k = 0; k < 2; ++k) \
        acc[ai][bj][m][n] = __builtin_amdgcn_mfma_f32_16x16x32_bf16(Bt[n][k], At[m][k], acc[ai][bj][m][n], 0, 0, 0); __builtin_amdgcn_s_setprio(0); } while (0)
#define PG8_WAIT_V(n) asm volatile("s_waitcnt vmcnt(" #n ")" ::: "memory")
#define PG8_WAIT_L(n) asm volatile("s_waitcnt lgkmcnt(" #n ")" ::: "memory")
#define PG8_BAR __builtin_amdgcn_s_barrier()
#define PG8_SCHED __builtin_amdgcn_sched_barrier(0)
    Unit cur, nxt; int ui = 0;
    if (!S.next(0, cur)) return;
    f32x4 acc[2][2][4][2];
#pragma unroll
    for (int a = 0; a < 2; ++a)
#pragma unroll
        for (int b = 0; b < 2; ++b)
#pragma unroll
            for (int m = 0; m < 4; ++m)
#pragma unroll
                for (int n = 0; n < 2; ++n) acc[a][b][m][n] = (f32x4){0.f, 0.f, 0.f, 0.f};
    bf16x8 At[4][2], B0[2][2], B1[2][2];
    const char* cA = (const char*)g.A + (size_t)cur.pm * tstepA; const char* cB = (const char*)g.Bt + (size_t)cur.pn * tstepB;
    PG8_STAGE(PG8_SB(0, 0), cB, voffB); PG8_STAGE(PG8_SB(0, 1), cB + hstepB, voffB); PG8_STAGE(PG8_SA(0, 0), cA, voffA); PG8_STAGE(PG8_SA(0, 1), cA + hstepA, voffA);
    if (wr == 1) PG8_BAR;
    PG8_WAIT_V(2); PG8_BAR;
    PG8_STAGE(PG8_SB(1, 0), cB + kstep, voffB); PG8_STAGE(PG8_SA(1, 0), cA + kstep, voffA); PG8_STAGE(PG8_SB(1, 1), cB + hstepB + kstep, voffB);
    PG8_WAIT_V(6); PG8_BAR;
    for (;;) {
        const bool has_next = S.next(ui + 1, nxt);
        const char* nA = has_next ? (const char*)g.A + (size_t)nxt.pm * tstepA : cA; const char* nB = has_next ? (const char*)g.Bt + (size_t)nxt.pn * tstepB : cB;
        for (int t = 0; t < nt; t += 2) {
            const bool last = (t == nt - 2);
            const char* a1 = cA + (size_t)(t + 1) * kstep;
            const char* a2 = last ? nA : cA + (size_t)(t + 2) * kstep; const char* b2 = last ? nB : cB + (size_t)(t + 2) * kstep;
            const char* a3 = a2 + kstep; const char* b3 = b2 + kstep;
            PG8_LDB(B0, 0, 0); PG8_LDB(B1, 0, 1); PG8_SCHED; PG8_LDA(At, 0, 0); PG8_STAGE(PG8_SA(1, 1), a1 + hstepA, voffA);
            PG8_WAIT_V(8); PG8_WAIT_L(0); PG8_BAR; PG8_MMA(0, 0, At, B0); PG8_MMA(0, 1, At, B1); PG8_BAR; PG8_SCHED;
            PG8_LDA(At, 0, 1); PG8_STAGE(PG8_SB(0, 0), b2, voffB); PG8_STAGE(PG8_SB(0, 1), b2 + hstepB, voffB); PG8_STAGE(PG8_SA(0, 0), a2, voffA);
            PG8_WAIT_V(8); PG8_WAIT_L(0); PG8_BAR; PG8_MMA(1, 0, At, B0); PG8_MMA(1, 1, At, B1); PG8_BAR; PG8_SCHED;
            PG8_LDB(B0, 1, 0); PG8_LDB(B1, 1, 1); PG8_SCHED; PG8_LDA(At, 1, 0); PG8_STAGE(PG8_SA(0, 1), a2 + hstepA, voffA);
            PG8_WAIT_V(8); PG8_WAIT_L(0); PG8_BAR; PG8_MMA(0, 0, At, B0); PG8_MMA(0, 1, At, B1); PG8_BAR; PG8_SCHED;
            PG8_LDA(At, 1, 1); PG8_STAGE(PG8_SB(1, 0), b3, voffB); PG8_STAGE(PG8_SB(1, 1), b3 + hstepB, voffB); PG8_STAGE(PG8_SA(1, 0), a3, voffA);
            PG8_WAIT_V(8); PG8_WAIT_L(0); PG8_BAR; PG8_MMA(1, 0, At, B0); PG8_MMA(1, 1, At, B1); PG8_BAR; PG8_SCHED;
        }
        if constexpr (ALIGN_EPI) { if (wr == 0) PG8_BAR; }
        E(acc, cur, wr, wc, fr, fq);
        if (!has_next) break;
#pragma unroll
        for (int a = 0; a < 2; ++a)
#pragma unroll
            for (int b = 0; b < 2; ++b)
#pragma unroll
                for (int m = 0; m < 4; ++m)
#pragma unroll
                    for (int n = 0; n < 2; ++n) acc[a][b][m][n] = (f32x4){0.f, 0.f, 0.f, 0.f};
        cur = nxt; cA = nA; cB = nB; ++ui;
        if constexpr (ALIGN_EPI) { if (wr == 1) PG8_BAR; }
    }
    PG8_WAIT_V(0);
    if constexpr (!ALIGN_EPI) { if (wr == 0) PG8_BAR; }
    PG8_BAR;
#undef PG8_SA
#undef PG8_SB
#undef PG8_STAGE
#undef PG8_LDA
#undef PG8_LDB
#undef PG8_MMA
#undef PG8_WAIT_V
#undef PG8_WAIT_L
#undef PG8_BAR
#undef PG8_SCHED
}

__device__ __forceinline__ float row_rstd(const float* ssq, int row, int fq) {
    const f32x4 p = *(const f32x4*)(ssq + (size_t)row * 16 + 4 * fq);
    float s = (p.x + p.y) + (p.z + p.w);
    s += __shfl_xor(s, 16); s += __shfl_xor(s, 32);
    return rsqrtf(s * (1.0f / 1024.0f) + EPS);
}

struct EpiInProj {
    static constexpr bool PERM = true;
    bf16_t* proj; float* scal; const float* ssq; bf16_t* hconv; bf16_t* hshift; float* out; int layer;
    __device__ __forceinline__ void operator()(const f32x4 (&acc)[2][2][4][2], const Unit& u, int wr, int wc, int fr, int fq) const {
        const int pn = u.pn;
#pragma unroll
        for (int ai = 0; ai < 2; ++ai)
#pragma unroll
            for (int m = 0; m < 4; ++m) {
                const int row = u.pm * BM + ai * HALF + wr * 64 + m * 16 + fr;
                const float rs = row_rstd(ssq, row, fq);
                if (pn < 14) {
#pragma unroll
                    for (int bj = 0; bj < 2; ++bj) {
                        const int c0 = pn * BM + bj * HALF + wc * 32 + 8 * fq;
                        const f32x4 v0 = acc[ai][bj][m][0] * rs, v1 = acc[ai][bj][m][1] * rs;
                        u32x4 w; w.x = cvt_pk_bf16(v0[0], v0[1]); w.y = cvt_pk_bf16(v0[2], v0[3]); w.z = cvt_pk_bf16(v1[0], v1[1]); w.w = cvt_pk_bf16(v1[2], v1[3]);
                        *(u32x4*)(proj + (size_t)row * PW + c0) = w;
                        if (m == 3) {
                            const int chunk = row >> 6;
                            if (fr >= 13 && pn >= 4 && pn < 11) {
                                const int j = fr - 13;
                                *(u32x4*)(hconv + ((size_t)chunk * 3 + j) * 1792 + (c0 - 1024)) = w;
                                if (chunk >= 255) {
                                    float* o;
                                    if (c0 < PC_SX) o = out + (chunk == 255 ? O_P_GDNC + ((size_t)layer * 3 + j) * 768 : O_S_GDNC + (((size_t)layer * 32 + (chunk - 256)) * 3 + j) * 768) + (c0 - PC_GQ);
                                    else o = out + (chunk == 255 ? O_P_SSMC + ((size_t)layer * 3 + j) * 1024 : O_S_SSMC + (((size_t)layer * 32 + (chunk - 256)) * 3 + j) * 1024) + (c0 - PC_SX);
                                    *(f32x4*)o = v0; *(f32x4*)(o + 4) = v1;
                                }
                            }
                            if (fr == 15 && (pn == 3 || pn >= 11)) {
                                const int oc = (pn == 3) ? (c0 - PC_R) : (c0 - 2560);
                                *(u32x4*)(hshift + (size_t)chunk * 1024 + oc) = w;
                                if (chunk >= 255) {
                                    float* o = out + (chunk == 255 ? O_P_SHIFT + (size_t)layer * 1024 : O_S_SHIFT + ((size_t)layer * 32 + (chunk - 256)) * 1024) + oc;
                                    *(f32x4*)o = v0; *(f32x4*)(o + 4) = v1;
                                }
                            }
                        }
                    }
                } else {
                    if (wc == 0 && fq < 2) {
                        const f32x4 v0 = acc[ai][0][m][0] * rs, v1 = acc[ai][0][m][1] * rs;
                        float* o = scal + (size_t)row * 16 + 8 * fq;
                        *(f32x4*)o = v0; *(f32x4*)(o + 4) = v1;
                    }
                }
            }
    }
};
struct EpiResid {
    static constexpr bool PERM = false;
    const float* base_p; const float* base_s; float* xres; bf16_t* xb; float* ssq;
    __device__ __forceinline__ void operator()(const f32x4 (&acc)[2][2][4][2], const Unit& u, int wr, int wc, int fr, int fq) const {
        const int col0 = u.pn * BM + wc * 32 + 4 * fq;
#pragma unroll
        for (int ai = 0; ai < 2; ++ai)
#pragma unroll
            for (int m = 0; m < 4; ++m) {
                const int row = u.pm * BM + ai * HALF + wr * 64 + m * 16 + fr;
                const float* bp = (row < TP) ? base_p + (size_t)row * DM : base_s + (size_t)(row - TP) * DM;
                float ss = 0.f;
#pragma unroll
                for (int bj = 0; bj < 2; ++bj)
#pragma unroll
                    for (int n = 0; n < 2; ++n) {
                        const int c = col0 + bj * HALF + n * 16;
                        const f32x4 x = *(const f32x4*)(bp + c) + acc[ai][bj][m][n];
                        *(f32x4*)(xres + (size_t)row * DM + c) = x;
                        u32x2 w; w.x = cvt_pk_bf16(x[0], x[1]); w.y = cvt_pk_bf16(x[2], x[3]);
                        *(u32x2*)(xb + (size_t)row * DM + c) = w;
                        ss += (x[0] * x[0] + x[1] * x[1]) + (x[2] * x[2] + x[3] * x[3]);
                    }
                ss += __shfl_xor(ss, 16); ss += __shfl_xor(ss, 32);
                if (fq == 0) ssq[(size_t)row * 16 + u.pn * 4 + wc] = ss;
            }
    }
};
struct EpiGateUp {
    static constexpr bool PERM = true;
    bf16_t* ff; const float* ssq;
    __device__ __forceinline__ void operator()(const f32x4 (&acc)[2][2][4][2], const Unit& u, int wr, int wc, int fr, int fq) const {
        const int c0 = u.pn * HALF + wc * 32 + 8 * fq;
#pragma unroll
        for (int ai = 0; ai < 2; ++ai)
#pragma unroll
            for (int m = 0; m < 4; ++m) {
                const int row = u.pm * BM + ai * HALF + wr * 64 + m * 16 + fr;
                const float rs = row_rstd(ssq, row, fq);
                float f[8];
#pragma unroll
                for (int n = 0; n < 2; ++n)
#pragma unroll
                    for (int i = 0; i < 4; ++i) { const float gg = acc[ai][0][m][n][i] * rs, uu = acc[ai][1][m][n][i] * rs; f[n * 4 + i] = siluf_(gg) * uu; }
                *(u32x4*)(ff + (size_t)row * FF + c0) = pack8(f);
            }
    }
};
}

#define XB_TMO      128
#define XB_XCNT(j)  (256  + 64 * (j))
#define XB_XSUB(j)  (1280 + 64 * (j))
#define XB_XGEN(j)  (2304 + 64 * (j))
#define XB_TOP      3328
#define XB_TOPGEN   3392
#define XCD_BAR_WORDS 3456
#define XB_SPIN_CAP (1u << 18)
__device__ __forceinline__ unsigned xb_ld(unsigned* p)              { return __hip_atomic_load(p, __ATOMIC_RELAXED, __HIP_MEMORY_SCOPE_AGENT); }
__device__ __forceinline__ unsigned xb_add(unsigned* p, unsigned v) { return __hip_atomic_fetch_add(p, v, __ATOMIC_RELAXED, __HIP_MEMORY_SCOPE_AGENT); }
__device__ __forceinline__ unsigned xb_xcc_id() { return (unsigned)__builtin_amdgcn_s_getreg((3 << 11) | 20) & 0xFu; }
#define XB_SPIN(cond, bar) do { unsigned _sp = 0; while (cond) { __builtin_amdgcn_s_sleep(1); \
    if ((++_sp & 255u) == 0u) { if (xb_ld(&(bar)[XB_TMO])) break; if (_sp > XB_SPIN_CAP) { atomicAdd(&(bar)[XB_TMO], 1u); break; } } } } while (0)
struct XcdBarrier { unsigned* bar; unsigned x; volatile LAS unsigned* st; };
__device__ __forceinline__ XcdBarrier xcd_barrier_post(unsigned* bar, volatile LAS unsigned* st) {
    XcdBarrier b; b.bar = bar; b.x = xb_xcc_id(); b.st = st;
    if (threadIdx.x == 0) (void)xb_add(&bar[XB_XCNT(b.x)], 1u);
    return b;
}
__device__ __forceinline__ void xcd_barrier_complete(unsigned* bar, unsigned x, unsigned& nloc, unsigned& nx) {
    const unsigned G = gridDim.x * gridDim.y * gridDim.z;
    unsigned sum, cnt, mine, sp = 0u;
    for (;;) {
        sum = 0u; cnt = 0u; mine = 0u;
#pragma unroll
        for (unsigned j = 0; j < 16; ++j) { const unsigned c = xb_ld(&bar[XB_XCNT(j)]); sum += c; cnt += (c > 0u) ? 1u : 0u; mine = (j == x) ? c : mine; }
        if (sum == G) break;
        __builtin_amdgcn_s_sleep(1);
        if ((++sp & 255u) == 0u) { if (xb_ld(&bar[XB_TMO])) break; if (sp > XB_SPIN_CAP) { atomicAdd(&bar[XB_TMO], 1u); break; } }
    }
    nloc = mine > 0u ? mine : 1u; nx = cnt > 0u ? cnt : 1u;
}
__device__ __forceinline__ void xcd_barrier(const XcdBarrier& b) {
    asm volatile("s_waitcnt vmcnt(0)" ::: "memory");
    __syncthreads();
    if (threadIdx.x == 0) {
        unsigned* bar = b.bar;
        __builtin_amdgcn_s_waitcnt(0);
        unsigned nloc = b.st[0], nx = b.st[1];
        if (nloc == 0u) { xcd_barrier_complete(bar, b.x, nloc, nx); b.st[0] = nloc; b.st[1] = nx; }
        const unsigned old = xb_add(&bar[XB_XSUB(b.x)], 1u);
        const unsigned gen = old / nloc;
        if (old + 1u == (gen + 1u) * nloc) {
            __builtin_amdgcn_fence(__ATOMIC_RELEASE, "agent");
            asm volatile("s_waitcnt vmcnt(0)" ::: "memory");
            const unsigned og = xb_add(&bar[XB_TOP], 1u);
            const unsigned tg = og / nx;
            if (og + 1u == (tg + 1u) * nx) xb_add(&bar[XB_TOPGEN], 1u);
            else XB_SPIN(xb_ld(&bar[XB_TOPGEN]) == tg, bar);
            __builtin_amdgcn_fence(__ATOMIC_ACQUIRE, "agent");
            xb_add(&bar[XB_XGEN(b.x)], 1u);
            asm volatile("s_waitcnt vmcnt(0)" ::: "memory");
        } else {
            XB_SPIN(xb_ld(&bar[XB_XGEN(b.x)]) == gen, bar);
            __builtin_amdgcn_fence(__ATOMIC_ACQUIRE, "agent");
            asm volatile("s_waitcnt vmcnt(0)" ::: "memory");
        }
    }
    __syncthreads();
}

struct Args { const float* in[37]; float* out; unsigned char* ws; int ph_lo, ph_hi; };
enum { I_XP = 0, I_XS, I_SGDN, I_SGDNC, I_SSSM, I_SSSMC, I_SRWKV, I_SSHIFT, I_NORM1, I_WIN, I_GCONVW, I_GALOG, I_GDTB, I_GNORMW,
       I_SCONVW, I_SCONVB, I_SALOG, I_SDTB, I_SD, I_SNORMW, I_RMU, I_RW0, I_RWUP, I_RA0, I_RAUP, I_RGUP, I_RKK, I_RKA, I_RRK, I_RLNW, I_RLNB,
       I_WOUT, I_NORM2, I_WG, I_WU, I_WD, I_FNORM };

struct Frame {
    LAS unsigned char* lds;
    int tid, lane, wave, vcu, G;
    const float* const* in; float* out; unsigned char* ws;
};
#define F_R1     ((bf16_t*)(F.ws + WS_R1))
#define F_R2     ((bf16_t*)(F.ws + WS_R2))
#define F_PROJ   ((bf16_t*)(F.ws + WS_PROJ))
#define F_SSQA   ((float*)(F.ws + WS_SSQA))
#define F_SSQD   ((float*)(F.ws + WS_SSQD))
#define F_SCAL   ((float*)(F.ws + WS_R2 + R2_SCAL))
#define F_HCONV  ((bf16_t*)(F.ws + WS_R2 + R2_HCONV))
#define F_HSHIFT ((bf16_t*)(F.ws + WS_R2 + R2_HSHIFT))
#define F_RW     ((float*)(F.ws + WS_R1 + R1_RW))
#define F_RKK    ((bf16_t*)(F.ws + WS_R1 + R1_RKK))
#define F_RB     ((bf16_t*)(F.ws + WS_R1 + R1_RB))
__device__ __forceinline__ bf16_t* w_in(const Frame& F, int l) { return (bf16_t*)(F.ws + WS_W + (size_t)l * W_LAYER_B); }
__device__ __forceinline__ bf16_t* w_out(const Frame& F, int l) { return (bf16_t*)(F.ws + WS_W + (size_t)l * W_LAYER_B + W_IN_B); }
__device__ __forceinline__ bf16_t* w_gu(const Frame& F, int l) { return (bf16_t*)(F.ws + WS_W + (size_t)l * W_LAYER_B + W_IN_B + W_OUT_B); }
__device__ __forceinline__ bf16_t* w_dn(const Frame& F, int l) { return (bf16_t*)(F.ws + WS_W + (size_t)l * W_LAYER_B + W_IN_B + W_OUT_B + W_GU_B); }

__device__ __forceinline__ int opaque_tid() { int t = threadIdx.x; asm volatile("" : "+v"(t)); return t; }
#define PHASE_IDS(F) do { (F).tid = opaque_tid(); (F).lane = (F).tid & 63; (F).wave = __builtin_amdgcn_readfirstlane((F).tid >> 6); } while (0)
__device__ __forceinline__ int inproj_dst(int n) {
    if (n < 768) return PC_GQ + n;
    if (n < 1024) return PC_ZG + (n - 768);
    if (n < 1032) return 3584 + (n - 1024);
    if (n < 1544) return PC_ZS + (n - 1032);
    if (n < 2568) return PC_SX + (n - 1544);
    if (n < 2576) return 3592 + (n - 2568);
    if (n < 2832) return PC_R + (n - 2576);
    if (n < 3344) return PC_RK + (n - 2832);
    return PC_RL + (n - 3344);
}
template <int MODE>
__device__ __forceinline__ void p0_transpose_item(const float* W, int K, int N, bf16_t* WT, const float* kscale, LAS float* scr, int item, int lane) {
    const int nblk = (N + 31) / 32, kb = item / nblk, nb = item % nblk, k0 = 64 * kb, n0 = 32 * nb;
    const int nn = n0 + (lane & 31);
#pragma unroll 8
    for (int i = 0; i < 32; ++i) { const int kk = 2 * i + (lane >> 5); scr[kk * 33 + (lane & 31)] = (nn < N) ? W[(size_t)(k0 + kk) * N + nn] : 0.f; }
    asm volatile("s_waitcnt lgkmcnt(0)" ::: "memory");
    const int c = lane & 7;
    float ks[8];
#pragma unroll
    for (int i = 0; i < 8; ++i) ks[i] = kscale ? kscale[k0 + 8 * c + i] : 1.f;
#pragma unroll
    for (int j = 0; j < 4; ++j) { const int nl = (lane >> 3) + 8 * j; const int n = n0 + nl; const LAS float* s = scr + (8 * c) * 33 + nl;
        u32x4 o; o.x = cvt_pk_bf16(s[0 * 33] * ks[0], s[1 * 33] * ks[1]); o.y = cvt_pk_bf16(s[2 * 33] * ks[2], s[3 * 33] * ks[3]);
        o.z = cvt_pk_bf16(s[4 * 33] * ks[4], s[5 * 33] * ks[5]); o.w = cvt_pk_bf16(s[6 * 33] * ks[6], s[7 * 33] * ks[7]);
        if (n < N) {
            int d;
            if (MODE == 0) d = n; else if (MODE == 1) d = inproj_dst(n); else if (MODE == 2) d = 256 * (n >> 7) + (n & 127); else d = 256 * (n >> 7) + 128 + (n & 127);
            *(u32x4*)(WT + (size_t)d * K + k0 + 8 * c) = o; } }
    asm volatile("s_waitcnt lgkmcnt(0)" ::: "memory");
}
__device__ __forceinline__ void p0_prologue(Frame& F) {
    PHASE_IDS(F);
    LAS float* scr = (LAS float*)(F.lds + F.wave * 16384);
    const int gw = F.vcu * 8 + F.wave, NGW = F.G * 8;
    constexpr int I_IN = 16 * 113, I_OUT = 16 * 32, I_G = 16 * 88, I_D = 44 * 32;
    constexpr int PER_L = I_IN + I_OUT + 2 * I_G + I_D;
    for (int it = gw; it < 2 * PER_L; it += NGW) {
        const int l = it / PER_L; int r = it % PER_L;
        if (r < I_IN) { p0_transpose_item<1>(F.in[I_WIN] + (size_t)l * DM * 3600, DM, 3600, w_in(F, l), F.in[I_NORM1] + l * DM, scr, r, F.lane); continue; } r -= I_IN;
        if (r < I_OUT) { p0_transpose_item<0>(F.in[I_WOUT] + (size_t)l * DM * DM, DM, DM, w_out(F, l), nullptr, scr, r, F.lane); continue; } r -= I_OUT;
        if (r < I_G) { p0_transpose_item<2>(F.in[I_WG] + (size_t)l * DM * FF, DM, FF, w_gu(F, l), F.in[I_NORM2] + l * DM, scr, r, F.lane); continue; } r -= I_G;
        if (r < I_G) { p0_transpose_item<3>(F.in[I_WU] + (size_t)l * DM * FF, DM, FF, w_gu(F, l), F.in[I_NORM2] + l * DM, scr, r, F.lane); continue; } r -= I_G;
        p0_transpose_item<0>(F.in[I_WD] + (size_t)l * FF * DM, FF, DM, w_dn(F, l), nullptr, scr, r, F.lane);
    }
    for (int m = gw; m < T; m += NGW) {
        const float* xr = (m < TP) ? F.in[I_XP] + (size_t)m * DM : F.in[I_XS] + (size_t)(m - TP) * DM;
        f32x4 v[4]; float s = 0.f;
#pragma unroll
        for (int j = 0; j < 4; ++j) { v[j] = *((const f32x4*)xr + F.lane + 64 * j); s += (v[j].x * v[j].x + v[j].y * v[j].y) + (v[j].z * v[j].z + v[j].w * v[j].w); }
        s = wave_sum(s);
#pragma unroll
        for (int j = 0; j < 4; ++j) { u32x2 w; w.x = cvt_pk_bf16(v[j].x, v[j].y); w.y = cvt_pk_bf16(v[j].z, v[j].w); *((u32x2*)(F_R1 + (size_t)m * DM) + F.lane + 64 * j) = w; }
        if (F.lane < 16) F_SSQA[(size_t)m * 16 + F.lane] = (F.lane == 0) ? s : 0.f;
    }
}

__device__ __forceinline__ void act_chunk(Frame& F, int l, int c) {
    PHASE_IDS(F);
    const int tid = F.tid;
    const size_t row0 = (size_t)c * 64;
    const bool prompt = c < 256; const int b = c - 256;
    bf16_t* const proj = F_PROJ;
    LAS float* inT = (LAS float*)F.lds;
    LAS bf16_t* kx = (LAS bf16_t*)(F.lds + 256 * 68 * 4);
    if (tid < 224) {
        const int col = 1024 + tid * 8;
        const bool gdn = tid < 96;
        const int cc = gdn ? (col - PC_GQ) : (col - PC_SX);
        const int C = gdn ? 768 : 1024;
        const float* cw = gdn ? F.in[I_GCONVW] + (size_t)l * 4 * 768 : F.in[I_SCONVW] + (size_t)l * 4 * 1024;
        float w[4][8], bias[8], p3[8], p2[8], p1[8];
#pragma unroll
        for (int j = 0; j < 4; ++j)
#pragma unroll
            for (int i = 0; i < 8; ++i) w[j][i] = cw[j * C + cc + i];
#pragma unroll
        for (int i = 0; i < 8; ++i) bias[i] = gdn ? 0.f : F.in[I_SCONVB][l * 1024 + cc + i];
        if (prompt) {
            if (c == 0) {
#pragma unroll
                for (int i = 0; i < 8; ++i) { p3[i] = 0.f; p2[i] = 0.f; p1[i] = 0.f; }
            } else {
                const bf16_t* h = F_HCONV + (size_t)(c - 1) * 3 * 1792 + (col - 1024);
                unpack8(*(const u32x4*)(h), p3); unpack8(*(const u32x4*)(h + 1792), p2); unpack8(*(const u32x4*)(h + 2 * 1792), p1);
            }
        } else {
            const float* st = gdn ? F.in[I_SGDNC] + ((size_t)l * 32 + b) * 3 * 768 + cc : F.in[I_SSSMC] + ((size_t)l * 32 + b) * 3 * 1024 + cc;
#pragma unroll
            for (int i = 0; i < 8; ++i) { p3[i] = st[i]; p2[i] = st[C + i]; p1[i] = st[2 * C + i]; }
        }
        const int kind = gdn ? (tid >> 5) : 3;
        for (int t = 0; t < 64; ++t) {
            bf16_t* p = proj + (row0 + t) * PW + col;
            float x[8], y[8];
            unpack8(*(const u32x4*)p, x);
#pragma unroll
            for (int i = 0; i < 8; ++i) { float a = w[0][i] * p3[i] + w[1][i] * p2[i] + w[2][i] * p1[i] + w[3][i] * x[i] + bias[i]; y[i] = siluf_(a); p3[i] = p2[i]; p2[i] = p1[i]; p1[i] = x[i]; }
            if (tid < 64) {
                float ss = 0.f;
#pragma unroll
                for (int i = 0; i < 8; ++i) ss += y[i] * y[i];
                ss += __shfl_xor(ss, 1); ss += __shfl_xor(ss, 2); ss += __shfl_xor(ss, 4);
                const float sc = rsqrtf(ss + EPS) * (kind == 0 ? 0.125f : 1.f);
#pragma unroll
                for (int i = 0; i < 8; ++i) y[i] *= sc;
            }
            *(u32x4*)p = pack8(y);
        }
    } else if (tid >= 256 && tid < 384) {
        const int o = 8 * (tid - 256);
        const int col = o < 256 ? PC_R + o : 2560 + o;
        float mu[8], prev[8];
#pragma unroll
        for (int i = 0; i < 8; ++i) mu[i] = F.in[I_RMU][l * 1024 + o + i];
        if (prompt) {
            if (c == 0) {
#pragma unroll
                for (int i = 0; i < 8; ++i) prev[i] = 0.f;
            } else unpack8(*(const u32x4*)(F_HSHIFT + (size_t)(c - 1) * 1024 + o), prev);
        } else {
            const float* st = F.in[I_SSHIFT] + ((size_t)l * 32 + b) * 1024 + o;
#pragma unroll
            for (int i = 0; i < 8; ++i) prev[i] = st[i];
        }
        for (int t = 0; t < 64; ++t) {
            bf16_t* p = proj + (row0 + t) * PW + col;
            float x[8], y[8];
            unpack8(*(const u32x4*)p, x);
#pragma unroll
            for (int i = 0; i < 8; ++i) { y[i] = x[i] + (prev[i] - x[i]) * mu[i]; prev[i] = x[i]; }
            if (o < 768) {
                const u32x4 pk = pack8(y);
                *(u32x4*)p = pk;
                if (o >= 256 && o < 512) *(LAS u32x4*)(kx + t * 256 + (o - 256)) = pk;
            } else {
                const int i0 = o - 768;
#pragma unroll
                for (int i = 0; i < 8; ++i) { const int ii = i0 + i; float v = y[i]; if (ii < 64) v = tanhf(v); else if (ii >= 128) v = sigmoidf_(v); inT[ii * 68 + t] = v; }
            }
        }
    }
    __syncthreads();
    {
        const int j = tid & 255, th = tid >> 8, t0 = 32 * th;
        float acc[32], iclr[32];
#pragma unroll
        for (int t = 0; t < 32; ++t) acc[t] = 0.f;
        { const float* wu = F.in[I_RWUP] + (size_t)l * 64 * 256 + j;
          for (int i = 0; i < 64; ++i) { const float wv = wu[i * 256];
#pragma unroll
              for (int q = 0; q < 8; ++q) { const f32x4 x = *(const LAS f32x4*)(inT + i * 68 + t0 + 4 * q); acc[4 * q] += x[0] * wv; acc[4 * q + 1] += x[1] * wv; acc[4 * q + 2] += x[2] * wv; acc[4 * q + 3] += x[3] * wv; } } }
        { const float w0 = F.in[I_RW0][l * 256 + j];
#pragma unroll
          for (int t = 0; t < 32; ++t) { const float wl = -softplusf_(-(w0 + acc[t])) - 0.5f; F_RW[(row0 + t0 + t) * 256 + j] = __expf(-__expf(wl)); } }
#pragma unroll
        for (int t = 0; t < 32; ++t) acc[t] = 0.f;
        { const float* wu = F.in[I_RAUP] + (size_t)l * 64 * 256 + j;
          for (int i = 0; i < 64; ++i) { const float wv = wu[i * 256];
#pragma unroll
              for (int q = 0; q < 8; ++q) { const f32x4 x = *(const LAS f32x4*)(inT + (64 + i) * 68 + t0 + 4 * q); acc[4 * q] += x[0] * wv; acc[4 * q + 1] += x[1] * wv; acc[4 * q + 2] += x[2] * wv; acc[4 * q + 3] += x[3] * wv; } } }
        { const float a0 = F.in[I_RA0][l * 256 + j];
#pragma unroll
          for (int t = 0; t < 32; ++t) iclr[t] = sigmoidf_(a0 + acc[t]); }
#pragma unroll
        for (int t = 0; t < 32; ++t) acc[t] = 0.f;
        { const float* wu = F.in[I_RGUP] + (size_t)l * 128 * 256 + j;
          for (int i = 0; i < 128; ++i) { const float wv = wu[i * 256];
#pragma unroll
              for (int q = 0; q < 8; ++q) { const f32x4 x = *(const LAS f32x4*)(inT + (128 + i) * 68 + t0 + 4 * q); acc[4 * q] += x[0] * wv; acc[4 * q + 1] += x[1] * wv; acc[4 * q + 2] += x[2] * wv; acc[4 * q + 3] += x[3] * wv; } } }
        const float kkw = F.in[I_RKK][l * 256 + j], kaw = F.in[I_RKA][l * 256 + j];
#pragma unroll
        for (int t = 0; t < 32; ++t) {
            const size_t row = row0 + t0 + t;
            proj[row * PW + PC_RL + j] = f2bf(acc[t]);
            const float k = bf2f(kx[(t0 + t) * 256 + j]);
            const float kq = k * kkw;
            const float ss = wave_sum(kq * kq);
            const float kk = kq * rsqrtf(ss + EPS);
            F_RKK[row * 256 + j] = f2bf(kk);
            F_RB[row * 256 + j] = f2bf(kk * iclr[t]);
            proj[row * PW + PC_RK + j] = f2bf(k * (1.f + (iclr[t] - 1.f) * kaw));
        }
    }
    for (int e = tid; e < 64 * 16; e += 512) {
        const int t = e >> 4, q = e & 15;
        float* p = F_SCAL + (row0 + t) * 16 + q;
        const float v = *p; float r;
        if (q < 4) r = -__expf(F.in[I_GALOG][l * 4 + q]) * softplusf_(v + F.in[I_GDTB][l * 4 + q]);
        else if (q < 8) r = sigmoidf_(v);
        else r = softplusf_(v + F.in[I_SDTB][l * 8 + (q - 8)]);
        *p = r;
    }
    __syncthreads();
}

__device__ __forceinline__ void stage_tile_f32(LAS float* dst, const bf16_t* src, int ld, int tid) {
    const int t = tid >> 3, d8 = (tid & 7) * 8;
    float v[8]; unpack8(*(const u32x4*)(src + (size_t)t * ld + d8), v);
    *(LAS f32x4*)(dst + t * 64 + d8) = (f32x4){v[0], v[1], v[2], v[3]}; *(LAS f32x4*)(dst + t * 64 + d8 + 4) = (f32x4){v[4], v[5], v[6], v[7]};
}
__device__ __forceinline__ void scan_gdn(Frame& F, int l, int s, int h) {
    const int tid = F.tid, lane = F.lane;
    const int nch = (s == 0) ? 256 : 1, c0 = (s == 0) ? 0 : 255 + s, b = s - 1;
    LAS float* qs = (LAS float*)F.lds; LAS float* ks = qs + 4096; LAS float* vs = ks + 4096; LAS float* zs = vs + 4096; LAS float* gs = zs + 4096; LAS float* bs = gs + 64;
    float S[64];
    if (s == 0) {
#pragma unroll
        for (int k = 0; k < 64; ++k) S[k] = 0.f;
    } else {
        const float* st = F.in[I_SGDN] + (((size_t)l * 32 + b) * 4 + h) * 4096 + lane;
#pragma unroll
        for (int k = 0; k < 64; ++k) S[k] = st[k * 64];
    }
    const float nw = F.in[I_GNORMW][l * 64 + lane];
    for (int ci = 0; ci < nch; ++ci) {
        const size_t row0 = (size_t)(c0 + ci) * 64;
        stage_tile_f32(qs, F_PROJ + row0 * PW + PC_GQ + h * 64, PW, tid);
        stage_tile_f32(ks, F_PROJ + row0 * PW + PC_GK + h * 64, PW, tid);
        stage_tile_f32(vs, F_PROJ + row0 * PW + PC_GV + h * 64, PW, tid);
        stage_tile_f32(zs, F_PROJ + row0 * PW + PC_ZG + h * 64, PW, tid);
        if (tid < 64) { gs[tid] = F_SCAL[(row0 + tid) * 16 + h]; bs[tid] = F_SCAL[(row0 + tid) * 16 + 4 + h]; }
        __syncthreads();
        if (F.wave == 0) {
            for (int t = 0; t < 64; ++t) {
                const float eg = __expf(gs[t]), beta = bs[t];
                float kS = 0.f;
#pragma unroll
                for (int q = 0; q < 16; ++q) { const f32x4 kv = *(const LAS f32x4*)(ks + t * 64 + 4 * q); kS += S[4 * q] * kv[0] + S[4 * q + 1] * kv[1] + S[4 * q + 2] * kv[2] + S[4 * q + 3] * kv[3]; }
                const float delta = beta * (vs[t * 64 + lane] - eg * kS);
                float o = 0.f;
#pragma unroll
                for (int q = 0; q < 16; ++q) { const f32x4 kv = *(const LAS f32x4*)(ks + t * 64 + 4 * q); const f32x4 qv = *(const LAS f32x4*)(qs + t * 64 + 4 * q);
#pragma unroll
                    for (int i = 0; i < 4; ++i) { S[4 * q + i] = S[4 * q + i] * eg + kv[i] * delta; o += S[4 * q + i] * qv[i]; } }
                const float ss = wave_sum(o * o);
                const float y = o * rsqrtf(ss * (1.f / 64.f) + EPS) * nw * siluf_(zs[t * 64 + lane]);
                F_PROJ[(row0 + t) * PW + PC_ZG + h * 64 + lane] = f2bf(y);
            }
        }
        __syncthreads();
    }
    if (F.wave == 0) {
        float* o = F.out + (s == 0 ? O_P_GDN + ((size_t)l * 4 + h) * 4096 : O_S_GDN + (((size_t)l * 32 + b) * 4 + h) * 4096) + lane;
#pragma unroll
        for (int k = 0; k < 64; ++k) o[k * 64] = S[k];
    }
}
__device__ __forceinline__ void scan_rwkv(Frame& F, int l, int s, int h) {
    const int tid = F.tid, lane = F.lane;
    const int nch = (s == 0) ? 256 : 1, c0 = (s == 0) ? 0 : 255 + s, b = s - 1;
    LAS float* rs = (LAS float*)F.lds; LAS float* wsd = rs + 4096; LAS float* ks = wsd + 4096; LAS float* as = ks + 4096; LAS float* bs = as + 4096; LAS float* vs = bs + 4096; LAS float* gs = vs + 4096;
    float S[64];
    if (s == 0) {
#pragma unroll
        for (int k = 0; k < 64; ++k) S[k] = 0.f;
    } else {
        const float* st = F.in[I_SRWKV] + (((size_t)l * 32 + b) * 4 + h) * 4096 + lane * 64;
#pragma unroll
        for (int k = 0; k < 64; ++k) S[k] = st[k];
    }
    const float lnw = F.in[I_RLNW][l * 256 + h * 64 + lane], lnb = F.in[I_RLNB][l * 256 + h * 64 + lane], rk = F.in[I_RRK][l * 256 + h * 64 + lane];
    for (int ci = 0; ci < nch; ++ci) {
        const size_t row0 = (size_t)(c0 + ci) * 64;
        stage_tile_f32(rs, F_PROJ + row0 * PW + PC_R + h * 64, PW, tid);
        stage_tile_f32(ks, F_PROJ + row0 * PW + PC_RK + h * 64, PW, tid);
        stage_tile_f32(vs, F_PROJ + row0 * PW + PC_RV + h * 64, PW, tid);
        stage_tile_f32(gs, F_PROJ + row0 * PW + PC_RL + h * 64, PW, tid);
        stage_tile_f32(as, F_RKK + row0 * 256 + h * 64, 256, tid);
        stage_tile_f32(bs, F_RB + row0 * 256 + h * 64, 256, tid);
        { const int t = tid >> 3, d8 = (tid & 7) * 8; const float* p = F_RW + (row0 + t) * 256 + h * 64 + d8;
          *(LAS f32x4*)(wsd + t * 64 + d8) = *(const f32x4*)p; *(LAS f32x4*)(wsd + t * 64 + d8 + 4) = *(const f32x4*)(p + 4); }
        __syncthreads();
        if (F.wave == 0) {
            for (int t = 0; t < 64; ++t) {
                float sa = 0.f;
#pragma unroll
                for (int q = 0; q < 16; ++q) { const f32x4 av = *(const LAS f32x4*)(as + t * 64 + 4 * q); sa += S[4 * q] * av[0] + S[4 * q + 1] * av[1] + S[4 * q + 2] * av[2] + S[4 * q + 3] * av[3]; }
                sa = -sa;
                const float vv = vs[t * 64 + lane];
                float y = 0.f;
#pragma unroll
                for (int q = 0; q < 16; ++q) {
                    const f32x4 wv = *(const LAS f32x4*)(wsd + t * 64 + 4 * q), bv = *(const LAS f32x4*)(bs + t * 64 + 4 * q), kv = *(const LAS f32x4*)(ks + t * 64 + 4 * q), rv = *(const LAS f32x4*)(rs + t * 64 + 4 * q);
#pragma unroll
                    for (int i = 0; i < 4; ++i) { S[4 * q + i] = S[4 * q + i] * wv[i] + sa * bv[i] + vv * kv[i]; y += S[4 * q + i] * rv[i]; } }
                const float mean = wave_sum(y) * (1.f / 64.f);
                const float d = y - mean;
                const float var = wave_sum(d * d) * (1.f / 64.f);
                const float yn = d * rsqrtf(var + 64e-5f) * lnw + lnb;
                const float bonus = wave_sum(rs[t * 64 + lane] * ks[t * 64 + lane] * rk) * vv;
                F_PROJ[(row0 + t) * PW + PC_R + h * 64 + lane] = f2bf((yn + bonus) * gs[t * 64 + lane]);
            }
        }
        __syncthreads();
    }
    if (F.wave == 0) {
        float* o = F.out + (s == 0 ? O_P_RWKV + ((size_t)l * 4 + h) * 4096 : O_S_RWKV + (((size_t)l * 32 + b) * 4 + h) * 4096) + lane * 64;
#pragma unroll
        for (int k = 0; k < 64; ++k) o[k] = S[k];
    }
}
__device__ __forceinline__ void scan_ssd(Frame& F, int l, int s, int g) {
    const int tid = F.tid, lane = F.lane, w = F.wave;
    const int nch = (s == 0) ? 256 : 1, c0 = (s == 0) ? 0 : 255 + s, b = s - 1;
    LAS float* Bs = (LAS float*)F.lds; LAS float* Cs = Bs + 8192;
    LAS bf16_t* xs = (LAS bf16_t*)(F.lds + 65536); LAS bf16_t* zs = xs + 16384;
    LAS float* ssn = (LAS float*)(F.lds + 131072); LAS float* dts = ssn + 256;
    const int head = 4 * g + (w & 3);
    float hst[128];
    if (w < 4) {
        if (s == 0) {
#pragma unroll
            for (int n = 0; n < 128; ++n) hst[n] = 0.f;
        } else {
            const float* st = F.in[I_SSSM] + ((((size_t)l * 32 + b) * 8 + head) * 64 + lane) * 128;
#pragma unroll
            for (int n = 0; n < 128; n += 4) { const f32x4 v = *(const f32x4*)(st + n); hst[n] = v[0]; hst[n + 1] = v[1]; hst[n + 2] = v[2]; hst[n + 3] = v[3]; }
        }
    }
    const float Aneg = -__expf(F.in[I_SALOG][l * 8 + head]), Dh = F.in[I_SD][l * 8 + head];
    for (int ci = 0; ci < nch; ++ci) {
        const size_t row0 = (size_t)(c0 + ci) * 64;
        { const int t = tid >> 3, n16 = (tid & 7) * 16;
          const bf16_t* pb = F_PROJ + (row0 + t) * PW + PC_SB + g * 128 + n16; const bf16_t* pc = F_PROJ + (row0 + t) * PW + PC_SC + g * 128 + n16;
          float v[8];
#pragma unroll
          for (int q = 0; q < 2; ++q) {
              unpack8(*(const u32x4*)(pb + 8 * q), v); *(LAS f32x4*)(Bs + t * 128 + n16 + 8 * q) = (f32x4){v[0], v[1], v[2], v[3]}; *(LAS f32x4*)(Bs + t * 128 + n16 + 8 * q + 4) = (f32x4){v[4], v[5], v[6], v[7]};
              unpack8(*(const u32x4*)(pc + 8 * q), v); *(LAS f32x4*)(Cs + t * 128 + n16 + 8 * q) = (f32x4){v[0], v[1], v[2], v[3]}; *(LAS f32x4*)(Cs + t * 128 + n16 + 8 * q + 4) = (f32x4){v[4], v[5], v[6], v[7]}; }
          const int c32 = (tid & 7) * 32;
          const bf16_t* px = F_PROJ + (row0 + t) * PW + PC_SX + g * 256 + c32; const bf16_t* pz = F_PROJ + (row0 + t) * PW + PC_ZS + g * 256 + c32;
#pragma unroll
          for (int q = 0; q < 4; ++q) { *(LAS u32x4*)(xs + t * 256 + c32 + 8 * q) = *(const u32x4*)(px + 8 * q); *(LAS u32x4*)(zs + t * 256 + c32 + 8 * q) = *(const u32x4*)(pz + 8 * q); }
          if (tid < 256) dts[tid] = F_SCAL[(row0 + (tid >> 2)) * 16 + 8 + g * 4 + (tid & 3)]; }
        __syncthreads();
        if (w < 4) {
            for (int t = 0; t < 64; ++t) {
                const float dtv = dts[t * 4 + w], dA = __expf(dtv * Aneg);
                const float x = bf2f(xs[t * 256 + w * 64 + lane]), xdt = x * dtv;
                float y = 0.f;
#pragma unroll
                for (int q = 0; q < 32; ++q) { const f32x4 bv = *(const LAS f32x4*)(Bs + t * 128 + 4 * q), cv = *(const LAS f32x4*)(Cs + t * 128 + 4 * q);
#pragma unroll
                    for (int i = 0; i < 4; ++i) { hst[4 * q + i] = hst[4 * q + i] * dA + xdt * bv[i]; y += hst[4 * q + i] * cv[i]; } }
                y += Dh * x;
                y *= siluf_(bf2f(zs[t * 256 + w * 64 + lane]));
                const float ss = wave_sum(y * y);
                if (lane == 0) ssn[t * 4 + w] = ss;
                const unsigned yb = __float_as_uint(y);
                zs[t * 256 + w * 64 + lane] = (bf16_t)(yb >> 16); xs[t * 256 + w * 64 + lane] = (bf16_t)(yb & 0xffffu);
            }
        }
        __syncthreads();
        { const int t = tid >> 3, c32 = (tid & 7) * 32;
          const f32x4 sv = *(const LAS f32x4*)(ssn + t * 4);
          const float sc = rsqrtf(((sv[0] + sv[1]) + (sv[2] + sv[3])) * (1.f / 256.f) + EPS);
          const float* nw = F.in[I_SNORMW] + l * 512 + g * 256 + c32;
#pragma unroll
          for (int q = 0; q < 4; ++q) { float o[8];
#pragma unroll
              for (int i = 0; i < 8; ++i) { const int cidx = t * 256 + c32 + 8 * q + i; const float y = __uint_as_float(((unsigned)zs[cidx] << 16) | (unsigned)xs[cidx]); o[i] = y * sc * nw[8 * q + i]; }
              *(u32x4*)(F_PROJ + (row0 + t) * PW + PC_ZS + g * 256 + c32 + 8 * q) = pack8(o); } }
        __syncthreads();
    }
    if (w < 4) {
        float* o = F.out + (s == 0 ? O_P_SSM + (((size_t)l * 8 + head) * 64 + lane) * 128 : O_S_SSM + ((((size_t)l * 32 + b) * 8 + head) * 64 + lane) * 128);
#pragma unroll
        for (int n = 0; n < 128; n += 4) *(f32x4*)(o + n) = (f32x4){hst[n], hst[n + 1], hst[n + 2], hst[n + 3]};
    }
}
__device__ __forceinline__ void scan_phase(Frame& F, int l) {
    PHASE_IDS(F);
    for (int it = F.vcu; it < 330; it += F.G) {
        if (it < 4) scan_gdn(F, l, 0, it);
        else if (it < 6) scan_ssd(F, l, 0, it - 4);
        else if (it < 10) scan_rwkv(F, l, 0, it - 6);
        else { const int r = it - 10;
            if (r < 128) scan_gdn(F, l, 1 + (r >> 2), r & 3);
            else if (r < 192) scan_ssd(F, l, 1 + ((r - 128) >> 1), (r - 128) & 1);
            else scan_rwkv(F, l, 1 + ((r - 192) >> 2), (r - 192) & 3); }
        __syncthreads();
    }
}
__device__ __forceinline__ void final_norm(Frame& F) {
    PHASE_IDS(F);
    const int gw = F.vcu * 8 + F.wave, NGW = F.G * 8;
    const float* fw = F.in[I_FNORM];
    f32x4 wv[4];
#pragma unroll
    for (int j = 0; j < 4; ++j) wv[j] = *((const f32x4*)fw + F.lane + 64 * j);
    for (int m = gw; m < T; m += NGW) {
        float s = (F.lane < 16) ? F_SSQA[(size_t)m * 16 + F.lane] : 0.f;
        s = wave_sum(s);
        const float rs = rsqrtf(s * (1.f / 1024.f) + EPS);
        f32x4* xr = (f32x4*)(F.out + (size_t)m * DM);
#pragma unroll
        for (int j = 0; j < 4; ++j) { f32x4 v = xr[F.lane + 64 * j]; v = v * rs * wv[j]; xr[F.lane + 64 * j] = v; }
    }
}

constexpr int N_PHASES = 14;
__global__ void __launch_bounds__(512, 2) mk_fwd(Args args) {
    extern __shared__ __attribute__((aligned(16))) unsigned char lds[];
    Frame F;
    F.lds = (LAS unsigned char*)lds;
    F.tid = threadIdx.x; F.lane = F.tid & 63; F.wave = __builtin_amdgcn_readfirstlane(F.tid >> 6);
    F.G = gridDim.x; { const int bx = blockIdx.x; F.vcu = (F.G % 8 == 0) ? (bx % 8) * (F.G / 8) + bx / 8 : bx; }
    F.in = args.in; F.out = args.out; F.ws = args.ws;
    volatile LAS unsigned* MISC = (volatile LAS unsigned*)(F.lds + MISC_OFF);
    for (int u = F.tid; u < (LDS_BYTES - LDSCTL_OFF) / 4; u += 512) ((LAS unsigned*)(F.lds + LDSCTL_OFF))[u] = 0u;
    __syncthreads();
    XcdBarrier bar; bar.bar = (unsigned*)(args.ws + WS_CTL) + CW_BAR; bar.x = 0; bar.st = nullptr;
    const int lo = args.ph_lo, hi = args.ph_hi;
    if (hi - lo > 1) bar = xcd_barrier_post((unsigned*)(args.ws + WS_CTL) + CW_BAR, MISC + 8);
#define IN(k) (lo <= (k) && (k) < hi)
#define SEAM(k) do { if (IN(k) && IN((k) + 1)) xcd_barrier(bar); } while (0)

    if (IN(0)) { p0_prologue(F); SEAM(0); }
    for (int l = 0; l < 2; ++l) {
        const int pb = 1 + 6 * l;
        if (IN(pb)) {
            pg8::Gemm g{F_R1, w_in(F, l), T, NIN, DM, DM}; pg8::StaticOrder S; S.init(T, NIN, F.G, (int)blockIdx.x);
            pg8::EpiInProj E{F_PROJ, F_SCAL, F_SSQA, F_HCONV, F_HSHIFT, F.out, l};
            pg8::gemm_phase<pg8::EpiInProj, true>(F.lds, g, S, E);
            SEAM(pb);
        }
        if (IN(pb + 1)) {
            for (int c = F.vcu; c < NCH; c += F.G) act_chunk(F, l, c);
            SEAM(pb + 1);
        }
        if (IN(pb + 2)) {
            scan_phase(F, l);
            SEAM(pb + 2);
        }
        if (IN(pb + 3)) {
            pg8::Gemm g{F_PROJ, w_out(F, l), T, DM, DM, PW}; pg8::StaticOrder S; S.init(T, DM, F.G, (int)blockIdx.x);
            const float* bp = l == 0 ? F.in[I_XP] : F.out; const float* bs = l == 0 ? F.in[I_XS] : F.out + (size_t)TP * DM;
            pg8::EpiResid E{bp, bs, F.out, F_R2, F_SSQD};
            pg8::gemm_phase<pg8::EpiResid, true>(F.lds, g, S, E);
            SEAM(pb + 3);
        }
        if (IN(pb + 4)) {
            pg8::Gemm g{F_R2, w_gu(F, l), T, NGU, DM, DM}; pg8::StaticOrder S; S.init(T, NGU, F.G, (int)blockIdx.x);
            pg8::EpiGateUp E{F_PROJ, F_SSQD};
            pg8::gemm_phase<pg8::EpiGateUp, true>(F.lds, g, S, E);
            SEAM(pb + 4);
        }
        if (IN(pb + 5)) {
            pg8::Gemm g{F_PROJ, w_dn(F, l), T, DM, FF, FF}; pg8::StaticOrder S; S.init(T, DM, F.G, (int)blockIdx.x);
            pg8::EpiResid E{F.out, F.out + (size_t)TP * DM, F.out, F_R1, F_SSQA};
            pg8::gemm_phase<pg8::EpiResid, true>(F.lds, g, S, E);
            SEAM(pb + 5);
        }
    }
    if (IN(13)) final_norm(F);
#undef IN
#undef SEAM
}

extern "C" void kernel_launch(void* const* d_in, const int* in_sizes, int n_in, void* d_out, int out_size, void* d_ws, size_t ws_size, hipStream_t stream) {
    static int grid = 0;
    if (grid == 0) {
        if (n_in != 37 || out_size != (int)O_END || ws_size < WS_END) { fprintf(stderr, "kernel_launch: unexpected shapes: n_in %d out %d ws %zu\n", n_in, out_size, ws_size); grid = -1; return; }
        int dev = 0, cus = 0;
        if (hipGetDevice(&dev) != hipSuccess || hipDeviceGetAttribute(&cus, hipDeviceAttributeMultiprocessorCount, dev) != hipSuccess) { grid = -1; return; }
        if (hipFuncSetAttribute((const void*)mk_fwd, hipFuncAttributeMaxDynamicSharedMemorySize, LDS_BYTES) != hipSuccess) { fprintf(stderr, "kernel_launch: hipFuncSetAttribute failed\n"); grid = -1; return; }
        int per_cu = 0;
        if (hipOccupancyMaxActiveBlocksPerMultiprocessor(&per_cu, (const void*)mk_fwd, 512, LDS_BYTES) != hipSuccess || per_cu < 1)
            fprintf(stderr, "kernel_launch: occupancy query reports %d workgroups per CU\n", per_cu);
        (void)hipGetLastError();
        grid = cus;
    }
    if (grid < 0) return;
    (void)hipMemsetAsync((char*)d_ws + WS_CTL, 0, 65536, stream);
    Args a{};
    for (int i = 0; i < 37; ++i) a.in[i] = (const float*)d_in[i];
    a.out = (float*)d_out; a.ws = (unsigned char*)d_ws;
#if MK_N_LAUNCHES == 1
    a.ph_lo = 0; a.ph_hi = N_PHASES;
    hipLaunchKernelGGL(mk_fwd, dim3(grid), dim3(512), LDS_BYTES, stream, a);
#else
    for (int p = 0; p < N_PHASES; ++p) { a.ph_lo = p; a.ph_hi = p + 1; hipLaunchKernelGGL(mk_fwd, dim3(grid), dim3(512), LDS_BYTES, stream, a); }
#endif
}
```

```cpp
#include <hip/hip_runtime.h>
#include <cstdio>
#include <cstdint>


#define LAS __attribute__((address_space(3)))
typedef unsigned short bf16_t;
typedef short bf16x8 __attribute__((ext_vector_type(8)));
typedef float f32x4 __attribute__((ext_vector_type(4)));
typedef float f32x2 __attribute__((ext_vector_type(2)));
typedef unsigned u32x4 __attribute__((ext_vector_type(4)));
typedef unsigned u32x2 __attribute__((ext_vector_type(2)));

constexpr int DM = 1024, TP = 16384, NB = 32, T = 18432, NCH = 288, NSEQ = 33;
constexpr int PW = 3584;
constexpr int NIN = 3840;
constexpr int FF = 2816, NGU = 5632;
constexpr float EPS = 1e-6f;
constexpr int PC_ZG = 0, PC_ZS = 256, PC_R = 768, PC_GQ = 1024, PC_GK = 1280, PC_GV = 1536, PC_SX = 1792, PC_SB = 2304, PC_SC = 2560,
              PC_RK = 2816, PC_RV = 3072, PC_RL = 3328;
constexpr size_t O_Y = 0;
constexpr size_t O_P_GDN = (size_t)T * DM;
constexpr size_t O_P_GDNC = O_P_GDN + 2 * 1 * 4 * 64 * 64;
constexpr size_t O_P_SSM = O_P_GDNC + 2 * 1 * 3 * 768;
constexpr size_t O_P_SSMC = O_P_SSM + 2 * 1 * 8 * 64 * 128;
constexpr size_t O_P_RWKV = O_P_SSMC + 2 * 1 * 3 * 1024;
constexpr size_t O_P_SHIFT = O_P_RWKV + 2 * 1 * 4 * 64 * 64;
constexpr size_t O_S_GDN = O_P_SHIFT + 2 * 1 * 1024;
constexpr size_t O_S_GDNC = O_S_GDN + (size_t)2 * 32 * 4 * 64 * 64;
constexpr size_t O_S_SSM = O_S_GDNC + (size_t)2 * 32 * 3 * 768;
constexpr size_t O_S_SSMC = O_S_SSM + (size_t)2 * 32 * 8 * 64 * 128;
constexpr size_t O_S_RWKV = O_S_SSMC + (size_t)2 * 32 * 3 * 1024;
constexpr size_t O_S_SHIFT = O_S_RWKV + (size_t)2 * 32 * 4 * 64 * 64;
constexpr size_t O_END = O_S_SHIFT + (size_t)2 * 32 * 1024;
static_assert(O_END == 25784832, "output size");

constexpr size_t WS_CTL = 0, CTL_BYTES = 1u << 20;
constexpr size_t W_IN_B = (size_t)NIN * DM * 2, W_OUT_B = (size_t)DM * DM * 2, W_GU_B = (size_t)NGU * DM * 2, W_DN_B = (size_t)DM * FF * 2;
constexpr size_t W_LAYER_B = W_IN_B + W_OUT_B + W_GU_B + W_DN_B;
constexpr size_t WS_W = WS_CTL + CTL_BYTES;
constexpr size_t WS_R1 = WS_W + 2 * W_LAYER_B;
constexpr size_t R_BYTES = (size_t)T * DM * 2;
constexpr size_t WS_R2 = WS_R1 + R_BYTES;
constexpr size_t WS_PROJ = WS_R2 + R_BYTES;
constexpr size_t PROJ_BYTES = (size_t)T * PW * 2;
constexpr size_t WS_SSQA = WS_PROJ + PROJ_BYTES;
constexpr size_t SSQ_BYTES = (size_t)T * 16 * 4;
constexpr size_t WS_SSQD = WS_SSQA + SSQ_BYTES;
constexpr size_t WS_END = WS_SSQD + SSQ_BYTES;
static_assert(WS_END <= 268435456, "d_ws map exceeds 256 MiB");
static_assert((size_t)T * FF * 2 <= PROJ_BYTES, "ff overlays proj");
constexpr size_t R2_SCAL = 0;
constexpr size_t R2_HCONV = R2_SCAL + (size_t)T * 16 * 4;
constexpr size_t R2_HSHIFT = R2_HCONV + (size_t)NCH * 3 * 1792 * 2;
constexpr size_t R2_ACUM = R2_HSHIFT + (size_t)NCH * 1024 * 2;
constexpr size_t R2_GCUM = R2_ACUM + (size_t)T * 8 * 4;
constexpr size_t R2_YOFF = R2_GCUM + (size_t)T * 4 * 4;
constexpr size_t R2_GW = R2_YOFF + (size_t)T * 512 * 2;
static_assert(R2_GW + (size_t)T * 256 * 2 <= R_BYTES, "R2 map");
constexpr size_t R1_RWA = 0;
constexpr size_t R1_RU = R1_RWA + (size_t)T * 256 * 2;
constexpr size_t R1_RBH = R1_RU + (size_t)T * 256 * 2;
constexpr size_t R1_RKV = R1_RBH + (size_t)T * 256 * 2;
static_assert(R1_RKV + (size_t)T * 256 * 2 <= R_BYTES, "R1 map");
constexpr size_t R2_RDV = R2_GW + (size_t)T * 256 * 2;
static_assert(R2_RDV + (size_t)NCH * 4 * 64 * 4 <= R_BYTES, "R2 map (dvec)");
constexpr int CW_BAR = 4096;

constexpr int RING_BYTES = 131072;
constexpr int LDSCTL_OFF = 143360, MISC_OFF = LDSCTL_OFF + 320;
constexpr int LDS_BYTES = 147456;

typedef __bf16 bf16x2_t __attribute__((ext_vector_type(2)));
__device__ __forceinline__ unsigned cvt_pk_bf16(float lo, float hi) { const f32x2 v = {lo, hi}; return __builtin_bit_cast(unsigned, __builtin_convertvector(v, bf16x2_t)); }
__device__ __forceinline__ float bf_lo(unsigned w) { return __uint_as_float(w << 16); }
__device__ __forceinline__ float bf_hi(unsigned w) { return __uint_as_float(w & 0xffff0000u); }
__device__ __forceinline__ float bf2f(bf16_t h) { return __uint_as_float(((unsigned)h) << 16); }
__device__ __forceinline__ bf16_t f2bf(float f) { return (bf16_t)(cvt_pk_bf16(f, 0.f) & 0xffffu); }
__device__ __forceinline__ void unpack8(u32x4 w, float (&o)[8]) {
    o[0] = bf_lo(w.x); o[1] = bf_hi(w.x); o[2] = bf_lo(w.y); o[3] = bf_hi(w.y); o[4] = bf_lo(w.z); o[5] = bf_hi(w.z); o[6] = bf_lo(w.w); o[7] = bf_hi(w.w); }
__device__ __forceinline__ u32x4 pack8(const float (&v)[8]) { u32x4 w; w.x = cvt_pk_bf16(v[0], v[1]); w.y = cvt_pk_bf16(v[2], v[3]); w.z = cvt_pk_bf16(v[4], v[5]); w.w = cvt_pk_bf16(v[6], v[7]); return w; }
__device__ __forceinline__ float wave_sum(float v) {
#pragma unroll
    for (int o = 1; o < 64; o <<= 1) v += __shfl_xor(v, o);
    return v;
}
#define LDS_BARRIER() do { asm volatile("s_waitcnt lgkmcnt(0)" ::: "memory"); __builtin_amdgcn_s_barrier(); asm volatile("" ::: "memory"); } while (0)
__device__ __forceinline__ float sigmoidf_(float x) { return __builtin_amdgcn_rcpf(1.f + __expf(-x)); }
__device__ __forceinline__ float siluf_(float x) { return x * __builtin_amdgcn_rcpf(1.f + __expf(-x)); }
__device__ __forceinline__ float tanhf_(float x) { return 1.f - 2.f * __builtin_amdgcn_rcpf(1.f + __expf(2.f * x)); }
__device__ __forceinline__ float softplusf_(float x) { return fmaxf(x, 0.f) + __logf(1.f + __expf(-fabsf(x))); }


typedef short s16x4 __attribute__((ext_vector_type(4)));
__device__ __forceinline__ f32x4 mma16(bf16x8 a, bf16x8 b, f32x4 c) { return __builtin_amdgcn_mfma_f32_16x16x32_bf16(a, b, c, 0, 0, 0); }
__device__ __forceinline__ bf16x8 cat4(s16x4 a, s16x4 b) { return (bf16x8){a[0], a[1], a[2], a[3], b[0], b[1], b[2], b[3]}; }
__device__ __forceinline__ bf16x8 frag_nat(const LAS bf16_t* Tt, int LD, int row0, int k0, int i16, int g) { return *(const LAS bf16x8*)(Tt + (row0 + i16) * LD + k0 + 8 * g); }
__device__ __forceinline__ bf16x8 frag_sig(const LAS bf16_t* Tt, int LD, int row0, int k0, int i16, int g) {
    const LAS bf16_t* p = Tt + (row0 + i16) * LD + k0 + 4 * g; return cat4(*(const LAS s16x4*)p, *(const LAS s16x4*)(p + 16)); }
__device__ __forceinline__ s16x4 tr4(const LAS bf16_t* p) { return __builtin_amdgcn_ds_read_tr16_b64_v4i16((LAS s16x4*)p); }
__device__ __forceinline__ bf16x8 frag_tr_nat(const LAS bf16_t* X, int LD, int k0, int c0, int i16, int g) {
    const LAS bf16_t* p = X + (k0 + 8 * g + (i16 >> 2)) * LD + c0 + 4 * (i16 & 3); return cat4(tr4(p), tr4(p + 4 * LD)); }
__device__ __forceinline__ bf16x8 frag_tr_sig(const LAS bf16_t* X, int LD, int k0, int c0, int i16, int g) {
    const LAS bf16_t* p = X + (k0 + 4 * g + (i16 >> 2)) * LD + c0 + 4 * (i16 & 3); return cat4(tr4(p), tr4(p + 16 * LD)); }
__device__ __forceinline__ bf16x8 acc_frag(f32x4 x0, f32x4 x1) {
    u32x4 w; w.x = cvt_pk_bf16(x0[0], x0[1]); w.y = cvt_pk_bf16(x0[2], x0[3]); w.z = cvt_pk_bf16(x1[0], x1[1]); w.w = cvt_pk_bf16(x1[2], x1[3]);
    return __builtin_bit_cast(bf16x8, w); }
__device__ __forceinline__ u32x2 pack4(f32x4 x) { u32x2 w; w.x = cvt_pk_bf16(x[0], x[1]); w.y = cvt_pk_bf16(x[2], x[3]); return w; }
__device__ __forceinline__ f32x4 unpack4(u32x2 w) { return (f32x4){bf_lo(w.x), bf_hi(w.x), bf_lo(w.y), bf_hi(w.y)}; }

namespace pg8 {
constexpr int BM = 256, BK = 64, HALF = 128, HTB = HALF * BK * 2, STAGE_BYTES = 8 * HTB, NXCD = 8, WGM = 8;
__host__ __device__ __forceinline__ int lds_byte(int r, int c) { const int st = (r >> 4) * 2 + (c >> 5), rr = r & 15, cc = c & 31, ob = rr * 64 + cc * 2; return st * 1024 + (ob ^ (((ob >> 9) & 1) << 5)); }
__host__ __device__ __forceinline__ void stage_rc(int b, int& R, int& C) { const int st = b / 1024, sb = b % 1024, swz = sb ^ (((sb >> 9) & 1) << 5); R = (st >> 1) * 16 + swz / 64; C = (st & 1) * 32 + (swz % 64) / 2; }
__host__ __device__ __forceinline__ int perm32(int rho) { const int n = rho >> 4, i = rho & 15; return 8 * (i >> 2) + 4 * n + (i & 3); }
struct Unit { int pm, pn; };
struct Gemm { const bf16_t* A; const bf16_t* Bt; int M, N, K, lda; };
struct StaticOrder {
    int nM, nN, nwg, G, c;
    __host__ __device__ void init(int M, int N, int G_, int c_) { nM = M / BM; nN = N / BM; nwg = nM * nN; G = G_; c = c_; }
    __host__ __device__ bool next(int i, Unit& u) const {
        const long L = (long)i * G + c; if (L >= nwg) return false;
        int wgid = (int)L; { const int q = nwg / NXCD, r = nwg % NXCD, xcd = wgid % NXCD, off = wgid / NXCD; wgid = (xcd < r ? xcd * (q + 1) : r * (q + 1) + (xcd - r) * q) + off; }
        const int nig = WGM * nN, gid = wgid / nig, fm = gid * WGM, gsz = (nM - fm) < WGM ? (nM - fm) : WGM;
        u.pm = fm + ((wgid % nig) % gsz); u.pn = (wgid % nig) / gsz; return true;
    }
};
template <class Epi, bool ALIGN_EPI>
__device__ __forceinline__ void gemm_phase(LAS unsigned char* lds, const Gemm g, const StaticOrder& S, const Epi& E) {
    int tid_ = threadIdx.x; asm volatile("" : "+v"(tid_));
    const int tid = tid_, wid = __builtin_amdgcn_readfirstlane(tid >> 6), lane = tid & 63, wr = wid >> 2, wc = wid & 3, fr = lane & 15, fq = lane >> 4;
    const int K = g.K, nt = K / BK, lda = g.lda;
    unsigned voffA[2], voffB[2];
#pragma unroll
    for (int i = 0; i < 2; ++i) { int R, C; stage_rc(tid * 16 + i * 8192, R, C); const int Rb = Epi::PERM ? ((R & ~31) + perm32(R & 31)) : R;
        voffA[i] = (unsigned)(R * lda + C) * 2u; voffB[i] = (unsigned)(Rb * K + C) * 2u; }
    const size_t kstep = (size_t)(BK * 2);
    const size_t hstepA = (size_t)HALF * lda * 2, hstepB = (size_t)HALF * K * 2;
    const size_t tstepA = 2 * hstepA, tstepB = 2 * hstepB;
    const unsigned ldsw = (unsigned)wid * 1024u;
    const int aoff = lds_byte(wr * 64 + fr, fq * 8), boff = lds_byte(wc * 32 + fr, fq * 8);
#define PG8_SA(b, h) (((b) * 2 + (h)) * HTB)
#define PG8_SB(b, h) ((4 + (b) * 2 + (h)) * HTB)
#define PG8_STAGE(bufoff, gbase, voff) do { _Pragma("unroll") for (int _i = 0; _i < 2; ++_i) \
        __builtin_amdgcn_global_load_lds((const unsigned*)((const char*)(gbase) + (voff)[_i]), (LAS unsigned*)(lds + (bufoff) + ldsw + _i * 8192), 16, 0, 0); } while (0)
#define PG8_LDA(dst, b, h) do { _Pragma("unroll") for (int m = 0; m < 4; ++m) _Pragma("unroll") for (int k = 0; k < 2; ++k) dst[m][k] = *(const LAS bf16x8*)(lds + PG8_SA(b, h) + aoff + m * 2048 + k * 1024); } while (0)
#define PG8_LDB(dst, b, h) do { _Pragma("unroll") for (int n = 0; n < 2; ++n) _Pragma("unroll") for (int k = 0; k < 2; ++k) dst[n][k] = *(const LAS bf16x8*)(lds + PG8_SB(b, h) + boff + n * 2048 + k * 1024); } while (0)
#define PG8_MMA(ai, bj, At, Bt) do { __builtin_amdgcn_s_setprio(1); _Pragma("unroll") for (int m = 0; m < 4; ++m) _Pragma("unroll") for (int n = 0; n < 2; ++n) _Pragma("unroll") for (int k = 0; k < 2; ++k) \
        acc[ai][bj][m][n] = __builtin_amdgcn_mfma_f32_16x16x32_bf16(Bt[n][k], At[m][k], acc[ai][bj][m][n], 0, 0, 0); __builtin_amdgcn_s_setprio(0); } while (0)
#define PG8_WAIT_V(n) asm volatile("s_waitcnt vmcnt(" #n ")" ::: "memory")
#define PG8_WAIT_L(n) asm volatile("s_waitcnt lgkmcnt(" #n ")" ::: "memory")
#define PG8_BAR __builtin_amdgcn_s_barrier()
#define PG8_SCHED __builtin_amdgcn_sched_barrier(0)
    Unit cur, nxt; int ui = 0;
    if (!S.next(0, cur)) return;
    f32x4 acc[2][2][4][2];
#pragma unroll
    for (int a = 0; a < 2; ++a)
#pragma unroll
        for (int b = 0; b < 2; ++b)
#pragma unroll
            for (int m = 0; m < 4; ++m)
#pragma unroll
                for (int n = 0; n < 2; ++n) acc[a][b][m][n] = (f32x4){0.f, 0.f, 0.f, 0.f};
    bf16x8 At[4][2], B0[2][2], B1[2][2];
    const char* cA = (const char*)g.A + (size_t)cur.pm * tstepA; const char* cB = (const char*)g.Bt + (size_t)cur.pn * tstepB;
    PG8_STAGE(PG8_SB(0, 0), cB, voffB); PG8_STAGE(PG8_SB(0, 1), cB + hstepB, voffB); PG8_STAGE(PG8_SA(0, 0), cA, voffA); PG8_STAGE(PG8_SA(0, 1), cA + hstepA, voffA);
    if (wr == 1) PG8_BAR;
    PG8_WAIT_V(2); PG8_BAR;
    PG8_STAGE(PG8_SB(1, 0), cB + kstep, voffB); PG8_STAGE(PG8_SA(1, 0), cA + kstep, voffA); PG8_STAGE(PG8_SB(1, 1), cB + hstepB + kstep, voffB);
    PG8_WAIT_V(6); PG8_BAR;
    for (;;) {
        const bool has_next = S.next(ui + 1, nxt);
        const char* nA = has_next ? (const char*)g.A + (size_t)nxt.pm * tstepA : cA; const char* nB = has_next ? (const char*)g.Bt + (size_t)nxt.pn * tstepB : cB;
        for (int t = 0; t < nt; t += 2) {
            const bool last = (t == nt - 2);
            const char* a1 = cA + (size_t)(t + 1) * kstep;
            const char* a2 = last ? nA : cA + (size_t)(t + 2) * kstep; const char* b2 = last ? nB : cB + (size_t)(t + 2) * kstep;
            const char* a3 = a2 + kstep; const char* b3 = b2 + kstep;
            PG8_LDB(B0, 0, 0); PG8_LDB(B1, 0, 1); PG8_SCHED; PG8_LDA(At, 0, 0); PG8_STAGE(PG8_SA(1, 1), a1 + hstepA, voffA);
            PG8_WAIT_V(8); PG8_WAIT_L(0); PG8_BAR; PG8_MMA(0, 0, At, B0); PG8_MMA(0, 1, At, B1); PG8_BAR; PG8_SCHED;
            PG8_LDA(At, 0, 1); PG8_STAGE(PG8_SB(0, 0), b2, voffB); PG8_STAGE(PG8_SB(0, 1), b2 + hstepB, voffB); PG8_STAGE(PG8_SA(0, 0), a2, voffA);
            PG8_WAIT_V(8); PG8_WAIT_L(0); PG8_BAR; PG8_MMA(1, 0, At, B0); PG8_MMA(1, 1, At, B1); PG8_BAR; PG8_SCHED;
            PG8_LDB(B0, 1, 0); PG8_LDB(B1, 1, 1); PG8_SCHED; PG8_LDA(At, 1, 0); PG8_STAGE(PG8_SA(0, 1), a2 + hstepA, voffA);
            PG8_WAIT_V(8); PG8_WAIT_L(0); PG8_BAR; PG8_MMA(0, 0, At, B0); PG8_MMA(0, 1, At, B1); PG8_BAR; PG8_SCHED;
            PG8_LDA(At, 1, 1); PG8_STAGE(PG8_SB(1, 0), b3, voffB); PG8_STAGE(PG8_SB(1, 1), b3 + hstepB, voffB); PG8_STAGE(PG8_SA(1, 0), a3, voffA);
            PG8_WAIT_V(8); PG8_WAIT_L(0); PG8_BAR; PG8_MMA(1, 0, At, B0); PG8_MMA(1, 1, At, B1); PG8_BAR; PG8_SCHED;
        }
        if constexpr (ALIGN_EPI) { if (wr == 0) PG8_BAR; }
        E(acc, cur, wr, wc, fr, fq);
        if (!has_next) break;
#pragma unroll
        for (int a = 0; a < 2; ++a)
#pragma unroll
            for (int b = 0; b < 2; ++b)
#pragma unroll
                for (int m = 0; m < 4; ++m)
#pragma unroll
                    for (int n = 0; n < 2; ++n) acc[a][b][m][n] = (f32x4){0.f, 0.f, 0.f, 0.f};
        cur = nxt; cA = nA; cB = nB; ++ui;
        if constexpr (ALIGN_EPI) { if (wr == 1) PG8_BAR; }
    }
    PG8_WAIT_V(0);
    if constexpr (!ALIGN_EPI) { if (wr == 0) PG8_BAR; }
    PG8_BAR;
#undef PG8_SA
#undef PG8_SB
#undef PG8_STAGE
#undef PG8_LDA
#undef PG8_LDB
#undef PG8_MMA
#undef PG8_WAIT_V
#undef PG8_WAIT_L
#undef PG8_BAR
#undef PG8_SCHED
}

__device__ __forceinline__ float row_rstd(const float* ssq, int row, int fq) {
    const f32x4 p = *(const f32x4*)(ssq + (size_t)row * 16 + 4 * fq);
    float s = (p.x + p.y) + (p.z + p.w);
    s += __shfl_xor(s, 16); s += __shfl_xor(s, 32);
    return rsqrtf(s * (1.0f / 1024.0f) + EPS);
}

struct EpiInProj {
    static constexpr bool PERM = true;
    bf16_t* proj; float* scal; const float* ssq; bf16_t* hconv; bf16_t* hshift; float* out; int layer;
    __device__ __forceinline__ void operator()(const f32x4 (&acc)[2][2][4][2], const Unit& u, int wr, int wc, int fr, int fq) const {
        const int pn = u.pn;
#pragma unroll
        for (int ai = 0; ai < 2; ++ai)
#pragma unroll
            for (int m = 0; m < 4; ++m) {
                const int row = u.pm * BM + ai * HALF + wr * 64 + m * 16 + fr;
                const float rs = row_rstd(ssq, row, fq);
                if (pn < 14) {
#pragma unroll
                    for (int bj = 0; bj < 2; ++bj) {
                        const int c0 = pn * BM + bj * HALF + wc * 32 + 8 * fq;
                        const f32x4 v0 = acc[ai][bj][m][0] * rs, v1 = acc[ai][bj][m][1] * rs;
                        u32x4 w; w.x = cvt_pk_bf16(v0[0], v0[1]); w.y = cvt_pk_bf16(v0[2], v0[3]); w.z = cvt_pk_bf16(v1[0], v1[1]); w.w = cvt_pk_bf16(v1[2], v1[3]);
                        *(u32x4*)(proj + (size_t)row * PW + c0) = w;
                        if (m == 3) {
                            const int chunk = row >> 6;
                            if (fr >= 13 && pn >= 4 && pn < 11) {
                                const int j = fr - 13;
                                *(u32x4*)(hconv + ((size_t)chunk * 3 + j) * 1792 + (c0 - 1024)) = w;
                                if (chunk >= 255) {
                                    float* o;
                                    if (c0 < PC_SX) o = out + (chunk == 255 ? O_P_GDNC + ((size_t)layer * 3 + j) * 768 : O_S_GDNC + (((size_t)layer * 32 + (chunk - 256)) * 3 + j) * 768) + (c0 - PC_GQ);
                                    else o = out + (chunk == 255 ? O_P_SSMC + ((size_t)layer * 3 + j) * 1024 : O_S_SSMC + (((size_t)layer * 32 + (chunk - 256)) * 3 + j) * 1024) + (c0 - PC_SX);
                                    *(f32x4*)o = v0; *(f32x4*)(o + 4) = v1;
                                }
                            }
                            if (fr == 15 && (pn == 3 || pn >= 11)) {
                                const int oc = (pn == 3) ? (c0 - PC_R) : (c0 - 2560);
                                *(u32x4*)(hshift + (size_t)chunk * 1024 + oc) = w;
                                if (chunk >= 255) {
                                    float* o = out + (chunk == 255 ? O_P_SHIFT + (size_t)layer * 1024 : O_S_SHIFT + ((size_t)layer * 32 + (chunk - 256)) * 1024) + oc;
                                    *(f32x4*)o = v0; *(f32x4*)(o + 4) = v1;
                                }
                            }
                        }
                    }
                } else {
                    if (wc == 0 && fq < 2) {
                        const f32x4 v0 = acc[ai][0][m][0] * rs, v1 = acc[ai][0][m][1] * rs;
                        float* o = scal + (size_t)row * 16 + 8 * fq;
                        *(f32x4*)o = v0; *(f32x4*)(o + 4) = v1;
                    }
                }
            }
    }
};
template <bool F32BASE> struct EpiResid {
    static constexpr bool PERM = true;
    const float* base_p; const float* base_s; bf16_t* xb; float* ssq;
    __device__ __forceinline__ void operator()(const f32x4 (&acc)[2][2][4][2], const Unit& u, int wr, int wc, int fr, int fq) const {
        const int col0 = u.pn * BM + wc * 32 + 8 * fq;
#pragma unroll
        for (int ai = 0; ai < 2; ++ai)
#pragma unroll
            for (int m = 0; m < 4; ++m) {
                const int row = u.pm * BM + ai * HALF + wr * 64 + m * 16 + fr;
                float ss = 0.f;
#pragma unroll
                for (int bj = 0; bj < 2; ++bj) {
                    const int c = col0 + bj * HALF;
                    float x[8];
                    if (F32BASE) {
                        const float* bp = ((row < TP) ? base_p + (size_t)row * DM : base_s + (size_t)(row - TP) * DM) + c;
                        const f32x4 b0 = *(const f32x4*)bp, b1 = *(const f32x4*)(bp + 4);
                        x[0] = b0[0]; x[1] = b0[1]; x[2] = b0[2]; x[3] = b0[3]; x[4] = b1[0]; x[5] = b1[1]; x[6] = b1[2]; x[7] = b1[3];
                    } else unpack8(*(const u32x4*)(xb + (size_t)row * DM + c), x);
#pragma unroll
                    for (int n = 0; n < 2; ++n)
#pragma unroll
                        for (int i = 0; i < 4; ++i) { const float v = x[4 * n + i] + acc[ai][bj][m][n][i]; x[4 * n + i] = v; ss += v * v; }
                    *(u32x4*)(xb + (size_t)row * DM + c) = pack8(x);
                }
                ss += __shfl_xor(ss, 16); ss += __shfl_xor(ss, 32);
                if (fq == 0) ssq[(size_t)row * 16 + u.pn * 4 + wc] = ss;
            }
    }
};
struct EpiGateUp {
    static constexpr bool PERM = true;
    bf16_t* ff; const float* ssq;
    __device__ __forceinline__ void operator()(const f32x4 (&acc)[2][2][4][2], const Unit& u, int wr, int wc, int fr, int fq) const {
        const int c0 = u.pn * HALF + wc * 32 + 8 * fq;
#pragma unroll
        for (int ai = 0; ai < 2; ++ai)
#pragma unroll
            for (int m = 0; m < 4; ++m) {
                const int row = u.pm * BM + ai * HALF + wr * 64 + m * 16 + fr;
                const float rs = row_rstd(ssq, row, fq);
                float f[8];
#pragma unroll
                for (int n = 0; n < 2; ++n)
#pragma unroll
                    for (int i = 0; i < 4; ++i) { const float gg = acc[ai][0][m][n][i] * rs, uu = acc[ai][1][m][n][i] * rs; f[n * 4 + i] = siluf_(gg) * uu; }
                *(u32x4*)(ff + (size_t)row * FF + c0) = pack8(f);
            }
    }
};
}

#define XB_TMO      128
#define XB_XCNT(j)  (256  + 64 * (j))
#define XB_XSUB(j)  (1280 + 64 * (j))
#define XB_XGEN(j)  (2304 + 64 * (j))
#define XB_TOP      3328
#define XB_TOPGEN   3392
#define XCD_BAR_WORDS 3456
#define XB_SPIN_CAP (1u << 18)
__device__ __forceinline__ unsigned xb_ld(unsigned* p)              { return __hip_atomic_load(p, __ATOMIC_RELAXED, __HIP_MEMORY_SCOPE_AGENT); }
__device__ __forceinline__ unsigned xb_add(unsigned* p, unsigned v) { return __hip_atomic_fetch_add(p, v, __ATOMIC_RELAXED, __HIP_MEMORY_SCOPE_AGENT); }
__device__ __forceinline__ unsigned xb_xcc_id() { return (unsigned)__builtin_amdgcn_s_getreg((3 << 11) | 20) & 0xFu; }
#define XB_SPIN(cond, bar) do { unsigned _sp = 0; while (cond) { __builtin_amdgcn_s_sleep(1); \
    if ((++_sp & 255u) == 0u) { if (xb_ld(&(bar)[XB_TMO])) break; if (_sp > XB_SPIN_CAP) { atomicAdd(&(bar)[XB_TMO], 1u); break; } } } } while (0)
struct XcdBarrier { unsigned* bar; unsigned x; volatile LAS unsigned* st; };
__device__ __forceinline__ XcdBarrier xcd_barrier_post(unsigned* bar, volatile LAS unsigned* st) {
    XcdBarrier b; b.bar = bar; b.x = xb_xcc_id(); b.st = st;
    if (threadIdx.x == 0) (void)xb_add(&bar[XB_XCNT(b.x)], 1u);
    return b;
}
__device__ __forceinline__ void xcd_barrier_complete(unsigned* bar, unsigned x, unsigned& nloc, unsigned& nx) {
    const unsigned G = gridDim.x * gridDim.y * gridDim.z;
    unsigned sum, cnt, mine, sp = 0u;
    for (;;) {
        sum = 0u; cnt = 0u; mine = 0u;
#pragma unroll
        for (unsigned j = 0; j < 16; ++j) { const unsigned c = xb_ld(&bar[XB_XCNT(j)]); sum += c; cnt += (c > 0u) ? 1u : 0u; mine = (j == x) ? c : mine; }
        if (sum == G) break;
        __builtin_amdgcn_s_sleep(1);
        if ((++sp & 255u) == 0u) { if (xb_ld(&bar[XB_TMO])) break; if (sp > XB_SPIN_CAP) { atomicAdd(&bar[XB_TMO], 1u); break; } }
    }
    nloc = mine > 0u ? mine : 1u; nx = cnt > 0u ? cnt : 1u;
}
__device__ __forceinline__ void xcd_barrier(const XcdBarrier& b) {
    asm volatile("s_waitcnt vmcnt(0)" ::: "memory");
    __syncthreads();
    if (threadIdx.x == 0) {
        unsigned* bar = b.bar;
        __builtin_amdgcn_s_waitcnt(0);
        unsigned nloc = b.st[0], nx = b.st[1];
        if (nloc == 0u) { xcd_barrier_complete(bar, b.x, nloc, nx); b.st[0] = nloc; b.st[1] = nx; }
        const unsigned old = xb_add(&bar[XB_XSUB(b.x)], 1u);
        const unsigned gen = old / nloc;
        if (old + 1u == (gen + 1u) * nloc) {
            __builtin_amdgcn_fence(__ATOMIC_RELEASE, "agent");
            asm volatile("s_waitcnt vmcnt(0)" ::: "memory");
            const unsigned og = xb_add(&bar[XB_TOP], 1u);
            const unsigned tg = og / nx;
            if (og + 1u == (tg + 1u) * nx) xb_add(&bar[XB_TOPGEN], 1u);
            else XB_SPIN(xb_ld(&bar[XB_TOPGEN]) == tg, bar);
            __builtin_amdgcn_fence(__ATOMIC_ACQUIRE, "agent");
            xb_add(&bar[XB_XGEN(b.x)], 1u);
            asm volatile("s_waitcnt vmcnt(0)" ::: "memory");
        } else {
            XB_SPIN(xb_ld(&bar[XB_XGEN(b.x)]) == gen, bar);
            __builtin_amdgcn_fence(__ATOMIC_ACQUIRE, "agent");
            asm volatile("s_waitcnt vmcnt(0)" ::: "memory");
        }
    }
    __syncthreads();
}

struct Args { const float* in[37]; float* out; unsigned char* ws; unsigned sched[8]; int nsched, pmode; };
enum { I_XP = 0, I_XS, I_SGDN, I_SGDNC, I_SSSM, I_SSSMC, I_SRWKV, I_SSHIFT, I_NORM1, I_WIN, I_GCONVW, I_GALOG, I_GDTB, I_GNORMW,
       I_SCONVW, I_SCONVB, I_SALOG, I_SDTB, I_SD, I_SNORMW, I_RMU, I_RW0, I_RWUP, I_RA0, I_RAUP, I_RGUP, I_RKK, I_RKA, I_RRK, I_RLNW, I_RLNB,
       I_WOUT, I_NORM2, I_WG, I_WU, I_WD, I_FNORM };

struct Frame {
    LAS unsigned char* lds;
    int tid, lane, wave, vcu, G;
    float* out; unsigned char* ws;
};
constexpr int PTRTAB_OFF = LDSCTL_OFF + 1024;
__device__ __forceinline__ const float* inptr(LAS unsigned char* lds, int i) {
    const unsigned long long v = ((const LAS unsigned long long*)(lds + PTRTAB_OFF))[i];
    const unsigned lo = __builtin_amdgcn_readfirstlane((unsigned)v), hi = __builtin_amdgcn_readfirstlane((unsigned)(v >> 32));
    return (const float*)(((unsigned long long)hi << 32) | lo);
}
#define INP(i) inptr(F.lds, (i))
#define F_R1     ((bf16_t*)(F.ws + WS_R1))
#define F_R2     ((bf16_t*)(F.ws + WS_R2))
#define F_PROJ   ((bf16_t*)(F.ws + WS_PROJ))
#define F_SSQA   ((float*)(F.ws + WS_SSQA))
#define F_SSQD   ((float*)(F.ws + WS_SSQD))
#define F_SCAL   ((float*)(F.ws + WS_R2 + R2_SCAL))
#define F_HCONV  ((bf16_t*)(F.ws + WS_R2 + R2_HCONV))
#define F_HSHIFT ((bf16_t*)(F.ws + WS_R2 + R2_HSHIFT))
#define F_RWA    ((bf16_t*)((unsigned char*)F.out + R1_RWA))
#define F_RU     ((bf16_t*)((unsigned char*)F.out + R1_RU))
#define F_RBH    ((bf16_t*)((unsigned char*)F.out + R1_RBH))
#define F_RKV    ((bf16_t*)((unsigned char*)F.out + R1_RKV))
#define F_RDV    ((float*)(F.ws + WS_R2 + R2_RDV))
#define F_ACUM   ((float*)(F.ws + WS_R2 + R2_ACUM))
#define F_GCUM   ((float*)(F.ws + WS_R2 + R2_GCUM))
#define F_YOFF   ((bf16_t*)(F.ws + WS_R2 + R2_YOFF))
#define F_GW     ((bf16_t*)(F.ws + WS_R2 + R2_GW))
__device__ __forceinline__ bf16_t* w_in(const Frame& F, int l) { return (bf16_t*)(F.ws + WS_W + (size_t)l * W_LAYER_B); }
__device__ __forceinline__ bf16_t* w_out(const Frame& F, int l) { return (bf16_t*)(F.ws + WS_W + (size_t)l * W_LAYER_B + W_IN_B); }
__device__ __forceinline__ bf16_t* w_gu(const Frame& F, int l) { return (bf16_t*)(F.ws + WS_W + (size_t)l * W_LAYER_B + W_IN_B + W_OUT_B); }
__device__ __forceinline__ bf16_t* w_dn(const Frame& F, int l) { return (bf16_t*)(F.ws + WS_W + (size_t)l * W_LAYER_B + W_IN_B + W_OUT_B + W_GU_B); }

template <class Tp> __device__ __forceinline__ LAS Tp* opaque_lds(LAS Tp* p) { unsigned a = (unsigned)(unsigned long long)p; asm volatile("" : "+v"(a)); return (LAS Tp*)(unsigned long long)a; }
constexpr int CW_AFLAG = 14336, CW_RFLAG = 14336 + 288;
__device__ __forceinline__ void publish_item(unsigned* flag) {
    asm volatile("s_waitcnt vmcnt(0)" ::: "memory");
    LDS_BARRIER();
    if (threadIdx.x == 0) {
        __builtin_amdgcn_fence(__ATOMIC_RELEASE, "agent");
        asm volatile("s_waitcnt vmcnt(0)" ::: "memory");
        __hip_atomic_fetch_add(flag, 1u, __ATOMIC_RELAXED, __HIP_MEMORY_SCOPE_AGENT);
    }
}
__device__ __forceinline__ int opaque_tid() { int t = threadIdx.x; asm volatile("" : "+v"(t)); return t; }
#define PHASE_IDS(F) do { (F).tid = opaque_tid(); (F).lane = (F).tid & 63; (F).wave = __builtin_amdgcn_readfirstlane((F).tid >> 6); } while (0)
__device__ __forceinline__ int inproj_dst(int n) {
    if (n < 768) return PC_GQ + n;
    if (n < 1024) return PC_ZG + (n - 768);
    if (n < 1032) return 3584 + (n - 1024);
    if (n < 1544) return PC_ZS + (n - 1032);
    if (n < 2568) return PC_SX + (n - 1544);
    if (n < 2576) return 3592 + (n - 2568);
    if (n < 2832) return PC_R + (n - 2576);
    if (n < 3344) return PC_RK + (n - 2832);
    return PC_RL + (n - 3344);
}
template <int MODE>
__device__ __forceinline__ void p0_transpose_item(const float* W, int K, int N, bf16_t* WT, const float* kscale, LAS float* scr, int item, int lane) {
    const int nblk = (N + 31) / 32, kb = item / nblk, nb = item % nblk, k0 = 64 * kb, n0 = 32 * nb;
    {
        const int rr = lane >> 3, c4 = (lane & 7) * 4;
        f32x4 v[8];
#pragma unroll
        for (int i = 0; i < 8; ++i) { const float* p = W + (size_t)(k0 + 8 * i + rr) * N + n0 + c4;
            if (n0 + c4 + 3 < N) v[i] = *(const f32x4*)p;
            else v[i] = (f32x4){0.f, 0.f, 0.f, 0.f}; }
#pragma unroll
        for (int i = 0; i < 8; ++i) { LAS float* s = scr + (8 * i + rr) * 33 + c4; s[0] = v[i][0]; s[1] = v[i][1]; s[2] = v[i][2]; s[3] = v[i][3]; }
    }
    asm volatile("s_waitcnt lgkmcnt(0)" ::: "memory");
    const int c = lane & 7;
    float ks[8];
#pragma unroll
    for (int i = 0; i < 8; ++i) ks[i] = kscale ? kscale[k0 + 8 * c + i] : 1.f;
#pragma unroll
    for (int j = 0; j < 4; ++j) { const int nl = (lane >> 3) + 8 * j; const int n = n0 + nl; const LAS float* s = scr + (8 * c) * 33 + nl;
        u32x4 o; o.x = cvt_pk_bf16(s[0 * 33] * ks[0], s[1 * 33] * ks[1]); o.y = cvt_pk_bf16(s[2 * 33] * ks[2], s[3 * 33] * ks[3]);
        o.z = cvt_pk_bf16(s[4 * 33] * ks[4], s[5 * 33] * ks[5]); o.w = cvt_pk_bf16(s[6 * 33] * ks[6], s[7 * 33] * ks[7]);
        if (n < N) {
            int d;
            if (MODE == 0) d = n; else if (MODE == 1) d = inproj_dst(n); else if (MODE == 2) d = 256 * (n >> 7) + (n & 127); else d = 256 * (n >> 7) + 128 + (n & 127);
            *(u32x4*)(WT + (size_t)d * K + k0 + 8 * c) = o; } }
    asm volatile("s_waitcnt lgkmcnt(0)" ::: "memory");
}
__device__ __forceinline__ void p0_prologue(Frame& F) {
    PHASE_IDS(F);
    LAS float* scr = (LAS float*)(F.lds + F.wave * 16384);
    const int gw = F.vcu * 8 + F.wave, NGW = F.G * 8;
    constexpr int I_IN = 16 * 113, I_OUT = 16 * 32, I_G = 16 * 88, I_D = 44 * 32;
    constexpr int PER_L = I_IN + I_OUT + 2 * I_G + I_D;
    for (int it = gw; it < 2 * PER_L; it += NGW) {
        const int l = it / PER_L; int r = it % PER_L;
        if (r < I_IN) { p0_transpose_item<1>(INP(I_WIN) + (size_t)l * DM * 3600, DM, 3600, w_in(F, l), INP(I_NORM1) + l * DM, scr, r, F.lane); continue; } r -= I_IN;
        if (r < I_OUT) { p0_transpose_item<0>(INP(I_WOUT) + (size_t)l * DM * DM, DM, DM, w_out(F, l), nullptr, scr, r, F.lane); continue; } r -= I_OUT;
        if (r < I_G) { p0_transpose_item<2>(INP(I_WG) + (size_t)l * DM * FF, DM, FF, w_gu(F, l), INP(I_NORM2) + l * DM, scr, r, F.lane); continue; } r -= I_G;
        if (r < I_G) { p0_transpose_item<3>(INP(I_WU) + (size_t)l * DM * FF, DM, FF, w_gu(F, l), INP(I_NORM2) + l * DM, scr, r, F.lane); continue; } r -= I_G;
        p0_transpose_item<0>(INP(I_WD) + (size_t)l * FF * DM, FF, DM, w_dn(F, l), nullptr, scr, r, F.lane);
    }
    for (int m = gw; m < T; m += NGW) {
        const float* xr = (m < TP) ? INP(I_XP) + (size_t)m * DM : INP(I_XS) + (size_t)(m - TP) * DM;
        f32x4 v[4]; float s = 0.f;
#pragma unroll
        for (int j = 0; j < 4; ++j) { v[j] = *((const f32x4*)xr + F.lane + 64 * j); s += (v[j].x * v[j].x + v[j].y * v[j].y) + (v[j].z * v[j].z + v[j].w * v[j].w); }
        s = wave_sum(s);
#pragma unroll
        for (int j = 0; j < 4; ++j) { u32x2 w; w.x = cvt_pk_bf16(v[j].x, v[j].y); w.y = cvt_pk_bf16(v[j].z, v[j].w); *((u32x2*)(F_R1 + (size_t)m * DM) + F.lane + 64 * j) = w; }
        if (F.lane < 16) F_SSQA[(size_t)m * 16 + F.lane] = (F.lane == 0) ? s : 0.f;
    }
}

template <int LDL, int SGN, class RhsFn>
__device__ __forceinline__ void tri_solve64(const LAS float* Lo, float (&x)[64], RhsFn rhs) {
    f32x4 cur[16], nxt[16];
#pragma unroll
    for (int i = 0; i < 64; ++i) {
        if (i + 1 < 64) {
#pragma unroll
            for (int m4 = 0; m4 < (i + 1 + 3) / 4; ++m4) nxt[m4] = *(const LAS f32x4*)(Lo + (i + 1) * LDL + 4 * m4);
        }
        float a0 = rhs(i), a1 = 0.f, a2 = 0.f, a3 = 0.f;
#pragma unroll
        for (int m4 = 0; m4 < (i + 3) / 4; ++m4) {
            if (4 * m4 + 0 < i) a0 += (SGN > 0 ? cur[m4][0] : -cur[m4][0]) * x[4 * m4 + 0];
            if (4 * m4 + 1 < i) a1 += (SGN > 0 ? cur[m4][1] : -cur[m4][1]) * x[4 * m4 + 1];
            if (4 * m4 + 2 < i) a2 += (SGN > 0 ? cur[m4][2] : -cur[m4][2]) * x[4 * m4 + 2];
            if (4 * m4 + 3 < i) a3 += (SGN > 0 ? cur[m4][3] : -cur[m4][3]) * x[4 * m4 + 3];
        }
        x[i] = (a0 + a1) + (a2 + a3);
        __builtin_amdgcn_sched_barrier(0);
#pragma unroll
        for (int m4 = 0; m4 < 16; ++m4) cur[m4] = nxt[m4];
    }
}
constexpr int ACT_KT = 0, ACT_VT = 33792, ACT_LM = 67584, ACT_SCL = 137216, ACT_GCL = 141312;
constexpr int ACT_LDK = 264, ACT_LDL = 68;
__device__ __forceinline__ void act_chunk(Frame& F, int l, int c) {
    PHASE_IDS(F);
    const int tid = F.tid;
    const size_t row0 = (size_t)c * 64;
    const bool prompt = c < 256; const int b = c - 256;
    bf16_t* const proj = F_PROJ;
    LAS float* inT = (LAS float*)F.lds;
    LAS bf16_t* kx = (LAS bf16_t*)(F.lds + 256 * 68 * 4);
    LAS bf16_t* Kt = (LAS bf16_t*)(F.lds + ACT_KT); LAS bf16_t* Vt = (LAS bf16_t*)(F.lds + ACT_VT); LAS float* Lm = (LAS float*)(F.lds + ACT_LM);
    LAS float* scl = (LAS float*)(F.lds + ACT_SCL); LAS float* gcl = (LAS float*)(F.lds + ACT_GCL);
    for (int e = tid; e < 64 * 16; e += 512) {
        const int t = e >> 4, q = e & 15;
        float* p = F_SCAL + (row0 + t) * 16 + q;
        const float v = *p; float r;
        if (q < 4) r = -__expf(INP(I_GALOG)[l * 4 + q]) * softplusf_(v + INP(I_GDTB)[l * 4 + q]);
        else if (q < 8) r = sigmoidf_(v);
        else r = softplusf_(v + INP(I_SDTB)[l * 8 + (q - 8)]);
        *p = r; scl[e] = r;
    }
    LDS_BARRIER();
    {
        const int w = F.wave, lane = F.lane;
        float v = scl[lane * 16 + 8 + w] * (-__expf(INP(I_SALOG)[l * 8 + w]));
#pragma unroll
        for (int o = 1; o < 64; o <<= 1) { const float tt = __shfl_up(v, o); if (lane >= o) v += tt; }
        F_ACUM[(row0 + lane) * 8 + w] = v;
        if (w < 4) {
            float gv = scl[lane * 16 + w];
#pragma unroll
            for (int o = 1; o < 64; o <<= 1) { const float tt = __shfl_up(gv, o); if (lane >= o) gv += tt; }
            F_GCUM[(row0 + lane) * 4 + w] = gv; gcl[w * 64 + lane] = gv;
        }
    }
    {
        const int cg = tid % 224, rh = tid / 224;
        const bool active = tid < 448;
        const int col = 1024 + cg * 8, t0 = 32 * rh;
        const bool gdn = cg < 96;
        const int cc = gdn ? (col - PC_GQ) : (col - PC_SX);
        const int C = gdn ? 768 : 1024;
        const int kind = gdn ? (cg >> 5) : 3;
        float w[4][8], bias[8], p3[8], p2[8], p1[8];
        u32x4 xr[16];
        if (active) {
            const float* cw = gdn ? INP(I_GCONVW) + (size_t)l * 4 * 768 : INP(I_SCONVW) + (size_t)l * 4 * 1024;
#pragma unroll
            for (int j = 0; j < 4; ++j)
#pragma unroll
                for (int i = 0; i < 8; ++i) w[j][i] = cw[j * C + cc + i];
#pragma unroll
            for (int i = 0; i < 8; ++i) bias[i] = gdn ? 0.f : INP(I_SCONVB)[l * 1024 + cc + i];
            if (rh == 1) {
                unpack8(*(const u32x4*)(proj + (row0 + t0 - 3) * PW + col), p3); unpack8(*(const u32x4*)(proj + (row0 + t0 - 2) * PW + col), p2); unpack8(*(const u32x4*)(proj + (row0 + t0 - 1) * PW + col), p1);
            } else if (prompt) {
                if (c == 0) {
#pragma unroll
                    for (int i = 0; i < 8; ++i) { p3[i] = 0.f; p2[i] = 0.f; p1[i] = 0.f; }
                } else {
                    const bf16_t* hp = F_HCONV + (size_t)(c - 1) * 3 * 1792 + (col - 1024);
                    unpack8(*(const u32x4*)(hp), p3); unpack8(*(const u32x4*)(hp + 1792), p2); unpack8(*(const u32x4*)(hp + 2 * 1792), p1);
                }
            } else {
                const float* st = gdn ? INP(I_SGDNC) + ((size_t)l * 32 + b) * 3 * 768 + cc : INP(I_SSSMC) + ((size_t)l * 32 + b) * 3 * 1024 + cc;
#pragma unroll
                for (int i = 0; i < 8; ++i) { p3[i] = st[i]; p2[i] = st[C + i]; p1[i] = st[2 * C + i]; }
            }
#pragma unroll
            for (int t = 0; t < 16; ++t) xr[t] = *(const u32x4*)(proj + (row0 + t0 + t) * PW + col);
        }
        asm volatile("s_waitcnt vmcnt(0)" ::: "memory");
        LDS_BARRIER();
#pragma unroll
        for (int bt = 0; bt < 2; ++bt) {
            if (active) {
#pragma unroll
                for (int t = 0; t < 16; ++t) {
                    const int tr = t0 + 16 * bt + t;
                    bf16_t* p = proj + (row0 + tr) * PW + col;
                    float x[8], y[8];
                    unpack8(xr[t], x);
#pragma unroll
                    for (int i = 0; i < 8; ++i) { float a = w[0][i] * p3[i] + w[1][i] * p2[i] + w[2][i] * p1[i] + w[3][i] * x[i] + bias[i]; y[i] = siluf_(a); p3[i] = p2[i]; p2[i] = p1[i]; p1[i] = x[i]; }
                    if (kind < 2) {
                        float ss = 0.f;
#pragma unroll
                        for (int i = 0; i < 8; ++i) ss += y[i] * y[i];
                        ss += __shfl_xor(ss, 1); ss += __shfl_xor(ss, 2); ss += __shfl_xor(ss, 4);
                        const float sc = rsqrtf(ss + EPS) * (kind == 0 ? 0.125f : 1.f);
#pragma unroll
                        for (int i = 0; i < 8; ++i) y[i] *= sc;
                    }
                    const u32x4 pk = pack8(y);
                    if (kind != 2) *(u32x4*)p = pk;
                    if (kind == 1) *(LAS u32x4*)(Kt + tr * ACT_LDK + (col - PC_GK)) = pk;
                    if (kind == 2) *(LAS u32x4*)(Vt + tr * ACT_LDK + (col - PC_GV)) = pk;
                }
                if (bt == 0) {
#pragma unroll
                    for (int t = 0; t < 16; ++t) xr[t] = *(const u32x4*)(proj + (row0 + t0 + 16 + t) * PW + col);
                }
            }
        }
    }
    LDS_BARRIER();
    {
        const int w = F.wave, lane = F.lane, i16 = lane & 15, g = lane >> 4, h = w >> 1, e = w & 1;
        LAS float* Lh = Lm + h * 64 * ACT_LDL;
#pragma unroll
        for (int ii = 0; ii < 2; ++ii) {
            const int it = e + 2 * ii;
#pragma unroll
            for (int jt = 0; jt < 4; ++jt) {
                if (jt <= it) {
                    f32x4 acc = (f32x4){0.f, 0.f, 0.f, 0.f};
#pragma unroll
                    for (int ks = 0; ks < 2; ++ks) acc = mma16(frag_nat(Kt, ACT_LDK, 16 * it, h * 64 + 32 * ks, i16, g), frag_nat(Kt, ACT_LDK, 16 * jt, h * 64 + 32 * ks, i16, g), acc);
                    const int j = 16 * jt + i16; const float gcj = gcl[h * 64 + j];
#pragma unroll
                    for (int r = 0; r < 4; ++r) { const int i = 16 * it + 4 * g + r;
                        const float f = (j < i) ? scl[i * 16 + 4 + h] * __expf(fminf(gcl[h * 64 + i] - gcj, 0.f)) : 0.f;
                        Lh[i * ACT_LDL + j] = acc[r] * f; }
                }
            }
        }
        LDS_BARRIER();
        float x[64];
        const LAS bf16_t* Rt = opaque_lds((e == 0 ? Vt : Kt) + h * 64 + lane); const float ef = (float)e;
        const LAS float* Lo = opaque_lds(Lh); const LAS float* sclo = opaque_lds(scl + 4 + h); const LAS float* gclo = opaque_lds(gcl + h * 64);
        tri_solve64<ACT_LDL, -1>(Lo, x, [&](int i) { return sclo[i * 16] * __expf(gclo[i] * ef) * bf2f(Rt[i * ACT_LDK]); });
        if (e == 0) {
            bf16_t* o = proj + (row0 + lane) * PW + PC_GV + h * 64;
#pragma unroll
            for (int q = 0; q < 8; ++q) { float y[8];
#pragma unroll
                for (int i = 0; i < 8; ++i) y[i] = x[8 * q + i];
                *(u32x4*)(o + 8 * q) = pack8(y); }
        } else {
            bf16_t* o = F_GW + (((size_t)c * 4 + h) * 64) * 64 + lane;
#pragma unroll
            for (int i = 0; i < 64; ++i) o[i * 64] = f2bf(-x[i]);
        }
    }
    publish_item((unsigned*)(F.ws + WS_CTL) + CW_AFLAG + c);
    LDS_BARRIER();
}

__device__ __forceinline__ void st8_wt(void* p, u32x2 v) { __hip_atomic_store((unsigned long long*)p, __builtin_bit_cast(unsigned long long, v), __ATOMIC_RELAXED, __HIP_MEMORY_SCOPE_AGENT); }
__device__ __forceinline__ u32x4 ld16_asm(const void* p) { u32x4 r; asm volatile("global_load_dwordx4 %0, %1, off sc1" : "=v"(r) : "v"(p)); return r; }
__device__ __forceinline__ float ld4_asm(const float* p) { float r; asm volatile("global_load_dword %0, %1, off sc1" : "=v"(r) : "v"(p)); return r; }
constexpr int RDY_SLACK = 8;
#define RDY_WORD(F) ((volatile LAS int*)((F).lds + MISC_OFF + 64))
__device__ __forceinline__ int rdy_advance(const unsigned* rdy, int rstride, unsigned rneed, int nxt, int nch, int lane) {
    const int k = nxt + (lane & 15);
    const bool ok = k < nch && (int)(__hip_atomic_load(rdy + (size_t)rstride * k, __ATOMIC_RELAXED, __HIP_MEMORY_SCOPE_AGENT) - rneed) >= 0;
    const unsigned long long m = __ballot(ok) & 0xffffull;
    return nxt + __builtin_ctzll(~m);
}
__device__ __forceinline__ int rdy_block(Frame& F, const unsigned* rdy, int rstride, unsigned rneed, int nxt, int upto, int nch) {
    unsigned sp = 0;
    while (nxt < upto && ++sp < 4000000u) { const int n2 = rdy_advance(rdy, rstride, rneed, nxt, nch, F.lane); if (n2 == nxt) __builtin_amdgcn_s_sleep(8); nxt = n2; }
    if (F.lane == 0) *RDY_WORD(F) = nxt - 1;
    return nxt;
}
#define RDY_LOADER_WAIT(F, k) do { const int kk_ = (k) < nch ? (k) : nch - 1; unsigned sp_ = 0; while (*RDY_WORD(F) < kk_ && ++sp_ < 40000000u) __builtin_amdgcn_s_sleep(1); } while (0)
#define SCAN_CL(k) (c0 + ((k) < nch ? (k) : nch - 1))
#define SCAN_LOADER6(LOADM, WRITEM, WAITM, NLD) do {            \
        RDY_LOADER_WAIT(F, 0); LOADM(SCAN_CL(0), 0); WAITM(0, 0); WRITEM(0, 0); \
        RDY_LOADER_WAIT(F, 1); LOADM(SCAN_CL(1), 1); RDY_LOADER_WAIT(F, 2); LOADM(SCAN_CL(2), 2); RDY_LOADER_WAIT(F, 3); LOADM(SCAN_CL(3), 3); RDY_LOADER_WAIT(F, 4); LOADM(SCAN_CL(4), 4); RDY_LOADER_WAIT(F, 5); LOADM(SCAN_CL(5), 5); \
        LDS_BARRIER(); \
        for (int r_ = 0; r_ < nch; r_ += 6) { \
            RDY_LOADER_WAIT(F, r_ + 6); LOADM(SCAN_CL(r_ + 6), 0); WAITM(1, 5 * (NLD)); WRITEM(1, 1); LDS_BARRIER(); if (r_ + 1 >= nch) break; \
            RDY_LOADER_WAIT(F, r_ + 7); LOADM(SCAN_CL(r_ + 7), 1); WAITM(2, 5 * (NLD)); WRITEM(0, 2); LDS_BARRIER(); if (r_ + 2 >= nch) break; \
            RDY_LOADER_WAIT(F, r_ + 8); LOADM(SCAN_CL(r_ + 8), 2); WAITM(3, 5 * (NLD)); WRITEM(1, 3); LDS_BARRIER(); if (r_ + 3 >= nch) break; \
            RDY_LOADER_WAIT(F, r_ + 9); LOADM(SCAN_CL(r_ + 9), 3); WAITM(4, 5 * (NLD)); WRITEM(0, 4); LDS_BARRIER(); if (r_ + 4 >= nch) break; \
            RDY_LOADER_WAIT(F, r_ + 10); LOADM(SCAN_CL(r_ + 10), 4); WAITM(5, 5 * (NLD)); WRITEM(1, 5); LDS_BARRIER(); if (r_ + 5 >= nch) break; \
            RDY_LOADER_WAIT(F, r_ + 11); LOADM(SCAN_CL(r_ + 11), 5); WAITM(0, 5 * (NLD)); WRITEM(0, 0); LDS_BARRIER(); \
        } \
        asm volatile("s_waitcnt vmcnt(0)" ::: "memory"); \
        } while (0)
#define SCAN_LOADER(LOADM, WRITEM, WAITM, NLD) do { \
          \
          \
        RDY_LOADER_WAIT(F, 0); LOADM(SCAN_CL(0), 0); WAITM(0, 0); WRITEM(0, 0); \
        RDY_LOADER_WAIT(F, 1); LOADM(SCAN_CL(1), 1); RDY_LOADER_WAIT(F, 2); LOADM(SCAN_CL(2), 2); RDY_LOADER_WAIT(F, 3); LOADM(SCAN_CL(3), 3); \
        LDS_BARRIER(); \
          \
        for (int r_ = 0; r_ < nch; r_ += 4) { \
            RDY_LOADER_WAIT(F, r_ + 4); LOADM(SCAN_CL(r_ + 4), 0); WAITM(1, 3 * (NLD)); WRITEM(1, 1); LDS_BARRIER(); if (r_ + 1 >= nch) break; \
            RDY_LOADER_WAIT(F, r_ + 5); LOADM(SCAN_CL(r_ + 5), 1); WAITM(2, 3 * (NLD)); WRITEM(0, 2); LDS_BARRIER(); if (r_ + 2 >= nch) break; \
            RDY_LOADER_WAIT(F, r_ + 6); LOADM(SCAN_CL(r_ + 6), 2); WAITM(3, 3 * (NLD)); WRITEM(1, 3); LDS_BARRIER(); if (r_ + 3 >= nch) break; \
            RDY_LOADER_WAIT(F, r_ + 7); LOADM(SCAN_CL(r_ + 7), 3); WAITM(0, 3 * (NLD)); WRITEM(0, 0); LDS_BARRIER(); \
        } \
        asm volatile("s_waitcnt vmcnt(0)" ::: "memory");      \
        } while (0)

constexpr int GDN_LD = 72;
constexpr int GDN_BUF = 3 * 64 * GDN_LD * 2 + 64;
__device__ __forceinline__ void scan_gdn2(Frame& F, int l, int s, int h, int vb, int ncw, unsigned* prog, unsigned pbase, unsigned* done, int pm, const unsigned* rdy, int rstride, unsigned rneed) {
    PHASE_IDS(F);
    const int tid = F.tid, lane = F.lane, w = F.wave, i16 = lane & 15, g = lane >> 4;
    const int nch = (s == 0) ? 256 : 1, c0 = (s == 0) ? 0 : 255 + s, b = s - 1;
    bf16_t* const proj = F_PROJ; bf16_t* const gw = F_GW; const float* const gcum = F_GCUM;
    {
        if (w == (ncw < 4 ? ncw : 0)) (void)rdy_block(F, rdy, rstride, rneed, 0, nch < RDY_SLACK ? nch : RDY_SLACK, nch);
        LDS_BARRIER();
    }
    if (w >= 4) {
        const int lt = tid - 256;
        const int umask = 128 * ncw - 1;
        u32x4 rw0[2], ru0[2], rk0[2], rw1[2], ru1[2], rk1[2], rw2[2], ru2[2], rk2[2], rw3[2], ru3[2], rk3[2], rw4[2], ru4[2], rk4[2], rw5[2], ru5[2], rk5[2]; float gc0[2], gl0, gc1[2], gl1, gc2[2], gl2, gc3[2], gl3, gc4[2], gl4, gc5[2], gl5;
        const bf16_t* pW[2]; const bf16_t* pU[2]; const bf16_t* pK[2]; const float* pG[2]; const float* const pGl = gcum + 63 * 4 + h;
#pragma unroll
        for (int q = 0; q < 2; ++q) { const int idx = q * 256 + lt, row = idx >> 3, col8 = (idx & 7) * 8, urow = vb + ((idx & umask) >> 3);
            pW[q] = gw + ((size_t)h * 64 + row) * 64 + col8; pU[q] = proj + (size_t)urow * PW + PC_GV + h * 64 + col8; pK[q] = proj + (size_t)row * PW + PC_GK + h * 64 + col8; pG[q] = gcum + row * 4 + h; }
#define GDN_LOAD(ch, S) do { const size_t oW_ = (size_t)(ch) * (4 * 4096), oP_ = (size_t)(ch) * (64 * PW), oG_ = (size_t)(ch) * 256; gl##S = ld4_asm(pGl + oG_); \
        _Pragma("unroll") for (int q = 0; q < 2; ++q) { rw##S[q] = ld16_asm(pW[q] + oW_); ru##S[q] = ld16_asm(pU[q] + oP_); rk##S[q] = ld16_asm(pK[q] + oP_); gc##S[q] = ld4_asm(pG[q] + oG_); } } while (0)
#define GDN_WAIT(S, N) asm volatile("s_waitcnt vmcnt(%9)" : "+v"(rw##S[0]), "+v"(rw##S[1]), "+v"(ru##S[0]), "+v"(ru##S[1]), "+v"(rk##S[0]), "+v"(rk##S[1]), "+v"(gc##S[0]), "+v"(gc##S[1]), "+v"(gl##S) : "n"(N))
#define GDN_WRITE(bb, S) do { LAS bf16_t* Wn_ = (LAS bf16_t*)(F.lds + (bb) * GDN_BUF); LAS bf16_t* Ut_ = Wn_ + 64 * GDN_LD; LAS bf16_t* Kd_ = Ut_ + 64 * GDN_LD; \
        _Pragma("unroll") for (int q = 0; q < 2; ++q) { const int idx = q * 256 + lt, row = idx >> 3, col8 = (idx & 7) * 8; \
            *(LAS u32x4*)(Wn_ + row * GDN_LD + col8) = rw##S[q]; *(LAS u32x4*)(Ut_ + (vb + ((idx & umask) >> 3)) * GDN_LD + col8) = ru##S[q]; \
            const float ks_ = __expf(gl##S - gc##S[q]); \
            float v_[8]; unpack8(rk##S[q], v_); _Pragma("unroll") for (int i = 0; i < 8; ++i) v_[i] *= ks_; *(LAS u32x4*)(Kd_ + row * GDN_LD + col8) = pack8(v_); } \
        if (lt == 0) *(LAS float*)(Kd_ + 64 * GDN_LD) = __expf(gl##S); } while (0)
        SCAN_LOADER6(GDN_LOAD, GDN_WRITE, GDN_WAIT, 9);
#undef GDN_LOAD
#undef GDN_WRITE
#undef GDN_WAIT
    } else if (w >= ncw) {
        int nxt = nch < RDY_SLACK ? nch : RDY_SLACK;
        LDS_BARRIER();
        for (int ci = 0; ci < nch; ++ci) {
            if (w == ncw && nxt < nch) { const int upto = ci + 1 + RDY_SLACK < nch ? ci + 1 + RDY_SLACK : nch; nxt = rdy_block(F, rdy, rstride, rneed, nxt, upto, nch); }
            LDS_BARRIER();
        }
    } else {
        const int n0 = vb + 16 * w;
        f32x4 S[4];
        if (s == 0) {
#pragma unroll
            for (int kt = 0; kt < 4; ++kt) S[kt] = (f32x4){0.f, 0.f, 0.f, 0.f};
        } else {
            const float* st = INP(I_SGDN) + (((size_t)l * 32 + b) * 4 + h) * 4096 + n0 + i16;
#pragma unroll
            for (int kt = 0; kt < 4; ++kt)
#pragma unroll
                for (int r = 0; r < 4; ++r) S[kt][r] = st[(16 * kt + 4 * g + r) * 64];
        }
        LDS_BARRIER();
        for (int ci = 0; ci < nch; ++ci) {
            const int chunk = c0 + ci; const size_t row0 = (size_t)chunk * 64;
            const LAS bf16_t* Wn = (const LAS bf16_t*)(F.lds + (ci & 1) * GDN_BUF); const LAS bf16_t* Ut = Wn + 64 * GDN_LD; const LAS bf16_t* Kd = Ut + 64 * GDN_LD;
            const float bd = *(const LAS float*)(Kd + 64 * GDN_LD);
            bf16x8 A1[4][2], A2[4][2]; u32x2 ui[4];
#pragma unroll
            for (int m = 0; m < 4; ++m) { ui[m] = *(const LAS u32x2*)(Ut + (n0 + i16) * GDN_LD + 16 * m + 4 * g);
#pragma unroll
                for (int ks = 0; ks < 2; ++ks) A1[m][ks] = frag_sig(Wn, GDN_LD, 16 * m, 32 * ks, i16, g); }
#pragma unroll
            for (int kt = 0; kt < 4; ++kt)
#pragma unroll
                for (int cs = 0; cs < 2; ++cs) A2[kt][cs] = frag_tr_sig(Kd, GDN_LD, 32 * cs, 16 * kt, i16, g);
            __builtin_amdgcn_sched_barrier(0);
            bf16x8 Sb[2];
#pragma unroll
            for (int ks = 0; ks < 2; ++ks) Sb[ks] = acc_frag(S[2 * ks], S[2 * ks + 1]);
            {
                bf16_t* ho = ((bf16_t*)((unsigned char*)F.out + (size_t)T * 256 * 2 * 4) + (size_t)(chunk) * 16384) + ((size_t)h * 64 + n0 + i16) * 64 + 4 * g;
#pragma unroll
                for (int kt = 0; kt < 4; ++kt) st8_wt(ho + 16 * kt, pack4(S[kt]));
            }
            f32x4 V[4];
            bf16_t* vo = proj + (row0 + n0 + i16) * PW + PC_GV + h * 64 + 4 * g;
#pragma unroll
            for (int m = 0; m < 4; ++m) {
                f32x4 acc = unpack4(ui[m]);
#pragma unroll
                for (int ks = 0; ks < 2; ++ks) acc = mma16(A1[m][ks], Sb[ks], acc);
                V[m] = acc;
            }
#pragma unroll
            for (int m = 0; m < 4; ++m) st8_wt(vo + 16 * m, pack4(V[m]));
            bf16x8 Ub[2];
#pragma unroll
            for (int cs = 0; cs < 2; ++cs) Ub[cs] = acc_frag(V[2 * cs], V[2 * cs + 1]);
#pragma unroll
            for (int kt = 0; kt < 4; ++kt) {
                f32x4 acc = S[kt] * bd;
#pragma unroll
                for (int cs = 0; cs < 2; ++cs) acc = mma16(A2[kt][cs], Ub[cs], acc);
                S[kt] = acc;
            }
            if (prog) {
                asm volatile("s_waitcnt vmcnt(48)" ::: "memory");
                if (lane == 0 && ci >= 6) __hip_atomic_store(prog + 64 * w, pbase + (unsigned)(ci - 6) + 1u, __ATOMIC_RELAXED, __HIP_MEMORY_SCOPE_AGENT);
            }
            LDS_BARRIER();
        }
        asm volatile("s_waitcnt vmcnt(0)" ::: "memory");
        if (prog && lane == 0) __hip_atomic_store(prog + 64 * w, pbase + (unsigned)nch, __ATOMIC_RELAXED, __HIP_MEMORY_SCOPE_AGENT);
        if (done && lane == 0) __hip_atomic_fetch_add(done, 1u, __ATOMIC_RELAXED, __HIP_MEMORY_SCOPE_AGENT);
        float* o = F.out + (s == 0 ? O_P_GDN + ((size_t)l * 4 + h) * 4096 : O_S_GDN + (((size_t)l * 32 + b) * 4 + h) * 4096) + n0 + i16;
#pragma unroll
        for (int kt = 0; kt < 4; ++kt)
#pragma unroll
            for (int r = 0; r < 4; ++r) o[(16 * kt + 4 * g + r) * 64] = S[kt][r];
    }
}
__device__ __forceinline__ void post_gdn(Frame& F, int l, int c, int hp) {
    PHASE_IDS(F);
    const int tid = F.tid, lane = F.lane, w = F.wave, i16 = lane & 15, g = lane >> 4;
    const size_t row0 = (size_t)c * 64;
    bf16_t* const proj = F_PROJ;
    constexpr int LQ = 136;
    LAS bf16_t* Qt = (LAS bf16_t*)F.lds; LAS bf16_t* Kt = Qt + 64 * LQ; LAS bf16_t* Ht = Kt + 64 * LQ; LAS bf16_t* Vn = Ht + 2 * 64 * GDN_LD; LAS float* gcs = (LAS float*)(Vn + 2 * 64 * GDN_LD);
    {
#pragma unroll
        for (int q = 0; q < 2; ++q) { const int idx = q * 512 + tid;
            { const int row = idx >> 4, col8 = (idx & 15) * 8;
              *(LAS u32x4*)(Qt + row * LQ + col8) = *(const u32x4*)(proj + (row0 + row) * PW + PC_GQ + hp * 128 + col8);
              *(LAS u32x4*)(Kt + row * LQ + col8) = *(const u32x4*)(proj + (row0 + row) * PW + PC_GK + hp * 128 + col8); }
            { const int hh = idx >> 9, row = (idx >> 3) & 63, col8 = (idx & 7) * 8;
              *(LAS u32x4*)(Ht + hh * 64 * GDN_LD + row * GDN_LD + col8) = *(const u32x4*)(((bf16_t*)((unsigned char*)F.out + (size_t)T * 256 * 2 * 4) + (size_t)(c) * 16384) + (((size_t)(2 * hp + hh) * 64) + row) * 64 + col8);
              *(LAS u32x4*)(Vn + hh * 64 * GDN_LD + row * GDN_LD + col8) = *(const u32x4*)(proj + (row0 + row) * PW + PC_GV + (2 * hp + hh) * 64 + col8); } }
        if (tid < 128) gcs[tid] = F_GCUM[(row0 + (tid & 63)) * 4 + 2 * hp + (tid >> 6)];
    }
    LDS_BARRIER();
    const int hh = w >> 2, it = w & 3, head = 2 * hp + hh;
    const LAS bf16_t* Hh = Ht + hh * 64 * GDN_LD; const LAS bf16_t* Vh = Vn + hh * 64 * GDN_LD;
    f32x4 AT[4];
    const float gci = gcs[hh * 64 + 16 * it + i16];
#pragma unroll
    for (int jt = 0; jt < 4; ++jt) {
        f32x4 acc = (f32x4){0.f, 0.f, 0.f, 0.f};
        if (jt <= it) {
#pragma unroll
            for (int ks = 0; ks < 2; ++ks) acc = mma16(frag_nat(Kt, LQ, 16 * jt, hh * 64 + 32 * ks, i16, g), frag_nat(Qt, LQ, 16 * it, hh * 64 + 32 * ks, i16, g), acc);
#pragma unroll
            for (int r = 0; r < 4; ++r) { const int j = 16 * jt + 4 * g + r, i = 16 * it + i16; acc[r] *= (j <= i) ? __expf(fminf(gci - gcs[hh * 64 + j], 0.f)) : 0.f; }
        }
        AT[jt] = acc;
    }
    f32x4 O[4]; float ss[4] = {0.f, 0.f, 0.f, 0.f};
#pragma unroll
    for (int vt = 0; vt < 4; ++vt) {
        f32x4 acc = (f32x4){0.f, 0.f, 0.f, 0.f};
#pragma unroll
        for (int ks = 0; ks < 2; ++ks) acc = mma16(frag_nat(Qt, LQ, 16 * it, hh * 64 + 32 * ks, i16, g), frag_nat(Hh, GDN_LD, 16 * vt, 32 * ks, i16, g), acc);
#pragma unroll
        for (int r = 0; r < 4; ++r) acc[r] *= __expf(gcs[hh * 64 + 16 * it + 4 * g + r]);
#pragma unroll
        for (int cs = 0; cs < 2; ++cs) if (2 * cs <= it) acc = mma16(acc_frag(AT[2 * cs], AT[2 * cs + 1]), frag_sig(Vh, GDN_LD, 16 * vt, 32 * cs, i16, g), acc);
        O[vt] = acc;
#pragma unroll
        for (int r = 0; r < 4; ++r) ss[r] += acc[r] * acc[r];
    }
#pragma unroll
    for (int r = 0; r < 4; ++r) { float t = ss[r]; t += __shfl_xor(t, 1); t += __shfl_xor(t, 2); t += __shfl_xor(t, 4); t += __shfl_xor(t, 8); ss[r] = rsqrtf(t * (1.f / 64.f) + EPS); }
#pragma unroll
    for (int vt = 0; vt < 4; ++vt) { const int v = 16 * vt + i16; const float nw = INP(I_GNORMW)[l * 64 + v];
#pragma unroll
        for (int r = 0; r < 4; ++r) { bf16_t* p = proj + (row0 + 16 * it + 4 * g + r) * PW + PC_ZG + head * 64 + v; *p = f2bf(O[vt][r] * ss[r] * nw * siluf_(bf2f(*p))); } }
    LDS_BARRIER();
}

constexpr int RW_LD = 72;
constexpr int RW_XD = 0, RW_XA = 9216, RW_WD = 18432, RW_WA = 27648, RW_RT = 36864, RW_KX = 46080, RW_VT = 55296, RW_XG = 64512, RW_WG = 81920, RW_EX = 100352;
constexpr int RW_L = 64512, RW_P = 81920;
struct RwkvTok { float cum[2][4], lw[2][4], iclr[2][4], kk[2][4], kp[2][4], kraw[2][4], c63[2], w0[2], a0[2], kkw[2], kaw[2]; };
template <bool POST>
__device__ __forceinline__ void rwkv_tokens(Frame& F, int l, int c, int h, RwkvTok& o, f32x4 (&Zg)[2]) {
    const int tid = F.tid, lane = F.lane, w = F.wave, i16 = lane & 15, g = lane >> 4, tt = w & 3, jh = w >> 2;
    const size_t row0 = (size_t)c * 64;
    bf16_t* const proj = F_PROJ;
    LAS bf16_t* Xd = (LAS bf16_t*)(F.lds + RW_XD); LAS bf16_t* Xa = (LAS bf16_t*)(F.lds + RW_XA); LAS bf16_t* Wd = (LAS bf16_t*)(F.lds + RW_WD); LAS bf16_t* Wa = (LAS bf16_t*)(F.lds + RW_WA);
    LAS bf16_t* Rt = (LAS bf16_t*)(F.lds + RW_RT); LAS bf16_t* Kx = (LAS bf16_t*)(F.lds + RW_KX); LAS bf16_t* Vt = (LAS bf16_t*)(F.lds + RW_VT);
    LAS bf16_t* Xg = (LAS bf16_t*)(F.lds + RW_XG); LAS bf16_t* Wg = (LAS bf16_t*)(F.lds + RW_WG);
    LAS float* ksq = (LAS float*)(F.lds + RW_EX); LAS float* ctot = ksq + 128;
    const int lt0 = (tid >> 5) * 4, lo8 = (tid & 31) * 8;
    const int wi = tid >> 3, wj8 = (tid & 7) * 8;
    const int rt = tid >> 3, rd8 = (tid & 7) * 8;
    u32x4 lx[4], lprev_b = (u32x4){0u, 0u, 0u, 0u}; f32x4 lprev_f[2], lmu[2];
    f32x4 wdv[2], wav[2], wgv[4];
    u32x4 rx[3], rpv_b[3]; f32x4 rpv_f[3][2], rmu[3][2];
    const bool smp = c >= 256;
    {
        const float* mup = INP(I_RMU) + l * 1024;
        const float* stp = INP(I_SSHIFT) + ((size_t)l * 32 + (smp ? c - 256 : 0)) * 1024;
        const int col = PC_RL + lo8;
        lmu[0] = *(const f32x4*)(mup + 768 + lo8); lmu[1] = *(const f32x4*)(mup + 768 + lo8 + 4);
        if (lt0 > 0) lprev_b = *(const u32x4*)(proj + (row0 + lt0 - 1) * PW + col);
        else if (!smp) { if (c > 0) lprev_b = *(const u32x4*)(F_HSHIFT + (size_t)(c - 1) * 1024 + 768 + lo8); }
        else { lprev_f[0] = *(const f32x4*)(stp + 768 + lo8); lprev_f[1] = *(const f32x4*)(stp + 768 + lo8 + 4); }
#pragma unroll
        for (int q = 0; q < 4; ++q) lx[q] = *(const u32x4*)(proj + (row0 + lt0 + q) * PW + col);
        { const float* p = INP(I_RWUP) + ((size_t)l * 64 + wi) * 256 + h * 64 + wj8; wdv[0] = *(const f32x4*)p; wdv[1] = *(const f32x4*)(p + 4); }
        { const float* p = INP(I_RAUP) + ((size_t)l * 64 + wi) * 256 + h * 64 + wj8; wav[0] = *(const f32x4*)p; wav[1] = *(const f32x4*)(p + 4); }
        if (POST) {
#pragma unroll
            for (int q2 = 0; q2 < 2; ++q2) { const float* p = INP(I_RGUP) + ((size_t)l * 128 + wi + 64 * q2) * 256 + h * 64 + wj8; wgv[2 * q2] = *(const f32x4*)p; wgv[2 * q2 + 1] = *(const f32x4*)(p + 4); }
        }
#pragma unroll
        for (int which = 0; which < 3; ++which) {
            const int pcol = (which == 0 ? PC_R : (which == 1 ? PC_RK : PC_RV)) + h * 64 + rd8, oc = which * 256 + h * 64 + rd8;
            const bf16_t* p = proj + (row0 + rt) * PW + pcol;
            rx[which] = *(const u32x4*)p;
            if (!POST) {
                rmu[which][0] = *(const f32x4*)(mup + oc); rmu[which][1] = *(const f32x4*)(mup + oc + 4);
                rpv_b[which] = (u32x4){0u, 0u, 0u, 0u};
                if (rt > 0) rpv_b[which] = *(const u32x4*)(p - PW);
                else if (!smp) { if (c > 0) rpv_b[which] = *(const u32x4*)(F_HSHIFT + (size_t)(c - 1) * 1024 + oc); }
                else { rpv_f[which][0] = *(const f32x4*)(stp + oc); rpv_f[which][1] = *(const f32x4*)(stp + oc + 4); }
            }
        }
#pragma unroll
        for (int q = 0; q < 2; ++q) { const int jc = l * 256 + h * 64 + 16 * (2 * jh + q) + i16;
            o.w0[q] = INP(I_RW0)[jc]; o.a0[q] = INP(I_RA0)[jc]; o.kkw[q] = INP(I_RKK)[jc]; o.kaw[q] = INP(I_RKA)[jc]; }
    }
    {
        float prev[8], mu[8] = {lmu[0][0], lmu[0][1], lmu[0][2], lmu[0][3], lmu[1][0], lmu[1][1], lmu[1][2], lmu[1][3]};
        if (lt0 == 0 && smp) { prev[0] = lprev_f[0][0]; prev[1] = lprev_f[0][1]; prev[2] = lprev_f[0][2]; prev[3] = lprev_f[0][3]; prev[4] = lprev_f[1][0]; prev[5] = lprev_f[1][1]; prev[6] = lprev_f[1][2]; prev[7] = lprev_f[1][3]; }
        else unpack8(lprev_b, prev);
#pragma unroll
        for (int q = 0; q < 4; ++q) {
            float x[8], y[8]; unpack8(lx[q], x);
#pragma unroll
            for (int i = 0; i < 8; ++i) { const float v = x[i] + (prev[i] - x[i]) * mu[i]; prev[i] = x[i]; y[i] = (lo8 < 64) ? tanhf_(v) : (lo8 >= 128 ? sigmoidf_(v) : v); }
            const u32x4 pk = pack8(y);
            if (lo8 < 64) *(LAS u32x4*)(Xd + (lt0 + q) * RW_LD + lo8) = pk;
            else if (lo8 < 128) *(LAS u32x4*)(Xa + (lt0 + q) * RW_LD + (lo8 - 64)) = pk;
            else if (POST) *(LAS u32x4*)(Xg + (lt0 + q) * 136 + (lo8 - 128)) = pk;
        }
        { const float v[8] = {wdv[0][0], wdv[0][1], wdv[0][2], wdv[0][3], wdv[1][0], wdv[1][1], wdv[1][2], wdv[1][3]}; *(LAS u32x4*)(Wd + wi * RW_LD + wj8) = pack8(v); }
        { const float v[8] = {wav[0][0], wav[0][1], wav[0][2], wav[0][3], wav[1][0], wav[1][1], wav[1][2], wav[1][3]}; *(LAS u32x4*)(Wa + wi * RW_LD + wj8) = pack8(v); }
        if (POST) {
#pragma unroll
            for (int q2 = 0; q2 < 2; ++q2) { const float v[8] = {wgv[2 * q2][0], wgv[2 * q2][1], wgv[2 * q2][2], wgv[2 * q2][3], wgv[2 * q2 + 1][0], wgv[2 * q2 + 1][1], wgv[2 * q2 + 1][2], wgv[2 * q2 + 1][3]};
                *(LAS u32x4*)(Wg + (wi + 64 * q2) * RW_LD + wj8) = pack8(v); }
        }
        u32x4 pk3[3];
#pragma unroll
        for (int which = 0; which < 3; ++which) {
            LAS bf16_t* dst = (which == 0 ? Rt : (which == 1 ? Kx : Vt)) + rt * RW_LD + rd8;
            if (POST) *(LAS u32x4*)dst = rx[which];
            else {
                float x[8], pv[8], y[8];
                unpack8(rx[which], x);
                if (rt == 0 && smp) { pv[0] = rpv_f[which][0][0]; pv[1] = rpv_f[which][0][1]; pv[2] = rpv_f[which][0][2]; pv[3] = rpv_f[which][0][3]; pv[4] = rpv_f[which][1][0]; pv[5] = rpv_f[which][1][1]; pv[6] = rpv_f[which][1][2]; pv[7] = rpv_f[which][1][3]; }
                else unpack8(rpv_b[which], pv);
#pragma unroll
                for (int i = 0; i < 8; ++i) y[i] = x[i] + (pv[i] - x[i]) * rmu[which][i >> 2][i & 3];
                pk3[which] = pack8(y);
                *(LAS u32x4*)dst = pk3[which];
            }
        }
        if (!POST) {
            LDS_BARRIER();
#pragma unroll
            for (int which = 0; which < 3; ++which) *(u32x4*)(proj + (row0 + rt) * PW + (which == 0 ? PC_R : (which == 1 ? PC_RK : PC_RV)) + h * 64 + rd8) = pk3[which];
        }
    }
    LDS_BARRIER();
    f32x4 Zd[2], Za[2];
#pragma unroll
    for (int q = 0; q < 2; ++q) {
        const int jt = 2 * jh + q;
        f32x4 a = (f32x4){0.f, 0.f, 0.f, 0.f}, bq = a, cq = a;
#pragma unroll
        for (int ks = 0; ks < 2; ++ks) {
            a = mma16(frag_nat(Xd, RW_LD, 16 * tt, 32 * ks, i16, g), frag_tr_nat(Wd, RW_LD, 32 * ks, 16 * jt, i16, g), a);
            bq = mma16(frag_nat(Xa, RW_LD, 16 * tt, 32 * ks, i16, g), frag_tr_nat(Wa, RW_LD, 32 * ks, 16 * jt, i16, g), bq);
        }
        if (POST) {
#pragma unroll
            for (int ks = 0; ks < 4; ++ks) cq = mma16(frag_nat(Xg, 136, 16 * tt, 32 * ks, i16, g), frag_tr_nat(Wg, RW_LD, 32 * ks, 16 * jt, i16, g), cq);
        }
        Zd[q] = a; Za[q] = bq; Zg[q] = cq;
    }
    float ksum[4] = {0.f, 0.f, 0.f, 0.f}, csum[2];
#pragma unroll
    for (int q = 0; q < 2; ++q) {
        const int j = 16 * (2 * jh + q) + i16, jc = l * 256 + h * 64 + j;
        const float w0 = o.w0[q], a0 = o.a0[q], kkw = o.kkw[q];
        float run = 0.f;
#pragma unroll
        for (int r = 0; r < 4; ++r) {
            const int t = 16 * tt + 4 * g + r;
            const float wl = -softplusf_(-(w0 + Zd[q][r])) - 0.5f;
            const float lw = -__expf(wl);
            o.lw[q][r] = lw; run += lw; o.cum[q][r] = run;
            o.iclr[q][r] = sigmoidf_(a0 + Za[q][r]);
            const float kr = bf2f(Kx[t * RW_LD + j]); o.kraw[q][r] = kr;
            const float kq = kr * kkw; o.kk[q][r] = kq; ksum[r] += kq * kq;
        }
        float tot = run;
        const float u1 = __shfl_up(tot, 16); if (g >= 1) tot += u1;
        const float u2 = __shfl_up(tot, 32); if (g >= 2) tot += u2;
        const float excl = tot - run;
#pragma unroll
        for (int r = 0; r < 4; ++r) o.cum[q][r] += excl;
        csum[q] = __shfl(tot, 48 + i16);
        if (g == 0) ctot[tt * 64 + j] = csum[q];
    }
#pragma unroll
    for (int r = 0; r < 4; ++r) { float s = ksum[r]; s += __shfl_xor(s, 1); s += __shfl_xor(s, 2); s += __shfl_xor(s, 4); s += __shfl_xor(s, 8); ksum[r] = s; }
    if (i16 == 0) {
#pragma unroll
        for (int r = 0; r < 4; ++r) ksq[jh * 64 + 16 * tt + 4 * g + r] = ksum[r];
    }
    LDS_BARRIER();
#pragma unroll
    for (int q = 0; q < 2; ++q) {
        const int j = 16 * (2 * jh + q) + i16, jc = l * 256 + h * 64 + j;
        const float kaw = o.kaw[q];
        float pre = 0.f, all = 0.f;
#pragma unroll
        for (int t4 = 0; t4 < 4; ++t4) { const float v = ctot[t4 * 64 + j]; all += v; if (t4 < tt) pre += v; }
        o.c63[q] = all;
#pragma unroll
        for (int r = 0; r < 4; ++r) {
            const int t = 16 * tt + 4 * g + r;
            o.cum[q][r] += pre;
            const float kn = rsqrtf(ksq[t] + ksq[64 + t] + EPS);
            o.kk[q][r] *= kn;
            o.kp[q][r] = o.kraw[q][r] * (1.f + (o.iclr[q][r] - 1.f) * kaw);
        }
    }
}
__device__ __forceinline__ void prep_rwkv(Frame& F, int l, int c, int h) {
    PHASE_IDS(F);
    const int lane = F.lane, w = F.wave, i16 = lane & 15, g = lane >> 4, tt = w & 3, jh = w >> 2;
    RwkvTok tk; f32x4 Zg[2];
    rwkv_tokens<false>(F, l, c, h, tk, Zg);
    LAS bf16_t* At = (LAS bf16_t*)(F.lds + RW_XD); LAS bf16_t* Bt = (LAS bf16_t*)(F.lds + RW_XA); LAS bf16_t* Kt = (LAS bf16_t*)(F.lds + RW_WD); LAS bf16_t* Kh = (LAS bf16_t*)(F.lds + RW_WA);
    LAS bf16_t* Vt = (LAS bf16_t*)(F.lds + RW_VT); LAS float* Lm = (LAS float*)(F.lds + RW_L); LAS float* Pm = (LAS float*)(F.lds + RW_P);
    bf16_t* const bh = F_RBH + (((size_t)c * 4 + h) * 64) * 64;
    LDS_BARRIER();
#pragma unroll
    for (int q = 0; q < 2; ++q) {
        const int j = 16 * (2 * jh + q) + i16;
#pragma unroll
        for (int r = 0; r < 4; ++r) {
            const int t = 16 * tt + 4 * g + r;
            const float cum = tk.cum[q][r], b = tk.kk[q][r] * tk.iclr[q][r], einv = __expf(-cum), elast = __expf(tk.c63[q] - cum);
            At[t * RW_LD + j] = f2bf(-tk.kk[q][r] * __expf(cum - tk.lw[q][r]));
            Bt[t * RW_LD + j] = f2bf(b * einv);
            Kt[t * RW_LD + j] = f2bf(tk.kp[q][r] * einv);
            Kh[t * RW_LD + j] = f2bf(tk.kp[q][r] * elast);
            bh[t * 64 + j] = f2bf(b * elast);
        }
        if (tt == 0 && g == 0) F_RDV[((size_t)c * 4 + h) * 64 + j] = __expf(tk.c63[q]);
    }
    LDS_BARRIER();
    if (jh == 0) {
#pragma unroll
        for (int st = 0; st < 4; ++st) if (st <= tt) {
            f32x4 acc = (f32x4){0.f, 0.f, 0.f, 0.f};
#pragma unroll
            for (int ks = 0; ks < 2; ++ks) acc = mma16(frag_nat(At, RW_LD, 16 * tt, 32 * ks, i16, g), frag_nat(Bt, RW_LD, 16 * st, 32 * ks, i16, g), acc);
#pragma unroll
            for (int r = 0; r < 4; ++r) { const int t = 16 * tt + 4 * g + r, s = 16 * st + i16; Lm[t * 68 + s] = (s < t) ? acc[r] : 0.f; }
        }
    }
    {
        f32x4 AK[4];
#pragma unroll
        for (int st = 0; st < 4; ++st) {
            f32x4 acc = (f32x4){0.f, 0.f, 0.f, 0.f};
            if (st <= tt) {
#pragma unroll
                for (int ks = 0; ks < 2; ++ks) acc = mma16(frag_nat(Kt, RW_LD, 16 * st, 32 * ks, i16, g), frag_nat(At, RW_LD, 16 * tt, 32 * ks, i16, g), acc);
#pragma unroll
                for (int r = 0; r < 4; ++r) { const int s = 16 * st + 4 * g + r, t = 16 * tt + i16; if (!(s < t)) acc[r] = 0.f; }
            }
            AK[st] = acc;
        }
#pragma unroll
        for (int q = 0; q < 2; ++q) {
            const int vt = 2 * jh + q;
            f32x4 acc = (f32x4){0.f, 0.f, 0.f, 0.f};
#pragma unroll
            for (int cs = 0; cs < 2; ++cs) if (2 * cs <= tt) acc = mma16(acc_frag(AK[2 * cs], AK[2 * cs + 1]), frag_tr_sig(Vt, RW_LD, 32 * cs, 16 * vt, i16, g), acc);
#pragma unroll
            for (int r = 0; r < 4; ++r) Pm[(16 * tt + 4 * g + r) * 68 + 16 * vt + i16] = acc[r];
            f32x4 kv = (f32x4){0.f, 0.f, 0.f, 0.f};
#pragma unroll
            for (int cs = 0; cs < 2; ++cs) kv = mma16(frag_tr_nat(Kh, RW_LD, 32 * cs, 16 * tt, i16, g), frag_tr_nat(Vt, RW_LD, 32 * cs, 16 * vt, i16, g), kv);
            *(u32x2*)(F_RKV + ((((size_t)c * 4 + h) * 64) + 16 * vt + i16) * 64 + 16 * tt + 4 * g) = pack4(kv);
        }
    }
    LDS_BARRIER();
    if (w < 2) {
        float x[64];
        const float ef = (float)w;
        const LAS float* Lo = opaque_lds(Lm); const LAS float* Po = opaque_lds(Pm + lane); const LAS bf16_t* Ao = opaque_lds(At + lane);
        tri_solve64<68, 1>(Lo, x, [&](int i) { return Po[i * 68] * (1.f - ef) + bf2f(Ao[i * RW_LD]) * ef; });
        if (w == 0) {
            bf16_t* o = F_RU + ((((size_t)c * 4 + h) * 64) + lane) * 64;
#pragma unroll
            for (int q = 0; q < 8; ++q) { float y[8];
#pragma unroll
                for (int i = 0; i < 8; ++i) y[i] = x[8 * q + i];
                *(u32x4*)(o + 8 * q) = pack8(y); }
        } else {
            bf16_t* o = F_RWA + (((size_t)c * 4 + h) * 64) * 64 + lane;
#pragma unroll
            for (int i = 0; i < 64; ++i) o[i * 64] = f2bf(x[i]);
        }
    }
    publish_item((unsigned*)(F.ws + WS_CTL) + CW_RFLAG + 4 * c + h);
    LDS_BARRIER();
}
constexpr int RWS_BUF = 4 * 64 * GDN_LD * 2 + 256;
__device__ __forceinline__ void scan_rwkv2(Frame& F, int l, int s, int h, int vb, int ncw, unsigned* prog, unsigned pbase, unsigned* done, int pm, const unsigned* rdy, int rstride, unsigned rneed) {
    PHASE_IDS(F);
    const int tid = F.tid, lane = F.lane, w = F.wave, i16 = lane & 15, g = lane >> 4;
    const int nch = (s == 0) ? 256 : 1, c0 = (s == 0) ? 0 : 255 + s, b = s - 1;
    const bf16_t* const rwa = F_RWA; bf16_t* const ru = F_RU; const bf16_t* const rbh = F_RBH; const bf16_t* const rkv = F_RKV; const float* const rdv = F_RDV;
    {
        if (w == (ncw < 4 ? ncw : 0)) (void)rdy_block(F, rdy, rstride, rneed, 0, nch < RDY_SLACK ? nch : RDY_SLACK, nch);
        LDS_BARRIER();
    }
    if (w >= 4) {
        const int lt = tid - 256;
        const int umask = 128 * ncw - 1;
        u32x4 r10[2], r20[2], r30[2], r40[2], r11[2], r21[2], r31[2], r41[2], r12[2], r22[2], r32[2], r42[2], r13[2], r23[2], r33[2], r43[2], r14[2], r24[2], r34[2], r44[2], r15[2], r25[2], r35[2], r45[2]; float dv0 = 0.f, dv1 = 0.f, dv2 = 0.f, dv3 = 0.f, dv4 = 0.f, dv5 = 0.f;
        const bf16_t* p1[2]; const bf16_t* p2[2]; const bf16_t* p3[2]; const bf16_t* p4[2]; const float* const pDv = rdv + h * 64 + (lt & 63);
#pragma unroll
        for (int q = 0; q < 2; ++q) { const int idx = q * 256 + lt, off = (idx >> 3) * 64 + (idx & 7) * 8, uoff = (vb + ((idx & umask) >> 3)) * 64 + (idx & 7) * 8;
            p1[q] = rwa + (size_t)h * 4096 + off; p2[q] = ru + (size_t)h * 4096 + uoff; p3[q] = rbh + (size_t)h * 4096 + off; p4[q] = rkv + (size_t)h * 4096 + uoff; }
#define RWS_LOAD(ch, S) do { const size_t o_ = (size_t)(ch) * (4 * 4096); dv##S = ld4_asm(pDv + (size_t)(ch) * 256); \
        _Pragma("unroll") for (int q = 0; q < 2; ++q) { r1##S[q] = ld16_asm(p1[q] + o_); r2##S[q] = ld16_asm(p2[q] + o_); r3##S[q] = ld16_asm(p3[q] + o_); r4##S[q] = ld16_asm(p4[q] + o_); } } while (0)
#define RWS_WAIT(S, N) asm volatile("s_waitcnt vmcnt(%9)" : "+v"(r1##S[0]), "+v"(r1##S[1]), "+v"(r2##S[0]), "+v"(r2##S[1]), "+v"(r3##S[0]), "+v"(r3##S[1]), "+v"(r4##S[0]), "+v"(r4##S[1]), "+v"(dv##S) : "n"(N))
#define RWS_WRITE(bb, S) do { LAS bf16_t* Wn_ = (LAS bf16_t*)(F.lds + (bb) * RWS_BUF); \
        _Pragma("unroll") for (int q = 0; q < 2; ++q) { const int idx = q * 256 + lt, off = (idx >> 3) * GDN_LD + (idx & 7) * 8, uoff = (vb + ((idx & umask) >> 3)) * GDN_LD + (idx & 7) * 8; \
            *(LAS u32x4*)(Wn_ + off) = r1##S[q]; *(LAS u32x4*)(Wn_ + 64 * GDN_LD + uoff) = r2##S[q]; *(LAS u32x4*)(Wn_ + 2 * 64 * GDN_LD + off) = r3##S[q]; *(LAS u32x4*)(Wn_ + 3 * 64 * GDN_LD + uoff) = r4##S[q]; } \
        if (lt < 64) ((LAS float*)(Wn_ + 4 * 64 * GDN_LD))[lt] = dv##S; } while (0)
        SCAN_LOADER6(RWS_LOAD, RWS_WRITE, RWS_WAIT, 9);
#undef RWS_LOAD
#undef RWS_WRITE
#undef RWS_WAIT
    } else if (w >= ncw) {
        int nxt = nch < RDY_SLACK ? nch : RDY_SLACK;
        LDS_BARRIER();
        for (int ci = 0; ci < nch; ++ci) {
            if (w == ncw && nxt < nch) { const int upto = ci + 1 + RDY_SLACK < nch ? ci + 1 + RDY_SLACK : nch; nxt = rdy_block(F, rdy, rstride, rneed, nxt, upto, nch); }
            LDS_BARRIER();
        }
    } else {
        const int n0 = vb + 16 * w;
        f32x4 S[4];
        if (s == 0) {
#pragma unroll
            for (int kt = 0; kt < 4; ++kt) S[kt] = (f32x4){0.f, 0.f, 0.f, 0.f};
        } else {
            const float* st = INP(I_SRWKV) + (((size_t)l * 32 + b) * 4 + h) * 4096 + (n0 + i16) * 64 + 4 * g;
#pragma unroll
            for (int kt = 0; kt < 4; ++kt) S[kt] = *(const f32x4*)(st + 16 * kt);
        }
        LDS_BARRIER();
        for (int ci = 0; ci < nch; ++ci) {
            const size_t b0 = (((size_t)(c0 + ci)) * 4 + h) * 4096;
            const LAS bf16_t* Wn = (const LAS bf16_t*)(F.lds + (ci & 1) * RWS_BUF); const LAS bf16_t* Ut = Wn + 64 * GDN_LD; const LAS bf16_t* Bh = Ut + 64 * GDN_LD; const LAS bf16_t* KVt = Bh + 64 * GDN_LD;
            const LAS float* dvec = (const LAS float*)(KVt + 64 * GDN_LD);
            bf16x8 A1[4][2], A2[4][2]; u32x2 ui[4], kvi[4]; f32x4 dq[4];
#pragma unroll
            for (int m = 0; m < 4; ++m) { ui[m] = *(const LAS u32x2*)(Ut + (n0 + i16) * GDN_LD + 16 * m + 4 * g);
#pragma unroll
                for (int ks = 0; ks < 2; ++ks) A1[m][ks] = frag_sig(Wn, GDN_LD, 16 * m, 32 * ks, i16, g); }
#pragma unroll
            for (int kt = 0; kt < 4; ++kt) { kvi[kt] = *(const LAS u32x2*)(KVt + (n0 + i16) * GDN_LD + 16 * kt + 4 * g); dq[kt] = *(const LAS f32x4*)(dvec + 16 * kt + 4 * g);
#pragma unroll
                for (int cs = 0; cs < 2; ++cs) A2[kt][cs] = frag_tr_sig(Bh, GDN_LD, 32 * cs, 16 * kt, i16, g); }
            __builtin_amdgcn_sched_barrier(0);
            bf16x8 Sb[2];
#pragma unroll
            for (int ks = 0; ks < 2; ++ks) Sb[ks] = acc_frag(S[2 * ks], S[2 * ks + 1]);
            {
                bf16_t* ho = F_RKV + b0 + (n0 + i16) * 64 + 4 * g;
#pragma unroll
                for (int kt = 0; kt < 4; ++kt) st8_wt(ho + 16 * kt, pack4(S[kt]));
            }
            f32x4 V[4];
            bf16_t* vo = ru + b0 + (n0 + i16) * 64 + 4 * g;
#pragma unroll
            for (int m = 0; m < 4; ++m) {
                f32x4 acc = unpack4(ui[m]);
#pragma unroll
                for (int ks = 0; ks < 2; ++ks) acc = mma16(A1[m][ks], Sb[ks], acc);
                V[m] = acc;
            }
#pragma unroll
            for (int m = 0; m < 4; ++m) st8_wt(vo + 16 * m, pack4(V[m]));
            bf16x8 Ub[2];
#pragma unroll
            for (int cs = 0; cs < 2; ++cs) Ub[cs] = acc_frag(V[2 * cs], V[2 * cs + 1]);
#pragma unroll
            for (int kt = 0; kt < 4; ++kt) {
                f32x4 acc = S[kt] * dq[kt] + unpack4(kvi[kt]);
#pragma unroll
                for (int cs = 0; cs < 2; ++cs) acc = mma16(A2[kt][cs], Ub[cs], acc);
                S[kt] = acc;
            }
            if (prog) {
                asm volatile("s_waitcnt vmcnt(48)" ::: "memory");
                if (lane == 0 && ci >= 6) __hip_atomic_store(prog + 64 * w, pbase + (unsigned)(ci - 6) + 1u, __ATOMIC_RELAXED, __HIP_MEMORY_SCOPE_AGENT);
            }
            LDS_BARRIER();
        }
        asm volatile("s_waitcnt vmcnt(0)" ::: "memory");
        if (prog && lane == 0) __hip_atomic_store(prog + 64 * w, pbase + (unsigned)nch, __ATOMIC_RELAXED, __HIP_MEMORY_SCOPE_AGENT);
        if (done && lane == 0) __hip_atomic_fetch_add(done, 1u, __ATOMIC_RELAXED, __HIP_MEMORY_SCOPE_AGENT);
        float* o = F.out + (s == 0 ? O_P_RWKV + ((size_t)l * 4 + h) * 4096 : O_S_RWKV + (((size_t)l * 32 + b) * 4 + h) * 4096) + (n0 + i16) * 64 + 4 * g;
#pragma unroll
        for (int kt = 0; kt < 4; ++kt) *(f32x4*)(o + 16 * kt) = S[kt];
    }
}
__device__ __forceinline__ void post_rwkv(Frame& F, int l, int c, int h) {
    PHASE_IDS(F);
    const int tid = F.tid, lane = F.lane, w = F.wave, i16 = lane & 15, g = lane >> 4, tt = w & 3, jh = w >> 2;
    const size_t row0 = (size_t)c * 64;
    RwkvTok tk; f32x4 Zg[2];
    rwkv_tokens<true>(F, l, c, h, tk, Zg);
    LAS bf16_t* Rd = (LAS bf16_t*)(F.lds + RW_XD); LAS bf16_t* Bt = (LAS bf16_t*)(F.lds + RW_XA); LAS bf16_t* Kt = (LAS bf16_t*)(F.lds + RW_WD); LAS bf16_t* Utl = (LAS bf16_t*)(F.lds + RW_WA);
    LAS bf16_t* Rt = (LAS bf16_t*)(F.lds + RW_RT); LAS bf16_t* Htl = (LAS bf16_t*)(F.lds + RW_KX); LAS bf16_t* Vt = (LAS bf16_t*)(F.lds + RW_VT);
    LAS float* ex = (LAS float*)(F.lds + RW_EX) + 512;
    float rr[2][4];
#pragma unroll
    for (int q = 0; q < 2; ++q)
#pragma unroll
        for (int r = 0; r < 4; ++r) rr[q][r] = bf2f(Rt[(16 * tt + 4 * g + r) * RW_LD + 16 * (2 * jh + q) + i16]);
    LDS_BARRIER();
#pragma unroll
    for (int q = 0; q < 2; ++q) {
        const int j = 16 * (2 * jh + q) + i16;
#pragma unroll
        for (int r = 0; r < 4; ++r) {
            const int t = 16 * tt + 4 * g + r;
            const float cum = tk.cum[q][r], einv = __expf(-cum);
            Rd[t * RW_LD + j] = f2bf(rr[q][r] * __expf(cum));
            Bt[t * RW_LD + j] = f2bf(tk.kk[q][r] * tk.iclr[q][r] * einv);
            Kt[t * RW_LD + j] = f2bf(tk.kp[q][r] * einv);
        }
    }
    {
        const int row = tid >> 3, col8 = (tid & 7) * 8; const size_t b0 = (((size_t)c * 4 + h) * 64 + row) * 64 + col8;
        *(LAS u32x4*)(Utl + row * RW_LD + col8) = *(const u32x4*)(F_RU + b0);
        *(LAS u32x4*)(Htl + row * RW_LD + col8) = *(const u32x4*)(F_RKV + b0);
    }
    LDS_BARRIER();
    f32x4 QB[4], QK[4];
#pragma unroll
    for (int st = 0; st < 4; ++st) {
        f32x4 a = (f32x4){0.f, 0.f, 0.f, 0.f}, bq = a;
        if (st <= tt) {
#pragma unroll
            for (int ks = 0; ks < 2; ++ks) {
                const bf16x8 rf = frag_nat(Rd, RW_LD, 16 * tt, 32 * ks, i16, g);
                a = mma16(frag_nat(Bt, RW_LD, 16 * st, 32 * ks, i16, g), rf, a);
                bq = mma16(frag_nat(Kt, RW_LD, 16 * st, 32 * ks, i16, g), rf, bq);
            }
#pragma unroll
            for (int r = 0; r < 4; ++r) { const int s = 16 * st + 4 * g + r, t = 16 * tt + i16; if (!(s <= t)) { a[r] = 0.f; bq[r] = 0.f; } }
        }
        QB[st] = a; QK[st] = bq;
    }
    f32x4 Y[2]; float s1[4] = {0.f, 0.f, 0.f, 0.f}, s2[4] = {0.f, 0.f, 0.f, 0.f}, bon[4] = {0.f, 0.f, 0.f, 0.f};
#pragma unroll
    for (int q = 0; q < 2; ++q) {
        const int vt = 2 * jh + q;
        f32x4 acc = (f32x4){0.f, 0.f, 0.f, 0.f};
#pragma unroll
        for (int ks = 0; ks < 2; ++ks) acc = mma16(frag_nat(Rd, RW_LD, 16 * tt, 32 * ks, i16, g), frag_nat(Htl, RW_LD, 16 * vt, 32 * ks, i16, g), acc);
#pragma unroll
        for (int cs = 0; cs < 2; ++cs) if (2 * cs <= tt) {
            acc = mma16(acc_frag(QB[2 * cs], QB[2 * cs + 1]), frag_sig(Utl, RW_LD, 16 * vt, 32 * cs, i16, g), acc);
            acc = mma16(acc_frag(QK[2 * cs], QK[2 * cs + 1]), frag_tr_sig(Vt, RW_LD, 32 * cs, 16 * vt, i16, g), acc);
        }
        Y[q] = acc;
        const float rkw = INP(I_RRK)[l * 256 + h * 64 + 16 * vt + i16];
#pragma unroll
        for (int r = 0; r < 4; ++r) { s1[r] += acc[r]; s2[r] += acc[r] * acc[r]; bon[r] += rr[q][r] * tk.kp[q][r] * rkw; }
    }
#pragma unroll
    for (int r = 0; r < 4; ++r) {
        float a = s1[r], bq = s2[r], cq = bon[r];
#pragma unroll
        for (int o = 1; o < 16; o <<= 1) { a += __shfl_xor(a, o); bq += __shfl_xor(bq, o); cq += __shfl_xor(cq, o); }
        if (i16 == 0) { const int t = 16 * tt + 4 * g + r; ex[(0 * 2 + jh) * 64 + t] = a; ex[(1 * 2 + jh) * 64 + t] = bq; ex[(2 * 2 + jh) * 64 + t] = cq; }
    }
    LDS_BARRIER();
    bf16_t* const proj = F_PROJ;
#pragma unroll
    for (int q = 0; q < 2; ++q) {
        const int v = 16 * (2 * jh + q) + i16, vc = l * 256 + h * 64 + v;
        const float lnw = INP(I_RLNW)[vc], lnb = INP(I_RLNB)[vc];
#pragma unroll
        for (int r = 0; r < 4; ++r) {
            const int t = 16 * tt + 4 * g + r;
            const float mean = (ex[t] + ex[64 + t]) * (1.f / 64.f);
            const float var = fmaxf((ex[128 + t] + ex[192 + t]) * (1.f / 64.f) - mean * mean, 0.f);
            const float bonus = (ex[256 + t] + ex[320 + t]) * bf2f(Vt[t * RW_LD + v]);
            const float yn = (Y[q][r] - mean) * rsqrtf(var + 64e-5f) * lnw + lnb;
            proj[(row0 + t) * PW + PC_R + h * 64 + v] = f2bf((yn + bonus) * Zg[q][r]);
        }
    }
    LDS_BARRIER();
}

constexpr int SSD_LDC = 136, SSD_LDX = 72;
constexpr int SSD_BUF = 64 * SSD_LDC * 2 * 2 + 64 * SSD_LDX * 2 + 64;
__device__ __forceinline__ void scan_ssd2(Frame& F, int l, int s, int hd, int vb, int ncw, unsigned* prog, unsigned pbase, unsigned* done, int pm, const unsigned* rdy, int rstride, unsigned rneed) {
    PHASE_IDS(F);
    const int tid = F.tid, lane = F.lane, w = F.wave, i16 = lane & 15, g = lane >> 4;
    const int nch = (s == 0) ? 256 : 1, c0 = (s == 0) ? 0 : 255 + s, b = s - 1, grp = hd >> 2;
    const bf16_t* const proj = F_PROJ; const float* const scal = F_SCAL; const float* const acum = F_ACUM;
    {
        if (w == (ncw < 4 ? ncw : 0)) (void)rdy_block(F, rdy, rstride, rneed, 0, nch < RDY_SLACK ? nch : RDY_SLACK, nch);
        LDS_BARRIER();
    }
    if (w >= 4) {
        const int lt = tid - 256;
        const int umask = 128 * ncw - 1, xsh = (ncw == 4) ? 3 : (ncw == 2 ? 2 : 1);
        u32x4 rc0[4], rb0[4], rx0[2], rc1[4], rb1[4], rx1[2], rc2[4], rb2[4], rx2[2], rc3[4], rb3[4], rx3[2]; float dt0[2], ac0[2], al0, dt1[2], ac1[2], al1, dt2[2], ac2[2], al2, dt3[2], ac3[2], al3;
        const bf16_t* pC[4]; const bf16_t* pB[4]; const bf16_t* pX[2]; const float* pDt[2]; const float* pAc[2]; const float* const pAl = acum + 63 * 8 + hd;
#pragma unroll
        for (int q = 0; q < 4; ++q) { const int idx = q * 256 + lt, row = idx >> 4, col8 = (idx & 15) * 8;
            pC[q] = proj + (size_t)row * PW + PC_SC + grp * 128 + col8; pB[q] = proj + (size_t)row * PW + PC_SB + grp * 128 + col8; }
#pragma unroll
        for (int q = 0; q < 2; ++q) { const int idx = (q * 256 + lt) & umask, row = idx >> xsh, col8 = vb + (idx & ((1 << xsh) - 1)) * 8;
            pX[q] = proj + (size_t)row * PW + PC_SX + hd * 64 + col8; pDt[q] = scal + row * 16 + 8 + hd; pAc[q] = acum + row * 8 + hd; }
#define SSD_LOAD(ch, S) do { const size_t oP_ = (size_t)(ch) * (64 * PW), oS_ = (size_t)(ch) * 1024, oA_ = (size_t)(ch) * 512; al##S = ld4_asm(pAl + oA_); \
        _Pragma("unroll") for (int q = 0; q < 4; ++q) { rc##S[q] = ld16_asm(pC[q] + oP_); rb##S[q] = ld16_asm(pB[q] + oP_); } \
        _Pragma("unroll") for (int q = 0; q < 2; ++q) { rx##S[q] = ld16_asm(pX[q] + oP_); dt##S[q] = ld4_asm(pDt[q] + oS_); ac##S[q] = ld4_asm(pAc[q] + oA_); } } while (0)
#define SSD_WAIT(S, N) asm volatile("s_waitcnt vmcnt(%15)" : "+v"(rc##S[0]), "+v"(rc##S[1]), "+v"(rc##S[2]), "+v"(rc##S[3]), "+v"(rb##S[0]), "+v"(rb##S[1]), "+v"(rb##S[2]), "+v"(rb##S[3]), \
        "+v"(rx##S[0]), "+v"(rx##S[1]), "+v"(dt##S[0]), "+v"(dt##S[1]), "+v"(ac##S[0]), "+v"(ac##S[1]), "+v"(al##S) : "n"(N))
#define SSD_WRITE(bb, S) do { LAS bf16_t* Ct_ = (LAS bf16_t*)(F.lds + (bb) * SSD_BUF); LAS bf16_t* Bt_ = Ct_ + 64 * SSD_LDC; LAS bf16_t* Xt_ = Bt_ + 64 * SSD_LDC; \
        _Pragma("unroll") for (int q = 0; q < 4; ++q) { const int idx = q * 256 + lt, row = idx >> 4, col8 = (idx & 15) * 8; \
            *(LAS u32x4*)(Ct_ + row * SSD_LDC + col8) = rc##S[q]; *(LAS u32x4*)(Bt_ + row * SSD_LDC + col8) = rb##S[q]; } \
        _Pragma("unroll") for (int q = 0; q < 2; ++q) { const int idx = (q * 256 + lt) & umask, row = idx >> xsh, col8 = vb + (idx & ((1 << xsh) - 1)) * 8; float v_[8]; unpack8(rx##S[q], v_); \
            const float sx_ = dt##S[q] * __expf(al##S - ac##S[q]); \
            _Pragma("unroll") for (int i = 0; i < 8; ++i) v_[i] *= sx_; *(LAS u32x4*)(Xt_ + row * SSD_LDX + col8) = pack8(v_); } \
        if (lt == 0) *(LAS float*)(Xt_ + 64 * SSD_LDX) = __expf(al##S); } while (0)
        SCAN_LOADER(SSD_LOAD, SSD_WRITE, SSD_WAIT, 15);
#undef SSD_LOAD
#undef SSD_WRITE
#undef SSD_WAIT
    } else if (w >= ncw) {
        int nxt = nch < RDY_SLACK ? nch : RDY_SLACK;
        LDS_BARRIER();
        for (int ci = 0; ci < nch; ++ci) {
            if (w == ncw && nxt < nch) { const int upto = ci + 1 + RDY_SLACK < nch ? ci + 1 + RDY_SLACK : nch; nxt = rdy_block(F, rdy, rstride, rneed, nxt, upto, nch); }
            LDS_BARRIER();
        }
    } else {
        const int n0 = vb + 16 * w, head = hd;
        f32x4 H[8];
        if (s == 0) {
#pragma unroll
            for (int nt = 0; nt < 8; ++nt) H[nt] = (f32x4){0.f, 0.f, 0.f, 0.f};
        } else {
            const float* st = INP(I_SSSM) + ((((size_t)l * 32 + b) * 8 + head) * 64 + n0 + i16) * 128 + 4 * g;
#pragma unroll
            for (int nt = 0; nt < 8; ++nt) H[nt] = *(const f32x4*)(st + 16 * nt);
        }
        bf16_t* const yoff = F_YOFF;
        LDS_BARRIER();
        for (int ci = 0; ci < nch; ++ci) {
            const LAS bf16_t* Ct = (const LAS bf16_t*)(F.lds + (ci & 1) * SSD_BUF); const LAS bf16_t* Bt = Ct + 64 * SSD_LDC; const LAS bf16_t* Xt = Bt + 64 * SSD_LDC;
            const float cd = *(const LAS float*)(Xt + 64 * SSD_LDX);
            bf16x8 A1[4][4], A2[8][2], Xb[2];
#pragma unroll
            for (int m = 0; m < 4; ++m)
#pragma unroll
                for (int ks = 0; ks < 4; ++ks) A1[m][ks] = frag_sig(Ct, SSD_LDC, 16 * m, 32 * ks, i16, g);
#pragma unroll
            for (int cs = 0; cs < 2; ++cs) Xb[cs] = frag_tr_nat(Xt, SSD_LDX, 32 * cs, n0, i16, g);
#pragma unroll
            for (int nt = 0; nt < 8; ++nt)
#pragma unroll
                for (int cs = 0; cs < 2; ++cs) A2[nt][cs] = frag_tr_nat(Bt, SSD_LDC, 32 * cs, 16 * nt, i16, g);
            __builtin_amdgcn_sched_barrier(0);
            bf16x8 Hb[4];
#pragma unroll
            for (int ks = 0; ks < 4; ++ks) Hb[ks] = acc_frag(H[2 * ks], H[2 * ks + 1]);
            bf16_t* yo = yoff + (((size_t)(c0 + ci) * 8 + head) * 64 + n0 + i16) * 64 + 4 * g;
            f32x4 Yv[4];
#pragma unroll
            for (int m = 0; m < 4; ++m) {
                f32x4 acc = (f32x4){0.f, 0.f, 0.f, 0.f};
#pragma unroll
                for (int ks = 0; ks < 4; ++ks) acc = mma16(A1[m][ks], Hb[ks], acc);
                Yv[m] = acc;
            }
#pragma unroll
            for (int nt = 0; nt < 8; ++nt) {
                f32x4 acc = H[nt] * cd;
#pragma unroll
                for (int cs = 0; cs < 2; ++cs) acc = mma16(A2[nt][cs], Xb[cs], acc);
                H[nt] = acc;
            }
#pragma unroll
            for (int m = 0; m < 4; ++m) st8_wt(yo + 16 * m, pack4(Yv[m]));
            if (prog) {
                asm volatile("s_waitcnt vmcnt(24)" ::: "memory");
                if (lane == 0 && ci >= 6) __hip_atomic_store(prog + 64 * w, pbase + (unsigned)(ci - 6) + 1u, __ATOMIC_RELAXED, __HIP_MEMORY_SCOPE_AGENT);
            }
            LDS_BARRIER();
        }
        asm volatile("s_waitcnt vmcnt(0)" ::: "memory");
        if (prog && lane == 0) __hip_atomic_store(prog + 64 * w, pbase + (unsigned)nch, __ATOMIC_RELAXED, __HIP_MEMORY_SCOPE_AGENT);
        if (done && lane == 0) __hip_atomic_fetch_add(done, 1u, __ATOMIC_RELAXED, __HIP_MEMORY_SCOPE_AGENT);
        float* o = F.out + (s == 0 ? O_P_SSM + (((size_t)l * 8 + head) * 64 + n0 + i16) * 128 : O_S_SSM + ((((size_t)l * 32 + b) * 8 + head) * 64 + n0 + i16) * 128) + 4 * g;
#pragma unroll
        for (int nt = 0; nt < 8; ++nt) *(f32x4*)(o + 16 * nt) = H[nt];
    }
}
__device__ __forceinline__ void post_ssd(Frame& F, int l, int c, int grp) {
    PHASE_IDS(F);
    const int tid = F.tid, lane = F.lane, w = F.wave, i16 = lane & 15, g = lane >> 4;
    const size_t row0 = (size_t)c * 64;
    bf16_t* const proj = F_PROJ;
    LAS bf16_t* Ct = (LAS bf16_t*)F.lds; LAS bf16_t* Bt = Ct + 64 * SSD_LDC; LAS bf16_t* Xt = Bt + 64 * SSD_LDC;
    LAS float* acs = (LAS float*)(Xt + 4 * 64 * SSD_LDX); LAS float* dts = acs + 256; LAS float* ssn = dts + 256;
    {
#pragma unroll
        for (int q = 0; q < 2; ++q) { const int idx = q * 512 + tid, row = idx >> 4, col8 = (idx & 15) * 8;
            *(LAS u32x4*)(Ct + row * SSD_LDC + col8) = *(const u32x4*)(proj + (row0 + row) * PW + PC_SC + grp * 128 + col8);
            *(LAS u32x4*)(Bt + row * SSD_LDC + col8) = *(const u32x4*)(proj + (row0 + row) * PW + PC_SB + grp * 128 + col8); }
#pragma unroll
        for (int q = 0; q < 4; ++q) { const int idx = q * 512 + tid, row = idx >> 5, col8 = (idx & 31) * 8, hh = col8 >> 6, cc = col8 & 63;
            *(LAS u32x4*)(Xt + hh * 64 * SSD_LDX + row * SSD_LDX + cc) = *(const u32x4*)(proj + (row0 + row) * PW + PC_SX + grp * 256 + col8); }
        if (tid < 256) { const int hh = tid >> 6, t = tid & 63; acs[tid] = F_ACUM[(row0 + t) * 8 + grp * 4 + hh]; dts[tid] = F_SCAL[(row0 + t) * 16 + 8 + grp * 4 + hh]; }
    }
    LDS_BARRIER();
    const int hh = w & 3, lh = w >> 2, hd = grp * 4 + hh;
    const LAS bf16_t* Xh = Xt + hh * 64 * SSD_LDX;
    const float Dh = INP(I_SD)[l * 8 + hd];
    float ssrow[2][4];
    f32x4 Y[2][4];
#pragma unroll
    for (int li = 0; li < 2; ++li) {
        const int ltile = 2 * lh + li;
        f32x4 ST[4];
#pragma unroll
        for (int st = 0; st < 4; ++st) {
            f32x4 acc = (f32x4){0.f, 0.f, 0.f, 0.f};
            if (st <= ltile) {
#pragma unroll
                for (int ks = 0; ks < 4; ++ks) acc = mma16(frag_nat(Bt, SSD_LDC, 16 * st, 32 * ks, i16, g), frag_nat(Ct, SSD_LDC, 16 * ltile, 32 * ks, i16, g), acc);
                const int lcol = 16 * ltile + i16; const float acl = acs[hh * 64 + lcol];
#pragma unroll
                for (int r = 0; r < 4; ++r) { const int srow = 16 * st + 4 * g + r; const float f = (srow <= lcol) ? __expf(fminf(acl - acs[hh * 64 + srow], 0.f)) * dts[hh * 64 + srow] : 0.f; acc[r] *= f; }
            }
            ST[st] = acc;
        }
#pragma unroll
        for (int pt = 0; pt < 4; ++pt) {
            f32x4 acc = (f32x4){0.f, 0.f, 0.f, 0.f};
#pragma unroll
            for (int cs = 0; cs < 2; ++cs) if (2 * cs <= ltile) acc = mma16(acc_frag(ST[2 * cs], ST[2 * cs + 1]), frag_tr_sig(Xh, SSD_LDX, 32 * cs, 16 * pt, i16, g), acc);
            const int p = 16 * pt + i16, lr0 = 16 * ltile + 4 * g;
            const f32x4 yo = unpack4(*(const u32x2*)(F_YOFF + (((size_t)c * 8 + hd) * 64 + p) * 64 + lr0));
#pragma unroll
            for (int r = 0; r < 4; ++r) {
                const int lrow = lr0 + r;
                const float x = bf2f(Xh[lrow * SSD_LDX + p]);
                const float z = bf2f(proj[(row0 + lrow) * PW + PC_ZS + hd * 64 + p]);
                acc[r] = (acc[r] + __expf(acs[hh * 64 + lrow]) * yo[r] + Dh * x) * siluf_(z);
            }
            Y[li][pt] = acc;
        }
#pragma unroll
        for (int r = 0; r < 4; ++r) { float ss = 0.f;
#pragma unroll
            for (int pt = 0; pt < 4; ++pt) ss += Y[li][pt][r] * Y[li][pt][r];
            ss += __shfl_xor(ss, 1); ss += __shfl_xor(ss, 2); ss += __shfl_xor(ss, 4); ss += __shfl_xor(ss, 8);
            ssrow[li][r] = ss; }
        if (i16 == 0) {
#pragma unroll
            for (int r = 0; r < 4; ++r) ssn[(16 * ltile + 4 * g + r) * 4 + hh] = ssrow[li][r];
        }
    }
    LDS_BARRIER();
#pragma unroll
    for (int li = 0; li < 2; ++li) {
        const int ltile = 2 * lh + li;
#pragma unroll
        for (int r = 0; r < 4; ++r) {
            const int lrow = 16 * ltile + 4 * g + r;
            const f32x4 sv = *(const LAS f32x4*)(ssn + lrow * 4);
            const float sc = rsqrtf(((sv[0] + sv[1]) + (sv[2] + sv[3])) * (1.f / 256.f) + EPS);
#pragma unroll
            for (int pt = 0; pt < 4; ++pt) { const int p = 16 * pt + i16;
                proj[(row0 + lrow) * PW + PC_ZS + hd * 64 + p] = f2bf(Y[li][pt][r] * sc * INP(I_SNORMW)[l * 512 + hd * 64 + p]); }
        }
    }
    LDS_BARRIER();
}

constexpr int NSL = 2;
constexpr int CW_PROG = 8192;
constexpr int CW_SDONE = 8192 + 64 * 64;
__device__ __forceinline__ void post_wait(Frame& F, int c, int q, unsigned pbase, unsigned sneed) {
    if (F.wave == 0) {
        unsigned* const ctl = (unsigned*)(F.ws + WS_CTL);
        const int lane = F.lane;
        unsigned* wp; unsigned need; bool act;
        if (c >= 256) { wp = ctl + CW_SDONE + 64 * (c - 256); need = sneed; act = lane == 0; }
        else {
            int gq0, ng;
            if (q < 2) { gq0 = 8 + 4 * q; ng = 4; } else if (q < 4) { gq0 = 2 * (q - 2); ng = 2; } else { gq0 = 4 + (q - 4); ng = 1; }
            act = lane < 4 * ng; wp = ctl + CW_PROG + 64 * (4 * gq0 + (act ? lane : 0)); need = pbase + (unsigned)c + 1u;
        }
        unsigned sp = 0;
        for (;;) { const bool ok = !act || (int)(xb_ld(wp) - need) >= 0; if (__all(ok) || ++sp > 2000000u) break; __builtin_amdgcn_s_sleep(4); }
        __builtin_amdgcn_fence(__ATOMIC_ACQUIRE, "agent");
        asm volatile("s_waitcnt vmcnt(0)" ::: "memory");
    }
    LDS_BARRIER();
}
__device__ __forceinline__ void scan_phase(Frame& F, int l, int mode, unsigned epoch) {
    PHASE_IDS(F);
    const int xl = F.vcu >> 5, slot = F.vcu & 31;
    unsigned* const ctl = (unsigned*)(F.ws + WS_CTL);
    const unsigned pbase = 1024u * epoch, sneed = 64u * (epoch + 1u), rneed = epoch + 1u;
    if (slot >= 2 * NSL) {
        const int j = xl * (32 - 2 * NSL) + (slot - 2 * NSL);
        for (int it = j; it < NCH * 5; it += 8 * (32 - 2 * NSL)) {
            int it_ = it; asm volatile("" : "+s"(it_));
            const int c = it_ / 5, q = it_ % 5;
            if (q == 0) act_chunk(F, l, c); else prep_rwkv(F, l, c, q - 1);
        }
    }
    for (int pass = 0; pass < 3; ++pass) {
        int kind, s, h, vb, ncw; unsigned* prog = nullptr; unsigned* done = nullptr;
        if (pass == 0) {
            if (slot >= 2 * NSL) continue;
            const int gq = xl + 8 * (slot / NSL);
            kind = gq < 4 ? 0 : (gq < 8 ? 1 : 2); h = gq < 4 ? gq : (gq < 8 ? gq - 4 : gq - 8); s = 0; ncw = 4 / NSL; vb = 16 * ncw * (slot % NSL);
            prog = ctl + CW_PROG + 64 * (4 * gq + ncw * (slot % NSL));
        } else {
            const int it = F.vcu + (pass - 1) * F.G;
            if (it >= 512) continue;
            if (it < 128) { kind = 0; s = 1 + (it >> 2); h = it & 3; }
            else if (it < 256) { kind = 1; s = 1 + ((it - 128) >> 2); h = (it - 128) & 3; }
            else { kind = 2; s = 1 + ((it - 256) >> 3); h = (it - 256) & 7; }
            vb = 0; ncw = 4; done = ctl + CW_SDONE + 64 * (s - 1);
        }
        const int cfirst = (s == 0) ? 0 : 255 + s;
        if (kind == 0) scan_gdn2(F, l, s, h, vb, ncw, prog, pbase, done, mode, ctl + CW_AFLAG + cfirst, 1, rneed);
        else if (kind == 1) scan_rwkv2(F, l, s, h, vb, ncw, prog, pbase, done, mode, ctl + CW_RFLAG + 4 * cfirst + h, 4, rneed);
        else scan_ssd2(F, l, s, h, vb, ncw, prog, pbase, done, mode, ctl + CW_AFLAG + cfirst, 1, rneed);
        __syncthreads();
    }
    if (slot >= 2 * NSL) {
        const int j = xl * (32 - 2 * NSL) + (slot - 2 * NSL);
        for (int it = j; it < NCH * 8; it += 8 * (32 - 2 * NSL)) {
            int it_ = it; asm volatile("" : "+s"(it_));
            const int c = it_ >> 3, q = it_ & 7;
            post_wait(F, c, q, pbase, sneed);
            if (q < 2) post_ssd(F, l, c, q); else if (q < 4) post_gdn(F, l, c, q - 2); else post_rwkv(F, l, c, q - 4);
        }
    }
}
__device__ __forceinline__ void final_norm(Frame& F) {
    PHASE_IDS(F);
    const int gw = F.vcu * 8 + F.wave, NGW = F.G * 8;
    const float* fw = INP(I_FNORM);
    float wv[16];
#pragma unroll
    for (int i = 0; i < 16; ++i) wv[i] = fw[16 * F.lane + i];
    for (int m = gw; m < T; m += NGW) {
        float s = (F.lane < 16) ? F_SSQA[(size_t)m * 16 + F.lane] : 0.f;
        s = wave_sum(s);
        const float rs = rsqrtf(s * (1.f / 1024.f) + EPS);
        const bf16_t* xr = F_R1 + (size_t)m * DM + 16 * F.lane;
        float x[16]; { float a[8], b[8]; unpack8(*(const u32x4*)xr, a); unpack8(*(const u32x4*)(xr + 8), b);
#pragma unroll
            for (int i = 0; i < 8; ++i) { x[i] = a[i]; x[8 + i] = b[i]; } }
        f32x4* o = (f32x4*)(F.out + (size_t)m * DM + 16 * F.lane);
#pragma unroll
        for (int q = 0; q < 4; ++q) o[q] = (f32x4){x[4 * q] * rs * wv[4 * q], x[4 * q + 1] * rs * wv[4 * q + 1], x[4 * q + 2] * rs * wv[4 * q + 2], x[4 * q + 3] * rs * wv[4 * q + 3]};
    }
}

constexpr int N_PHASES = 16;
__global__ void __launch_bounds__(512, 2) mk_fwd(Args args) {
    extern __shared__ __attribute__((aligned(16))) unsigned char lds[];
    Frame F;
    F.lds = (LAS unsigned char*)lds;
    F.tid = threadIdx.x; F.lane = F.tid & 63; F.wave = __builtin_amdgcn_readfirstlane(F.tid >> 6);
    F.G = gridDim.x; { const int bx = blockIdx.x; F.vcu = (F.G % 8 == 0) ? (bx % 8) * (F.G / 8) + bx / 8 : bx; }
    F.out = args.out; F.ws = args.ws;
    volatile LAS unsigned* MISC = (volatile LAS unsigned*)(F.lds + MISC_OFF);
    for (int u = F.tid; u < (LDS_BYTES - LDSCTL_OFF) / 4; u += 512) ((LAS unsigned*)(F.lds + LDSCTL_OFF))[u] = 0u;
    __syncthreads();
    if (F.tid == 0) {
#pragma unroll
        for (int i = 0; i < 37; ++i) ((LAS unsigned long long*)(F.lds + PTRTAB_OFF))[i] = (unsigned long long)args.in[i];
    }
    __syncthreads();
    XcdBarrier bar = xcd_barrier_post((unsigned*)(args.ws + WS_CTL) + CW_BAR, MISC + 8);
    const int ns = args.nsched; unsigned nscan = 0;
    for (int si = 0; si < ns; ++si) {
        const int pe = (int)((args.sched[si >> 2] >> (8 * (si & 3))) & 0xffu); const int p = pe & 0x7f; const bool probe = (pe & 0x80) != 0;
        if (p == 0) p0_prologue(F);
        else if (p == 15) final_norm(F);
        else {
            const int l = (p - 1) / 7, sub = (p - 1) % 7;
            if (sub == 0) {
                pg8::Gemm g{F_R1, w_in(F, l), T, NIN, DM, DM}; pg8::StaticOrder S; S.init(T, NIN, F.G, (int)blockIdx.x);
                pg8::EpiInProj E{F_PROJ, F_SCAL, F_SSQA, F_HCONV, F_HSHIFT, F.out, l};
                pg8::gemm_phase<pg8::EpiInProj, true>(F.lds, g, S, E);
            } else if (sub == 1) { }
            else if (sub == 2) scan_phase(F, l, 0, nscan++);
            else if (sub == 3) { }
            else if (sub == 4) {
                pg8::Gemm g{F_PROJ, w_out(F, l), T, DM, DM, PW}; pg8::StaticOrder S; S.init(T, DM, F.G, (int)blockIdx.x);
                if (l == 0) { pg8::EpiResid<true> E{INP(I_XP), INP(I_XS), F_R1, F_SSQD}; pg8::gemm_phase<pg8::EpiResid<true>, true>(F.lds, g, S, E); }
                else { pg8::EpiResid<false> E{nullptr, nullptr, F_R1, F_SSQD}; pg8::gemm_phase<pg8::EpiResid<false>, true>(F.lds, g, S, E); }
            } else if (sub == 5) {
                pg8::Gemm g{F_R1, w_gu(F, l), T, NGU, DM, DM}; pg8::StaticOrder S; S.init(T, NGU, F.G, (int)blockIdx.x);
                pg8::EpiGateUp E{F_PROJ, F_SSQD};
                pg8::gemm_phase<pg8::EpiGateUp, true>(F.lds, g, S, E);
            } else {
                pg8::Gemm g{F_PROJ, w_dn(F, l), T, DM, FF, FF}; pg8::StaticOrder S; S.init(T, DM, F.G, (int)blockIdx.x);
                pg8::EpiResid<false> E{nullptr, nullptr, F_R1, F_SSQA};
                pg8::gemm_phase<pg8::EpiResid<false>, true>(F.lds, g, S, E);
            }
        }
        if (si + 1 < ns) xcd_barrier(bar);
    }
}

extern "C" void kernel_launch(void* const* d_in, const int* in_sizes, int n_in, void* d_out, int out_size, void* d_ws, size_t ws_size, hipStream_t stream) {
    static int grid = 0;
    if (grid == 0) {
        if (n_in != 37 || out_size != (int)O_END || ws_size < 268435456) { fprintf(stderr, "kernel_launch: unexpected shapes: n_in %d out %d ws %zu\n", n_in, out_size, ws_size); grid = -1; return; }
        int dev = 0, cus = 0;
        if (hipGetDevice(&dev) != hipSuccess || hipDeviceGetAttribute(&cus, hipDeviceAttributeMultiprocessorCount, dev) != hipSuccess) { grid = -1; return; }
        if (hipFuncSetAttribute((const void*)mk_fwd, hipFuncAttributeMaxDynamicSharedMemorySize, LDS_BYTES) != hipSuccess) { fprintf(stderr, "kernel_launch: hipFuncSetAttribute failed\n"); grid = -1; return; }
        int per_cu = 0;
        if (hipOccupancyMaxActiveBlocksPerMultiprocessor(&per_cu, (const void*)mk_fwd, 512, LDS_BYTES) != hipSuccess || per_cu < 1)
            fprintf(stderr, "kernel_launch: occupancy query reports %d workgroups per CU\n", per_cu);
        (void)hipGetLastError();
        grid = cus;
    }
    if (grid < 0) return;
    (void)hipMemsetAsync((char*)d_ws + WS_CTL, 0, 65536, stream);
    Args a{};
    for (int i = 0; i < 37; ++i) a.in[i] = (const float*)d_in[i];
    a.out = (float*)d_out; a.ws = (unsigned char*)d_ws;
    {
        int n = 0; unsigned char s[32];
#ifndef PROBE_K
#define PROBE_K -1
#endif
        if (PROBE_K >= 0) { s[n++] = 0x80; for (int p = 1; p <= PROBE_K; ++p) if ((p - 1) % 7 != 3 && (p - 1) % 7 != 1) s[n++] = (unsigned char)(0x80 | p); }
        for (int p = 0; p < N_PHASES; ++p) if (p == 0 || p == 15 || ((p - 1) % 7 != 3 && (p - 1) % 7 != 1)) s[n++] = (unsigned char)p;
        for (int i = 0; i < n; ++i) a.sched[i >> 2] |= (unsigned)s[i] << (8 * (i & 3));
        a.nsched = n;
#ifndef PROBE_MODE
#define PROBE_MODE 31
#endif
        a.pmode = PROBE_MODE;
    }
    hipLaunchKernelGGL(mk_fwd, dim3(grid), dim3(512), LDS_BYTES, stream, a);
}
```

```cpp
#include <hip/hip_runtime.h>
#include <cstdio>
#include <cstdint>


#define LAS __attribute__((address_space(3)))
typedef unsigned short bf16_t;
typedef short bf16x8 __attribute__((ext_vector_type(8)));
typedef float f32x4 __attribute__((ext_vector_type(4)));
typedef float f32x2 __attribute__((ext_vector_type(2)));
typedef unsigned u32x4 __attribute__((ext_vector_type(4)));
typedef unsigned u32x2 __attribute__((ext_vector_type(2)));

constexpr int DM = 1024, TP = 16384, NB = 32, T = 18432, NCH = 288, NSEQ = 33;
constexpr int PW = 3584;
constexpr int NIN = 3840;
constexpr int FF = 2816, NGU = 5632;
constexpr float EPS = 1e-6f;
constexpr int PC_ZG = 0, PC_ZS = 256, PC_R = 768, PC_GQ = 1024, PC_GK = 1280, PC_GV = 1536, PC_SX = 1792, PC_SB = 2304, PC_SC = 2560,
              PC_RK = 2816, PC_RV = 3072, PC_RL = 3328;
constexpr size_t O_Y = 0;
constexpr size_t O_P_GDN = (size_t)T * DM;
constexpr size_t O_P_GDNC = O_P_GDN + 2 * 1 * 4 * 64 * 64;
constexpr size_t O_P_SSM = O_P_GDNC + 2 * 1 * 3 * 768;
constexpr size_t O_P_SSMC = O_P_SSM + 2 * 1 * 8 * 64 * 128;
constexpr size_t O_P_RWKV = O_P_SSMC + 2 * 1 * 3 * 1024;
constexpr size_t O_P_SHIFT = O_P_RWKV + 2 * 1 * 4 * 64 * 64;
constexpr size_t O_S_GDN = O_P_SHIFT + 2 * 1 * 1024;
constexpr size_t O_S_GDNC = O_S_GDN + (size_t)2 * 32 * 4 * 64 * 64;
constexpr size_t O_S_SSM = O_S_GDNC + (size_t)2 * 32 * 3 * 768;
constexpr size_t O_S_SSMC = O_S_SSM + (size_t)2 * 32 * 8 * 64 * 128;
constexpr size_t O_S_RWKV = O_S_SSMC + (size_t)2 * 32 * 3 * 1024;
constexpr size_t O_S_SHIFT = O_S_RWKV + (size_t)2 * 32 * 4 * 64 * 64;
constexpr size_t O_END = O_S_SHIFT + (size_t)2 * 32 * 1024;
static_assert(O_END == 25784832, "output size");

constexpr size_t WS_CTL = 0, CTL_BYTES = 1u << 20;
constexpr size_t W_IN_B = (size_t)NIN * DM * 2, W_OUT_B = (size_t)DM * DM * 2, W_GU_B = (size_t)NGU * DM * 2, W_DN_B = (size_t)DM * FF * 2;
constexpr size_t W_LAYER_B = W_IN_B + W_OUT_B + W_GU_B + W_DN_B;
constexpr size_t WS_W = WS_CTL + CTL_BYTES;
constexpr size_t WS_R1 = WS_W + 2 * W_LAYER_B;
constexpr size_t R_BYTES = (size_t)T * DM * 2;
constexpr size_t WS_R2 = WS_R1 + R_BYTES;
constexpr size_t WS_PROJ = WS_R2 + R_BYTES;
constexpr size_t PROJ_BYTES = (size_t)T * PW * 2;
constexpr size_t WS_SSQA = WS_PROJ + PROJ_BYTES;
constexpr size_t SSQ_BYTES = (size_t)T * 16 * 4;
constexpr size_t WS_SSQD = WS_SSQA + SSQ_BYTES;
constexpr size_t WS_END = WS_SSQD + SSQ_BYTES;
static_assert(WS_END <= 268435456, "d_ws map exceeds 256 MiB");
static_assert((size_t)T * FF * 2 <= PROJ_BYTES, "ff overlays proj");
constexpr size_t R2_SCAL = 0;
constexpr size_t R2_HCONV = R2_SCAL + (size_t)T * 16 * 4;
constexpr size_t R2_HSHIFT = R2_HCONV + (size_t)NCH * 3 * 1792 * 2;
constexpr size_t R2_ACUM = R2_HSHIFT + (size_t)NCH * 1024 * 2;
constexpr size_t R2_GCUM = R2_ACUM + (size_t)T * 8 * 4;
constexpr size_t R2_YOFF = R2_GCUM + (size_t)T * 4 * 4;
constexpr size_t R2_GW = R2_YOFF + (size_t)T * 512 * 2;
static_assert(R2_GW + (size_t)T * 256 * 2 <= R_BYTES, "R2 map");
constexpr size_t R1_RWA = 0;
constexpr size_t R1_RU = R1_RWA + (size_t)T * 256 * 2;
constexpr size_t R1_RBH = R1_RU + (size_t)T * 256 * 2;
constexpr size_t R1_RKV = R1_RBH + (size_t)T * 256 * 2;
static_assert(R1_RKV + (size_t)T * 256 * 2 <= R_BYTES, "R1 map");
constexpr size_t R2_RDV = R2_GW + (size_t)T * 256 * 2;
static_assert(R2_RDV + (size_t)NCH * 4 * 64 * 4 <= R_BYTES, "R2 map (dvec)");
constexpr int CW_BAR = 4096;

constexpr int RING_BYTES = 131072;
constexpr int LDSCTL_OFF = 143360, MISC_OFF = LDSCTL_OFF + 320;
constexpr int LDS_BYTES = 147456;

typedef __bf16 bf16x2_t __attribute__((ext_vector_type(2)));
__device__ __forceinline__ unsigned cvt_pk_bf16(float lo, float hi) { const f32x2 v = {lo, hi}; return __builtin_bit_cast(unsigned, __builtin_convertvector(v, bf16x2_t)); }
__device__ __forceinline__ float bf_lo(unsigned w) { return __uint_as_float(w << 16); }
__device__ __forceinline__ float bf_hi(unsigned w) { return __uint_as_float(w & 0xffff0000u); }
__device__ __forceinline__ float bf2f(bf16_t h) { return __uint_as_float(((unsigned)h) << 16); }
__device__ __forceinline__ bf16_t f2bf(float f) { return (bf16_t)(cvt_pk_bf16(f, 0.f) & 0xffffu); }
__device__ __forceinline__ void unpack8(u32x4 w, float (&o)[8]) {
    o[0] = bf_lo(w.x); o[1] = bf_hi(w.x); o[2] = bf_lo(w.y); o[3] = bf_hi(w.y); o[4] = bf_lo(w.z); o[5] = bf_hi(w.z); o[6] = bf_lo(w.w); o[7] = bf_hi(w.w); }
__device__ __forceinline__ u32x4 pack8(const float (&v)[8]) { u32x4 w; w.x = cvt_pk_bf16(v[0], v[1]); w.y = cvt_pk_bf16(v[2], v[3]); w.z = cvt_pk_bf16(v[4], v[5]); w.w = cvt_pk_bf16(v[6], v[7]); return w; }
__device__ __forceinline__ float wave_sum(float v) {
#pragma unroll
    for (int o = 1; o < 64; o <<= 1) v += __shfl_xor(v, o);
    return v;
}
#define LDS_BARRIER() do { asm volatile("s_waitcnt lgkmcnt(0)" ::: "memory"); __builtin_amdgcn_s_barrier(); asm volatile("" ::: "memory"); } while (0)
__device__ __forceinline__ float sigmoidf_(float x) { return __builtin_amdgcn_rcpf(1.f + __expf(-x)); }
__device__ __forceinline__ float siluf_(float x) { return x * __builtin_amdgcn_rcpf(1.f + __expf(-x)); }
__device__ __forceinline__ float tanhf_(float x) { return 1.f - 2.f * __builtin_amdgcn_rcpf(1.f + __expf(2.f * x)); }
__device__ __forceinline__ float softplusf_(float x) { return fmaxf(x, 0.f) + __logf(1.f + __expf(-fabsf(x))); }


typedef short s16x4 __attribute__((ext_vector_type(4)));
__device__ __forceinline__ f32x4 mma16(bf16x8 a, bf16x8 b, f32x4 c) { return __builtin_amdgcn_mfma_f32_16x16x32_bf16(a, b, c, 0, 0, 0); }
__device__ __forceinline__ bf16x8 cat4(s16x4 a, s16x4 b) { return (bf16x8){a[0], a[1], a[2], a[3], b[0], b[1], b[2], b[3]}; }
__device__ __forceinline__ bf16x8 frag_nat(const LAS bf16_t* Tt, int LD, int row0, int k0, int i16, int g) { return *(const LAS bf16x8*)(Tt + (row0 + i16) * LD + k0 + 8 * g); }
__device__ __forceinline__ bf16x8 frag_sig(const LAS bf16_t* Tt, int LD, int row0, int k0, int i16, int g) {
    const LAS bf16_t* p = Tt + (row0 + i16) * LD + k0 + 4 * g; return cat4(*(const LAS s16x4*)p, *(const LAS s16x4*)(p + 16)); }
__device__ __forceinline__ s16x4 tr4(const LAS bf16_t* p) { return __builtin_amdgcn_ds_read_tr16_b64_v4i16((LAS s16x4*)p); }
__device__ __forceinline__ bf16x8 frag_tr_nat(const LAS bf16_t* X, int LD, int k0, int c0, int i16, int g) {
    const LAS bf16_t* p = X + (k0 + 8 * g + (i16 >> 2)) * LD + c0 + 4 * (i16 & 3); return cat4(tr4(p), tr4(p + 4 * LD)); }
__device__ __forceinline__ bf16x8 frag_tr_sig(const LAS bf16_t* X, int LD, int k0, int c0, int i16, int g) {
    const LAS bf16_t* p = X + (k0 + 4 * g + (i16 >> 2)) * LD + c0 + 4 * (i16 & 3); return cat4(tr4(p), tr4(p + 16 * LD)); }
__device__ __forceinline__ bf16x8 acc_frag(f32x4 x0, f32x4 x1) {
    u32x4 w; w.x = cvt_pk_bf16(x0[0], x0[1]); w.y = cvt_pk_bf16(x0[2], x0[3]); w.z = cvt_pk_bf16(x1[0], x1[1]); w.w = cvt_pk_bf16(x1[2], x1[3]);
    return __builtin_bit_cast(bf16x8, w); }
__device__ __forceinline__ u32x2 pack4(f32x4 x) { u32x2 w; w.x = cvt_pk_bf16(x[0], x[1]); w.y = cvt_pk_bf16(x[2], x[3]); return w; }
__device__ __forceinline__ f32x4 unpack4(u32x2 w) { return (f32x4){bf_lo(w.x), bf_hi(w.x), bf_lo(w.y), bf_hi(w.y)}; }

namespace pg8 {
constexpr int BM = 256, BK = 64, HALF = 128, HTB = HALF * BK * 2, STAGE_BYTES = 8 * HTB, NXCD = 8, WGM = 8;
__host__ __device__ __forceinline__ int lds_byte(int r, int c) { const int st = (r >> 4) * 2 + (c >> 5), rr = r & 15, cc = c & 31, ob = rr * 64 + cc * 2; return st * 1024 + (ob ^ (((ob >> 9) & 1) << 5)); }
__host__ __device__ __forceinline__ void stage_rc(int b, int& R, int& C) { const int st = b / 1024, sb = b % 1024, swz = sb ^ (((sb >> 9) & 1) << 5); R = (st >> 1) * 16 + swz / 64; C = (st & 1) * 32 + (swz % 64) / 2; }
__host__ __device__ __forceinline__ int perm32(int rho) { const int n = rho >> 4, i = rho & 15; return 8 * (i >> 2) + 4 * n + (i & 3); }
struct Unit { int pm, pn; };
struct Gemm { const bf16_t* A; const bf16_t* Bt; int M, N, K, lda; };
struct StaticOrder {
    int nM, nN, nwg, G, c;
    __host__ __device__ void init(int M, int N, int G_, int c_) { nM = M / BM; nN = N / BM; nwg = nM * nN; G = G_; c = c_; }
    __host__ __device__ bool next(int i, Unit& u) const {
        const long L = (long)i * G + c; if (L >= nwg) return false;
        int wgid = (int)L; { const int q = nwg / NXCD, r = nwg % NXCD, xcd = wgid % NXCD, off = wgid / NXCD; wgid = (xcd < r ? xcd * (q + 1) : r * (q + 1) + (xcd - r) * q) + off; }
        const int nig = WGM * nN, gid = wgid / nig, fm = gid * WGM, gsz = (nM - fm) < WGM ? (nM - fm) : WGM;
        u.pm = fm + ((wgid % nig) % gsz); u.pn = (wgid % nig) / gsz; return true;
    }
};
template <class Epi, bool ALIGN_EPI>
__device__ __forceinline__ void gemm_phase(LAS unsigned char* lds, const Gemm g, const StaticOrder& S, const Epi& E) {
    int tid_ = threadIdx.x; asm volatile("" : "+v"(tid_));
    const int tid = tid_, wid = __builtin_amdgcn_readfirstlane(tid >> 6), lane = tid & 63, wr = wid >> 2, wc = wid & 3, fr = lane & 15, fq = lane >> 4;
    const int K = g.K, nt = K / BK, lda = g.lda;
    unsigned voffA[2], voffB[2];
#pragma unroll
    for (int i = 0; i < 2; ++i) { int R, C; stage_rc(tid * 16 + i * 8192, R, C); const int Rb = Epi::PERM ? ((R & ~31) + perm32(R & 31)) : R;
        voffA[i] = (unsigned)(R * lda + C) * 2u; voffB[i] = (unsigned)(Rb * K + C) * 2u; }
    const size_t kstep = (size_t)(BK * 2);
    const size_t hstepA = (size_t)HALF * lda * 2, hstepB = (size_t)HALF * K * 2;
    const size_t tstepA = 2 * hstepA, tstepB = 2 * hstepB;
    const unsigned ldsw = (unsigned)wid * 1024u;
    const int aoff = lds_byte(wr * 64 + fr, fq * 8), boff = lds_byte(wc * 32 + fr, fq * 8);
#define PG8_SA(b, h) (((b) * 2 + (h)) * HTB)
#define PG8_SB(b, h) ((4 + (b) * 2 + (h)) * HTB)
#define PG8_STAGE(bufoff, gbase, voff) do { _Pragma("unroll") for (int _i = 0; _i < 2; ++_i) \
        __builtin_amdgcn_global_load_lds((const unsigned*)((const char*)(gbase) + (voff)[_i]), (LAS unsigned*)(lds + (bufoff) + ldsw + _i * 8192), 16, 0, 0); } while (0)
#define PG8_LDA(dst, b, h) do { _Pragma("unroll") for (int m = 0; m < 4; ++m) _Pragma("unroll") for (int k = 0; k < 2; ++k) dst[m][k] = *(const LAS bf16x8*)(lds + PG8_SA(b, h) + aoff + m * 2048 + k * 1024); } while (0)
#define PG8_LDB(dst, b, h) do { _Pragma("unroll") for (int n = 0; n < 2; ++n) _Pragma("unroll") for (int k = 0; k < 2; ++k) dst[n][k] = *(const LAS bf16x8*)(lds + PG8_SB(b, h) + boff + n * 2048 + k * 1024); } while (0)
#define PG8_MMA(ai, bj, At, Bt) do { __builtin_amdgcn_s_setprio(1); _Pragma("unroll") for (int m = 0; m < 4; ++m) _Pragma("unroll") for (int n = 0; n < 2; ++n) _Pragma("unroll") for (int k = 0; k < 2; ++k) \
        acc[ai][bj][m][n] = __builtin_amdgcn_mfma_f32_16x16x32_bf16(Bt[n][k], At[m][k], acc[ai][bj][m][n], 0, 0, 0); __builtin_amdgcn_s_setprio(0); } while (0)
#define PG8_WAIT_V(n) asm volatile("s_waitcnt vmcnt(" #n ")" ::: "memory")
#define PG8_WAIT_L(n) asm volatile("s_waitcnt lgkmcnt(" #n ")" ::: "memory")
#define PG8_BAR __builtin_amdgcn_s_barrier()
#define PG8_SCHED __builtin_amdgcn_sched_barrier(0)
    Unit cur, nxt; int ui = 0;
    if (!S.next(0, cur)) return;
    f32x4 acc[2][2][4][2];
#pragma unroll
    for (int a = 0; a < 2; ++a)
#pragma unroll
        for (int b = 0; b < 2; ++b)
#pragma unroll
            for (int m = 0; m < 4; ++m)
#pragma unroll
                for (int n = 0; n < 2; ++n) acc[a][b][m][n] = (f32x4){0.f, 0.f, 0.f, 0.f};
    bf16x8 At[4][2], B0[2][2], B1[2][2];
    const char* cA = (const char*)g.A + (size_t)cur.pm * tstepA; const char* cB = (const char*)g.Bt + (size_t)cur.pn * tstepB;
    PG8_STAGE(PG8_SB(0, 0), cB, voffB); PG8_STAGE(PG8_SB(0, 1), cB + hstepB, voffB); PG8_STAGE(PG8_SA(0, 0), cA, voffA); PG8_STAGE(PG8_SA(0, 1), cA + hstepA, voffA);
    if (wr == 1) PG8_BAR;
    PG8_WAIT_V(2); PG8_BAR;
    PG8_STAGE(PG8_SB(1, 0), cB + kstep, voffB); PG8_STAGE(PG8_SA(1, 0), cA + kstep, voffA); PG8_STAGE(PG8_SB(1, 1), cB + hstepB + kstep, voffB);
    PG8_WAIT_V(6); PG8_BAR;
    for (;;) {
        const bool has_next = S.next(ui + 1, nxt);
        const char* nA = has_next ? (const char*)g.A + (size_t)nxt.pm * tstepA : cA; const char* nB = has_next ? (const char*)g.Bt + (size_t)nxt.pn * tstepB : cB;
        for (int t = 0; t < nt; t += 2) {
            const bool last = (t == nt - 2);
            const char* a1 = cA + (size_t)(t + 1) * kstep;
            const char* a2 = last ? nA : cA + (size_t)(t + 2) * kstep; const char* b2 = last ? nB : cB + (size_t)(t + 2) * kstep;
            const char* a3 = a2 + kstep; const char* b3 = b2 + kstep;
            PG8_LDB(B0, 0, 0); PG8_LDB(B1, 0, 1); PG8_SCHED; PG8_LDA(At, 0, 0); PG8_STAGE(PG8_SA(1, 1), a1 + hstepA, voffA);
            PG8_WAIT_V(8); PG8_WAIT_L(0); PG8_BAR; PG8_MMA(0, 0, At, B0); PG8_MMA(0, 1, At, B1); PG8_BAR; PG8_SCHED;
            PG8_LDA(At, 0, 1); PG8_STAGE(PG8_SB(0, 0), b2, voffB); PG8_STAGE(PG8_SB(0, 1), b2 + hstepB, voffB); PG8_STAGE(PG8_SA(0, 0), a2, voffA);
            PG8_WAIT_V(8); PG8_WAIT_L(0); PG8_BAR; PG8_MMA(1, 0, At, B0); PG8_MMA(1, 1, At, B1); PG8_BAR; PG8_SCHED;
            PG8_LDB(B0, 1, 0); PG8_LDB(B1, 1, 1); PG8_SCHED; PG8_LDA(At, 1, 0); PG8_STAGE(PG8_SA(0, 1), a2 + hstepA, voffA);
            PG8_WAIT_V(8); PG8_WAIT_L(0); PG8_BAR; PG8_MMA(0, 0, At, B0); PG8_MMA(0, 1, At, B1); PG8_BAR; PG8_SCHED;
            PG8_LDA(At, 1, 1); PG8_STAGE(PG8_SB(1, 0), b3, voffB); PG8_STAGE(PG8_SB(1, 1), b3 + hstepB, voffB); PG8_STAGE(PG8_SA(1, 0), a3, voffA);
            PG8_WAIT_V(8); PG8_WAIT_L(0); PG8_BAR; PG8_MMA(1, 0, At, B0); PG8_MMA(1, 1, At, B1); PG8_BAR; PG8_SCHED;
        }
        if constexpr (ALIGN_EPI) { if (wr == 0) PG8_BAR; }
        E(acc, cur, wr, wc, fr, fq);
        if (!has_next) break;
#pragma unroll
        for (int a = 0; a < 2; ++a)
#pragma unroll
            for (int b = 0; b < 2; ++b)
#pragma unroll
                for (int m = 0; m < 4; ++m)
#pragma unroll
                    for (int n = 0; n < 2; ++n) acc[a][b][m][n] = (f32x4){0.f, 0.f, 0.f, 0.f};
        cur = nxt; cA = nA; cB = nB; ++ui;
        if constexpr (ALIGN_EPI) { if (wr == 1) PG8_BAR; }
    }
    PG8_WAIT_V(0);
    if constexpr (!ALIGN_EPI) { if (wr == 0) PG8_BAR; }
    PG8_BAR;
#undef PG8_SA
#undef PG8_SB
#undef PG8_STAGE
#undef PG8_LDA
#undef PG8_LDB
#undef PG8_MMA
#undef PG8_WAIT_V
#undef PG8_WAIT_L
#undef PG8_BAR
#undef PG8_SCHED
}

__device__ __forceinline__ float row_rstd(const float* ssq, int row, int fq) {
    const f32x4 p = *(const f32x4*)(ssq + (size_t)row * 16 + 4 * fq);
    float s = (p.x + p.y) + (p.z + p.w);
    s += __shfl_xor(s, 16); s += __shfl_xor(s, 32);
    return rsqrtf(s * (1.0f / 1024.0f) + EPS);
}

struct EpiInProj {
    static constexpr bool PERM = true;
    bf16_t* proj; float* scal; const float* ssq; bf16_t* hconv; bf16_t* hshift; float* out; int layer;
    __device__ __forceinline__ void operator()(const f32x4 (&acc)[2][2][4][2], const Unit& u, int wr, int wc, int fr, int fq) const {
        const int pn = u.pn;
#pragma unroll
        for (int ai = 0; ai < 2; ++ai)
#pragma unroll
            for (int m = 0; m < 4; ++m) {
                const int row = u.pm * BM + ai * HALF + wr * 64 + m * 16 + fr;
                const float rs = row_rstd(ssq, row, fq);
                {
#pragma unroll
                    for (int bj = 0; bj < 2; ++bj) {
                        const int c0 = pn * BM + bj * HALF + wc * 32 + 8 * fq;
                        const f32x4 v0 = acc[ai][bj][m][0] * rs, v1 = acc[ai][bj][m][1] * rs;
                        u32x4 w; w.x = cvt_pk_bf16(v0[0], v0[1]); w.y = cvt_pk_bf16(v0[2], v0[3]); w.z = cvt_pk_bf16(v1[0], v1[1]); w.w = cvt_pk_bf16(v1[2], v1[3]);
                        *(u32x4*)(proj + (size_t)row * PW + c0) = w;
                        if (m == 3) {
                            const int chunk = row >> 6;
                            if (fr >= 13 && pn >= 4 && pn < 11) {
                                const int j = fr - 13;
                                *(u32x4*)(hconv + ((size_t)chunk * 3 + j) * 1792 + (c0 - 1024)) = w;
                                if (chunk >= 255) {
                                    float* o;
                                    if (c0 < PC_SX) o = out + (chunk == 255 ? O_P_GDNC + ((size_t)layer * 3 + j) * 768 : O_S_GDNC + (((size_t)layer * 32 + (chunk - 256)) * 3 + j) * 768) + (c0 - PC_GQ);
                                    else o = out + (chunk == 255 ? O_P_SSMC + ((size_t)layer * 3 + j) * 1024 : O_S_SSMC + (((size_t)layer * 32 + (chunk - 256)) * 3 + j) * 1024) + (c0 - PC_SX);
                                    *(f32x4*)o = v0; *(f32x4*)(o + 4) = v1;
                                }
                            }
                            if (fr == 15 && (pn == 3 || pn >= 11)) {
                                const int oc = (pn == 3) ? (c0 - PC_R) : (c0 - 2560);
                                *(u32x4*)(hshift + (size_t)chunk * 1024 + oc) = w;
                                if (chunk >= 255) {
                                    float* o = out + (chunk == 255 ? O_P_SHIFT + (size_t)layer * 1024 : O_S_SHIFT + ((size_t)layer * 32 + (chunk - 256)) * 1024) + oc;
                                    *(f32x4*)o = v0; *(f32x4*)(o + 4) = v1;
                                }
                            }
                        }
                    }
                }
            }
    }
};
template <bool F32BASE> struct EpiResid {
    static constexpr bool PERM = true;
    const float* base_p; const float* base_s; bf16_t* xb; float* ssq;
    __device__ __forceinline__ void operator()(const f32x4 (&acc)[2][2][4][2], const Unit& u, int wr, int wc, int fr, int fq) const {
        const int col0 = u.pn * BM + wc * 32 + 8 * fq;
#pragma unroll
        for (int ai = 0; ai < 2; ++ai)
#pragma unroll
            for (int m = 0; m < 4; ++m) {
                const int row = u.pm * BM + ai * HALF + wr * 64 + m * 16 + fr;
                float ss = 0.f;
#pragma unroll
                for (int bj = 0; bj < 2; ++bj) {
                    const int c = col0 + bj * HALF;
                    float x[8];
                    if (F32BASE) {
                        const float* bp = ((row < TP) ? base_p + (size_t)row * DM : base_s + (size_t)(row - TP) * DM) + c;
                        const f32x4 b0 = *(const f32x4*)bp, b1 = *(const f32x4*)(bp + 4);
                        x[0] = b0[0]; x[1] = b0[1]; x[2] = b0[2]; x[3] = b0[3]; x[4] = b1[0]; x[5] = b1[1]; x[6] = b1[2]; x[7] = b1[3];
                    } else unpack8(*(const u32x4*)(xb + (size_t)row * DM + c), x);
#pragma unroll
                    for (int n = 0; n < 2; ++n)
#pragma unroll
                        for (int i = 0; i < 4; ++i) { const float v = x[4 * n + i] + acc[ai][bj][m][n][i]; x[4 * n + i] = v; ss += v * v; }
                    *(u32x4*)(xb + (size_t)row * DM + c) = pack8(x);
                }
                ss += __shfl_xor(ss, 16); ss += __shfl_xor(ss, 32);
                if (fq == 0) ssq[(size_t)row * 16 + u.pn * 4 + wc] = ss;
            }
    }
};
struct EpiGateUp {
    static constexpr bool PERM = true;
    bf16_t* ff; const float* ssq;
    __device__ __forceinline__ void operator()(const f32x4 (&acc)[2][2][4][2], const Unit& u, int wr, int wc, int fr, int fq) const {
        const int c0 = u.pn * HALF + wc * 32 + 8 * fq;
#pragma unroll
        for (int ai = 0; ai < 2; ++ai)
#pragma unroll
            for (int m = 0; m < 4; ++m) {
                const int row = u.pm * BM + ai * HALF + wr * 64 + m * 16 + fr;
                const float rs = row_rstd(ssq, row, fq);
                float f[8];
#pragma unroll
                for (int n = 0; n < 2; ++n)
#pragma unroll
                    for (int i = 0; i < 4; ++i) { const float gg = acc[ai][0][m][n][i] * rs, uu = acc[ai][1][m][n][i] * rs; f[n * 4 + i] = siluf_(gg) * uu; }
                *(u32x4*)(ff + (size_t)row * FF + c0) = pack8(f);
            }
    }
};
}

#define XB_TMO      128
#define XB_XCNT(j)  (256  + 64 * (j))
#define XB_XSUB(j)  (1280 + 64 * (j))
#define XB_XGEN(j)  (2304 + 64 * (j))
#define XB_TOP      3328
#define XB_TOPGEN   3392
#define XCD_BAR_WORDS 3456
#define XB_SPIN_CAP (1u << 18)
__device__ __forceinline__ unsigned xb_ld(unsigned* p)              { return __hip_atomic_load(p, __ATOMIC_RELAXED, __HIP_MEMORY_SCOPE_AGENT); }
__device__ __forceinline__ unsigned xb_add(unsigned* p, unsigned v) { return __hip_atomic_fetch_add(p, v, __ATOMIC_RELAXED, __HIP_MEMORY_SCOPE_AGENT); }
__device__ __forceinline__ unsigned xb_xcc_id() { return (unsigned)__builtin_amdgcn_s_getreg((3 << 11) | 20) & 0xFu; }
#define XB_SPIN(cond, bar) do { unsigned _sp = 0; while (cond) { __builtin_amdgcn_s_sleep(1); \
    if ((++_sp & 255u) == 0u) { if (xb_ld(&(bar)[XB_TMO])) break; if (_sp > XB_SPIN_CAP) { atomicAdd(&(bar)[XB_TMO], 1u); break; } } } } while (0)
struct XcdBarrier { unsigned* bar; unsigned x; volatile LAS unsigned* st; };
__device__ __forceinline__ XcdBarrier xcd_barrier_post(unsigned* bar, volatile LAS unsigned* st) {
    XcdBarrier b; b.bar = bar; b.x = xb_xcc_id(); b.st = st;
    if (threadIdx.x == 0) (void)xb_add(&bar[XB_XCNT(b.x)], 1u);
    return b;
}
__device__ __forceinline__ void xcd_barrier_complete(unsigned* bar, unsigned x, unsigned& nloc, unsigned& nx) {
    const unsigned G = gridDim.x * gridDim.y * gridDim.z;
    unsigned sum, cnt, mine, sp = 0u;
    for (;;) {
        sum = 0u; cnt = 0u; mine = 0u;
#pragma unroll
        for (unsigned j = 0; j < 16; ++j) { const unsigned c = xb_ld(&bar[XB_XCNT(j)]); sum += c; cnt += (c > 0u) ? 1u : 0u; mine = (j == x) ? c : mine; }
        if (sum == G) break;
        __builtin_amdgcn_s_sleep(1);
        if ((++sp & 255u) == 0u) { if (xb_ld(&bar[XB_TMO])) break; if (sp > XB_SPIN_CAP) { atomicAdd(&bar[XB_TMO], 1u); break; } }
    }
    nloc = mine > 0u ? mine : 1u; nx = cnt > 0u ? cnt : 1u;
}
__device__ __forceinline__ void xcd_barrier(const XcdBarrier& b) {
    asm volatile("s_waitcnt vmcnt(0)" ::: "memory");
    __syncthreads();
    if (threadIdx.x == 0) {
        unsigned* bar = b.bar;
        __builtin_amdgcn_s_waitcnt(0);
        unsigned nloc = b.st[0], nx = b.st[1];
        if (nloc == 0u) { xcd_barrier_complete(bar, b.x, nloc, nx); b.st[0] = nloc; b.st[1] = nx; }
        const unsigned old = xb_add(&bar[XB_XSUB(b.x)], 1u);
        const unsigned gen = old / nloc;
        if (old + 1u == (gen + 1u) * nloc) {
            __builtin_amdgcn_fence(__ATOMIC_RELEASE, "agent");
            asm volatile("s_waitcnt vmcnt(0)" ::: "memory");
            const unsigned og = xb_add(&bar[XB_TOP], 1u);
            const unsigned tg = og / nx;
            if (og + 1u == (tg + 1u) * nx) xb_add(&bar[XB_TOPGEN], 1u);
            else XB_SPIN(xb_ld(&bar[XB_TOPGEN]) == tg, bar);
            __builtin_amdgcn_fence(__ATOMIC_ACQUIRE, "agent");
            xb_add(&bar[XB_XGEN(b.x)], 1u);
            asm volatile("s_waitcnt vmcnt(0)" ::: "memory");
        } else {
            XB_SPIN(xb_ld(&bar[XB_XGEN(b.x)]) == gen, bar);
            __builtin_amdgcn_fence(__ATOMIC_ACQUIRE, "agent");
            asm volatile("s_waitcnt vmcnt(0)" ::: "memory");
        }
    }
    __syncthreads();
}

struct Args { const float* in[37]; float* out; unsigned char* ws; unsigned sched[8]; int nsched, pmode; };
enum { I_XP = 0, I_XS, I_SGDN, I_SGDNC, I_SSSM, I_SSSMC, I_SRWKV, I_SSHIFT, I_NORM1, I_WIN, I_GCONVW, I_GALOG, I_GDTB, I_GNORMW,
       I_SCONVW, I_SCONVB, I_SALOG, I_SDTB, I_SD, I_SNORMW, I_RMU, I_RW0, I_RWUP, I_RA0, I_RAUP, I_RGUP, I_RKK, I_RKA, I_RRK, I_RLNW, I_RLNB,
       I_WOUT, I_NORM2, I_WG, I_WU, I_WD, I_FNORM };

struct Frame {
    LAS unsigned char* lds;
    int tid, lane, wave, vcu, G;
    float* out; unsigned char* ws;
};
constexpr int PTRTAB_OFF = LDSCTL_OFF + 1024;
__device__ __forceinline__ const float* inptr(LAS unsigned char* lds, int i) {
    const unsigned long long v = ((const LAS unsigned long long*)(lds + PTRTAB_OFF))[i];
    const unsigned lo = __builtin_amdgcn_readfirstlane((unsigned)v), hi = __builtin_amdgcn_readfirstlane((unsigned)(v >> 32));
    return (const float*)(((unsigned long long)hi << 32) | lo);
}
#define INP(i) inptr(F.lds, (i))
#define F_R1     ((bf16_t*)(F.ws + WS_R1))
#define F_R2     ((bf16_t*)(F.ws + WS_R2))
#define F_PROJ   ((bf16_t*)(F.ws + WS_PROJ))
#define F_SSQA   ((float*)(F.ws + WS_SSQA))
#define F_SSQD   ((float*)(F.ws + WS_SSQD))
#define F_SCAL   ((float*)(F.ws + WS_R2 + R2_SCAL))
#define F_HCONV  ((bf16_t*)(F.ws + WS_R2 + R2_HCONV))
#define F_HSHIFT ((bf16_t*)(F.ws + WS_R2 + R2_HSHIFT))
#define F_RWA    ((bf16_t*)((unsigned char*)F.out + R1_RWA))
#define F_RU     ((bf16_t*)((unsigned char*)F.out + R1_RU))
#define F_RBH    ((bf16_t*)((unsigned char*)F.out + R1_RBH))
#define F_RKV    ((bf16_t*)((unsigned char*)F.out + R1_RKV))
#define F_RDV    ((float*)(F.ws + WS_R2 + R2_RDV))
#define F_ACUM   ((float*)(F.ws + WS_R2 + R2_ACUM))
#define F_GCUM   ((float*)(F.ws + WS_R2 + R2_GCUM))
#define F_YOFF   ((bf16_t*)(F.ws + WS_R2 + R2_YOFF))
#define F_GW     ((bf16_t*)(F.ws + WS_R2 + R2_GW))
__device__ __forceinline__ bf16_t* w_in(const Frame& F, int l) { return (bf16_t*)(F.ws + WS_W + (size_t)l * W_LAYER_B); }
__device__ __forceinline__ bf16_t* w_out(const Frame& F, int l) { return (bf16_t*)(F.ws + WS_W + (size_t)l * W_LAYER_B + W_IN_B); }
__device__ __forceinline__ bf16_t* w_gu(const Frame& F, int l) { return (bf16_t*)(F.ws + WS_W + (size_t)l * W_LAYER_B + W_IN_B + W_OUT_B); }
__device__ __forceinline__ bf16_t* w_dn(const Frame& F, int l) { return (bf16_t*)(F.ws + WS_W + (size_t)l * W_LAYER_B + W_IN_B + W_OUT_B + W_GU_B); }

template <class Tp> __device__ __forceinline__ LAS Tp* opaque_lds(LAS Tp* p) { unsigned a = (unsigned)(unsigned long long)p; asm volatile("" : "+v"(a)); return (LAS Tp*)(unsigned long long)a; }
constexpr int CW_AFLAG = 14336, CW_RFLAG = 14336 + 288;
__device__ __forceinline__ void publish_item(unsigned* flag) {
    asm volatile("s_waitcnt vmcnt(0)" ::: "memory");
    LDS_BARRIER();
    if (threadIdx.x == 0) {
        __builtin_amdgcn_fence(__ATOMIC_RELEASE, "agent");
        asm volatile("s_waitcnt vmcnt(0)" ::: "memory");
        __hip_atomic_fetch_add(flag, 1u, __ATOMIC_RELAXED, __HIP_MEMORY_SCOPE_AGENT);
    }
}
__device__ __forceinline__ int opaque_tid() { int t = threadIdx.x; asm volatile("" : "+v"(t)); return t; }
#define PHASE_IDS(F) do { (F).tid = opaque_tid(); (F).lane = (F).tid & 63; (F).wave = __builtin_amdgcn_readfirstlane((F).tid >> 6); } while (0)
__device__ __forceinline__ int inproj_dst(int n) {
    if (n < 768) return PC_GQ + n;
    if (n < 1024) return PC_ZG + (n - 768);
    if (n < 1032) return 3584 + (n - 1024);
    if (n < 1544) return PC_ZS + (n - 1032);
    if (n < 2568) return PC_SX + (n - 1544);
    if (n < 2576) return 3592 + (n - 2568);
    if (n < 2832) return PC_R + (n - 2576);
    if (n < 3344) return PC_RK + (n - 2832);
    return PC_RL + (n - 3344);
}
template <int MODE>
__device__ __forceinline__ void p0_transpose_item(const float* W, int K, int N, bf16_t* WT, const float* kscale, LAS float* scr, int item, int lane) {
    const int nblk = (N + 31) / 32, kb = item / nblk, nb = item % nblk, k0 = 64 * kb, n0 = 32 * nb;
    {
        const int rr = lane >> 3, c4 = (lane & 7) * 4;
        f32x4 v[8];
#pragma unroll
        for (int i = 0; i < 8; ++i) { const float* p = W + (size_t)(k0 + 8 * i + rr) * N + n0 + c4;
            if (n0 + c4 + 3 < N) v[i] = *(const f32x4*)p;
            else v[i] = (f32x4){0.f, 0.f, 0.f, 0.f}; }
#pragma unroll
        for (int i = 0; i < 8; ++i) { LAS float* s = scr + (8 * i + rr) * 33 + c4; s[0] = v[i][0]; s[1] = v[i][1]; s[2] = v[i][2]; s[3] = v[i][3]; }
    }
    asm volatile("s_waitcnt lgkmcnt(0)" ::: "memory");
    const int c = lane & 7;
    float ks[8];
#pragma unroll
    for (int i = 0; i < 8; ++i) ks[i] = kscale ? kscale[k0 + 8 * c + i] : 1.f;
#pragma unroll
    for (int j = 0; j < 4; ++j) { const int nl = (lane >> 3) + 8 * j; const int n = n0 + nl; const LAS float* s = scr + (8 * c) * 33 + nl;
        u32x4 o; o.x = cvt_pk_bf16(s[0 * 33] * ks[0], s[1 * 33] * ks[1]); o.y = cvt_pk_bf16(s[2 * 33] * ks[2], s[3 * 33] * ks[3]);
        o.z = cvt_pk_bf16(s[4 * 33] * ks[4], s[5 * 33] * ks[5]); o.w = cvt_pk_bf16(s[6 * 33] * ks[6], s[7 * 33] * ks[7]);
        if (n < N) {
            int d;
            if (MODE == 0) d = n; else if (MODE == 1) d = inproj_dst(n); else if (MODE == 2) d = 256 * (n >> 7) + (n & 127); else d = 256 * (n >> 7) + 128 + (n & 127);
            *(u32x4*)(WT + (size_t)d * K + k0 + 8 * c) = o; } }
    asm volatile("s_waitcnt lgkmcnt(0)" ::: "memory");
}
__device__ __forceinline__ void p0_prologue(Frame& F) {
    PHASE_IDS(F);
    LAS float* scr = (LAS float*)(F.lds + F.wave * 16384);
    const int gw = F.vcu * 8 + F.wave, NGW = F.G * 8;
    constexpr int I_IN = 16 * 113, I_OUT = 16 * 32, I_G = 16 * 88, I_D = 44 * 32;
    constexpr int PER_L = I_IN + I_OUT + 2 * I_G + I_D;
    for (int it = gw; it < 2 * PER_L; it += NGW) {
        const int l = it / PER_L; int r = it % PER_L;
        if (r < I_IN) { p0_transpose_item<1>(INP(I_WIN) + (size_t)l * DM * 3600, DM, 3600, w_in(F, l), INP(I_NORM1) + l * DM, scr, r, F.lane); continue; } r -= I_IN;
        if (r < I_OUT) { p0_transpose_item<0>(INP(I_WOUT) + (size_t)l * DM * DM, DM, DM, w_out(F, l), nullptr, scr, r, F.lane); continue; } r -= I_OUT;
        if (r < I_G) { p0_transpose_item<2>(INP(I_WG) + (size_t)l * DM * FF, DM, FF, w_gu(F, l), INP(I_NORM2) + l * DM, scr, r, F.lane); continue; } r -= I_G;
        if (r < I_G) { p0_transpose_item<3>(INP(I_WU) + (size_t)l * DM * FF, DM, FF, w_gu(F, l), INP(I_NORM2) + l * DM, scr, r, F.lane); continue; } r -= I_G;
        p0_transpose_item<0>(INP(I_WD) + (size_t)l * FF * DM, FF, DM, w_dn(F, l), nullptr, scr, r, F.lane);
    }
    for (int m = gw; m < T; m += NGW) {
        const float* xr = (m < TP) ? INP(I_XP) + (size_t)m * DM : INP(I_XS) + (size_t)(m - TP) * DM;
        f32x4 v[4]; float s = 0.f;
#pragma unroll
        for (int j = 0; j < 4; ++j) { v[j] = *((const f32x4*)xr + F.lane + 64 * j); s += (v[j].x * v[j].x + v[j].y * v[j].y) + (v[j].z * v[j].z + v[j].w * v[j].w); }
        s = wave_sum(s);
#pragma unroll
        for (int j = 0; j < 4; ++j) { u32x2 w; w.x = cvt_pk_bf16(v[j].x, v[j].y); w.y = cvt_pk_bf16(v[j].z, v[j].w); *((u32x2*)(F_R1 + (size_t)m * DM) + F.lane + 64 * j) = w; }
        if (F.lane < 16) F_SSQA[(size_t)m * 16 + F.lane] = (F.lane == 0) ? s : 0.f;
    }
}

template <int LDL, int SGN, class RhsFn>
__device__ __forceinline__ void tri_solve64(const LAS float* Lo, float (&x)[64], RhsFn rhs) {
    f32x4 cur[16], nxt[16];
#pragma unroll
    for (int i = 0; i < 64; ++i) {
        if (i + 1 < 64) {
#pragma unroll
            for (int m4 = 0; m4 < (i + 1 + 3) / 4; ++m4) nxt[m4] = *(const LAS f32x4*)(Lo + (i + 1) * LDL + 4 * m4);
        }
        float a0 = rhs(i), a1 = 0.f, a2 = 0.f, a3 = 0.f;
#pragma unroll
        for (int m4 = 0; m4 < (i + 3) / 4; ++m4) {
            if (4 * m4 + 0 < i) a0 += (SGN > 0 ? cur[m4][0] : -cur[m4][0]) * x[4 * m4 + 0];
            if (4 * m4 + 1 < i) a1 += (SGN > 0 ? cur[m4][1] : -cur[m4][1]) * x[4 * m4 + 1];
            if (4 * m4 + 2 < i) a2 += (SGN > 0 ? cur[m4][2] : -cur[m4][2]) * x[4 * m4 + 2];
            if (4 * m4 + 3 < i) a3 += (SGN > 0 ? cur[m4][3] : -cur[m4][3]) * x[4 * m4 + 3];
        }
        x[i] = (a0 + a1) + (a2 + a3);
        __builtin_amdgcn_sched_barrier(0);
#pragma unroll
        for (int m4 = 0; m4 < 16; ++m4) cur[m4] = nxt[m4];
    }
}
constexpr int ACT_KT = 0, ACT_VT = 33792, ACT_LM = 67584, ACT_SCL = 137216, ACT_GCL = 141312;
constexpr int ACT_LDK = 264, ACT_LDL = 68;
__device__ __forceinline__ void act_chunk(Frame& F, int l, int c) {
    PHASE_IDS(F);
    const int tid = F.tid;
    const size_t row0 = (size_t)c * 64;
    const bool prompt = c < 256; const int b = c - 256;
    bf16_t* const proj = F_PROJ;
    LAS float* inT = (LAS float*)F.lds;
    LAS bf16_t* kx = (LAS bf16_t*)(F.lds + 256 * 68 * 4);
    LAS bf16_t* Kt = (LAS bf16_t*)(F.lds + ACT_KT); LAS bf16_t* Vt = (LAS bf16_t*)(F.lds + ACT_VT); LAS float* Lm = (LAS float*)(F.lds + ACT_LM);
    LAS float* scl = (LAS float*)(F.lds + ACT_SCL); LAS float* gcl = (LAS float*)(F.lds + ACT_GCL);
    LAS float* part = (LAS float*)(F.lds + ACT_LM); LAS float* rsl = part + 2 * 64 * 16;
    {
        const int w = F.wave, lane = F.lane, i16 = lane & 15, g = lane >> 4, rt = w & 3, kh = w >> 2;
        const bf16_t* ap = F_R1 + (row0 + 16 * rt + i16) * DM + kh * 512 + 8 * g;
        const bf16_t* bp = w_in(F, l) + (size_t)(PW + i16) * DM + kh * 512 + 8 * g;
        bf16x8 a[16], b[16];
#pragma unroll
        for (int ks = 0; ks < 16; ++ks) { a[ks] = *(const bf16x8*)(ap + 32 * ks); b[ks] = *(const bf16x8*)(bp + 32 * ks); }
        if (tid < 64) { const f32x4* sp = (const f32x4*)(F_SSQA + (row0 + tid) * 16); const f32x4 p0 = sp[0], p1 = sp[1], p2 = sp[2], p3 = sp[3];
            const float s = ((p0.x + p0.y) + (p0.z + p0.w)) + ((p1.x + p1.y) + (p1.z + p1.w)) + ((p2.x + p2.y) + (p2.z + p2.w)) + ((p3.x + p3.y) + (p3.z + p3.w));
            rsl[tid] = rsqrtf(s * (1.0f / 1024.0f) + EPS); }
        f32x4 acc0 = (f32x4){0.f, 0.f, 0.f, 0.f}, acc1 = (f32x4){0.f, 0.f, 0.f, 0.f};
#pragma unroll
        for (int ks = 0; ks < 16; ks += 2) { acc0 = mma16(a[ks], b[ks], acc0); acc1 = mma16(a[ks + 1], b[ks + 1], acc1); }
#pragma unroll
        for (int r = 0; r < 4; ++r) part[(kh * 64 + 16 * rt + 4 * g + r) * 16 + i16] = acc0[r] + acc1[r];
    }
    LDS_BARRIER();
    for (int e = tid; e < 64 * 16; e += 512) {
        const int t = e >> 4, q = e & 15;
        float* p = F_SCAL + (row0 + t) * 16 + q;
        const float v = (part[e] + part[1024 + e]) * rsl[t]; float r;
        if (q < 4) r = -__expf(INP(I_GALOG)[l * 4 + q]) * softplusf_(v + INP(I_GDTB)[l * 4 + q]);
        else if (q < 8) r = sigmoidf_(v);
        else r = softplusf_(v + INP(I_SDTB)[l * 8 + (q - 8)]);
        *p = r; scl[e] = r;
    }
    LDS_BARRIER();
    {
        const int w = F.wave, lane = F.lane;
        float v = scl[lane * 16 + 8 + w] * (-__expf(INP(I_SALOG)[l * 8 + w]));
#pragma unroll
        for (int o = 1; o < 64; o <<= 1) { const float tt = __shfl_up(v, o); if (lane >= o) v += tt; }
        F_ACUM[(row0 + lane) * 8 + w] = v;
        if (w < 4) {
            float gv = scl[lane * 16 + w];
#pragma unroll
            for (int o = 1; o < 64; o <<= 1) { const float tt = __shfl_up(gv, o); if (lane >= o) gv += tt; }
            F_GCUM[(row0 + lane) * 4 + w] = gv; gcl[w * 64 + lane] = gv;
        }
    }
    {
        const int cg = tid % 224, rh = tid / 224;
        const bool active = tid < 448;
        const int col = 1024 + cg * 8, t0 = 32 * rh;
        const bool gdn = cg < 96;
        const int cc = gdn ? (col - PC_GQ) : (col - PC_SX);
        const int C = gdn ? 768 : 1024;
        const int kind = gdn ? (cg >> 5) : 3;
        float w[4][8], bias[8], p3[8], p2[8], p1[8];
        u32x4 xr[16];
        if (active) {
            const float* cw = gdn ? INP(I_GCONVW) + (size_t)l * 4 * 768 : INP(I_SCONVW) + (size_t)l * 4 * 1024;
#pragma unroll
            for (int j = 0; j < 4; ++j)
#pragma unroll
                for (int i = 0; i < 8; ++i) w[j][i] = cw[j * C + cc + i];
#pragma unroll
            for (int i = 0; i < 8; ++i) bias[i] = gdn ? 0.f : INP(I_SCONVB)[l * 1024 + cc + i];
            if (rh == 1) {
                unpack8(*(const u32x4*)(proj + (row0 + t0 - 3) * PW + col), p3); unpack8(*(const u32x4*)(proj + (row0 + t0 - 2) * PW + col), p2); unpack8(*(const u32x4*)(proj + (row0 + t0 - 1) * PW + col), p1);
            } else if (prompt) {
                if (c == 0) {
#pragma unroll
                    for (int i = 0; i < 8; ++i) { p3[i] = 0.f; p2[i] = 0.f; p1[i] = 0.f; }
                } else {
                    const bf16_t* hp = F_HCONV + (size_t)(c - 1) * 3 * 1792 + (col - 1024);
                    unpack8(*(const u32x4*)(hp), p3); unpack8(*(const u32x4*)(hp + 1792), p2); unpack8(*(const u32x4*)(hp + 2 * 1792), p1);
                }
            } else {
                const float* st = gdn ? INP(I_SGDNC) + ((size_t)l * 32 + b) * 3 * 768 + cc : INP(I_SSSMC) + ((size_t)l * 32 + b) * 3 * 1024 + cc;
#pragma unroll
                for (int i = 0; i < 8; ++i) { p3[i] = st[i]; p2[i] = st[C + i]; p1[i] = st[2 * C + i]; }
            }
#pragma unroll
            for (int t = 0; t < 16; ++t) xr[t] = *(const u32x4*)(proj + (row0 + t0 + t) * PW + col);
        }
        asm volatile("s_waitcnt vmcnt(0)" ::: "memory");
        LDS_BARRIER();
#pragma unroll
        for (int bt = 0; bt < 2; ++bt) {
            if (active) {
#pragma unroll
                for (int t = 0; t < 16; ++t) {
                    const int tr = t0 + 16 * bt + t;
                    bf16_t* p = proj + (row0 + tr) * PW + col;
                    float x[8], y[8];
                    unpack8(xr[t], x);
#pragma unroll
                    for (int i = 0; i < 8; ++i) { float a = w[0][i] * p3[i] + w[1][i] * p2[i] + w[2][i] * p1[i] + w[3][i] * x[i] + bias[i]; y[i] = siluf_(a); p3[i] = p2[i]; p2[i] = p1[i]; p1[i] = x[i]; }
                    if (kind < 2) {
                        float ss = 0.f;
#pragma unroll
                        for (int i = 0; i < 8; ++i) ss += y[i] * y[i];
                        ss += __shfl_xor(ss, 1); ss += __shfl_xor(ss, 2); ss += __shfl_xor(ss, 4);
                        const float sc = rsqrtf(ss + EPS) * (kind == 0 ? 0.125f : 1.f);
#pragma unroll
                        for (int i = 0; i < 8; ++i) y[i] *= sc;
                    }
                    const u32x4 pk = pack8(y);
                    if (kind != 2) *(u32x4*)p = pk;
                    if (kind == 1) *(LAS u32x4*)(Kt + tr * ACT_LDK + (col - PC_GK)) = pk;
                    if (kind == 2) *(LAS u32x4*)(Vt + tr * ACT_LDK + (col - PC_GV)) = pk;
                }
                if (bt == 0) {
#pragma unroll
                    for (int t = 0; t < 16; ++t) xr[t] = *(const u32x4*)(proj + (row0 + t0 + 16 + t) * PW + col);
                }
            }
        }
    }
    LDS_BARRIER();
    {
        const int w = F.wave, lane = F.lane, i16 = lane & 15, g = lane >> 4, h = w >> 1, e = w & 1;
        LAS float* Lh = Lm + h * 64 * ACT_LDL;
#pragma unroll
        for (int ii = 0; ii < 2; ++ii) {
            const int it = e + 2 * ii;
#pragma unroll
            for (int jt = 0; jt < 4; ++jt) {
                if (jt <= it) {
                    f32x4 acc = (f32x4){0.f, 0.f, 0.f, 0.f};
#pragma unroll
                    for (int ks = 0; ks < 2; ++ks) acc = mma16(frag_nat(Kt, ACT_LDK, 16 * it, h * 64 + 32 * ks, i16, g), frag_nat(Kt, ACT_LDK, 16 * jt, h * 64 + 32 * ks, i16, g), acc);
                    const int j = 16 * jt + i16; const float gcj = gcl[h * 64 + j];
#pragma unroll
                    for (int r = 0; r < 4; ++r) { const int i = 16 * it + 4 * g + r;
                        const float f = (j < i) ? scl[i * 16 + 4 + h] * __expf(fminf(gcl[h * 64 + i] - gcj, 0.f)) : 0.f;
                        Lh[i * ACT_LDL + j] = acc[r] * f; }
                }
            }
        }
        LDS_BARRIER();
        float x[64];
        const LAS bf16_t* Rt = opaque_lds((e == 0 ? Vt : Kt) + h * 64 + lane); const float ef = (float)e;
        const LAS float* Lo = opaque_lds(Lh); const LAS float* sclo = opaque_lds(scl + 4 + h); const LAS float* gclo = opaque_lds(gcl + h * 64);
        tri_solve64<ACT_LDL, -1>(Lo, x, [&](int i) { return sclo[i * 16] * __expf(gclo[i] * ef) * bf2f(Rt[i * ACT_LDK]); });
        if (e == 0) {
            bf16_t* o = proj + (row0 + lane) * PW + PC_GV + h * 64;
#pragma unroll
            for (int q = 0; q < 8; ++q) { float y[8];
#pragma unroll
                for (int i = 0; i < 8; ++i) y[i] = x[8 * q + i];
                *(u32x4*)(o + 8 * q) = pack8(y); }
        } else {
            bf16_t* o = F_GW + (((size_t)c * 4 + h) * 64) * 64 + lane;
#pragma unroll
            for (int i = 0; i < 64; ++i) o[i * 64] = f2bf(-x[i]);
        }
    }
    publish_item((unsigned*)(F.ws + WS_CTL) + CW_AFLAG + c);
    LDS_BARRIER();
}

__device__ __forceinline__ void st8_wt(void* p, u32x2 v) { __hip_atomic_store((unsigned long long*)p, __builtin_bit_cast(unsigned long long, v), __ATOMIC_RELAXED, __HIP_MEMORY_SCOPE_AGENT); }
__device__ __forceinline__ u32x4 ld16_asm(const void* p) { u32x4 r; asm volatile("global_load_dwordx4 %0, %1, off sc1" : "=v"(r) : "v"(p)); return r; }
__device__ __forceinline__ float ld4_asm(const float* p) { float r; asm volatile("global_load_dword %0, %1, off sc1" : "=v"(r) : "v"(p)); return r; }
constexpr int RDY_SLACK = 8;
#define RDY_WORD(F) ((volatile LAS int*)((F).lds + MISC_OFF + 64))
__device__ __forceinline__ int rdy_advance(const unsigned* rdy, int rstride, unsigned rneed, int nxt, int nch, int lane) {
    const int k = nxt + (lane & 15);
    const bool ok = k < nch && (int)(__hip_atomic_load(rdy + (size_t)rstride * k, __ATOMIC_RELAXED, __HIP_MEMORY_SCOPE_AGENT) - rneed) >= 0;
    const unsigned long long m = __ballot(ok) & 0xffffull;
    return nxt + __builtin_ctzll(~m);
}
__device__ __forceinline__ int rdy_block(Frame& F, const unsigned* rdy, int rstride, unsigned rneed, int nxt, int upto, int nch) {
    unsigned sp = 0;
    while (nxt < upto && ++sp < 4000000u) { const int n2 = rdy_advance(rdy, rstride, rneed, nxt, nch, F.lane); if (n2 == nxt) __builtin_amdgcn_s_sleep(8); nxt = n2; }
    if (F.lane == 0) *RDY_WORD(F) = nxt - 1;
    return nxt;
}
#define RDY_LOADER_WAIT(F, k) do { const int kk_ = (k) < nch ? (k) : nch - 1; unsigned sp_ = 0; while (*RDY_WORD(F) < kk_ && ++sp_ < 40000000u) __builtin_amdgcn_s_sleep(1); } while (0)
#define SCAN_CL(k) (c0 + ((k) < nch ? (k) : nch - 1))
#define SCAN_LOADER6(LOADM, WRITEM, WAITM, NLD) do {            \
        RDY_LOADER_WAIT(F, 0); LOADM(SCAN_CL(0), 0); WAITM(0, 0); WRITEM(0, 0); \
        RDY_LOADER_WAIT(F, 1); LOADM(SCAN_CL(1), 1); RDY_LOADER_WAIT(F, 2); LOADM(SCAN_CL(2), 2); RDY_LOADER_WAIT(F, 3); LOADM(SCAN_CL(3), 3); RDY_LOADER_WAIT(F, 4); LOADM(SCAN_CL(4), 4); RDY_LOADER_WAIT(F, 5); LOADM(SCAN_CL(5), 5); \
        LDS_BARRIER(); \
        for (int r_ = 0; r_ < nch; r_ += 6) { \
            RDY_LOADER_WAIT(F, r_ + 6); LOADM(SCAN_CL(r_ + 6), 0); WAITM(1, 5 * (NLD)); WRITEM(1, 1); LDS_BARRIER(); if (r_ + 1 >= nch) break; \
            RDY_LOADER_WAIT(F, r_ + 7); LOADM(SCAN_CL(r_ + 7), 1); WAITM(2, 5 * (NLD)); WRITEM(0, 2); LDS_BARRIER(); if (r_ + 2 >= nch) break; \
            RDY_LOADER_WAIT(F, r_ + 8); LOADM(SCAN_CL(r_ + 8), 2); WAITM(3, 5 * (NLD)); WRITEM(1, 3); LDS_BARRIER(); if (r_ + 3 >= nch) break; \
            RDY_LOADER_WAIT(F, r_ + 9); LOADM(SCAN_CL(r_ + 9), 3); WAITM(4, 5 * (NLD)); WRITEM(0, 4); LDS_BARRIER(); if (r_ + 4 >= nch) break; \
            RDY_LOADER_WAIT(F, r_ + 10); LOADM(SCAN_CL(r_ + 10), 4); WAITM(5, 5 * (NLD)); WRITEM(1, 5); LDS_BARRIER(); if (r_ + 5 >= nch) break; \
            RDY_LOADER_WAIT(F, r_ + 11); LOADM(SCAN_CL(r_ + 11), 5); WAITM(0, 5 * (NLD)); WRITEM(0, 0); LDS_BARRIER(); \
        } \
        asm volatile("s_waitcnt vmcnt(0)" ::: "memory"); \
        } while (0)
#define SCAN_LOADER(LOADM, WRITEM, WAITM, NLD) do { \
          \
          \
        RDY_LOADER_WAIT(F, 0); LOADM(SCAN_CL(0), 0); WAITM(0, 0); WRITEM(0, 0); \
        RDY_LOADER_WAIT(F, 1); LOADM(SCAN_CL(1), 1); RDY_LOADER_WAIT(F, 2); LOADM(SCAN_CL(2), 2); RDY_LOADER_WAIT(F, 3); LOADM(SCAN_CL(3), 3); \
        LDS_BARRIER(); \
          \
        for (int r_ = 0; r_ < nch; r_ += 4) { \
            RDY_LOADER_WAIT(F, r_ + 4); LOADM(SCAN_CL(r_ + 4), 0); WAITM(1, 3 * (NLD)); WRITEM(1, 1); LDS_BARRIER(); if (r_ + 1 >= nch) break; \
            RDY_LOADER_WAIT(F, r_ + 5); LOADM(SCAN_CL(r_ + 5), 1); WAITM(2, 3 * (NLD)); WRITEM(0, 2); LDS_BARRIER(); if (r_ + 2 >= nch) break; \
            RDY_LOADER_WAIT(F, r_ + 6); LOADM(SCAN_CL(r_ + 6), 2); WAITM(3, 3 * (NLD)); WRITEM(1, 3); LDS_BARRIER(); if (r_ + 3 >= nch) break; \
            RDY_LOADER_WAIT(F, r_ + 7); LOADM(SCAN_CL(r_ + 7), 3); WAITM(0, 3 * (NLD)); WRITEM(0, 0); LDS_BARRIER(); \
        } \
        asm volatile("s_waitcnt vmcnt(0)" ::: "memory");      \
        } while (0)

constexpr int GDN_LD = 72;
constexpr int GDN_BUF = 3 * 64 * GDN_LD * 2 + 64;
__device__ __forceinline__ void scan_gdn2(Frame& F, int l, int s, int h, int vb, int ncw, unsigned* prog, unsigned pbase, unsigned* done, int pm, const unsigned* rdy, int rstride, unsigned rneed) {
    PHASE_IDS(F);
    const int tid = F.tid, lane = F.lane, w = F.wave, i16 = lane & 15, g = lane >> 4;
    const int nch = (s == 0) ? 256 : 1, c0 = (s == 0) ? 0 : 255 + s, b = s - 1;
    bf16_t* const proj = F_PROJ; bf16_t* const gw = F_GW; const float* const gcum = F_GCUM;
    {
        if (w == (ncw < 4 ? ncw : 0)) (void)rdy_block(F, rdy, rstride, rneed, 0, nch < RDY_SLACK ? nch : RDY_SLACK, nch);
        LDS_BARRIER();
    }
    if (w >= 4) {
        const int lt = tid - 256;
        const int umask = 128 * ncw - 1;
        u32x4 rw0[2], ru0[2], rk0[2], rw1[2], ru1[2], rk1[2], rw2[2], ru2[2], rk2[2], rw3[2], ru3[2], rk3[2], rw4[2], ru4[2], rk4[2], rw5[2], ru5[2], rk5[2]; float gc0[2], gl0, gc1[2], gl1, gc2[2], gl2, gc3[2], gl3, gc4[2], gl4, gc5[2], gl5;
        const bf16_t* pW[2]; const bf16_t* pU[2]; const bf16_t* pK[2]; const float* pG[2]; const float* const pGl = gcum + 63 * 4 + h;
#pragma unroll
        for (int q = 0; q < 2; ++q) { const int idx = q * 256 + lt, row = idx >> 3, col8 = (idx & 7) * 8, urow = vb + ((idx & umask) >> 3);
            pW[q] = gw + ((size_t)h * 64 + row) * 64 + col8; pU[q] = proj + (size_t)urow * PW + PC_GV + h * 64 + col8; pK[q] = proj + (size_t)row * PW + PC_GK + h * 64 + col8; pG[q] = gcum + row * 4 + h; }
#define GDN_LOAD(ch, S) do { const size_t oW_ = (size_t)(ch) * (4 * 4096), oP_ = (size_t)(ch) * (64 * PW), oG_ = (size_t)(ch) * 256; gl##S = ld4_asm(pGl + oG_); \
        _Pragma("unroll") for (int q = 0; q < 2; ++q) { rw##S[q] = ld16_asm(pW[q] + oW_); ru##S[q] = ld16_asm(pU[q] + oP_); rk##S[q] = ld16_asm(pK[q] + oP_); gc##S[q] = ld4_asm(pG[q] + oG_); } } while (0)
#define GDN_WAIT(S, N) asm volatile("s_waitcnt vmcnt(%9)" : "+v"(rw##S[0]), "+v"(rw##S[1]), "+v"(ru##S[0]), "+v"(ru##S[1]), "+v"(rk##S[0]), "+v"(rk##S[1]), "+v"(gc##S[0]), "+v"(gc##S[1]), "+v"(gl##S) : "n"(N))
#define GDN_WRITE(bb, S) do { LAS bf16_t* Wn_ = (LAS bf16_t*)(F.lds + (bb) * GDN_BUF); LAS bf16_t* Ut_ = Wn_ + 64 * GDN_LD; LAS bf16_t* Kd_ = Ut_ + 64 * GDN_LD; \
        _Pragma("unroll") for (int q = 0; q < 2; ++q) { const int idx = q * 256 + lt, row = idx >> 3, col8 = (idx & 7) * 8; \
            *(LAS u32x4*)(Wn_ + row * GDN_LD + col8) = rw##S[q]; *(LAS u32x4*)(Ut_ + (vb + ((idx & umask) >> 3)) * GDN_LD + col8) = ru##S[q]; \
            const float ks_ = __expf(gl##S - gc##S[q]); \
            float v_[8]; unpack8(rk##S[q], v_); _Pragma("unroll") for (int i = 0; i < 8; ++i) v_[i] *= ks_; *(LAS u32x4*)(Kd_ + row * GDN_LD + col8) = pack8(v_); } \
        if (lt == 0) *(LAS float*)(Kd_ + 64 * GDN_LD) = __expf(gl##S); } while (0)
        SCAN_LOADER6(GDN_LOAD, GDN_WRITE, GDN_WAIT, 9);
#undef GDN_LOAD
#undef GDN_WRITE
#undef GDN_WAIT
    } else if (w >= ncw) {
        int nxt = nch < RDY_SLACK ? nch : RDY_SLACK;
        LDS_BARRIER();
        for (int ci = 0; ci < nch; ++ci) {
            if (w == ncw && nxt < nch) { const int upto = ci + 1 + RDY_SLACK < nch ? ci + 1 + RDY_SLACK : nch; nxt = rdy_block(F, rdy, rstride, rneed, nxt, upto, nch); }
            LDS_BARRIER();
        }
    } else {
        const int n0 = vb + 16 * w;
        f32x4 S[4];
        if (s == 0) {
#pragma unroll
            for (int kt = 0; kt < 4; ++kt) S[kt] = (f32x4){0.f, 0.f, 0.f, 0.f};
        } else {
            const float* st = INP(I_SGDN) + (((size_t)l * 32 + b) * 4 + h) * 4096 + n0 + i16;
#pragma unroll
            for (int kt = 0; kt < 4; ++kt)
#pragma unroll
                for (int r = 0; r < 4; ++r) S[kt][r] = st[(16 * kt + 4 * g + r) * 64];
        }
        LDS_BARRIER();
        for (int ci = 0; ci < nch; ++ci) {
            const int chunk = c0 + ci; const size_t row0 = (size_t)chunk * 64;
            const LAS bf16_t* Wn = (const LAS bf16_t*)(F.lds + (ci & 1) * GDN_BUF); const LAS bf16_t* Ut = Wn + 64 * GDN_LD; const LAS bf16_t* Kd = Ut + 64 * GDN_LD;
            const float bd = *(const LAS float*)(Kd + 64 * GDN_LD);
            bf16x8 A1[4][2], A2[4][2]; u32x2 ui[4];
#pragma unroll
            for (int m = 0; m < 4; ++m) { ui[m] = *(const LAS u32x2*)(Ut + (n0 + i16) * GDN_LD + 16 * m + 4 * g);
#pragma unroll
                for (int ks = 0; ks < 2; ++ks) A1[m][ks] = frag_sig(Wn, GDN_LD, 16 * m, 32 * ks, i16, g); }
#pragma unroll
            for (int kt = 0; kt < 4; ++kt)
#pragma unroll
                for (int cs = 0; cs < 2; ++cs) A2[kt][cs] = frag_tr_sig(Kd, GDN_LD, 32 * cs, 16 * kt, i16, g);
            __builtin_amdgcn_sched_barrier(0);
            bf16x8 Sb[2];
#pragma unroll
            for (int ks = 0; ks < 2; ++ks) Sb[ks] = acc_frag(S[2 * ks], S[2 * ks + 1]);
            {
                bf16_t* ho = ((bf16_t*)((unsigned char*)F.out + (size_t)T * 256 * 2 * 4) + (size_t)(chunk) * 16384) + ((size_t)h * 64 + n0 + i16) * 64 + 4 * g;
#pragma unroll
                for (int kt = 0; kt < 4; ++kt) st8_wt(ho + 16 * kt, pack4(S[kt]));
            }
            f32x4 V[4];
            bf16_t* vo = proj + (row0 + n0 + i16) * PW + PC_GV + h * 64 + 4 * g;
#pragma unroll
            for (int m = 0; m < 4; ++m) {
                f32x4 acc = unpack4(ui[m]);
#pragma unroll
                for (int ks = 0; ks < 2; ++ks) acc = mma16(A1[m][ks], Sb[ks], acc);
                V[m] = acc;
            }
#pragma unroll
            for (int m = 0; m < 4; ++m) st8_wt(vo + 16 * m, pack4(V[m]));
            bf16x8 Ub[2];
#pragma unroll
            for (int cs = 0; cs < 2; ++cs) Ub[cs] = acc_frag(V[2 * cs], V[2 * cs + 1]);
#pragma unroll
            for (int kt = 0; kt < 4; ++kt) {
                f32x4 acc = S[kt] * bd;
#pragma unroll
                for (int cs = 0; cs < 2; ++cs) acc = mma16(A2[kt][cs], Ub[cs], acc);
                S[kt] = acc;
            }
            if (prog) {
                asm volatile("s_waitcnt vmcnt(48)" ::: "memory");
                if (lane == 0 && ci >= 6) __hip_atomic_store(prog + 64 * w, pbase + (unsigned)(ci - 6) + 1u, __ATOMIC_RELAXED, __HIP_MEMORY_SCOPE_AGENT);
            }
            LDS_BARRIER();
        }
        asm volatile("s_waitcnt vmcnt(0)" ::: "memory");
        if (prog && lane == 0) __hip_atomic_store(prog + 64 * w, pbase + (unsigned)nch, __ATOMIC_RELAXED, __HIP_MEMORY_SCOPE_AGENT);
        if (done && lane == 0) __hip_atomic_fetch_add(done, 1u, __ATOMIC_RELAXED, __HIP_MEMORY_SCOPE_AGENT);
        float* o = F.out + (s == 0 ? O_P_GDN + ((size_t)l * 4 + h) * 4096 : O_S_GDN + (((size_t)l * 32 + b) * 4 + h) * 4096) + n0 + i16;
#pragma unroll
        for (int kt = 0; kt < 4; ++kt)
#pragma unroll
            for (int r = 0; r < 4; ++r) o[(16 * kt + 4 * g + r) * 64] = S[kt][r];
    }
}
__device__ __forceinline__ void post_gdn(Frame& F, int l, int c, int hp) {
    PHASE_IDS(F);
    const int tid = F.tid, lane = F.lane, w = F.wave, i16 = lane & 15, g = lane >> 4;
    const size_t row0 = (size_t)c * 64;
    bf16_t* const proj = F_PROJ;
    constexpr int LQ = 136;
    LAS bf16_t* Qt = (LAS bf16_t*)F.lds; LAS bf16_t* Kt = Qt + 64 * LQ; LAS bf16_t* Ht = Kt + 64 * LQ; LAS bf16_t* Vn = Ht + 2 * 64 * GDN_LD; LAS float* gcs = (LAS float*)(Vn + 2 * 64 * GDN_LD);
    {
#pragma unroll
        for (int q = 0; q < 2; ++q) { const int idx = q * 512 + tid;
            { const int row = idx >> 4, col8 = (idx & 15) * 8;
              *(LAS u32x4*)(Qt + row * LQ + col8) = *(const u32x4*)(proj + (row0 + row) * PW + PC_GQ + hp * 128 + col8);
              *(LAS u32x4*)(Kt + row * LQ + col8) = *(const u32x4*)(proj + (row0 + row) * PW + PC_GK + hp * 128 + col8); }
            { const int hh = idx >> 9, row = (idx >> 3) & 63, col8 = (idx & 7) * 8;
              *(LAS u32x4*)(Ht + hh * 64 * GDN_LD + row * GDN_LD + col8) = *(const u32x4*)(((bf16_t*)((unsigned char*)F.out + (size_t)T * 256 * 2 * 4) + (size_t)(c) * 16384) + (((size_t)(2 * hp + hh) * 64) + row) * 64 + col8);
              *(LAS u32x4*)(Vn + hh * 64 * GDN_LD + row * GDN_LD + col8) = *(const u32x4*)(proj + (row0 + row) * PW + PC_GV + (2 * hp + hh) * 64 + col8); } }
        if (tid < 128) gcs[tid] = F_GCUM[(row0 + (tid & 63)) * 4 + 2 * hp + (tid >> 6)];
    }
    LDS_BARRIER();
    const int hh = w >> 2, it = w & 3, head = 2 * hp + hh;
    const LAS bf16_t* Hh = Ht + hh * 64 * GDN_LD; const LAS bf16_t* Vh = Vn + hh * 64 * GDN_LD;
    f32x4 AT[4];
    const float gci = gcs[hh * 64 + 16 * it + i16];
#pragma unroll
    for (int jt = 0; jt < 4; ++jt) {
        f32x4 acc = (f32x4){0.f, 0.f, 0.f, 0.f};
        if (jt <= it) {
#pragma unroll
            for (int ks = 0; ks < 2; ++ks) acc = mma16(frag_nat(Kt, LQ, 16 * jt, hh * 64 + 32 * ks, i16, g), frag_nat(Qt, LQ, 16 * it, hh * 64 + 32 * ks, i16, g), acc);
#pragma unroll
            for (int r = 0; r < 4; ++r) { const int j = 16 * jt + 4 * g + r, i = 16 * it + i16; acc[r] *= (j <= i) ? __expf(fminf(gci - gcs[hh * 64 + j], 0.f)) : 0.f; }
        }
        AT[jt] = acc;
    }
    f32x4 O[4]; float ss[4] = {0.f, 0.f, 0.f, 0.f};
#pragma unroll
    for (int vt = 0; vt < 4; ++vt) {
        f32x4 acc = (f32x4){0.f, 0.f, 0.f, 0.f};
#pragma unroll
        for (int ks = 0; ks < 2; ++ks) acc = mma16(frag_nat(Qt, LQ, 16 * it, hh * 64 + 32 * ks, i16, g), frag_nat(Hh, GDN_LD, 16 * vt, 32 * ks, i16, g), acc);
#pragma unroll
        for (int r = 0; r < 4; ++r) acc[r] *= __expf(gcs[hh * 64 + 16 * it + 4 * g + r]);
#pragma unroll
        for (int cs = 0; cs < 2; ++cs) if (2 * cs <= it) acc = mma16(acc_frag(AT[2 * cs], AT[2 * cs + 1]), frag_sig(Vh, GDN_LD, 16 * vt, 32 * cs, i16, g), acc);
        O[vt] = acc;
#pragma unroll
        for (int r = 0; r < 4; ++r) ss[r] += acc[r] * acc[r];
    }
#pragma unroll
    for (int r = 0; r < 4; ++r) { float t = ss[r]; t += __shfl_xor(t, 1); t += __shfl_xor(t, 2); t += __shfl_xor(t, 4); t += __shfl_xor(t, 8); ss[r] = rsqrtf(t * (1.f / 64.f) + EPS); }
#pragma unroll
    for (int vt = 0; vt < 4; ++vt) { const int v = 16 * vt + i16; const float nw = INP(I_GNORMW)[l * 64 + v];
#pragma unroll
        for (int r = 0; r < 4; ++r) { bf16_t* p = proj + (row0 + 16 * it + 4 * g + r) * PW + PC_ZG + head * 64 + v; *p = f2bf(O[vt][r] * ss[r] * nw * siluf_(bf2f(*p))); } }
    LDS_BARRIER();
}

constexpr int RW_LD = 72;
constexpr int RW_XD = 0, RW_XA = 9216, RW_WD = 18432, RW_WA = 27648, RW_RT = 36864, RW_KX = 46080, RW_VT = 55296, RW_XG = 64512, RW_WG = 81920, RW_EX = 100352;
constexpr int RW_L = 64512, RW_P = 81920;
struct RwkvTok { float cum[2][4], lw[2][4], iclr[2][4], kk[2][4], kp[2][4], kraw[2][4], c63[2], w0[2], a0[2], kkw[2], kaw[2]; };
template <bool POST>
__device__ __forceinline__ void rwkv_tokens(Frame& F, int l, int c, int h, RwkvTok& o, f32x4 (&Zg)[2]) {
    const int tid = F.tid, lane = F.lane, w = F.wave, i16 = lane & 15, g = lane >> 4, tt = w & 3, jh = w >> 2;
    const size_t row0 = (size_t)c * 64;
    bf16_t* const proj = F_PROJ;
    LAS bf16_t* Xd = (LAS bf16_t*)(F.lds + RW_XD); LAS bf16_t* Xa = (LAS bf16_t*)(F.lds + RW_XA); LAS bf16_t* Wd = (LAS bf16_t*)(F.lds + RW_WD); LAS bf16_t* Wa = (LAS bf16_t*)(F.lds + RW_WA);
    LAS bf16_t* Rt = (LAS bf16_t*)(F.lds + RW_RT); LAS bf16_t* Kx = (LAS bf16_t*)(F.lds + RW_KX); LAS bf16_t* Vt = (LAS bf16_t*)(F.lds + RW_VT);
    LAS bf16_t* Xg = (LAS bf16_t*)(F.lds + RW_XG); LAS bf16_t* Wg = (LAS bf16_t*)(F.lds + RW_WG);
    LAS float* ksq = (LAS float*)(F.lds + RW_EX); LAS float* ctot = ksq + 128;
    const int lt0 = (tid >> 5) * 4, lo8 = (tid & 31) * 8;
    const int wi = tid >> 3, wj8 = (tid & 7) * 8;
    const int rt = tid >> 3, rd8 = (tid & 7) * 8;
    u32x4 lx[4], lprev_b = (u32x4){0u, 0u, 0u, 0u}; f32x4 lprev_f[2], lmu[2];
    f32x4 wdv[2], wav[2], wgv[4];
    u32x4 rx[3], rpv_b[3]; f32x4 rpv_f[3][2], rmu[3][2];
    const bool smp = c >= 256;
    {
        const float* mup = INP(I_RMU) + l * 1024;
        const float* stp = INP(I_SSHIFT) + ((size_t)l * 32 + (smp ? c - 256 : 0)) * 1024;
        const int col = PC_RL + lo8;
        lmu[0] = *(const f32x4*)(mup + 768 + lo8); lmu[1] = *(const f32x4*)(mup + 768 + lo8 + 4);
        if (lt0 > 0) lprev_b = *(const u32x4*)(proj + (row0 + lt0 - 1) * PW + col);
        else if (!smp) { if (c > 0) lprev_b = *(const u32x4*)(F_HSHIFT + (size_t)(c - 1) * 1024 + 768 + lo8); }
        else { lprev_f[0] = *(const f32x4*)(stp + 768 + lo8); lprev_f[1] = *(const f32x4*)(stp + 768 + lo8 + 4); }
#pragma unroll
        for (int q = 0; q < 4; ++q) lx[q] = *(const u32x4*)(proj + (row0 + lt0 + q) * PW + col);
        { const float* p = INP(I_RWUP) + ((size_t)l * 64 + wi) * 256 + h * 64 + wj8; wdv[0] = *(const f32x4*)p; wdv[1] = *(const f32x4*)(p + 4); }
        { const float* p = INP(I_RAUP) + ((size_t)l * 64 + wi) * 256 + h * 64 + wj8; wav[0] = *(const f32x4*)p; wav[1] = *(const f32x4*)(p + 4); }
        if (POST) {
#pragma unroll
            for (int q2 = 0; q2 < 2; ++q2) { const float* p = INP(I_RGUP) + ((size_t)l * 128 + wi + 64 * q2) * 256 + h * 64 + wj8; wgv[2 * q2] = *(const f32x4*)p; wgv[2 * q2 + 1] = *(const f32x4*)(p + 4); }
        }
#pragma unroll
        for (int which = 0; which < 3; ++which) {
            const int pcol = (which == 0 ? PC_R : (which == 1 ? PC_RK : PC_RV)) + h * 64 + rd8, oc = which * 256 + h * 64 + rd8;
            const bf16_t* p = proj + (row0 + rt) * PW + pcol;
            rx[which] = *(const u32x4*)p;
            if (!POST) {
                rmu[which][0] = *(const f32x4*)(mup + oc); rmu[which][1] = *(const f32x4*)(mup + oc + 4);
                rpv_b[which] = (u32x4){0u, 0u, 0u, 0u};
                if (rt > 0) rpv_b[which] = *(const u32x4*)(p - PW);
                else if (!smp) { if (c > 0) rpv_b[which] = *(const u32x4*)(F_HSHIFT + (size_t)(c - 1) * 1024 + oc); }
                else { rpv_f[which][0] = *(const f32x4*)(stp + oc); rpv_f[which][1] = *(const f32x4*)(stp + oc + 4); }
            }
        }
#pragma unroll
        for (int q = 0; q < 2; ++q) { const int jc = l * 256 + h * 64 + 16 * (2 * jh + q) + i16;
            o.w0[q] = INP(I_RW0)[jc]; o.a0[q] = INP(I_RA0)[jc]; o.kkw[q] = INP(I_RKK)[jc]; o.kaw[q] = INP(I_RKA)[jc]; }
    }
    {
        float prev[8], mu[8] = {lmu[0][0], lmu[0][1], lmu[0][2], lmu[0][3], lmu[1][0], lmu[1][1], lmu[1][2], lmu[1][3]};
        if (lt0 == 0 && smp) { prev[0] = lprev_f[0][0]; prev[1] = lprev_f[0][1]; prev[2] = lprev_f[0][2]; prev[3] = lprev_f[0][3]; prev[4] = lprev_f[1][0]; prev[5] = lprev_f[1][1]; prev[6] = lprev_f[1][2]; prev[7] = lprev_f[1][3]; }
        else unpack8(lprev_b, prev);
#pragma unroll
        for (int q = 0; q < 4; ++q) {
            float x[8], y[8]; unpack8(lx[q], x);
#pragma unroll
            for (int i = 0; i < 8; ++i) { const float v = x[i] + (prev[i] - x[i]) * mu[i]; prev[i] = x[i]; y[i] = (lo8 < 64) ? tanhf_(v) : (lo8 >= 128 ? sigmoidf_(v) : v); }
            const u32x4 pk = pack8(y);
            if (lo8 < 64) *(LAS u32x4*)(Xd + (lt0 + q) * RW_LD + lo8) = pk;
            else if (lo8 < 128) *(LAS u32x4*)(Xa + (lt0 + q) * RW_LD + (lo8 - 64)) = pk;
            else if (POST) *(LAS u32x4*)(Xg + (lt0 + q) * 136 + (lo8 - 128)) = pk;
        }
        { const float v[8] = {wdv[0][0], wdv[0][1], wdv[0][2], wdv[0][3], wdv[1][0], wdv[1][1], wdv[1][2], wdv[1][3]}; *(LAS u32x4*)(Wd + wi * RW_LD + wj8) = pack8(v); }
        { const float v[8] = {wav[0][0], wav[0][1], wav[0][2], wav[0][3], wav[1][0], wav[1][1], wav[1][2], wav[1][3]}; *(LAS u32x4*)(Wa + wi * RW_LD + wj8) = pack8(v); }
        if (POST) {
#pragma unroll
            for (int q2 = 0; q2 < 2; ++q2) { const float v[8] = {wgv[2 * q2][0], wgv[2 * q2][1], wgv[2 * q2][2], wgv[2 * q2][3], wgv[2 * q2 + 1][0], wgv[2 * q2 + 1][1], wgv[2 * q2 + 1][2], wgv[2 * q2 + 1][3]};
                *(LAS u32x4*)(Wg + (wi + 64 * q2) * RW_LD + wj8) = pack8(v); }
        }
        u32x4 pk3[3];
#pragma unroll
        for (int which = 0; which < 3; ++which) {
            LAS bf16_t* dst = (which == 0 ? Rt : (which == 1 ? Kx : Vt)) + rt * RW_LD + rd8;
            if (POST) *(LAS u32x4*)dst = rx[which];
            else {
                float x[8], pv[8], y[8];
                unpack8(rx[which], x);
                if (rt == 0 && smp) { pv[0] = rpv_f[which][0][0]; pv[1] = rpv_f[which][0][1]; pv[2] = rpv_f[which][0][2]; pv[3] = rpv_f[which][0][3]; pv[4] = rpv_f[which][1][0]; pv[5] = rpv_f[which][1][1]; pv[6] = rpv_f[which][1][2]; pv[7] = rpv_f[which][1][3]; }
                else unpack8(rpv_b[which], pv);
#pragma unroll
                for (int i = 0; i < 8; ++i) y[i] = x[i] + (pv[i] - x[i]) * rmu[which][i >> 2][i & 3];
                pk3[which] = pack8(y);
                *(LAS u32x4*)dst = pk3[which];
            }
        }
        if (!POST) {
            LDS_BARRIER();
#pragma unroll
            for (int which = 0; which < 3; ++which) *(u32x4*)(proj + (row0 + rt) * PW + (which == 0 ? PC_R : (which == 1 ? PC_RK : PC_RV)) + h * 64 + rd8) = pk3[which];
        }
    }
    LDS_BARRIER();
    f32x4 Zd[2], Za[2];
#pragma unroll
    for (int q = 0; q < 2; ++q) {
        const int jt = 2 * jh + q;
        f32x4 a = (f32x4){0.f, 0.f, 0.f, 0.f}, bq = a, cq = a;
#pragma unroll
        for (int ks = 0; ks < 2; ++ks) {
            a = mma16(frag_nat(Xd, RW_LD, 16 * tt, 32 * ks, i16, g), frag_tr_nat(Wd, RW_LD, 32 * ks, 16 * jt, i16, g), a);
            bq = mma16(frag_nat(Xa, RW_LD, 16 * tt, 32 * ks, i16, g), frag_tr_nat(Wa, RW_LD, 32 * ks, 16 * jt, i16, g), bq);
        }
        if (POST) {
#pragma unroll
            for (int ks = 0; ks < 4; ++ks) cq = mma16(frag_nat(Xg, 136, 16 * tt, 32 * ks, i16, g), frag_tr_nat(Wg, RW_LD, 32 * ks, 16 * jt, i16, g), cq);
        }
        Zd[q] = a; Za[q] = bq; Zg[q] = cq;
    }
    float ksum[4] = {0.f, 0.f, 0.f, 0.f}, csum[2];
#pragma unroll
    for (int q = 0; q < 2; ++q) {
        const int j = 16 * (2 * jh + q) + i16, jc = l * 256 + h * 64 + j;
        const float w0 = o.w0[q], a0 = o.a0[q], kkw = o.kkw[q];
        float run = 0.f;
#pragma unroll
        for (int r = 0; r < 4; ++r) {
            const int t = 16 * tt + 4 * g + r;
            const float wl = -softplusf_(-(w0 + Zd[q][r])) - 0.5f;
            const float lw = -__expf(wl);
            o.lw[q][r] = lw; run += lw; o.cum[q][r] = run;
            o.iclr[q][r] = sigmoidf_(a0 + Za[q][r]);
            const float kr = bf2f(Kx[t * RW_LD + j]); o.kraw[q][r] = kr;
            const float kq = kr * kkw; o.kk[q][r] = kq; ksum[r] += kq * kq;
        }
        float tot = run;
        const float u1 = __shfl_up(tot, 16); if (g >= 1) tot += u1;
        const float u2 = __shfl_up(tot, 32); if (g >= 2) tot += u2;
        const float excl = tot - run;
#pragma unroll
        for (int r = 0; r < 4; ++r) o.cum[q][r] += excl;
        csum[q] = __shfl(tot, 48 + i16);
        if (g == 0) ctot[tt * 64 + j] = csum[q];
    }
#pragma unroll
    for (int r = 0; r < 4; ++r) { float s = ksum[r]; s += __shfl_xor(s, 1); s += __shfl_xor(s, 2); s += __shfl_xor(s, 4); s += __shfl_xor(s, 8); ksum[r] = s; }
    if (i16 == 0) {
#pragma unroll
        for (int r = 0; r < 4; ++r) ksq[jh * 64 + 16 * tt + 4 * g + r] = ksum[r];
    }
    LDS_BARRIER();
#pragma unroll
    for (int q = 0; q < 2; ++q) {
        const int j = 16 * (2 * jh + q) + i16, jc = l * 256 + h * 64 + j;
        const float kaw = o.kaw[q];
        float pre = 0.f, all = 0.f;
#pragma unroll
        for (int t4 = 0; t4 < 4; ++t4) { const float v = ctot[t4 * 64 + j]; all += v; if (t4 < tt) pre += v; }
        o.c63[q] = all;
#pragma unroll
        for (int r = 0; r < 4; ++r) {
            const int t = 16 * tt + 4 * g + r;
            o.cum[q][r] += pre;
            const float kn = rsqrtf(ksq[t] + ksq[64 + t] + EPS);
            o.kk[q][r] *= kn;
            o.kp[q][r] = o.kraw[q][r] * (1.f + (o.iclr[q][r] - 1.f) * kaw);
        }
    }
}
__device__ __forceinline__ void prep_rwkv(Frame& F, int l, int c, int h) {
    PHASE_IDS(F);
    const int lane = F.lane, w = F.wave, i16 = lane & 15, g = lane >> 4, tt = w & 3, jh = w >> 2;
    RwkvTok tk; f32x4 Zg[2];
    rwkv_tokens<false>(F, l, c, h, tk, Zg);
    LAS bf16_t* At = (LAS bf16_t*)(F.lds + RW_XD); LAS bf16_t* Bt = (LAS bf16_t*)(F.lds + RW_XA); LAS bf16_t* Kt = (LAS bf16_t*)(F.lds + RW_WD); LAS bf16_t* Kh = (LAS bf16_t*)(F.lds + RW_WA);
    LAS bf16_t* Vt = (LAS bf16_t*)(F.lds + RW_VT); LAS float* Lm = (LAS float*)(F.lds + RW_L); LAS float* Pm = (LAS float*)(F.lds + RW_P);
    bf16_t* const bh = F_RBH + (((size_t)c * 4 + h) * 64) * 64;
    LDS_BARRIER();
#pragma unroll
    for (int q = 0; q < 2; ++q) {
        const int j = 16 * (2 * jh + q) + i16;
#pragma unroll
        for (int r = 0; r < 4; ++r) {
            const int t = 16 * tt + 4 * g + r;
            const float cum = tk.cum[q][r], b = tk.kk[q][r] * tk.iclr[q][r], einv = __expf(-cum), elast = __expf(tk.c63[q] - cum);
            At[t * RW_LD + j] = f2bf(-tk.kk[q][r] * __expf(cum - tk.lw[q][r]));
            Bt[t * RW_LD + j] = f2bf(b * einv);
            Kt[t * RW_LD + j] = f2bf(tk.kp[q][r] * einv);
            Kh[t * RW_LD + j] = f2bf(tk.kp[q][r] * elast);
            bh[t * 64 + j] = f2bf(b * elast);
        }
        if (tt == 0 && g == 0) F_RDV[((size_t)c * 4 + h) * 64 + j] = __expf(tk.c63[q]);
    }
    LDS_BARRIER();
    if (jh == 0) {
#pragma unroll
        for (int st = 0; st < 4; ++st) if (st <= tt) {
            f32x4 acc = (f32x4){0.f, 0.f, 0.f, 0.f};
#pragma unroll
            for (int ks = 0; ks < 2; ++ks) acc = mma16(frag_nat(At, RW_LD, 16 * tt, 32 * ks, i16, g), frag_nat(Bt, RW_LD, 16 * st, 32 * ks, i16, g), acc);
#pragma unroll
            for (int r = 0; r < 4; ++r) { const int t = 16 * tt + 4 * g + r, s = 16 * st + i16; Lm[t * 68 + s] = (s < t) ? acc[r] : 0.f; }
        }
    }
    {
        f32x4 AK[4];
#pragma unroll
        for (int st = 0; st < 4; ++st) {
            f32x4 acc = (f32x4){0.f, 0.f, 0.f, 0.f};
            if (st <= tt) {
#pragma unroll
                for (int ks = 0; ks < 2; ++ks) acc = mma16(frag_nat(Kt, RW_LD, 16 * st, 32 * ks, i16, g), frag_nat(At, RW_LD, 16 * tt, 32 * ks, i16, g), acc);
#pragma unroll
                for (int r = 0; r < 4; ++r) { const int s = 16 * st + 4 * g + r, t = 16 * tt + i16; if (!(s < t)) acc[r] = 0.f; }
            }
            AK[st] = acc;
        }
#pragma unroll
        for (int q = 0; q < 2; ++q) {
            const int vt = 2 * jh + q;
            f32x4 acc = (f32x4){0.f, 0.f, 0.f, 0.f};
#pragma unroll
            for (int cs = 0; cs < 2; ++cs) if (2 * cs <= tt) acc = mma16(acc_frag(AK[2 * cs], AK[2 * cs + 1]), frag_tr_sig(Vt, RW_LD, 32 * cs, 16 * vt, i16, g), acc);
#pragma unroll
            for (int r = 0; r < 4; ++r) Pm[(16 * tt + 4 * g + r) * 68 + 16 * vt + i16] = acc[r];
            f32x4 kv = (f32x4){0.f, 0.f, 0.f, 0.f};
#pragma unroll
            for (int cs = 0; cs < 2; ++cs) kv = mma16(frag_tr_nat(Kh, RW_LD, 32 * cs, 16 * tt, i16, g), frag_tr_nat(Vt, RW_LD, 32 * cs, 16 * vt, i16, g), kv);
            *(u32x2*)(F_RKV + ((((size_t)c * 4 + h) * 64) + 16 * vt + i16) * 64 + 16 * tt + 4 * g) = pack4(kv);
        }
    }
    LDS_BARRIER();
    if (w < 2) {
        float x[64];
        const float ef = (float)w;
        const LAS float* Lo = opaque_lds(Lm); const LAS float* Po = opaque_lds(Pm + lane); const LAS bf16_t* Ao = opaque_lds(At + lane);
        tri_solve64<68, 1>(Lo, x, [&](int i) { return Po[i * 68] * (1.f - ef) + bf2f(Ao[i * RW_LD]) * ef; });
        if (w == 0) {
            bf16_t* o = F_RU + ((((size_t)c * 4 + h) * 64) + lane) * 64;
#pragma unroll
            for (int q = 0; q < 8; ++q) { float y[8];
#pragma unroll
                for (int i = 0; i < 8; ++i) y[i] = x[8 * q + i];
                *(u32x4*)(o + 8 * q) = pack8(y); }
        } else {
            bf16_t* o = F_RWA + (((size_t)c * 4 + h) * 64) * 64 + lane;
#pragma unroll
            for (int i = 0; i < 64; ++i) o[i * 64] = f2bf(x[i]);
        }
    }
    publish_item((unsigned*)(F.ws + WS_CTL) + CW_RFLAG + 4 * c + h);
    LDS_BARRIER();
}
constexpr int RWS_BUF = 4 * 64 * GDN_LD * 2 + 256;
__device__ __forceinline__ void scan_rwkv2(Frame& F, int l, int s, int h, int vb, int ncw, unsigned* prog, unsigned pbase, unsigned* done, int pm, const unsigned* rdy, int rstride, unsigned rneed) {
    PHASE_IDS(F);
    const int tid = F.tid, lane = F.lane, w = F.wave, i16 = lane & 15, g = lane >> 4;
    const int nch = (s == 0) ? 256 : 1, c0 = (s == 0) ? 0 : 255 + s, b = s - 1;
    const bf16_t* const rwa = F_RWA; bf16_t* const ru = F_RU; const bf16_t* const rbh = F_RBH; const bf16_t* const rkv = F_RKV; const float* const rdv = F_RDV;
    {
        if (w == (ncw < 4 ? ncw : 0)) (void)rdy_block(F, rdy, rstride, rneed, 0, nch < RDY_SLACK ? nch : RDY_SLACK, nch);
        LDS_BARRIER();
    }
    if (w >= 4) {
        const int lt = tid - 256;
        const int umask = 128 * ncw - 1;
        u32x4 r10[2], r20[2], r30[2], r40[2], r11[2], r21[2], r31[2], r41[2], r12[2], r22[2], r32[2], r42[2], r13[2], r23[2], r33[2], r43[2], r14[2], r24[2], r34[2], r44[2], r15[2], r25[2], r35[2], r45[2]; float dv0 = 0.f, dv1 = 0.f, dv2 = 0.f, dv3 = 0.f, dv4 = 0.f, dv5 = 0.f;
        const bf16_t* p1[2]; const bf16_t* p2[2]; const bf16_t* p3[2]; const bf16_t* p4[2]; const float* const pDv = rdv + h * 64 + (lt & 63);
#pragma unroll
        for (int q = 0; q < 2; ++q) { const int idx = q * 256 + lt, off = (idx >> 3) * 64 + (idx & 7) * 8, uoff = (vb + ((idx & umask) >> 3)) * 64 + (idx & 7) * 8;
            p1[q] = rwa + (size_t)h * 4096 + off; p2[q] = ru + (size_t)h * 4096 + uoff; p3[q] = rbh + (size_t)h * 4096 + off; p4[q] = rkv + (size_t)h * 4096 + uoff; }
#define RWS_LOAD(ch, S) do { const size_t o_ = (size_t)(ch) * (4 * 4096); dv##S = ld4_asm(pDv + (size_t)(ch) * 256); \
        _Pragma("unroll") for (int q = 0; q < 2; ++q) { r1##S[q] = ld16_asm(p1[q] + o_); r2##S[q] = ld16_asm(p2[q] + o_); r3##S[q] = ld16_asm(p3[q] + o_); r4##S[q] = ld16_asm(p4[q] + o_); } } while (0)
#define RWS_WAIT(S, N) asm volatile("s_waitcnt vmcnt(%9)" : "+v"(r1##S[0]), "+v"(r1##S[1]), "+v"(r2##S[0]), "+v"(r2##S[1]), "+v"(r3##S[0]), "+v"(r3##S[1]), "+v"(r4##S[0]), "+v"(r4##S[1]), "+v"(dv##S) : "n"(N))
#define RWS_WRITE(bb, S) do { LAS bf16_t* Wn_ = (LAS bf16_t*)(F.lds + (bb) * RWS_BUF); \
        _Pragma("unroll") for (int q = 0; q < 2; ++q) { const int idx = q * 256 + lt, off = (idx >> 3) * GDN_LD + (idx & 7) * 8, uoff = (vb + ((idx & umask) >> 3)) * GDN_LD + (idx & 7) * 8; \
            *(LAS u32x4*)(Wn_ + off) = r1##S[q]; *(LAS u32x4*)(Wn_ + 64 * GDN_LD + uoff) = r2##S[q]; *(LAS u32x4*)(Wn_ + 2 * 64 * GDN_LD + off) = r3##S[q]; *(LAS u32x4*)(Wn_ + 3 * 64 * GDN_LD + uoff) = r4##S[q]; } \
        if (lt < 64) ((LAS float*)(Wn_ + 4 * 64 * GDN_LD))[lt] = dv##S; } while (0)
        SCAN_LOADER6(RWS_LOAD, RWS_WRITE, RWS_WAIT, 9);
#undef RWS_LOAD
#undef RWS_WRITE
#undef RWS_WAIT
    } else if (w >= ncw) {
        int nxt = nch < RDY_SLACK ? nch : RDY_SLACK;
        LDS_BARRIER();
        for (int ci = 0; ci < nch; ++ci) {
            if (w == ncw && nxt < nch) { const int upto = ci + 1 + RDY_SLACK < nch ? ci + 1 + RDY_SLACK : nch; nxt = rdy_block(F, rdy, rstride, rneed, nxt, upto, nch); }
            LDS_BARRIER();
        }
    } else {
        const int n0 = vb + 16 * w;
        f32x4 S[4];
        if (s == 0) {
#pragma unroll
            for (int kt = 0; kt < 4; ++kt) S[kt] = (f32x4){0.f, 0.f, 0.f, 0.f};
        } else {
            const float* st = INP(I_SRWKV) + (((size_t)l * 32 + b) * 4 + h) * 4096 + (n0 + i16) * 64 + 4 * g;
#pragma unroll
            for (int kt = 0; kt < 4; ++kt) S[kt] = *(const f32x4*)(st + 16 * kt);
        }
        LDS_BARRIER();
        for (int ci = 0; ci < nch; ++ci) {
            const size_t b0 = (((size_t)(c0 + ci)) * 4 + h) * 4096;
            const LAS bf16_t* Wn = (const LAS bf16_t*)(F.lds + (ci & 1) * RWS_BUF); const LAS bf16_t* Ut = Wn + 64 * GDN_LD; const LAS bf16_t* Bh = Ut + 64 * GDN_LD; const LAS bf16_t* KVt = Bh + 64 * GDN_LD;
            const LAS float* dvec = (const LAS float*)(KVt + 64 * GDN_LD);
            bf16x8 A1[4][2], A2[4][2]; u32x2 ui[4], kvi[4]; f32x4 dq[4];
#pragma unroll
            for (int m = 0; m < 4; ++m) { ui[m] = *(const LAS u32x2*)(Ut + (n0 + i16) * GDN_LD + 16 * m + 4 * g);
#pragma unroll
                for (int ks = 0; ks < 2; ++ks) A1[m][ks] = frag_sig(Wn, GDN_LD, 16 * m, 32 * ks, i16, g); }
#pragma unroll
            for (int kt = 0; kt < 4; ++kt) { kvi[kt] = *(const LAS u32x2*)(KVt + (n0 + i16) * GDN_LD + 16 * kt + 4 * g); dq[kt] = *(const LAS f32x4*)(dvec + 16 * kt + 4 * g);
#pragma unroll
                for (int cs = 0; cs < 2; ++cs) A2[kt][cs] = frag_tr_sig(Bh, GDN_LD, 32 * cs, 16 * kt, i16, g); }
            __builtin_amdgcn_sched_barrier(0);
            bf16x8 Sb[2];
#pragma unroll
            for (int ks = 0; ks < 2; ++ks) Sb[ks] = acc_frag(S[2 * ks], S[2 * ks + 1]);
            {
                bf16_t* ho = F_RKV + b0 + (n0 + i16) * 64 + 4 * g;
#pragma unroll
                for (int kt = 0; kt < 4; ++kt) st8_wt(ho + 16 * kt, pack4(S[kt]));
            }
            f32x4 V[4];
            bf16_t* vo = ru + b0 + (n0 + i16) * 64 + 4 * g;
#pragma unroll
            for (int m = 0; m < 4; ++m) {
                f32x4 acc = unpack4(ui[m]);
#pragma unroll
                for (int ks = 0; ks < 2; ++ks) acc = mma16(A1[m][ks], Sb[ks], acc);
                V[m] = acc;
            }
#pragma unroll
            for (int m = 0; m < 4; ++m) st8_wt(vo + 16 * m, pack4(V[m]));
            bf16x8 Ub[2];
#pragma unroll
            for (int cs = 0; cs < 2; ++cs) Ub[cs] = acc_frag(V[2 * cs], V[2 * cs + 1]);
#pragma unroll
            for (int kt = 0; kt < 4; ++kt) {
                f32x4 acc = S[kt] * dq[kt] + unpack4(kvi[kt]);
#pragma unroll
                for (int cs = 0; cs < 2; ++cs) acc = mma16(A2[kt][cs], Ub[cs], acc);
                S[kt] = acc;
            }
            if (prog) {
                asm volatile("s_waitcnt vmcnt(48)" ::: "memory");
                if (lane == 0 && ci >= 6) __hip_atomic_store(prog + 64 * w, pbase + (unsigned)(ci - 6) + 1u, __ATOMIC_RELAXED, __HIP_MEMORY_SCOPE_AGENT);
            }
            LDS_BARRIER();
        }
        asm volatile("s_waitcnt vmcnt(0)" ::: "memory");
        if (prog && lane == 0) __hip_atomic_store(prog + 64 * w, pbase + (unsigned)nch, __ATOMIC_RELAXED, __HIP_MEMORY_SCOPE_AGENT);
        if (done && lane == 0) __hip_atomic_fetch_add(done, 1u, __ATOMIC_RELAXED, __HIP_MEMORY_SCOPE_AGENT);
        float* o = F.out + (s == 0 ? O_P_RWKV + ((size_t)l * 4 + h) * 4096 : O_S_RWKV + (((size_t)l * 32 + b) * 4 + h) * 4096) + (n0 + i16) * 64 + 4 * g;
#pragma unroll
        for (int kt = 0; kt < 4; ++kt) *(f32x4*)(o + 16 * kt) = S[kt];
    }
}
__device__ __forceinline__ void post_rwkv(Frame& F, int l, int c, int h) {
    PHASE_IDS(F);
    const int tid = F.tid, lane = F.lane, w = F.wave, i16 = lane & 15, g = lane >> 4, tt = w & 3, jh = w >> 2;
    const size_t row0 = (size_t)c * 64;
    RwkvTok tk; f32x4 Zg[2];
    rwkv_tokens<true>(F, l, c, h, tk, Zg);
    LAS bf16_t* Rd = (LAS bf16_t*)(F.lds + RW_XD); LAS bf16_t* Bt = (LAS bf16_t*)(F.lds + RW_XA); LAS bf16_t* Kt = (LAS bf16_t*)(F.lds + RW_WD); LAS bf16_t* Utl = (LAS bf16_t*)(F.lds + RW_WA);
    LAS bf16_t* Rt = (LAS bf16_t*)(F.lds + RW_RT); LAS bf16_t* Htl = (LAS bf16_t*)(F.lds + RW_KX); LAS bf16_t* Vt = (LAS bf16_t*)(F.lds + RW_VT);
    LAS float* ex = (LAS float*)(F.lds + RW_EX) + 512;
    float rr[2][4];
#pragma unroll
    for (int q = 0; q < 2; ++q)
#pragma unroll
        for (int r = 0; r < 4; ++r) rr[q][r] = bf2f(Rt[(16 * tt + 4 * g + r) * RW_LD + 16 * (2 * jh + q) + i16]);
    LDS_BARRIER();
#pragma unroll
    for (int q = 0; q < 2; ++q) {
        const int j = 16 * (2 * jh + q) + i16;
#pragma unroll
        for (int r = 0; r < 4; ++r) {
            const int t = 16 * tt + 4 * g + r;
            const float cum = tk.cum[q][r], einv = __expf(-cum);
            Rd[t * RW_LD + j] = f2bf(rr[q][r] * __expf(cum));
            Bt[t * RW_LD + j] = f2bf(tk.kk[q][r] * tk.iclr[q][r] * einv);
            Kt[t * RW_LD + j] = f2bf(tk.kp[q][r] * einv);
        }
    }
    {
        const int row = tid >> 3, col8 = (tid & 7) * 8; const size_t b0 = (((size_t)c * 4 + h) * 64 + row) * 64 + col8;
        *(LAS u32x4*)(Utl + row * RW_LD + col8) = *(const u32x4*)(F_RU + b0);
        *(LAS u32x4*)(Htl + row * RW_LD + col8) = *(const u32x4*)(F_RKV + b0);
    }
    LDS_BARRIER();
    f32x4 QB[4], QK[4];
#pragma unroll
    for (int st = 0; st < 4; ++st) {
        f32x4 a = (f32x4){0.f, 0.f, 0.f, 0.f}, bq = a;
        if (st <= tt) {
#pragma unroll
            for (int ks = 0; ks < 2; ++ks) {
                const bf16x8 rf = frag_nat(Rd, RW_LD, 16 * tt, 32 * ks, i16, g);
                a = mma16(frag_nat(Bt, RW_LD, 16 * st, 32 * ks, i16, g), rf, a);
                bq = mma16(frag_nat(Kt, RW_LD, 16 * st, 32 * ks, i16, g), rf, bq);
            }
#pragma unroll
            for (int r = 0; r < 4; ++r) { const int s = 16 * st + 4 * g + r, t = 16 * tt + i16; if (!(s <= t)) { a[r] = 0.f; bq[r] = 0.f; } }
        }
        QB[st] = a; QK[st] = bq;
    }
    f32x4 Y[2]; float s1[4] = {0.f, 0.f, 0.f, 0.f}, s2[4] = {0.f, 0.f, 0.f, 0.f}, bon[4] = {0.f, 0.f, 0.f, 0.f};
#pragma unroll
    for (int q = 0; q < 2; ++q) {
        const int vt = 2 * jh + q;
        f32x4 acc = (f32x4){0.f, 0.f, 0.f, 0.f};
#pragma unroll
        for (int ks = 0; ks < 2; ++ks) acc = mma16(frag_nat(Rd, RW_LD, 16 * tt, 32 * ks, i16, g), frag_nat(Htl, RW_LD, 16 * vt, 32 * ks, i16, g), acc);
#pragma unroll
        for (int cs = 0; cs < 2; ++cs) if (2 * cs <= tt) {
            acc = mma16(acc_frag(QB[2 * cs], QB[2 * cs + 1]), frag_sig(Utl, RW_LD, 16 * vt, 32 * cs, i16, g), acc);
            acc = mma16(acc_frag(QK[2 * cs], QK[2 * cs + 1]), frag_tr_sig(Vt, RW_LD, 32 * cs, 16 * vt, i16, g), acc);
        }
        Y[q] = acc;
        const float rkw = INP(I_RRK)[l * 256 + h * 64 + 16 * vt + i16];
#pragma unroll
        for (int r = 0; r < 4; ++r) { s1[r] += acc[r]; s2[r] += acc[r] * acc[r]; bon[r] += rr[q][r] * tk.kp[q][r] * rkw; }
    }
#pragma unroll
    for (int r = 0; r < 4; ++r) {
        float a = s1[r], bq = s2[r], cq = bon[r];
#pragma unroll
        for (int o = 1; o < 16; o <<= 1) { a += __shfl_xor(a, o); bq += __shfl_xor(bq, o); cq += __shfl_xor(cq, o); }
        if (i16 == 0) { const int t = 16 * tt + 4 * g + r; ex[(0 * 2 + jh) * 64 + t] = a; ex[(1 * 2 + jh) * 64 + t] = bq; ex[(2 * 2 + jh) * 64 + t] = cq; }
    }
    LDS_BARRIER();
    bf16_t* const proj = F_PROJ;
#pragma unroll
    for (int q = 0; q < 2; ++q) {
        const int v = 16 * (2 * jh + q) + i16, vc = l * 256 + h * 64 + v;
        const float lnw = INP(I_RLNW)[vc], lnb = INP(I_RLNB)[vc];
#pragma unroll
        for (int r = 0; r < 4; ++r) {
            const int t = 16 * tt + 4 * g + r;
            const float mean = (ex[t] + ex[64 + t]) * (1.f / 64.f);
            const float var = fmaxf((ex[128 + t] + ex[192 + t]) * (1.f / 64.f) - mean * mean, 0.f);
            const float bonus = (ex[256 + t] + ex[320 + t]) * bf2f(Vt[t * RW_LD + v]);
            const float yn = (Y[q][r] - mean) * rsqrtf(var + 64e-5f) * lnw + lnb;
            proj[(row0 + t) * PW + PC_R + h * 64 + v] = f2bf((yn + bonus) * Zg[q][r]);
        }
    }
    LDS_BARRIER();
}

constexpr int SSD_LDC = 136, SSD_LDX = 72;
constexpr int SSD_BUF = 64 * SSD_LDC * 2 * 2 + 64 * SSD_LDX * 2 + 64;
__device__ __forceinline__ void scan_ssd2(Frame& F, int l, int s, int hd, int vb, int ncw, unsigned* prog, unsigned pbase, unsigned* done, int pm, const unsigned* rdy, int rstride, unsigned rneed) {
    PHASE_IDS(F);
    const int tid = F.tid, lane = F.lane, w = F.wave, i16 = lane & 15, g = lane >> 4;
    const int nch = (s == 0) ? 256 : 1, c0 = (s == 0) ? 0 : 255 + s, b = s - 1, grp = hd >> 2;
    const bf16_t* const proj = F_PROJ; const float* const scal = F_SCAL; const float* const acum = F_ACUM;
    {
        if (w == (ncw < 4 ? ncw : 0)) (void)rdy_block(F, rdy, rstride, rneed, 0, nch < RDY_SLACK ? nch : RDY_SLACK, nch);
        LDS_BARRIER();
    }
    if (w >= 4) {
        const int lt = tid - 256;
        const int umask = 128 * ncw - 1, xsh = (ncw == 4) ? 3 : (ncw == 2 ? 2 : 1);
        u32x4 rc0[4], rb0[4], rx0[2], rc1[4], rb1[4], rx1[2], rc2[4], rb2[4], rx2[2], rc3[4], rb3[4], rx3[2]; float dt0[2], ac0[2], al0, dt1[2], ac1[2], al1, dt2[2], ac2[2], al2, dt3[2], ac3[2], al3;
        const bf16_t* pC[4]; const bf16_t* pB[4]; const bf16_t* pX[2]; const float* pDt[2]; const float* pAc[2]; const float* const pAl = acum + 63 * 8 + hd;
#pragma unroll
        for (int q = 0; q < 4; ++q) { const int idx = q * 256 + lt, row = idx >> 4, col8 = (idx & 15) * 8;
            pC[q] = proj + (size_t)row * PW + PC_SC + grp * 128 + col8; pB[q] = proj + (size_t)row * PW + PC_SB + grp * 128 + col8; }
#pragma unroll
        for (int q = 0; q < 2; ++q) { const int idx = (q * 256 + lt) & umask, row = idx >> xsh, col8 = vb + (idx & ((1 << xsh) - 1)) * 8;
            pX[q] = proj + (size_t)row * PW + PC_SX + hd * 64 + col8; pDt[q] = scal + row * 16 + 8 + hd; pAc[q] = acum + row * 8 + hd; }
#define SSD_LOAD(ch, S) do { const size_t oP_ = (size_t)(ch) * (64 * PW), oS_ = (size_t)(ch) * 1024, oA_ = (size_t)(ch) * 512; al##S = ld4_asm(pAl + oA_); \
        _Pragma("unroll") for (int q = 0; q < 4; ++q) { rc##S[q] = ld16_asm(pC[q] + oP_); rb##S[q] = ld16_asm(pB[q] + oP_); } \
        _Pragma("unroll") for (int q = 0; q < 2; ++q) { rx##S[q] = ld16_asm(pX[q] + oP_); dt##S[q] = ld4_asm(pDt[q] + oS_); ac##S[q] = ld4_asm(pAc[q] + oA_); } } while (0)
#define SSD_WAIT(S, N) asm volatile("s_waitcnt vmcnt(%15)" : "+v"(rc##S[0]), "+v"(rc##S[1]), "+v"(rc##S[2]), "+v"(rc##S[3]), "+v"(rb##S[0]), "+v"(rb##S[1]), "+v"(rb##S[2]), "+v"(rb##S[3]), \
        "+v"(rx##S[0]), "+v"(rx##S[1]), "+v"(dt##S[0]), "+v"(dt##S[1]), "+v"(ac##S[0]), "+v"(ac##S[1]), "+v"(al##S) : "n"(N))
#define SSD_WRITE(bb, S) do { LAS bf16_t* Ct_ = (LAS bf16_t*)(F.lds + (bb) * SSD_BUF); LAS bf16_t* Bt_ = Ct_ + 64 * SSD_LDC; LAS bf16_t* Xt_ = Bt_ + 64 * SSD_LDC; \
        _Pragma("unroll") for (int q = 0; q < 4; ++q) { const int idx = q * 256 + lt, row = idx >> 4, col8 = (idx & 15) * 8; \
            *(LAS u32x4*)(Ct_ + row * SSD_LDC + col8) = rc##S[q]; *(LAS u32x4*)(Bt_ + row * SSD_LDC + col8) = rb##S[q]; } \
        _Pragma("unroll") for (int q = 0; q < 2; ++q) { const int idx = (q * 256 + lt) & umask, row = idx >> xsh, col8 = vb + (idx & ((1 << xsh) - 1)) * 8; float v_[8]; unpack8(rx##S[q], v_); \
            const float sx_ = dt##S[q] * __expf(al##S - ac##S[q]); \
            _Pragma("unroll") for (int i = 0; i < 8; ++i) v_[i] *= sx_; *(LAS u32x4*)(Xt_ + row * SSD_LDX + col8) = pack8(v_); } \
        if (lt == 0) *(LAS float*)(Xt_ + 64 * SSD_LDX) = __expf(al##S); } while (0)
        SCAN_LOADER(SSD_LOAD, SSD_WRITE, SSD_WAIT, 15);
#undef SSD_LOAD
#undef SSD_WRITE
#undef SSD_WAIT
    } else if (w >= ncw) {
        int nxt = nch < RDY_SLACK ? nch : RDY_SLACK;
        LDS_BARRIER();
        for (int ci = 0; ci < nch; ++ci) {
            if (w == ncw && nxt < nch) { const int upto = ci + 1 + RDY_SLACK < nch ? ci + 1 + RDY_SLACK : nch; nxt = rdy_block(F, rdy, rstride, rneed, nxt, upto, nch); }
            LDS_BARRIER();
        }
    } else {
        const int n0 = vb + 16 * w, head = hd;
        f32x4 H[8];
        if (s == 0) {
#pragma unroll
            for (int nt = 0; nt < 8; ++nt) H[nt] = (f32x4){0.f, 0.f, 0.f, 0.f};
        } else {
            const float* st = INP(I_SSSM) + ((((size_t)l * 32 + b) * 8 + head) * 64 + n0 + i16) * 128 + 4 * g;
#pragma unroll
            for (int nt = 0; nt < 8; ++nt) H[nt] = *(const f32x4*)(st + 16 * nt);
        }
        bf16_t* const yoff = F_YOFF;
        LDS_BARRIER();
        for (int ci = 0; ci < nch; ++ci) {
            const LAS bf16_t* Ct = (const LAS bf16_t*)(F.lds + (ci & 1) * SSD_BUF); const LAS bf16_t* Bt = Ct + 64 * SSD_LDC; const LAS bf16_t* Xt = Bt + 64 * SSD_LDC;
            const float cd = *(const LAS float*)(Xt + 64 * SSD_LDX);
            bf16x8 A1[4][4], A2[8][2], Xb[2];
#pragma unroll
            for (int m = 0; m < 4; ++m)
#pragma unroll
                for (int ks = 0; ks < 4; ++ks) A1[m][ks] = frag_sig(Ct, SSD_LDC, 16 * m, 32 * ks, i16, g);
#pragma unroll
            for (int cs = 0; cs < 2; ++cs) Xb[cs] = frag_tr_nat(Xt, SSD_LDX, 32 * cs, n0, i16, g);
#pragma unroll
            for (int nt = 0; nt < 8; ++nt)
#pragma unroll
                for (int cs = 0; cs < 2; ++cs) A2[nt][cs] = frag_tr_nat(Bt, SSD_LDC, 32 * cs, 16 * nt, i16, g);
            __builtin_amdgcn_sched_barrier(0);
            bf16x8 Hb[4];
#pragma unroll
            for (int ks = 0; ks < 4; ++ks) Hb[ks] = acc_frag(H[2 * ks], H[2 * ks + 1]);
            bf16_t* yo = yoff + (((size_t)(c0 + ci) * 8 + head) * 64 + n0 + i16) * 64 + 4 * g;
            f32x4 Yv[4];
#pragma unroll
            for (int m = 0; m < 4; ++m) {
                f32x4 acc = (f32x4){0.f, 0.f, 0.f, 0.f};
#pragma unroll
                for (int ks = 0; ks < 4; ++ks) acc = mma16(A1[m][ks], Hb[ks], acc);
                Yv[m] = acc;
            }
#pragma unroll
            for (int nt = 0; nt < 8; ++nt) {
                f32x4 acc = H[nt] * cd;
#pragma unroll
                for (int cs = 0; cs < 2; ++cs) acc = mma16(A2[nt][cs], Xb[cs], acc);
                H[nt] = acc;
            }
#pragma unroll
            for (int m = 0; m < 4; ++m) st8_wt(yo + 16 * m, pack4(Yv[m]));
            if (prog) {
                asm volatile("s_waitcnt vmcnt(24)" ::: "memory");
                if (lane == 0 && ci >= 6) __hip_atomic_store(prog + 64 * w, pbase + (unsigned)(ci - 6) + 1u, __ATOMIC_RELAXED, __HIP_MEMORY_SCOPE_AGENT);
            }
            LDS_BARRIER();
        }
        asm volatile("s_waitcnt vmcnt(0)" ::: "memory");
        if (prog && lane == 0) __hip_atomic_store(prog + 64 * w, pbase + (unsigned)nch, __ATOMIC_RELAXED, __HIP_MEMORY_SCOPE_AGENT);
        if (done && lane == 0) __hip_atomic_fetch_add(done, 1u, __ATOMIC_RELAXED, __HIP_MEMORY_SCOPE_AGENT);
        float* o = F.out + (s == 0 ? O_P_SSM + (((size_t)l * 8 + head) * 64 + n0 + i16) * 128 : O_S_SSM + ((((size_t)l * 32 + b) * 8 + head) * 64 + n0 + i16) * 128) + 4 * g;
#pragma unroll
        for (int nt = 0; nt < 8; ++nt) *(f32x4*)(o + 16 * nt) = H[nt];
    }
}
__device__ __forceinline__ void post_ssd(Frame& F, int l, int c, int grp) {
    PHASE_IDS(F);
    const int tid = F.tid, lane = F.lane, w = F.wave, i16 = lane & 15, g = lane >> 4;
    const size_t row0 = (size_t)c * 64;
    bf16_t* const proj = F_PROJ;
    LAS bf16_t* Ct = (LAS bf16_t*)F.lds; LAS bf16_t* Bt = Ct + 64 * SSD_LDC; LAS bf16_t* Xt = Bt + 64 * SSD_LDC;
    LAS float* acs = (LAS float*)(Xt + 4 * 64 * SSD_LDX); LAS float* dts = acs + 256; LAS float* ssn = dts + 256;
    {
#pragma unroll
        for (int q = 0; q < 2; ++q) { const int idx = q * 512 + tid, row = idx >> 4, col8 = (idx & 15) * 8;
            *(LAS u32x4*)(Ct + row * SSD_LDC + col8) = *(const u32x4*)(proj + (row0 + row) * PW + PC_SC + grp * 128 + col8);
            *(LAS u32x4*)(Bt + row * SSD_LDC + col8) = *(const u32x4*)(proj + (row0 + row) * PW + PC_SB + grp * 128 + col8); }
#pragma unroll
        for (int q = 0; q < 4; ++q) { const int idx = q * 512 + tid, row = idx >> 5, col8 = (idx & 31) * 8, hh = col8 >> 6, cc = col8 & 63;
            *(LAS u32x4*)(Xt + hh * 64 * SSD_LDX + row * SSD_LDX + cc) = *(const u32x4*)(proj + (row0 + row) * PW + PC_SX + grp * 256 + col8); }
        if (tid < 256) { const int hh = tid >> 6, t = tid & 63; acs[tid] = F_ACUM[(row0 + t) * 8 + grp * 4 + hh]; dts[tid] = F_SCAL[(row0 + t) * 16 + 8 + grp * 4 + hh]; }
    }
    LDS_BARRIER();
    const int hh = w & 3, lh = w >> 2, hd = grp * 4 + hh;
    const LAS bf16_t* Xh = Xt + hh * 64 * SSD_LDX;
    const float Dh = INP(I_SD)[l * 8 + hd];
    float ssrow[2][4];
    f32x4 Y[2][4];
#pragma unroll
    for (int li = 0; li < 2; ++li) {
        const int ltile = 2 * lh + li;
        f32x4 ST[4];
#pragma unroll
        for (int st = 0; st < 4; ++st) {
            f32x4 acc = (f32x4){0.f, 0.f, 0.f, 0.f};
            if (st <= ltile) {
#pragma unroll
                for (int ks = 0; ks < 4; ++ks) acc = mma16(frag_nat(Bt, SSD_LDC, 16 * st, 32 * ks, i16, g), frag_nat(Ct, SSD_LDC, 16 * ltile, 32 * ks, i16, g), acc);
                const int lcol = 16 * ltile + i16; const float acl = acs[hh * 64 + lcol];
#pragma unroll
                for (int r = 0; r < 4; ++r) { const int srow = 16 * st + 4 * g + r; const float f = (srow <= lcol) ? __expf(fminf(acl - acs[hh * 64 + srow], 0.f)) * dts[hh * 64 + srow] : 0.f; acc[r] *= f; }
            }
            ST[st] = acc;
        }
#pragma unroll
        for (int pt = 0; pt < 4; ++pt) {
            f32x4 acc = (f32x4){0.f, 0.f, 0.f, 0.f};
#pragma unroll
            for (int cs = 0; cs < 2; ++cs) if (2 * cs <= ltile) acc = mma16(acc_frag(ST[2 * cs], ST[2 * cs + 1]), frag_tr_sig(Xh, SSD_LDX, 32 * cs, 16 * pt, i16, g), acc);
            const int p = 16 * pt + i16, lr0 = 16 * ltile + 4 * g;
            const f32x4 yo = unpack4(*(const u32x2*)(F_YOFF + (((size_t)c * 8 + hd) * 64 + p) * 64 + lr0));
#pragma unroll
            for (int r = 0; r < 4; ++r) {
                const int lrow = lr0 + r;
                const float x = bf2f(Xh[lrow * SSD_LDX + p]);
                const float z = bf2f(proj[(row0 + lrow) * PW + PC_ZS + hd * 64 + p]);
                acc[r] = (acc[r] + __expf(acs[hh * 64 + lrow]) * yo[r] + Dh * x) * siluf_(z);
            }
            Y[li][pt] = acc;
        }
#pragma unroll
        for (int r = 0; r < 4; ++r) { float ss = 0.f;
#pragma unroll
            for (int pt = 0; pt < 4; ++pt) ss += Y[li][pt][r] * Y[li][pt][r];
            ss += __shfl_xor(ss, 1); ss += __shfl_xor(ss, 2); ss += __shfl_xor(ss, 4); ss += __shfl_xor(ss, 8);
            ssrow[li][r] = ss; }
        if (i16 == 0) {
#pragma unroll
            for (int r = 0; r < 4; ++r) ssn[(16 * ltile + 4 * g + r) * 4 + hh] = ssrow[li][r];
        }
    }
    LDS_BARRIER();
#pragma unroll
    for (int li = 0; li < 2; ++li) {
        const int ltile = 2 * lh + li;
#pragma unroll
        for (int r = 0; r < 4; ++r) {
            const int lrow = 16 * ltile + 4 * g + r;
            const f32x4 sv = *(const LAS f32x4*)(ssn + lrow * 4);
            const float sc = rsqrtf(((sv[0] + sv[1]) + (sv[2] + sv[3])) * (1.f / 256.f) + EPS);
#pragma unroll
            for (int pt = 0; pt < 4; ++pt) { const int p = 16 * pt + i16;
                proj[(row0 + lrow) * PW + PC_ZS + hd * 64 + p] = f2bf(Y[li][pt][r] * sc * INP(I_SNORMW)[l * 512 + hd * 64 + p]); }
        }
    }
    LDS_BARRIER();
}

constexpr int NSL = 2;
constexpr int CW_PROG = 8192;
constexpr int CW_SDONE = 8192 + 64 * 64;
__device__ __forceinline__ void post_wait(Frame& F, int c, int q, unsigned pbase, unsigned sneed) {
    if (F.wave == 0) {
        unsigned* const ctl = (unsigned*)(F.ws + WS_CTL);
        const int lane = F.lane;
        unsigned* wp; unsigned need; bool act;
        if (c >= 256) { wp = ctl + CW_SDONE + 64 * (c - 256); need = sneed; act = lane == 0; }
        else {
            int gq0, ng;
            if (q < 2) { gq0 = 8 + 4 * q; ng = 4; } else if (q < 4) { gq0 = 2 * (q - 2); ng = 2; } else { gq0 = 4 + (q - 4); ng = 1; }
            act = lane < 4 * ng; wp = ctl + CW_PROG + 64 * (4 * gq0 + (act ? lane : 0)); need = pbase + (unsigned)c + 1u;
        }
        unsigned sp = 0;
        for (;;) { const bool ok = !act || (int)(xb_ld(wp) - need) >= 0; if (__all(ok) || ++sp > 2000000u) break; __builtin_amdgcn_s_sleep(4); }
        __builtin_amdgcn_fence(__ATOMIC_ACQUIRE, "agent");
        asm volatile("s_waitcnt vmcnt(0)" ::: "memory");
    }
    LDS_BARRIER();
}
__device__ __forceinline__ void scan_phase(Frame& F, int l, int mode, unsigned epoch) {
    PHASE_IDS(F);
    const int xl = F.vcu >> 5, slot = F.vcu & 31;
    unsigned* const ctl = (unsigned*)(F.ws + WS_CTL);
    const unsigned pbase = 1024u * epoch, sneed = 64u * (epoch + 1u), rneed = epoch + 1u;
    if (slot >= 2 * NSL) {
        const int j = xl * (32 - 2 * NSL) + (slot - 2 * NSL);
        for (int it = j; it < NCH * 5; it += 8 * (32 - 2 * NSL)) {
            int it_ = it; asm volatile("" : "+s"(it_));
            const int c = it_ / 5, q = it_ % 5;
            if (q == 0) act_chunk(F, l, c); else prep_rwkv(F, l, c, q - 1);
        }
    }
    for (int pass = 0; pass < 3; ++pass) {
        int kind, s, h, vb, ncw; unsigned* prog = nullptr; unsigned* done = nullptr;
        if (pass == 0) {
            if (slot >= 2 * NSL) continue;
            const int gq = xl + 8 * (slot / NSL);
            kind = gq < 4 ? 0 : (gq < 8 ? 1 : 2); h = gq < 4 ? gq : (gq < 8 ? gq - 4 : gq - 8); s = 0; ncw = 4 / NSL; vb = 16 * ncw * (slot % NSL);
            prog = ctl + CW_PROG + 64 * (4 * gq + ncw * (slot % NSL));
        } else {
            const int it = F.vcu + (pass - 1) * F.G;
            if (it >= 512) continue;
            if (it < 128) { kind = 0; s = 1 + (it >> 2); h = it & 3; }
            else if (it < 256) { kind = 1; s = 1 + ((it - 128) >> 2); h = (it - 128) & 3; }
            else { kind = 2; s = 1 + ((it - 256) >> 3); h = (it - 256) & 7; }
            vb = 0; ncw = 4; done = ctl + CW_SDONE + 64 * (s - 1);
        }
        const int cfirst = (s == 0) ? 0 : 255 + s;
        if (kind == 0) scan_gdn2(F, l, s, h, vb, ncw, prog, pbase, done, mode, ctl + CW_AFLAG + cfirst, 1, rneed);
        else if (kind == 1) scan_rwkv2(F, l, s, h, vb, ncw, prog, pbase, done, mode, ctl + CW_RFLAG + 4 * cfirst + h, 4, rneed);
        else scan_ssd2(F, l, s, h, vb, ncw, prog, pbase, done, mode, ctl + CW_AFLAG + cfirst, 1, rneed);
        __syncthreads();
    }
    if (slot >= 2 * NSL) {
        const int j = xl * (32 - 2 * NSL) + (slot - 2 * NSL);
        for (int it = j; it < NCH * 8; it += 8 * (32 - 2 * NSL)) {
            int it_ = it; asm volatile("" : "+s"(it_));
            const int c = it_ >> 3, q = it_ & 7;
            post_wait(F, c, q, pbase, sneed);
            if (q < 2) post_ssd(F, l, c, q); else if (q < 4) post_gdn(F, l, c, q - 2); else post_rwkv(F, l, c, q - 4);
        }
    }
}
__device__ __forceinline__ void final_norm(Frame& F) {
    PHASE_IDS(F);
    const int gw = F.vcu * 8 + F.wave, NGW = F.G * 8;
    const float* fw = INP(I_FNORM);
    float wv[16];
#pragma unroll
    for (int i = 0; i < 16; ++i) wv[i] = fw[16 * F.lane + i];
    for (int m = gw; m < T; m += NGW) {
        float s = (F.lane < 16) ? F_SSQA[(size_t)m * 16 + F.lane] : 0.f;
        s = wave_sum(s);
        const float rs = rsqrtf(s * (1.f / 1024.f) + EPS);
        const bf16_t* xr = F_R1 + (size_t)m * DM + 16 * F.lane;
        float x[16]; { float a[8], b[8]; unpack8(*(const u32x4*)xr, a); unpack8(*(const u32x4*)(xr + 8), b);
#pragma unroll
            for (int i = 0; i < 8; ++i) { x[i] = a[i]; x[8 + i] = b[i]; } }
        f32x4* o = (f32x4*)(F.out + (size_t)m * DM + 16 * F.lane);
#pragma unroll
        for (int q = 0; q < 4; ++q) o[q] = (f32x4){x[4 * q] * rs * wv[4 * q], x[4 * q + 1] * rs * wv[4 * q + 1], x[4 * q + 2] * rs * wv[4 * q + 2], x[4 * q + 3] * rs * wv[4 * q + 3]};
    }
}

constexpr int N_PHASES = 16;
__global__ void __launch_bounds__(512, 2) mk_fwd(Args args) {
    extern __shared__ __attribute__((aligned(16))) unsigned char lds[];
    Frame F;
    F.lds = (LAS unsigned char*)lds;
    F.tid = threadIdx.x; F.lane = F.tid & 63; F.wave = __builtin_amdgcn_readfirstlane(F.tid >> 6);
    F.G = gridDim.x; { const int bx = blockIdx.x; F.vcu = (F.G % 8 == 0) ? (bx % 8) * (F.G / 8) + bx / 8 : bx; }
    F.out = args.out; F.ws = args.ws;
    volatile LAS unsigned* MISC = (volatile LAS unsigned*)(F.lds + MISC_OFF);
    for (int u = F.tid; u < (LDS_BYTES - LDSCTL_OFF) / 4; u += 512) ((LAS unsigned*)(F.lds + LDSCTL_OFF))[u] = 0u;
    __syncthreads();
    if (F.tid == 0) {
#pragma unroll
        for (int i = 0; i < 37; ++i) ((LAS unsigned long long*)(F.lds + PTRTAB_OFF))[i] = (unsigned long long)args.in[i];
    }
    __syncthreads();
    XcdBarrier bar = xcd_barrier_post((unsigned*)(args.ws + WS_CTL) + CW_BAR, MISC + 8);
    const int ns = args.nsched; unsigned nscan = 0;
    for (int si = 0; si < ns; ++si) {
        const int pe = (int)((args.sched[si >> 2] >> (8 * (si & 3))) & 0xffu); const int p = pe & 0x7f; const bool probe = (pe & 0x80) != 0;
        if (p == 0) p0_prologue(F);
        else if (p == 15) final_norm(F);
        else {
            const int l = (p - 1) / 7, sub = (p - 1) % 7;
            if (sub == 0) {
                pg8::Gemm g{F_R1, w_in(F, l), T, PW, DM, DM}; pg8::StaticOrder S; S.init(T, PW, F.G, (int)blockIdx.x);
                pg8::EpiInProj E{F_PROJ, F_SCAL, F_SSQA, F_HCONV, F_HSHIFT, F.out, l};
                pg8::gemm_phase<pg8::EpiInProj, true>(F.lds, g, S, E);
            } else if (sub == 1) { }
            else if (sub == 2) scan_phase(F, l, 0, nscan++);
            else if (sub == 3) { }
            else if (sub == 4) {
                pg8::Gemm g{F_PROJ, w_out(F, l), T, DM, DM, PW}; pg8::StaticOrder S; S.init(T, DM, F.G, (int)blockIdx.x);
                if (l == 0) { pg8::EpiResid<true> E{INP(I_XP), INP(I_XS), F_R1, F_SSQD}; pg8::gemm_phase<pg8::EpiResid<true>, true>(F.lds, g, S, E); }
                else { pg8::EpiResid<false> E{nullptr, nullptr, F_R1, F_SSQD}; pg8::gemm_phase<pg8::EpiResid<false>, true>(F.lds, g, S, E); }
            } else if (sub == 5) {
                pg8::Gemm g{F_R1, w_gu(F, l), T, NGU, DM, DM}; pg8::StaticOrder S; S.init(T, NGU, F.G, (int)blockIdx.x);
                pg8::EpiGateUp E{F_PROJ, F_SSQD};
                pg8::gemm_phase<pg8::EpiGateUp, true>(F.lds, g, S, E);
            } else {
                pg8::Gemm g{F_PROJ, w_dn(F, l), T, DM, FF, FF}; pg8::StaticOrder S; S.init(T, DM, F.G, (int)blockIdx.x);
                pg8::EpiResid<false> E{nullptr, nullptr, F_R1, F_SSQA};
                pg8::gemm_phase<pg8::EpiResid<false>, true>(F.lds, g, S, E);
            }
        }
        if (si + 1 < ns) xcd_barrier(bar);
    }
}

extern "C" void kernel_launch(void* const* d_in, const int* in_sizes, int n_in, void* d_out, int out_size, void* d_ws, size_t ws_size, hipStream_t stream) {
    static int grid = 0;
    if (grid == 0) {
        if (n_in != 37 || out_size != (int)O_END || ws_size < 268435456) { fprintf(stderr, "kernel_launch: unexpected shapes: n_in %d out %d ws %zu\n", n_in, out_size, ws_size); grid = -1; return; }
        int dev = 0, cus = 0;
        if (hipGetDevice(&dev) != hipSuccess || hipDeviceGetAttribute(&cus, hipDeviceAttributeMultiprocessorCount, dev) != hipSuccess) { grid = -1; return; }
        if (hipFuncSetAttribute((const void*)mk_fwd, hipFuncAttributeMaxDynamicSharedMemorySize, LDS_BYTES) != hipSuccess) { fprintf(stderr, "kernel_launch: hipFuncSetAttribute failed\n"); grid = -1; return; }
        int per_cu = 0;
        if (hipOccupancyMaxActiveBlocksPerMultiprocessor(&per_cu, (const void*)mk_fwd, 512, LDS_BYTES) != hipSuccess || per_cu < 1)
            fprintf(stderr, "kernel_launch: occupancy query reports %d workgroups per CU\n", per_cu);
        (void)hipGetLastError();
        grid = cus;
    }
    if (grid < 0) return;
    (void)hipMemsetAsync((char*)d_ws + WS_CTL, 0, 65536, stream);
    Args a{};
    for (int i = 0; i < 37; ++i) a.in[i] = (const float*)d_in[i];
    a.out = (float*)d_out; a.ws = (unsigned char*)d_ws;
    {
        int n = 0; unsigned char s[32];
#ifndef PROBE_K
#define PROBE_K -1
#endif
        if (PROBE_K >= 0) { s[n++] = 0x80; for (int p = 1; p <= PROBE_K; ++p) if ((p - 1) % 7 != 3 && (p - 1) % 7 != 1) s[n++] = (unsigned char)(0x80 | p); }
        for (int p = 0; p < N_PHASES; ++p) if (p == 0 || p == 15 || ((p - 1) % 7 != 3 && (p - 1) % 7 != 1)) s[n++] = (unsigned char)p;
        for (int i = 0; i < n; ++i) a.sched[i >> 2] |= (unsigned)s[i] << (8 * (i & 3));
        a.nsched = n;
#ifndef PROBE_MODE
#define PROBE_MODE 31
#endif
        a.pmode = PROBE_MODE;
    }
    hipLaunchKernelGGL(mk_fwd, dim3(grid), dim3(512), LDS_BYTES, stream, a);
}
```

```cpp
#include <hip/hip_runtime.h>
#include <cstdio>
#include <cstdint>


#define LAS __attribute__((address_space(3)))
typedef unsigned short bf16_t;
typedef short bf16x8 __attribute__((ext_vector_type(8)));
typedef float f32x4 __attribute__((ext_vector_type(4)));
typedef float f32x2 __attribute__((ext_vector_type(2)));
typedef unsigned u32x4 __attribute__((ext_vector_type(4)));
typedef unsigned u32x2 __attribute__((ext_vector_type(2)));

constexpr int DM = 1024, TP = 16384, NB = 32, T = 18432, NCH = 288, NSEQ = 33;
constexpr int PW = 3584;
constexpr int NIN = 3840;
constexpr int FF = 2816, NGU = 5632;
constexpr float EPS = 1e-6f;
constexpr int PC_ZG = 0, PC_ZS = 256, PC_R = 768, PC_GQ = 1024, PC_GK = 1280, PC_GV = 1536, PC_SX = 1792, PC_SB = 2304, PC_SC = 2560,
              PC_RK = 2816, PC_RV = 3072, PC_RL = 3328;
constexpr size_t O_Y = 0;
constexpr size_t O_P_GDN = (size_t)T * DM;
constexpr size_t O_P_GDNC = O_P_GDN + 2 * 1 * 4 * 64 * 64;
constexpr size_t O_P_SSM = O_P_GDNC + 2 * 1 * 3 * 768;
constexpr size_t O_P_SSMC = O_P_SSM + 2 * 1 * 8 * 64 * 128;
constexpr size_t O_P_RWKV = O_P_SSMC + 2 * 1 * 3 * 1024;
constexpr size_t O_P_SHIFT = O_P_RWKV + 2 * 1 * 4 * 64 * 64;
constexpr size_t O_S_GDN = O_P_SHIFT + 2 * 1 * 1024;
constexpr size_t O_S_GDNC = O_S_GDN + (size_t)2 * 32 * 4 * 64 * 64;
constexpr size_t O_S_SSM = O_S_GDNC + (size_t)2 * 32 * 3 * 768;
constexpr size_t O_S_SSMC = O_S_SSM + (size_t)2 * 32 * 8 * 64 * 128;
constexpr size_t O_S_RWKV = O_S_SSMC + (size_t)2 * 32 * 3 * 1024;
constexpr size_t O_S_SHIFT = O_S_RWKV + (size_t)2 * 32 * 4 * 64 * 64;
constexpr size_t O_END = O_S_SHIFT + (size_t)2 * 32 * 1024;
static_assert(O_END == 25784832, "output size");

constexpr size_t WS_CTL = 0, CTL_BYTES = 1u << 20;
constexpr size_t W_IN_B = (size_t)NIN * DM * 2, W_OUT_B = (size_t)DM * DM * 2, W_GU_B = (size_t)NGU * DM * 2, W_DN_B = (size_t)DM * FF * 2;
constexpr size_t W_LAYER_B = W_IN_B + W_OUT_B + W_GU_B + W_DN_B;
constexpr size_t WS_W = WS_CTL + CTL_BYTES;
constexpr size_t WS_R1 = WS_W + 2 * W_LAYER_B;
constexpr size_t R_BYTES = (size_t)T * DM * 2;
constexpr size_t WS_R2 = WS_R1 + R_BYTES;
constexpr size_t WS_PROJ = WS_R2 + R_BYTES;
constexpr size_t PROJ_BYTES = (size_t)T * PW * 2;
constexpr size_t WS_SSQA = WS_PROJ + PROJ_BYTES;
constexpr size_t SSQ_BYTES = (size_t)T * 16 * 4;
constexpr size_t WS_SSQD = WS_SSQA + SSQ_BYTES;
constexpr size_t WS_END = WS_SSQD + SSQ_BYTES;
static_assert(WS_END <= 268435456, "d_ws map exceeds 256 MiB");
static_assert((size_t)T * FF * 2 <= PROJ_BYTES, "ff overlays proj");
constexpr size_t R2_SCAL = 0;
constexpr size_t R2_HCONV = R2_SCAL + (size_t)T * 16 * 4;
constexpr size_t R2_HSHIFT = R2_HCONV + (size_t)NCH * 3 * 1792 * 2;
constexpr size_t R2_ACUM = R2_HSHIFT + (size_t)NCH * 1024 * 2;
constexpr size_t R2_GCUM = R2_ACUM + (size_t)T * 8 * 4;
constexpr size_t R2_YOFF = R2_GCUM + (size_t)T * 4 * 4;
constexpr size_t R2_GW = R2_YOFF + (size_t)T * 512 * 2;
static_assert(R2_GW + (size_t)T * 256 * 2 <= R_BYTES, "R2 map");
constexpr size_t R1_RWA = 0;
constexpr size_t R1_RU = R1_RWA + (size_t)T * 256 * 2;
constexpr size_t R1_RBH = R1_RU + (size_t)T * 256 * 2;
constexpr size_t R1_RKV = R1_RBH + (size_t)T * 256 * 2;
static_assert(R1_RKV + (size_t)T * 256 * 2 <= R_BYTES, "R1 map");
constexpr size_t R2_RDV = R2_GW + (size_t)T * 256 * 2;
static_assert(R2_RDV + (size_t)NCH * 4 * 64 * 4 <= R_BYTES, "R2 map (dvec)");
constexpr int CW_BAR = 4096;

constexpr int RING_BYTES = 131072;
constexpr int LDSCTL_OFF = 143360, MISC_OFF = LDSCTL_OFF + 320;
constexpr int LDS_BYTES = 147456;

typedef __bf16 bf16x2_t __attribute__((ext_vector_type(2)));
__device__ __forceinline__ unsigned cvt_pk_bf16(float lo, float hi) { const f32x2 v = {lo, hi}; return __builtin_bit_cast(unsigned, __builtin_convertvector(v, bf16x2_t)); }
__device__ __forceinline__ float bf_lo(unsigned w) { return __uint_as_float(w << 16); }
__device__ __forceinline__ float bf_hi(unsigned w) { return __uint_as_float(w & 0xffff0000u); }
__device__ __forceinline__ float bf2f(bf16_t h) { return __uint_as_float(((unsigned)h) << 16); }
__device__ __forceinline__ bf16_t f2bf(float f) { return (bf16_t)(cvt_pk_bf16(f, 0.f) & 0xffffu); }
__device__ __forceinline__ void unpack8(u32x4 w, float (&o)[8]) {
    o[0] = bf_lo(w.x); o[1] = bf_hi(w.x); o[2] = bf_lo(w.y); o[3] = bf_hi(w.y); o[4] = bf_lo(w.z); o[5] = bf_hi(w.z); o[6] = bf_lo(w.w); o[7] = bf_hi(w.w); }
__device__ __forceinline__ u32x4 pack8(const float (&v)[8]) { u32x4 w; w.x = cvt_pk_bf16(v[0], v[1]); w.y = cvt_pk_bf16(v[2], v[3]); w.z = cvt_pk_bf16(v[4], v[5]); w.w = cvt_pk_bf16(v[6], v[7]); return w; }
__device__ __forceinline__ float wave_sum(float v) {
#pragma unroll
    for (int o = 1; o < 64; o <<= 1) v += __shfl_xor(v, o);
    return v;
}
#define LDS_BARRIER() do { asm volatile("s_waitcnt lgkmcnt(0)" ::: "memory"); __builtin_amdgcn_s_barrier(); asm volatile("" ::: "memory"); } while (0)
__device__ __forceinline__ float sigmoidf_(float x) { return __builtin_amdgcn_rcpf(1.f + __expf(-x)); }
__device__ __forceinline__ float siluf_(float x) { return x * __builtin_amdgcn_rcpf(1.f + __expf(-x)); }
__device__ __forceinline__ float tanhf_(float x) { return 1.f - 2.f * __builtin_amdgcn_rcpf(1.f + __expf(2.f * x)); }
__device__ __forceinline__ float softplusf_(float x) { return fmaxf(x, 0.f) + __logf(1.f + __expf(-fabsf(x))); }


typedef short s16x4 __attribute__((ext_vector_type(4)));
__device__ __forceinline__ f32x4 mma16(bf16x8 a, bf16x8 b, f32x4 c) { return __builtin_amdgcn_mfma_f32_16x16x32_bf16(a, b, c, 0, 0, 0); }
__device__ __forceinline__ bf16x8 cat4(s16x4 a, s16x4 b) { return (bf16x8){a[0], a[1], a[2], a[3], b[0], b[1], b[2], b[3]}; }
__device__ __forceinline__ bf16x8 frag_nat(const LAS bf16_t* Tt, int LD, int row0, int k0, int i16, int g) { return *(const LAS bf16x8*)(Tt + (row0 + i16) * LD + k0 + 8 * g); }
__device__ __forceinline__ bf16x8 frag_sig(const LAS bf16_t* Tt, int LD, int row0, int k0, int i16, int g) {
    const LAS bf16_t* p = Tt + (row0 + i16) * LD + k0 + 4 * g; return cat4(*(const LAS s16x4*)p, *(const LAS s16x4*)(p + 16)); }
__device__ __forceinline__ s16x4 tr4(const LAS bf16_t* p) { return __builtin_amdgcn_ds_read_tr16_b64_v4i16((LAS s16x4*)p); }
__device__ __forceinline__ bf16x8 frag_tr_nat(const LAS bf16_t* X, int LD, int k0, int c0, int i16, int g) {
    const LAS bf16_t* p = X + (k0 + 8 * g + (i16 >> 2)) * LD + c0 + 4 * (i16 & 3); return cat4(tr4(p), tr4(p + 4 * LD)); }
__device__ __forceinline__ bf16x8 frag_tr_sig(const LAS bf16_t* X, int LD, int k0, int c0, int i16, int g) {
    const LAS bf16_t* p = X + (k0 + 4 * g + (i16 >> 2)) * LD + c0 + 4 * (i16 & 3); return cat4(tr4(p), tr4(p + 16 * LD)); }
__device__ __forceinline__ bf16x8 acc_frag(f32x4 x0, f32x4 x1) {
    u32x4 w; w.x = cvt_pk_bf16(x0[0], x0[1]); w.y = cvt_pk_bf16(x0[2], x0[3]); w.z = cvt_pk_bf16(x1[0], x1[1]); w.w = cvt_pk_bf16(x1[2], x1[3]);
    return __builtin_bit_cast(bf16x8, w); }
__device__ __forceinline__ u32x2 pack4(f32x4 x) { u32x2 w; w.x = cvt_pk_bf16(x[0], x[1]); w.y = cvt_pk_bf16(x[2], x[3]); return w; }
__device__ __forceinline__ f32x4 unpack4(u32x2 w) { return (f32x4){bf_lo(w.x), bf_hi(w.x), bf_lo(w.y), bf_hi(w.y)}; }

namespace pg8 {
constexpr int BM = 256, BK = 64, HALF = 128, HTB = HALF * BK * 2, STAGE_BYTES = 8 * HTB, NXCD = 8, WGM = 8;
__host__ __device__ __forceinline__ int lds_byte(int r, int c) { const int st = (r >> 4) * 2 + (c >> 5), rr = r & 15, cc = c & 31, ob = rr * 64 + cc * 2; return st * 1024 + (ob ^ (((ob >> 9) & 1) << 5)); }
__host__ __device__ __forceinline__ void stage_rc(int b, int& R, int& C) { const int st = b / 1024, sb = b % 1024, swz = sb ^ (((sb >> 9) & 1) << 5); R = (st >> 1) * 16 + swz / 64; C = (st & 1) * 32 + (swz % 64) / 2; }
__host__ __device__ __forceinline__ int perm32(int rho) { const int n = rho >> 4, i = rho & 15; return 8 * (i >> 2) + 4 * n + (i & 3); }
struct Unit { int pm, pn; };
struct Gemm { const bf16_t* A; const bf16_t* Bt; int M, N, K, lda; };
struct StaticOrder {
    int nM, nN, nwg, G, c;
    __host__ __device__ void init(int M, int N, int G_, int c_, int bm = BM) { nM = M / bm; nN = N / BM; nwg = nM * nN; G = G_; c = c_; }
    __host__ __device__ bool next(int i, Unit& u) const {
        const long L = (long)i * G + c; if (L >= nwg) return false;
        int wgid = (int)L; { const int q = nwg / NXCD, r = nwg % NXCD, xcd = wgid % NXCD, off = wgid / NXCD; wgid = (xcd < r ? xcd * (q + 1) : r * (q + 1) + (xcd - r) * q) + off; }
        const int nig = WGM * nN, gid = wgid / nig, fm = gid * WGM, gsz = (nM - fm) < WGM ? (nM - fm) : WGM;
        u.pm = fm + ((wgid % nig) % gsz); u.pn = (wgid % nig) / gsz; return true;
    }
};
template <class Epi, bool ALIGN_EPI, int MT = 4>
__device__ __forceinline__ void gemm_phase(LAS unsigned char* lds, const Gemm g, const StaticOrder& S, const Epi& E) {
    int tid_ = threadIdx.x; asm volatile("" : "+v"(tid_));
    const int tid = tid_, wid = __builtin_amdgcn_readfirstlane(tid >> 6), lane = tid & 63, wr = wid >> 2, wc = wid & 3, fr = lane & 15, fq = lane >> 4;
    const int K = g.K, nt = K / BK, lda = g.lda;
    unsigned voffA[2], voffB[2];
#pragma unroll
    for (int i = 0; i < 2; ++i) { int R, C; stage_rc(tid * 16 + i * 8192, R, C); const int Rb = Epi::PERM ? ((R & ~31) + perm32(R & 31)) : R;
        voffA[i] = (unsigned)(R * lda + C) * 2u; voffB[i] = (unsigned)(Rb * K + C) * 2u; }
    const size_t kstep = (size_t)(BK * 2);
    const size_t hstepA = (size_t)(32 * MT) * lda * 2, hstepB = (size_t)HALF * K * 2;
    const size_t tstepA = 2 * hstepA, tstepB = 2 * hstepB;
    const unsigned ldsw = (unsigned)wid * 1024u;
    const int aoff = lds_byte(wr * (16 * MT) + fr, fq * 8), boff = lds_byte(wc * 32 + fr, fq * 8);
#define PG8_SA(b, h) (((b) * 2 + (h)) * HTB)
#define PG8_SB(b, h) ((4 + (b) * 2 + (h)) * HTB)
#define PG8_STAGE(bufoff, gbase, voff) do { _Pragma("unroll") for (int _i = 0; _i < 2; ++_i) \
        __builtin_amdgcn_global_load_lds((const unsigned*)((const char*)(gbase) + (voff)[_i]), (LAS unsigned*)(lds + (bufoff) + ldsw + _i * 8192), 16, 0, 0); } while (0)
#define PG8_LDA(dst, b, h) do { _Pragma("unroll") for (int m = 0; m < MT; ++m) _Pragma("unroll") for (int k = 0; k < 2; ++k) dst[m][k] = *(const LAS bf16x8*)(lds + PG8_SA(b, h) + aoff + m * 2048 + k * 1024); } while (0)
#define PG8_LDB(dst, b, h) do { _Pragma("unroll") for (int n = 0; n < 2; ++n) _Pragma("unroll") for (int k = 0; k < 2; ++k) dst[n][k] = *(const LAS bf16x8*)(lds + PG8_SB(b, h) + boff + n * 2048 + k * 1024); } while (0)
#define PG8_MMA(ai, bj, At, Bt) do { __builtin_amdgcn_s_setprio(1); _Pragma("unroll") for (int m = 0; m < MT; ++m) _Pragma("unroll") for (int n = 0; n < 2; ++n) _Pragma("unroll") for (int k = 0; k < 2; ++k) \
        acc[ai][bj][m][n] = __builtin_amdgcn_mfma_f32_16x16x32_bf16(Bt[n][k], At[m][k], acc[ai][bj][m][n], 0, 0, 0); __builtin_amdgcn_s_setprio(0); } while (0)
#define PG8_WAIT_V(n) asm volatile("s_waitcnt vmcnt(" #n ")" ::: "memory")
#define PG8_WAIT_L(n) asm volatile("s_waitcnt lgkmcnt(" #n ")" ::: "memory")
#define PG8_BAR __builtin_amdgcn_s_barrier()
#define PG8_SCHED __builtin_amdgcn_sched_barrier(0)
    Unit cur, nxt; int ui = 0;
    if (!S.next(0, cur)) return;
    f32x4 acc[2][2][4][2];
#pragma unroll
    for (int a = 0; a < 2; ++a)
#pragma unroll
        for (int b = 0; b < 2; ++b)
#pragma unroll
            for (int m = 0; m < 4; ++m)
#pragma unroll
                for (int n = 0; n < 2; ++n) acc[a][b][m][n] = (f32x4){0.f, 0.f, 0.f, 0.f};
    bf16x8 At[4][2], B0[2][2], B1[2][2];
    const char* cA = (const char*)g.A + (size_t)cur.pm * tstepA; const char* cB = (const char*)g.Bt + (size_t)cur.pn * tstepB;
    PG8_STAGE(PG8_SB(0, 0), cB, voffB); PG8_STAGE(PG8_SB(0, 1), cB + hstepB, voffB); PG8_STAGE(PG8_SA(0, 0), cA, voffA); PG8_STAGE(PG8_SA(0, 1), cA + hstepA, voffA);
    if (wr == 1) PG8_BAR;
    PG8_WAIT_V(2); PG8_BAR;
    PG8_STAGE(PG8_SB(1, 0), cB + kstep, voffB); PG8_STAGE(PG8_SA(1, 0), cA + kstep, voffA); PG8_STAGE(PG8_SB(1, 1), cB + hstepB + kstep, voffB);
    PG8_WAIT_V(6); PG8_BAR;
    for (;;) {
        const bool has_next = S.next(ui + 1, nxt);
        const char* nA = has_next ? (const char*)g.A + (size_t)nxt.pm * tstepA : cA; const char* nB = has_next ? (const char*)g.Bt + (size_t)nxt.pn * tstepB : cB;
        for (int t = 0; t < nt; t += 2) {
            const bool last = (t == nt - 2);
            const char* a1 = cA + (size_t)(t + 1) * kstep;
            const char* a2 = last ? nA : cA + (size_t)(t + 2) * kstep; const char* b2 = last ? nB : cB + (size_t)(t + 2) * kstep;
            const char* a3 = a2 + kstep; const char* b3 = b2 + kstep;
            PG8_LDB(B0, 0, 0); PG8_LDB(B1, 0, 1); PG8_SCHED; PG8_LDA(At, 0, 0); PG8_STAGE(PG8_SA(1, 1), a1 + hstepA, voffA);
            PG8_WAIT_V(8); PG8_WAIT_L(0); PG8_BAR; PG8_MMA(0, 0, At, B0); PG8_MMA(0, 1, At, B1); PG8_BAR; PG8_SCHED;
            PG8_LDA(At, 0, 1); PG8_STAGE(PG8_SB(0, 0), b2, voffB); PG8_STAGE(PG8_SB(0, 1), b2 + hstepB, voffB); PG8_STAGE(PG8_SA(0, 0), a2, voffA);
            PG8_WAIT_V(8); PG8_WAIT_L(0); PG8_BAR; PG8_MMA(1, 0, At, B0); PG8_MMA(1, 1, At, B1); PG8_BAR; PG8_SCHED;
            PG8_LDB(B0, 1, 0); PG8_LDB(B1, 1, 1); PG8_SCHED; PG8_LDA(At, 1, 0); PG8_STAGE(PG8_SA(0, 1), a2 + hstepA, voffA);
            PG8_WAIT_V(8); PG8_WAIT_L(0); PG8_BAR; PG8_MMA(0, 0, At, B0); PG8_MMA(0, 1, At, B1); PG8_BAR; PG8_SCHED;
            PG8_LDA(At, 1, 1); PG8_STAGE(PG8_SB(1, 0), b3, voffB); PG8_STAGE(PG8_SB(1, 1), b3 + hstepB, voffB); PG8_STAGE(PG8_SA(1, 0), a3, voffA);
            PG8_WAIT_V(8); PG8_WAIT_L(0); PG8_BAR; PG8_MMA(1, 0, At, B0); PG8_MMA(1, 1, At, B1); PG8_BAR; PG8_SCHED;
        }
        if constexpr (ALIGN_EPI) { if (wr == 0) PG8_BAR; }
        E(acc, cur, wr, wc, fr, fq);
        if (!has_next) break;
#pragma unroll
        for (int a = 0; a < 2; ++a)
#pragma unroll
            for (int b = 0; b < 2; ++b)
#pragma unroll
                for (int m = 0; m < 4; ++m)
#pragma unroll
                    for (int n = 0; n < 2; ++n) acc[a][b][m][n] = (f32x4){0.f, 0.f, 0.f, 0.f};
        cur = nxt; cA = nA; cB = nB; ++ui;
        if constexpr (ALIGN_EPI) { if (wr == 1) PG8_BAR; }
    }
    PG8_WAIT_V(0);
    if constexpr (!ALIGN_EPI) { if (wr == 0) PG8_BAR; }
    PG8_BAR;
#undef PG8_SA
#undef PG8_SB
#undef PG8_STAGE
#undef PG8_LDA
#undef PG8_LDB
#undef PG8_MMA
#undef PG8_WAIT_V
#undef PG8_WAIT_L
#undef PG8_BAR
#undef PG8_SCHED
}

__device__ __forceinline__ float row_rstd(const float* ssq, int row, int fq) {
    const f32x4 p = *(const f32x4*)(ssq + (size_t)row * 16 + 4 * fq);
    float s = (p.x + p.y) + (p.z + p.w);
    s += __shfl_xor(s, 16); s += __shfl_xor(s, 32);
    return rsqrtf(s * (1.0f / 1024.0f) + EPS);
}

struct EpiInProj {
    static constexpr bool PERM = true;
    bf16_t* proj; float* scal; const float* ssq; bf16_t* hconv; bf16_t* hshift; float* out; int layer;
    __device__ __forceinline__ void operator()(const f32x4 (&acc)[2][2][4][2], const Unit& u, int wr, int wc, int fr, int fq) const {
        const int pn = u.pn;
#pragma unroll
        for (int ai = 0; ai < 2; ++ai)
#pragma unroll
            for (int m = 0; m < 4; ++m) {
                const int row = u.pm * BM + ai * HALF + wr * 64 + m * 16 + fr;
                const float rs = row_rstd(ssq, row, fq);
                {
#pragma unroll
                    for (int bj = 0; bj < 2; ++bj) {
                        const int c0 = pn * BM + bj * HALF + wc * 32 + 8 * fq;
                        const f32x4 v0 = acc[ai][bj][m][0] * rs, v1 = acc[ai][bj][m][1] * rs;
                        u32x4 w; w.x = cvt_pk_bf16(v0[0], v0[1]); w.y = cvt_pk_bf16(v0[2], v0[3]); w.z = cvt_pk_bf16(v1[0], v1[1]); w.w = cvt_pk_bf16(v1[2], v1[3]);
                        *(u32x4*)(proj + (size_t)row * PW + c0) = w;
                        if (m == 3) {
                            const int chunk = row >> 6;
                            if (fr >= 13 && pn >= 4 && pn < 11) {
                                const int j = fr - 13;
                                *(u32x4*)(hconv + ((size_t)chunk * 3 + j) * 1792 + (c0 - 1024)) = w;
                                if (chunk >= 255) {
                                    float* o;
                                    if (c0 < PC_SX) o = out + (chunk == 255 ? O_P_GDNC + ((size_t)layer * 3 + j) * 768 : O_S_GDNC + (((size_t)layer * 32 + (chunk - 256)) * 3 + j) * 768) + (c0 - PC_GQ);
                                    else o = out + (chunk == 255 ? O_P_SSMC + ((size_t)layer * 3 + j) * 1024 : O_S_SSMC + (((size_t)layer * 32 + (chunk - 256)) * 3 + j) * 1024) + (c0 - PC_SX);
                                    *(f32x4*)o = v0; *(f32x4*)(o + 4) = v1;
                                }
                            }
                            if (fr == 15 && (pn == 3 || pn >= 11)) {
                                const int oc = (pn == 3) ? (c0 - PC_R) : (c0 - 2560);
                                *(u32x4*)(hshift + (size_t)chunk * 1024 + oc) = w;
                                if (chunk >= 255) {
                                    float* o = out + (chunk == 255 ? O_P_SHIFT + (size_t)layer * 1024 : O_S_SHIFT + ((size_t)layer * 32 + (chunk - 256)) * 1024) + oc;
                                    *(f32x4*)o = v0; *(f32x4*)(o + 4) = v1;
                                }
                            }
                        }
                    }
                }
            }
    }
};
template <bool F32BASE, int MT> struct EpiResid {
    static constexpr bool PERM = true;
    const float* base_p; const float* base_s; bf16_t* xb; float* ssq;
    __device__ __forceinline__ void operator()(const f32x4 (&acc)[2][2][4][2], const Unit& u, int wr, int wc, int fr, int fq) const {
        const int col0 = u.pn * BM + wc * 32 + 8 * fq;
#pragma unroll
        for (int ai = 0; ai < 2; ++ai)
#pragma unroll
            for (int m = 0; m < MT; ++m) {
                const int row = u.pm * (64 * MT) + ai * (32 * MT) + wr * (16 * MT) + m * 16 + fr;
                float ss = 0.f;
#pragma unroll
                for (int bj = 0; bj < 2; ++bj) {
                    const int c = col0 + bj * HALF;
                    float x[8];
                    if (F32BASE) {
                        const float* bp = ((row < TP) ? base_p + (size_t)row * DM : base_s + (size_t)(row - TP) * DM) + c;
                        const f32x4 b0 = *(const f32x4*)bp, b1 = *(const f32x4*)(bp + 4);
                        x[0] = b0[0]; x[1] = b0[1]; x[2] = b0[2]; x[3] = b0[3]; x[4] = b1[0]; x[5] = b1[1]; x[6] = b1[2]; x[7] = b1[3];
                    } else unpack8(*(const u32x4*)(xb + (size_t)row * DM + c), x);
#pragma unroll
                    for (int n = 0; n < 2; ++n)
#pragma unroll
                        for (int i = 0; i < 4; ++i) { const float v = x[4 * n + i] + acc[ai][bj][m][n][i]; x[4 * n + i] = v; ss += v * v; }
                    *(u32x4*)(xb + (size_t)row * DM + c) = pack8(x);
                }
                ss += __shfl_xor(ss, 16); ss += __shfl_xor(ss, 32);
                if (fq == 0) ssq[(size_t)row * 16 + u.pn * 4 + wc] = ss;
            }
    }
};
struct EpiGateUp {
    static constexpr bool PERM = true;
    bf16_t* ff; const float* ssq;
    __device__ __forceinline__ void operator()(const f32x4 (&acc)[2][2][4][2], const Unit& u, int wr, int wc, int fr, int fq) const {
        const int c0 = u.pn * HALF + wc * 32 + 8 * fq;
#pragma unroll
        for (int ai = 0; ai < 2; ++ai)
#pragma unroll
            for (int m = 0; m < 4; ++m) {
                const int row = u.pm * BM + ai * HALF + wr * 64 + m * 16 + fr;
                const float rs = row_rstd(ssq, row, fq);
                float f[8];
#pragma unroll
                for (int n = 0; n < 2; ++n)
#pragma unroll
                    for (int i = 0; i < 4; ++i) { const float gg = acc[ai][0][m][n][i] * rs, uu = acc[ai][1][m][n][i] * rs; f[n * 4 + i] = siluf_(gg) * uu; }
                *(u32x4*)(ff + (size_t)row * FF + c0) = pack8(f);
            }
    }
};
}

#define XB_TMO      128
#define XB_XCNT(j)  (256  + 64 * (j))
#define XB_XSUB(j)  (1280 + 64 * (j))
#define XB_XGEN(j)  (2304 + 64 * (j))
#define XB_TOP      3328
#define XB_TOPGEN   3392
#define XCD_BAR_WORDS 3456
#define XB_SPIN_CAP (1u << 18)
__device__ __forceinline__ unsigned xb_ld(unsigned* p)              { return __hip_atomic_load(p, __ATOMIC_RELAXED, __HIP_MEMORY_SCOPE_AGENT); }
__device__ __forceinline__ unsigned xb_add(unsigned* p, unsigned v) { return __hip_atomic_fetch_add(p, v, __ATOMIC_RELAXED, __HIP_MEMORY_SCOPE_AGENT); }
__device__ __forceinline__ unsigned xb_xcc_id() { return (unsigned)__builtin_amdgcn_s_getreg((3 << 11) | 20) & 0xFu; }
#define XB_SPIN(cond, bar) do { unsigned _sp = 0; while (cond) { __builtin_amdgcn_s_sleep(1); \
    if ((++_sp & 255u) == 0u) { if (xb_ld(&(bar)[XB_TMO])) break; if (_sp > XB_SPIN_CAP) { atomicAdd(&(bar)[XB_TMO], 1u); break; } } } } while (0)
struct XcdBarrier { unsigned* bar; unsigned x; volatile LAS unsigned* st; };
__device__ __forceinline__ XcdBarrier xcd_barrier_post(unsigned* bar, volatile LAS unsigned* st) {
    XcdBarrier b; b.bar = bar; b.x = xb_xcc_id(); b.st = st;
    if (threadIdx.x == 0) (void)xb_add(&bar[XB_XCNT(b.x)], 1u);
    return b;
}
__device__ __forceinline__ void xcd_barrier_complete(unsigned* bar, unsigned x, unsigned& nloc, unsigned& nx) {
    const unsigned G = gridDim.x * gridDim.y * gridDim.z;
    unsigned sum, cnt, mine, sp = 0u;
    for (;;) {
        sum = 0u; cnt = 0u; mine = 0u;
#pragma unroll
        for (unsigned j = 0; j < 16; ++j) { const unsigned c = xb_ld(&bar[XB_XCNT(j)]); sum += c; cnt += (c > 0u) ? 1u : 0u; mine = (j == x) ? c : mine; }
        if (sum == G) break;
        __builtin_amdgcn_s_sleep(1);
        if ((++sp & 255u) == 0u) { if (xb_ld(&bar[XB_TMO])) break; if (sp > XB_SPIN_CAP) { atomicAdd(&bar[XB_TMO], 1u); break; } }
    }
    nloc = mine > 0u ? mine : 1u; nx = cnt > 0u ? cnt : 1u;
}
__device__ __forceinline__ void xcd_barrier(const XcdBarrier& b) {
    asm volatile("s_waitcnt vmcnt(0)" ::: "memory");
    __syncthreads();
    if (threadIdx.x == 0) {
        unsigned* bar = b.bar;
        __builtin_amdgcn_s_waitcnt(0);
        unsigned nloc = b.st[0], nx = b.st[1];
        if (nloc == 0u) { xcd_barrier_complete(bar, b.x, nloc, nx); b.st[0] = nloc; b.st[1] = nx; }
        const unsigned old = xb_add(&bar[XB_XSUB(b.x)], 1u);
        const unsigned gen = old / nloc;
        if (old + 1u == (gen + 1u) * nloc) {
            __builtin_amdgcn_fence(__ATOMIC_RELEASE, "agent");
            asm volatile("s_waitcnt vmcnt(0)" ::: "memory");
            const unsigned og = xb_add(&bar[XB_TOP], 1u);
            const unsigned tg = og / nx;
            if (og + 1u == (tg + 1u) * nx) xb_add(&bar[XB_TOPGEN], 1u);
            else XB_SPIN(xb_ld(&bar[XB_TOPGEN]) == tg, bar);
            __builtin_amdgcn_fence(__ATOMIC_ACQUIRE, "agent");
            xb_add(&bar[XB_XGEN(b.x)], 1u);
            asm volatile("s_waitcnt vmcnt(0)" ::: "memory");
        } else {
            XB_SPIN(xb_ld(&bar[XB_XGEN(b.x)]) == gen, bar);
            __builtin_amdgcn_fence(__ATOMIC_ACQUIRE, "agent");
            asm volatile("s_waitcnt vmcnt(0)" ::: "memory");
        }
    }
    __syncthreads();
}

struct Args { const float* in[37]; float* out; unsigned char* ws; unsigned sched[8]; int nsched, pmode; };
enum { I_XP = 0, I_XS, I_SGDN, I_SGDNC, I_SSSM, I_SSSMC, I_SRWKV, I_SSHIFT, I_NORM1, I_WIN, I_GCONVW, I_GALOG, I_GDTB, I_GNORMW,
       I_SCONVW, I_SCONVB, I_SALOG, I_SDTB, I_SD, I_SNORMW, I_RMU, I_RW0, I_RWUP, I_RA0, I_RAUP, I_RGUP, I_RKK, I_RKA, I_RRK, I_RLNW, I_RLNB,
       I_WOUT, I_NORM2, I_WG, I_WU, I_WD, I_FNORM };

struct Frame {
    LAS unsigned char* lds;
    int tid, lane, wave, vcu, G;
    float* out; unsigned char* ws;
};
constexpr int PTRTAB_OFF = LDSCTL_OFF + 1024;
__device__ __forceinline__ const float* inptr(LAS unsigned char* lds, int i) {
    const unsigned long long v = ((const LAS unsigned long long*)(lds + PTRTAB_OFF))[i];
    const unsigned lo = __builtin_amdgcn_readfirstlane((unsigned)v), hi = __builtin_amdgcn_readfirstlane((unsigned)(v >> 32));
    return (const float*)(((unsigned long long)hi << 32) | lo);
}
#define INP(i) inptr(F.lds, (i))
#define F_R1     ((bf16_t*)(F.ws + WS_R1))
#define F_R2     ((bf16_t*)(F.ws + WS_R2))
#define F_PROJ   ((bf16_t*)(F.ws + WS_PROJ))
#define F_SSQA   ((float*)(F.ws + WS_SSQA))
#define F_SSQD   ((float*)(F.ws + WS_SSQD))
#define F_SCAL   ((float*)(F.ws + WS_R2 + R2_SCAL))
#define F_HCONV  ((bf16_t*)(F.ws + WS_R2 + R2_HCONV))
#define F_HSHIFT ((bf16_t*)(F.ws + WS_R2 + R2_HSHIFT))
#define F_RWA    ((bf16_t*)((unsigned char*)F.out + R1_RWA))
#define F_RU     ((bf16_t*)((unsigned char*)F.out + R1_RU))
#define F_RBH    ((bf16_t*)((unsigned char*)F.out + R1_RBH))
#define F_RKV    ((bf16_t*)((unsigned char*)F.out + R1_RKV))
#define F_RDV    ((float*)(F.ws + WS_R2 + R2_RDV))
#define F_ACUM   ((float*)(F.ws + WS_R2 + R2_ACUM))
#define F_GCUM   ((float*)(F.ws + WS_R2 + R2_GCUM))
#define F_YOFF   ((bf16_t*)(F.ws + WS_R2 + R2_YOFF))
#define F_GW     ((bf16_t*)(F.ws + WS_R2 + R2_GW))
__device__ __forceinline__ bf16_t* w_in(const Frame& F, int l) { return (bf16_t*)(F.ws + WS_W + (size_t)l * W_LAYER_B); }
__device__ __forceinline__ bf16_t* w_out(const Frame& F, int l) { return (bf16_t*)(F.ws + WS_W + (size_t)l * W_LAYER_B + W_IN_B); }
__device__ __forceinline__ bf16_t* w_gu(const Frame& F, int l) { return (bf16_t*)(F.ws + WS_W + (size_t)l * W_LAYER_B + W_IN_B + W_OUT_B); }
__device__ __forceinline__ bf16_t* w_dn(const Frame& F, int l) { return (bf16_t*)(F.ws + WS_W + (size_t)l * W_LAYER_B + W_IN_B + W_OUT_B + W_GU_B); }

template <class Tp> __device__ __forceinline__ LAS Tp* opaque_lds(LAS Tp* p) { unsigned a = (unsigned)(unsigned long long)p; asm volatile("" : "+v"(a)); return (LAS Tp*)(unsigned long long)a; }
constexpr int CW_AFLAG = 14336, CW_RFLAG = 14336 + 288;
__device__ __forceinline__ void publish_item(unsigned* flag) {
    asm volatile("s_waitcnt vmcnt(0)" ::: "memory");
    LDS_BARRIER();
    if (threadIdx.x == 0) {
        __builtin_amdgcn_fence(__ATOMIC_RELEASE, "agent");
        asm volatile("s_waitcnt vmcnt(0)" ::: "memory");
        __hip_atomic_fetch_add(flag, 1u, __ATOMIC_RELAXED, __HIP_MEMORY_SCOPE_AGENT);
    }
}
__device__ __forceinline__ int opaque_tid() { int t = threadIdx.x; asm volatile("" : "+v"(t)); return t; }
#define PHASE_IDS(F) do { (F).tid = opaque_tid(); (F).lane = (F).tid & 63; (F).wave = __builtin_amdgcn_readfirstlane((F).tid >> 6); } while (0)
__device__ __forceinline__ int inproj_dst(int n) {
    if (n < 768) return PC_GQ + n;
    if (n < 1024) return PC_ZG + (n - 768);
    if (n < 1032) return 3584 + (n - 1024);
    if (n < 1544) return PC_ZS + (n - 1032);
    if (n < 2568) return PC_SX + (n - 1544);
    if (n < 2576) return 3592 + (n - 2568);
    if (n < 2832) return PC_R + (n - 2576);
    if (n < 3344) return PC_RK + (n - 2832);
    return PC_RL + (n - 3344);
}
template <int MODE>
__device__ __forceinline__ void p0_transpose_item(const float* W, int K, int N, bf16_t* WT, const float* kscale, LAS float* scr, int item, int lane) {
    const int nblk = (N + 31) / 32, kb = item / nblk, nb = item % nblk, k0 = 64 * kb, n0 = 32 * nb;
    {
        const int rr = lane >> 3, c4 = (lane & 7) * 4;
        f32x4 v[8];
#pragma unroll
        for (int i = 0; i < 8; ++i) { const float* p = W + (size_t)(k0 + 8 * i + rr) * N + n0 + c4;
            if (n0 + c4 + 3 < N) v[i] = *(const f32x4*)p;
            else v[i] = (f32x4){0.f, 0.f, 0.f, 0.f}; }
#pragma unroll
        for (int i = 0; i < 8; ++i) { LAS float* s = scr + (8 * i + rr) * 33 + c4; s[0] = v[i][0]; s[1] = v[i][1]; s[2] = v[i][2]; s[3] = v[i][3]; }
    }
    asm volatile("s_waitcnt lgkmcnt(0)" ::: "memory");
    const int c = lane & 7;
    float ks[8];
#pragma unroll
    for (int i = 0; i < 8; ++i) ks[i] = kscale ? kscale[k0 + 8 * c + i] : 1.f;
#pragma unroll
    for (int j = 0; j < 4; ++j) { const int nl = (lane >> 3) + 8 * j; const int n = n0 + nl; const LAS float* s = scr + (8 * c) * 33 + nl;
        u32x4 o; o.x = cvt_pk_bf16(s[0 * 33] * ks[0], s[1 * 33] * ks[1]); o.y = cvt_pk_bf16(s[2 * 33] * ks[2], s[3 * 33] * ks[3]);
        o.z = cvt_pk_bf16(s[4 * 33] * ks[4], s[5 * 33] * ks[5]); o.w = cvt_pk_bf16(s[6 * 33] * ks[6], s[7 * 33] * ks[7]);
        if (n < N) {
            int d;
            if (MODE == 0) d = n; else if (MODE == 1) d = inproj_dst(n); else if (MODE == 2) d = 256 * (n >> 7) + (n & 127); else d = 256 * (n >> 7) + 128 + (n & 127);
            *(u32x4*)(WT + (size_t)d * K + k0 + 8 * c) = o; } }
    asm volatile("s_waitcnt lgkmcnt(0)" ::: "memory");
}
__device__ __forceinline__ void p0_prologue(Frame& F) {
    PHASE_IDS(F);
    LAS float* scr = (LAS float*)(F.lds + F.wave * 16384);
    const int gw = F.vcu * 8 + F.wave, NGW = F.G * 8;
    constexpr int I_IN = 16 * 113, I_OUT = 16 * 32, I_G = 16 * 88, I_D = 44 * 32;
    constexpr int PER_L = I_IN + I_OUT + 2 * I_G + I_D;
    for (int it = gw; it < 2 * PER_L; it += NGW) {
        const int l = it / PER_L; int r = it % PER_L;
        if (r < I_IN) { p0_transpose_item<1>(INP(I_WIN) + (size_t)l * DM * 3600, DM, 3600, w_in(F, l), INP(I_NORM1) + l * DM, scr, r, F.lane); continue; } r -= I_IN;
        if (r < I_OUT) { p0_transpose_item<0>(INP(I_WOUT) + (size_t)l * DM * DM, DM, DM, w_out(F, l), nullptr, scr, r, F.lane); continue; } r -= I_OUT;
        if (r < I_G) { p0_transpose_item<2>(INP(I_WG) + (size_t)l * DM * FF, DM, FF, w_gu(F, l), INP(I_NORM2) + l * DM, scr, r, F.lane); continue; } r -= I_G;
        if (r < I_G) { p0_transpose_item<3>(INP(I_WU) + (size_t)l * DM * FF, DM, FF, w_gu(F, l), INP(I_NORM2) + l * DM, scr, r, F.lane); continue; } r -= I_G;
        p0_transpose_item<0>(INP(I_WD) + (size_t)l * FF * DM, FF, DM, w_dn(F, l), nullptr, scr, r, F.lane);
    }
    for (int m = gw; m < T; m += NGW) {
        const float* xr = (m < TP) ? INP(I_XP) + (size_t)m * DM : INP(I_XS) + (size_t)(m - TP) * DM;
        f32x4 v[4]; float s = 0.f;
#pragma unroll
        for (int j = 0; j < 4; ++j) { v[j] = *((const f32x4*)xr + F.lane + 64 * j); s += (v[j].x * v[j].x + v[j].y * v[j].y) + (v[j].z * v[j].z + v[j].w * v[j].w); }
        s = wave_sum(s);
#pragma unroll
        for (int j = 0; j < 4; ++j) { u32x2 w; w.x = cvt_pk_bf16(v[j].x, v[j].y); w.y = cvt_pk_bf16(v[j].z, v[j].w); *((u32x2*)(F_R1 + (size_t)m * DM) + F.lane + 64 * j) = w; }
        if (F.lane < 16) F_SSQA[(size_t)m * 16 + F.lane] = (F.lane == 0) ? s : 0.f;
    }
}

template <int LDL, int SGN, class RhsFn>
__device__ __forceinline__ void tri_solve64(const LAS float* Lo, float (&x)[64], RhsFn rhs) {
    f32x4 cur[16], nxt[16];
#pragma unroll
    for (int i = 0; i < 64; ++i) {
        if (i + 1 < 64) {
#pragma unroll
            for (int m4 = 0; m4 < (i + 1 + 3) / 4; ++m4) nxt[m4] = *(const LAS f32x4*)(Lo + (i + 1) * LDL + 4 * m4);
        }
        float a0 = rhs(i), a1 = 0.f, a2 = 0.f, a3 = 0.f;
#pragma unroll
        for (int m4 = 0; m4 < (i + 3) / 4; ++m4) {
            if (4 * m4 + 0 < i) a0 += (SGN > 0 ? cur[m4][0] : -cur[m4][0]) * x[4 * m4 + 0];
            if (4 * m4 + 1 < i) a1 += (SGN > 0 ? cur[m4][1] : -cur[m4][1]) * x[4 * m4 + 1];
            if (4 * m4 + 2 < i) a2 += (SGN > 0 ? cur[m4][2] : -cur[m4][2]) * x[4 * m4 + 2];
            if (4 * m4 + 3 < i) a3 += (SGN > 0 ? cur[m4][3] : -cur[m4][3]) * x[4 * m4 + 3];
        }
        x[i] = (a0 + a1) + (a2 + a3);
        __builtin_amdgcn_sched_barrier(0);
#pragma unroll
        for (int m4 = 0; m4 < 16; ++m4) cur[m4] = nxt[m4];
    }
}
constexpr int ACT_KT = 0, ACT_VT = 33792, ACT_LM = 67584, ACT_SCL = 137216, ACT_GCL = 141312;
constexpr int ACT_LDK = 264, ACT_LDL = 68;
__device__ __forceinline__ void act_chunk(Frame& F, int l, int c) {
    PHASE_IDS(F);
    const int tid = F.tid;
    const size_t row0 = (size_t)c * 64;
    const bool prompt = c < 256; const int b = c - 256;
    bf16_t* const proj = F_PROJ;
    LAS float* inT = (LAS float*)F.lds;
    LAS bf16_t* kx = (LAS bf16_t*)(F.lds + 256 * 68 * 4);
    LAS bf16_t* Kt = (LAS bf16_t*)(F.lds + ACT_KT); LAS bf16_t* Vt = (LAS bf16_t*)(F.lds + ACT_VT); LAS float* Lm = (LAS float*)(F.lds + ACT_LM);
    LAS float* scl = (LAS float*)(F.lds + ACT_SCL); LAS float* gcl = (LAS float*)(F.lds + ACT_GCL);
    LAS float* part = (LAS float*)(F.lds + ACT_LM); LAS float* rsl = part + 2 * 64 * 16;
    {
        const int w = F.wave, lane = F.lane, i16 = lane & 15, g = lane >> 4, rt = w & 3, kh = w >> 2;
        const bf16_t* ap = F_R1 + (row0 + 16 * rt + i16) * DM + kh * 512 + 8 * g;
        const bf16_t* bp = w_in(F, l) + (size_t)(PW + i16) * DM + kh * 512 + 8 * g;
        bf16x8 a[16], b[16];
#pragma unroll
        for (int ks = 0; ks < 16; ++ks) { a[ks] = *(const bf16x8*)(ap + 32 * ks); b[ks] = *(const bf16x8*)(bp + 32 * ks); }
        if (tid < 64) { const f32x4* sp = (const f32x4*)(F_SSQA + (row0 + tid) * 16); const f32x4 p0 = sp[0], p1 = sp[1], p2 = sp[2], p3 = sp[3];
            const float s = ((p0.x + p0.y) + (p0.z + p0.w)) + ((p1.x + p1.y) + (p1.z + p1.w)) + ((p2.x + p2.y) + (p2.z + p2.w)) + ((p3.x + p3.y) + (p3.z + p3.w));
            rsl[tid] = rsqrtf(s * (1.0f / 1024.0f) + EPS); }
        f32x4 acc0 = (f32x4){0.f, 0.f, 0.f, 0.f}, acc1 = (f32x4){0.f, 0.f, 0.f, 0.f};
#pragma unroll
        for (int ks = 0; ks < 16; ks += 2) { acc0 = mma16(a[ks], b[ks], acc0); acc1 = mma16(a[ks + 1], b[ks + 1], acc1); }
#pragma unroll
        for (int r = 0; r < 4; ++r) part[(kh * 64 + 16 * rt + 4 * g + r) * 16 + i16] = acc0[r] + acc1[r];
    }
    LDS_BARRIER();
    for (int e = tid; e < 64 * 16; e += 512) {
        const int t = e >> 4, q = e & 15;
        float* p = F_SCAL + (row0 + t) * 16 + q;
        const float v = (part[e] + part[1024 + e]) * rsl[t]; float r;
        if (q < 4) r = -__expf(INP(I_GALOG)[l * 4 + q]) * softplusf_(v + INP(I_GDTB)[l * 4 + q]);
        else if (q < 8) r = sigmoidf_(v);
        else r = softplusf_(v + INP(I_SDTB)[l * 8 + (q - 8)]);
        *p = r; scl[e] = r;
    }
    LDS_BARRIER();
    {
        const int w = F.wave, lane = F.lane;
        float v = scl[lane * 16 + 8 + w] * (-__expf(INP(I_SALOG)[l * 8 + w]));
#pragma unroll
        for (int o = 1; o < 64; o <<= 1) { const float tt = __shfl_up(v, o); if (lane >= o) v += tt; }
        F_ACUM[(row0 + lane) * 8 + w] = v;
        if (w < 4) {
            float gv = scl[lane * 16 + w];
#pragma unroll
            for (int o = 1; o < 64; o <<= 1) { const float tt = __shfl_up(gv, o); if (lane >= o) gv += tt; }
            F_GCUM[(row0 + lane) * 4 + w] = gv; gcl[w * 64 + lane] = gv;
        }
    }
    {
        const int cg = tid % 224, rh = tid / 224;
        const bool active = tid < 448;
        const int col = 1024 + cg * 8, t0 = 32 * rh;
        const bool gdn = cg < 96;
        const int cc = gdn ? (col - PC_GQ) : (col - PC_SX);
        const int C = gdn ? 768 : 1024;
        const int kind = gdn ? (cg >> 5) : 3;
        float w[4][8], bias[8], p3[8], p2[8], p1[8];
        u32x4 xr[16];
        if (active) {
            const float* cw = gdn ? INP(I_GCONVW) + (size_t)l * 4 * 768 : INP(I_SCONVW) + (size_t)l * 4 * 1024;
#pragma unroll
            for (int j = 0; j < 4; ++j)
#pragma unroll
                for (int i = 0; i < 8; ++i) w[j][i] = cw[j * C + cc + i];
#pragma unroll
            for (int i = 0; i < 8; ++i) bias[i] = gdn ? 0.f : INP(I_SCONVB)[l * 1024 + cc + i];
            if (rh == 1) {
                unpack8(*(const u32x4*)(proj + (row0 + t0 - 3) * PW + col), p3); unpack8(*(const u32x4*)(proj + (row0 + t0 - 2) * PW + col), p2); unpack8(*(const u32x4*)(proj + (row0 + t0 - 1) * PW + col), p1);
            } else if (prompt) {
                if (c == 0) {
#pragma unroll
                    for (int i = 0; i < 8; ++i) { p3[i] = 0.f; p2[i] = 0.f; p1[i] = 0.f; }
                } else {
                    const bf16_t* hp = F_HCONV + (size_t)(c - 1) * 3 * 1792 + (col - 1024);
                    unpack8(*(const u32x4*)(hp), p3); unpack8(*(const u32x4*)(hp + 1792), p2); unpack8(*(const u32x4*)(hp + 2 * 1792), p1);
                }
            } else {
                const float* st = gdn ? INP(I_SGDNC) + ((size_t)l * 32 + b) * 3 * 768 + cc : INP(I_SSSMC) + ((size_t)l * 32 + b) * 3 * 1024 + cc;
#pragma unroll
                for (int i = 0; i < 8; ++i) { p3[i] = st[i]; p2[i] = st[C + i]; p1[i] = st[2 * C + i]; }
            }
#pragma unroll
            for (int t = 0; t < 16; ++t) xr[t] = *(const u32x4*)(proj + (row0 + t0 + t) * PW + col);
        }
        asm volatile("s_waitcnt vmcnt(0)" ::: "memory");
        LDS_BARRIER();
#pragma unroll
        for (int bt = 0; bt < 2; ++bt) {
            if (active) {
#pragma unroll
                for (int t = 0; t < 16; ++t) {
                    const int tr = t0 + 16 * bt + t;
                    bf16_t* p = proj + (row0 + tr) * PW + col;
                    float x[8], y[8];
                    unpack8(xr[t], x);
#pragma unroll
                    for (int i = 0; i < 8; ++i) { float a = w[0][i] * p3[i] + w[1][i] * p2[i] + w[2][i] * p1[i] + w[3][i] * x[i] + bias[i]; y[i] = siluf_(a); p3[i] = p2[i]; p2[i] = p1[i]; p1[i] = x[i]; }
                    if (kind < 2) {
                        float ss = 0.f;
#pragma unroll
                        for (int i = 0; i < 8; ++i) ss += y[i] * y[i];
                        ss += __shfl_xor(ss, 1); ss += __shfl_xor(ss, 2); ss += __shfl_xor(ss, 4);
                        const float sc = rsqrtf(ss + EPS) * (kind == 0 ? 0.125f : 1.f);
#pragma unroll
                        for (int i = 0; i < 8; ++i) y[i] *= sc;
                    }
                    const u32x4 pk = pack8(y);
                    if (kind != 2) *(u32x4*)p = pk;
                    if (kind == 1) *(LAS u32x4*)(Kt + tr * ACT_LDK + (col - PC_GK)) = pk;
                    if (kind == 2) *(LAS u32x4*)(Vt + tr * ACT_LDK + (col - PC_GV)) = pk;
                }
                if (bt == 0) {
#pragma unroll
                    for (int t = 0; t < 16; ++t) xr[t] = *(const u32x4*)(proj + (row0 + t0 + 16 + t) * PW + col);
                }
            }
        }
    }
    LDS_BARRIER();
    {
        const int w = F.wave, lane = F.lane, i16 = lane & 15, g = lane >> 4, h = w >> 1, e = w & 1;
        LAS float* Lh = Lm + h * 64 * ACT_LDL;
#pragma unroll
        for (int ii = 0; ii < 2; ++ii) {
            const int it = e + 2 * ii;
#pragma unroll
            for (int jt = 0; jt < 4; ++jt) {
                if (jt <= it) {
                    f32x4 acc = (f32x4){0.f, 0.f, 0.f, 0.f};
#pragma unroll
                    for (int ks = 0; ks < 2; ++ks) acc = mma16(frag_nat(Kt, ACT_LDK, 16 * it, h * 64 + 32 * ks, i16, g), frag_nat(Kt, ACT_LDK, 16 * jt, h * 64 + 32 * ks, i16, g), acc);
                    const int j = 16 * jt + i16; const float gcj = gcl[h * 64 + j];
#pragma unroll
                    for (int r = 0; r < 4; ++r) { const int i = 16 * it + 4 * g + r;
                        const float f = (j < i) ? scl[i * 16 + 4 + h] * __expf(fminf(gcl[h * 64 + i] - gcj, 0.f)) : 0.f;
                        Lh[i * ACT_LDL + j] = acc[r] * f; }
                }
            }
        }
        LDS_BARRIER();
        float x[64];
        const LAS bf16_t* Rt = opaque_lds((e == 0 ? Vt : Kt) + h * 64 + lane); const float ef = (float)e;
        const LAS float* Lo = opaque_lds(Lh); const LAS float* sclo = opaque_lds(scl + 4 + h); const LAS float* gclo = opaque_lds(gcl + h * 64);
        tri_solve64<ACT_LDL, -1>(Lo, x, [&](int i) { return sclo[i * 16] * __expf(gclo[i] * ef) * bf2f(Rt[i * ACT_LDK]); });
        if (e == 0) {
            bf16_t* o = proj + (row0 + lane) * PW + PC_GV + h * 64;
#pragma unroll
            for (int q = 0; q < 8; ++q) { float y[8];
#pragma unroll
                for (int i = 0; i < 8; ++i) y[i] = x[8 * q + i];
                *(u32x4*)(o + 8 * q) = pack8(y); }
        } else {
            bf16_t* o = F_GW + (((size_t)c * 4 + h) * 64) * 64 + lane;
#pragma unroll
            for (int i = 0; i < 64; ++i) o[i * 64] = f2bf(-x[i]);
        }
    }
    publish_item((unsigned*)(F.ws + WS_CTL) + CW_AFLAG + c);
    LDS_BARRIER();
}

__device__ __forceinline__ void st8_wt(void* p, u32x2 v) { __hip_atomic_store((unsigned long long*)p, __builtin_bit_cast(unsigned long long, v), __ATOMIC_RELAXED, __HIP_MEMORY_SCOPE_AGENT); }
__device__ __forceinline__ u32x4 ld16_asm(const void* p) { u32x4 r; asm volatile("global_load_dwordx4 %0, %1, off sc1" : "=v"(r) : "v"(p)); return r; }
__device__ __forceinline__ float ld4_asm(const float* p) { float r; asm volatile("global_load_dword %0, %1, off sc1" : "=v"(r) : "v"(p)); return r; }
constexpr int RDY_SLACK = 8;
#define RDY_WORD(F) ((volatile LAS int*)((F).lds + MISC_OFF + 64))
__device__ __forceinline__ int rdy_advance(const unsigned* rdy, int rstride, unsigned rneed, int nxt, int nch, int lane) {
    const int k = nxt + (lane & 15);
    const bool ok = k < nch && (int)(__hip_atomic_load(rdy + (size_t)rstride * k, __ATOMIC_RELAXED, __HIP_MEMORY_SCOPE_AGENT) - rneed) >= 0;
    const unsigned long long m = __ballot(ok) & 0xffffull;
    return nxt + __builtin_ctzll(~m);
}
__device__ __forceinline__ int rdy_block(Frame& F, const unsigned* rdy, int rstride, unsigned rneed, int nxt, int upto, int nch) {
    unsigned sp = 0;
    while (nxt < upto && ++sp < 4000000u) { const int n2 = rdy_advance(rdy, rstride, rneed, nxt, nch, F.lane); if (n2 == nxt) __builtin_amdgcn_s_sleep(8); nxt = n2; }
    if (F.lane == 0) *RDY_WORD(F) = nxt - 1;
    return nxt;
}
#define RDY_LOADER_WAIT(F, k) do { const int kk_ = (k) < nch ? (k) : nch - 1; unsigned sp_ = 0; while (*RDY_WORD(F) < kk_ && ++sp_ < 40000000u) __builtin_amdgcn_s_sleep(1); } while (0)
#define SCAN_CL(k) (c0 + ((k) < nch ? (k) : nch - 1))
#define SCAN_LOADER6(LOADM, WRITEM, WAITM, NLD) do {            \
        RDY_LOADER_WAIT(F, 0); LOADM(SCAN_CL(0), 0); WAITM(0, 0); WRITEM(0, 0); \
        RDY_LOADER_WAIT(F, 1); LOADM(SCAN_CL(1), 1); RDY_LOADER_WAIT(F, 2); LOADM(SCAN_CL(2), 2); RDY_LOADER_WAIT(F, 3); LOADM(SCAN_CL(3), 3); RDY_LOADER_WAIT(F, 4); LOADM(SCAN_CL(4), 4); RDY_LOADER_WAIT(F, 5); LOADM(SCAN_CL(5), 5); \
        LDS_BARRIER(); \
        for (int r_ = 0; r_ < nch; r_ += 6) { \
            RDY_LOADER_WAIT(F, r_ + 6); LOADM(SCAN_CL(r_ + 6), 0); WAITM(1, 5 * (NLD)); WRITEM(1, 1); LDS_BARRIER(); if (r_ + 1 >= nch) break; \
            RDY_LOADER_WAIT(F, r_ + 7); LOADM(SCAN_CL(r_ + 7), 1); WAITM(2, 5 * (NLD)); WRITEM(0, 2); LDS_BARRIER(); if (r_ + 2 >= nch) break; \
            RDY_LOADER_WAIT(F, r_ + 8); LOADM(SCAN_CL(r_ + 8), 2); WAITM(3, 5 * (NLD)); WRITEM(1, 3); LDS_BARRIER(); if (r_ + 3 >= nch) break; \
            RDY_LOADER_WAIT(F, r_ + 9); LOADM(SCAN_CL(r_ + 9), 3); WAITM(4, 5 * (NLD)); WRITEM(0, 4); LDS_BARRIER(); if (r_ + 4 >= nch) break; \
            RDY_LOADER_WAIT(F, r_ + 10); LOADM(SCAN_CL(r_ + 10), 4); WAITM(5, 5 * (NLD)); WRITEM(1, 5); LDS_BARRIER(); if (r_ + 5 >= nch) break; \
            RDY_LOADER_WAIT(F, r_ + 11); LOADM(SCAN_CL(r_ + 11), 5); WAITM(0, 5 * (NLD)); WRITEM(0, 0); LDS_BARRIER(); \
        } \
        asm volatile("s_waitcnt vmcnt(0)" ::: "memory"); \
        } while (0)
#define SCAN_LOADER(LOADM, WRITEM, WAITM, NLD) do { \
          \
          \
        RDY_LOADER_WAIT(F, 0); LOADM(SCAN_CL(0), 0); WAITM(0, 0); WRITEM(0, 0); \
        RDY_LOADER_WAIT(F, 1); LOADM(SCAN_CL(1), 1); RDY_LOADER_WAIT(F, 2); LOADM(SCAN_CL(2), 2); RDY_LOADER_WAIT(F, 3); LOADM(SCAN_CL(3), 3); \
        LDS_BARRIER(); \
          \
        for (int r_ = 0; r_ < nch; r_ += 4) { \
            RDY_LOADER_WAIT(F, r_ + 4); LOADM(SCAN_CL(r_ + 4), 0); WAITM(1, 3 * (NLD)); WRITEM(1, 1); LDS_BARRIER(); if (r_ + 1 >= nch) break; \
            RDY_LOADER_WAIT(F, r_ + 5); LOADM(SCAN_CL(r_ + 5), 1); WAITM(2, 3 * (NLD)); WRITEM(0, 2); LDS_BARRIER(); if (r_ + 2 >= nch) break; \
            RDY_LOADER_WAIT(F, r_ + 6); LOADM(SCAN_CL(r_ + 6), 2); WAITM(3, 3 * (NLD)); WRITEM(1, 3); LDS_BARRIER(); if (r_ + 3 >= nch) break; \
            RDY_LOADER_WAIT(F, r_ + 7); LOADM(SCAN_CL(r_ + 7), 3); WAITM(0, 3 * (NLD)); WRITEM(0, 0); LDS_BARRIER(); \
        } \
        asm volatile("s_waitcnt vmcnt(0)" ::: "memory");      \
        } while (0)

constexpr int GDN_LD = 72;
constexpr int GDN_BUF = 3 * 64 * GDN_LD * 2 + 64;
__device__ __forceinline__ void scan_gdn2(Frame& F, int l, int s, int h, int vb, int ncw, unsigned* prog, unsigned pbase, unsigned* done, int pm, const unsigned* rdy, int rstride, unsigned rneed) {
    PHASE_IDS(F);
    const int tid = F.tid, lane = F.lane, w = F.wave, i16 = lane & 15, g = lane >> 4;
    const int nch = (s == 0) ? 256 : 1, c0 = (s == 0) ? 0 : 255 + s, b = s - 1;
    bf16_t* const proj = F_PROJ; bf16_t* const gw = F_GW; const float* const gcum = F_GCUM;
    {
        if (w == (ncw < 4 ? ncw : 0)) (void)rdy_block(F, rdy, rstride, rneed, 0, nch < RDY_SLACK ? nch : RDY_SLACK, nch);
        LDS_BARRIER();
    }
    if (w >= 4) {
        const int lt = tid - 256;
        const int umask = 128 * ncw - 1;
        u32x4 rw0[2], ru0[2], rk0[2], rw1[2], ru1[2], rk1[2], rw2[2], ru2[2], rk2[2], rw3[2], ru3[2], rk3[2], rw4[2], ru4[2], rk4[2], rw5[2], ru5[2], rk5[2]; float gc0[2], gl0, gc1[2], gl1, gc2[2], gl2, gc3[2], gl3, gc4[2], gl4, gc5[2], gl5;
        const bf16_t* pW[2]; const bf16_t* pU[2]; const bf16_t* pK[2]; const float* pG[2]; const float* const pGl = gcum + 63 * 4 + h;
#pragma unroll
        for (int q = 0; q < 2; ++q) { const int idx = q * 256 + lt, row = idx >> 3, col8 = (idx & 7) * 8, urow = vb + ((idx & umask) >> 3);
            pW[q] = gw + ((size_t)h * 64 + row) * 64 + col8; pU[q] = proj + (size_t)urow * PW + PC_GV + h * 64 + col8; pK[q] = proj + (size_t)row * PW + PC_GK + h * 64 + col8; pG[q] = gcum + row * 4 + h; }
#define GDN_LOAD(ch, S) do { const size_t oW_ = (size_t)(ch) * (4 * 4096), oP_ = (size_t)(ch) * (64 * PW), oG_ = (size_t)(ch) * 256; gl##S = ld4_asm(pGl + oG_); \
        _Pragma("unroll") for (int q = 0; q < 2; ++q) { rw##S[q] = ld16_asm(pW[q] + oW_); ru##S[q] = ld16_asm(pU[q] + oP_); rk##S[q] = ld16_asm(pK[q] + oP_); gc##S[q] = ld4_asm(pG[q] + oG_); } } while (0)
#define GDN_WAIT(S, N) asm volatile("s_waitcnt vmcnt(%9)" : "+v"(rw##S[0]), "+v"(rw##S[1]), "+v"(ru##S[0]), "+v"(ru##S[1]), "+v"(rk##S[0]), "+v"(rk##S[1]), "+v"(gc##S[0]), "+v"(gc##S[1]), "+v"(gl##S) : "n"(N))
#define GDN_WRITE(bb, S) do { LAS bf16_t* Wn_ = (LAS bf16_t*)(F.lds + (bb) * GDN_BUF); LAS bf16_t* Ut_ = Wn_ + 64 * GDN_LD; LAS bf16_t* Kd_ = Ut_ + 64 * GDN_LD; \
        _Pragma("unroll") for (int q = 0; q < 2; ++q) { const int idx = q * 256 + lt, row = idx >> 3, col8 = (idx & 7) * 8; \
            *(LAS u32x4*)(Wn_ + row * GDN_LD + col8) = rw##S[q]; *(LAS u32x4*)(Ut_ + (vb + ((idx & umask) >> 3)) * GDN_LD + col8) = ru##S[q]; \
            const float ks_ = __expf(gl##S - gc##S[q]); \
            float v_[8]; unpack8(rk##S[q], v_); _Pragma("unroll") for (int i = 0; i < 8; ++i) v_[i] *= ks_; *(LAS u32x4*)(Kd_ + row * GDN_LD + col8) = pack8(v_); } \
        if (lt == 0) *(LAS float*)(Kd_ + 64 * GDN_LD) = __expf(gl##S); } while (0)
        SCAN_LOADER6(GDN_LOAD, GDN_WRITE, GDN_WAIT, 9);
#undef GDN_LOAD
#undef GDN_WRITE
#undef GDN_WAIT
    } else if (w >= ncw) {
        int nxt = nch < RDY_SLACK ? nch : RDY_SLACK;
        LDS_BARRIER();
        for (int ci = 0; ci < nch; ++ci) {
            if (w == ncw && nxt < nch) { const int upto = ci + 1 + RDY_SLACK < nch ? ci + 1 + RDY_SLACK : nch; nxt = rdy_block(F, rdy, rstride, rneed, nxt, upto, nch); }
            LDS_BARRIER();
        }
    } else {
        const int n0 = vb + 16 * w;
        f32x4 S[4];
        if (s == 0) {
#pragma unroll
            for (int kt = 0; kt < 4; ++kt) S[kt] = (f32x4){0.f, 0.f, 0.f, 0.f};
        } else {
            const float* st = INP(I_SGDN) + (((size_t)l * 32 + b) * 4 + h) * 4096 + n0 + i16;
#pragma unroll
            for (int kt = 0; kt < 4; ++kt)
#pragma unroll
                for (int r = 0; r < 4; ++r) S[kt][r] = st[(16 * kt + 4 * g + r) * 64];
        }
        LDS_BARRIER();
        for (int ci = 0; ci < nch; ++ci) {
            const int chunk = c0 + ci; const size_t row0 = (size_t)chunk * 64;
            const LAS bf16_t* Wn = (const LAS bf16_t*)(F.lds + (ci & 1) * GDN_BUF); const LAS bf16_t* Ut = Wn + 64 * GDN_LD; const LAS bf16_t* Kd = Ut + 64 * GDN_LD;
            const float bd = *(const LAS float*)(Kd + 64 * GDN_LD);
            bf16x8 A1[4][2], A2[4][2]; u32x2 ui[4];
#pragma unroll
            for (int m = 0; m < 4; ++m) { ui[m] = *(const LAS u32x2*)(Ut + (n0 + i16) * GDN_LD + 16 * m + 4 * g);
#pragma unroll
                for (int ks = 0; ks < 2; ++ks) A1[m][ks] = frag_sig(Wn, GDN_LD, 16 * m, 32 * ks, i16, g); }
#pragma unroll
            for (int kt = 0; kt < 4; ++kt)
#pragma unroll
                for (int cs = 0; cs < 2; ++cs) A2[kt][cs] = frag_tr_sig(Kd, GDN_LD, 32 * cs, 16 * kt, i16, g);
            __builtin_amdgcn_sched_barrier(0);
            bf16x8 Sb[2];
#pragma unroll
            for (int ks = 0; ks < 2; ++ks) Sb[ks] = acc_frag(S[2 * ks], S[2 * ks + 1]);
            {
                bf16_t* ho = ((bf16_t*)((unsigned char*)F.out + (size_t)T * 256 * 2 * 4) + (size_t)(chunk) * 16384) + ((size_t)h * 64 + n0 + i16) * 64 + 4 * g;
#pragma unroll
                for (int kt = 0; kt < 4; ++kt) st8_wt(ho + 16 * kt, pack4(S[kt]));
            }
            f32x4 V[4];
            bf16_t* vo = proj + (row0 + n0 + i16) * PW + PC_GV + h * 64 + 4 * g;
#pragma unroll
            for (int m = 0; m < 4; ++m) {
                f32x4 acc = unpack4(ui[m]);
#pragma unroll
                for (int ks = 0; ks < 2; ++ks) acc = mma16(A1[m][ks], Sb[ks], acc);
                V[m] = acc;
            }
#pragma unroll
            for (int m = 0; m < 4; ++m) st8_wt(vo + 16 * m, pack4(V[m]));
            bf16x8 Ub[2];
#pragma unroll
            for (int cs = 0; cs < 2; ++cs) Ub[cs] = acc_frag(V[2 * cs], V[2 * cs + 1]);
#pragma unroll
            for (int kt = 0; kt < 4; ++kt) {
                f32x4 acc = S[kt] * bd;
#pragma unroll
                for (int cs = 0; cs < 2; ++cs) acc = mma16(A2[kt][cs], Ub[cs], acc);
                S[kt] = acc;
            }
            if (prog) {
                asm volatile("s_waitcnt vmcnt(48)" ::: "memory");
                if (lane == 0 && ci >= 6) __hip_atomic_store(prog + 64 * w, pbase + (unsigned)(ci - 6) + 1u, __ATOMIC_RELAXED, __HIP_MEMORY_SCOPE_AGENT);
            }
            LDS_BARRIER();
        }
        asm volatile("s_waitcnt vmcnt(0)" ::: "memory");
        if (prog && lane == 0) __hip_atomic_store(prog + 64 * w, pbase + (unsigned)nch, __ATOMIC_RELAXED, __HIP_MEMORY_SCOPE_AGENT);
        if (done && lane == 0) __hip_atomic_fetch_add(done, 1u, __ATOMIC_RELAXED, __HIP_MEMORY_SCOPE_AGENT);
        float* o = F.out + (s == 0 ? O_P_GDN + ((size_t)l * 4 + h) * 4096 : O_S_GDN + (((size_t)l * 32 + b) * 4 + h) * 4096) + n0 + i16;
#pragma unroll
        for (int kt = 0; kt < 4; ++kt)
#pragma unroll
            for (int r = 0; r < 4; ++r) o[(16 * kt + 4 * g + r) * 64] = S[kt][r];
    }
}
__device__ __forceinline__ void post_gdn(Frame& F, int l, int c, int hp) {
    PHASE_IDS(F);
    const int tid = F.tid, lane = F.lane, w = F.wave, i16 = lane & 15, g = lane >> 4;
    const size_t row0 = (size_t)c * 64;
    bf16_t* const proj = F_PROJ;
    constexpr int LQ = 136;
    LAS bf16_t* Qt = (LAS bf16_t*)F.lds; LAS bf16_t* Kt = Qt + 64 * LQ; LAS bf16_t* Ht = Kt + 64 * LQ; LAS bf16_t* Vn = Ht + 2 * 64 * GDN_LD; LAS float* gcs = (LAS float*)(Vn + 2 * 64 * GDN_LD);
    {
#pragma unroll
        for (int q = 0; q < 2; ++q) { const int idx = q * 512 + tid;
            { const int row = idx >> 4, col8 = (idx & 15) * 8;
              *(LAS u32x4*)(Qt + row * LQ + col8) = *(const u32x4*)(proj + (row0 + row) * PW + PC_GQ + hp * 128 + col8);
              *(LAS u32x4*)(Kt + row * LQ + col8) = *(const u32x4*)(proj + (row0 + row) * PW + PC_GK + hp * 128 + col8); }
            { const int hh = idx >> 9, row = (idx >> 3) & 63, col8 = (idx & 7) * 8;
              *(LAS u32x4*)(Ht + hh * 64 * GDN_LD + row * GDN_LD + col8) = *(const u32x4*)(((bf16_t*)((unsigned char*)F.out + (size_t)T * 256 * 2 * 4) + (size_t)(c) * 16384) + (((size_t)(2 * hp + hh) * 64) + row) * 64 + col8);
              *(LAS u32x4*)(Vn + hh * 64 * GDN_LD + row * GDN_LD + col8) = *(const u32x4*)(proj + (row0 + row) * PW + PC_GV + (2 * hp + hh) * 64 + col8); } }
        if (tid < 128) gcs[tid] = F_GCUM[(row0 + (tid & 63)) * 4 + 2 * hp + (tid >> 6)];
    }
    LDS_BARRIER();
    const int hh = w >> 2, it = w & 3, head = 2 * hp + hh;
    const LAS bf16_t* Hh = Ht + hh * 64 * GDN_LD; const LAS bf16_t* Vh = Vn + hh * 64 * GDN_LD;
    f32x4 AT[4];
    const float gci = gcs[hh * 64 + 16 * it + i16];
#pragma unroll
    for (int jt = 0; jt < 4; ++jt) {
        f32x4 acc = (f32x4){0.f, 0.f, 0.f, 0.f};
        if (jt <= it) {
#pragma unroll
            for (int ks = 0; ks < 2; ++ks) acc = mma16(frag_nat(Kt, LQ, 16 * jt, hh * 64 + 32 * ks, i16, g), frag_nat(Qt, LQ, 16 * it, hh * 64 + 32 * ks, i16, g), acc);
#pragma unroll
            for (int r = 0; r < 4; ++r) { const int j = 16 * jt + 4 * g + r, i = 16 * it + i16; acc[r] *= (j <= i) ? __expf(fminf(gci - gcs[hh * 64 + j], 0.f)) : 0.f; }
        }
        AT[jt] = acc;
    }
    f32x4 O[4]; float ss[4] = {0.f, 0.f, 0.f, 0.f};
#pragma unroll
    for (int vt = 0; vt < 4; ++vt) {
        f32x4 acc = (f32x4){0.f, 0.f, 0.f, 0.f};
#pragma unroll
        for (int ks = 0; ks < 2; ++ks) acc = mma16(frag_nat(Qt, LQ, 16 * it, hh * 64 + 32 * ks, i16, g), frag_nat(Hh, GDN_LD, 16 * vt, 32 * ks, i16, g), acc);
#pragma unroll
        for (int r = 0; r < 4; ++r) acc[r] *= __expf(gcs[hh * 64 + 16 * it + 4 * g + r]);
#pragma unroll
        for (int cs = 0; cs < 2; ++cs) if (2 * cs <= it) acc = mma16(acc_frag(AT[2 * cs], AT[2 * cs + 1]), frag_sig(Vh, GDN_LD, 16 * vt, 32 * cs, i16, g), acc);
        O[vt] = acc;
#pragma unroll
        for (int r = 0; r < 4; ++r) ss[r] += acc[r] * acc[r];
    }
#pragma unroll
    for (int r = 0; r < 4; ++r) { float t = ss[r]; t += __shfl_xor(t, 1); t += __shfl_xor(t, 2); t += __shfl_xor(t, 4); t += __shfl_xor(t, 8); ss[r] = rsqrtf(t * (1.f / 64.f) + EPS); }
#pragma unroll
    for (int vt = 0; vt < 4; ++vt) { const int v = 16 * vt + i16; const float nw = INP(I_GNORMW)[l * 64 + v];
#pragma unroll
        for (int r = 0; r < 4; ++r) { bf16_t* p = proj + (row0 + 16 * it + 4 * g + r) * PW + PC_ZG + head * 64 + v; *p = f2bf(O[vt][r] * ss[r] * nw * siluf_(bf2f(*p))); } }
    LDS_BARRIER();
}

constexpr int RW_LD = 72;
constexpr int RW_XD = 0, RW_XA = 9216, RW_WD = 18432, RW_WA = 27648, RW_RT = 36864, RW_KX = 46080, RW_VT = 55296, RW_XG = 64512, RW_WG = 81920, RW_EX = 100352;
constexpr int RW_L = 64512, RW_P = 81920;
struct RwkvTok { float cum[2][4], lw[2][4], iclr[2][4], kk[2][4], kp[2][4], kraw[2][4], c63[2], w0[2], a0[2], kkw[2], kaw[2]; };
template <bool POST>
__device__ __forceinline__ void rwkv_tokens(Frame& F, int l, int c, int h, RwkvTok& o, f32x4 (&Zg)[2]) {
    const int tid = F.tid, lane = F.lane, w = F.wave, i16 = lane & 15, g = lane >> 4, tt = w & 3, jh = w >> 2;
    const size_t row0 = (size_t)c * 64;
    bf16_t* const proj = F_PROJ;
    LAS bf16_t* Xd = (LAS bf16_t*)(F.lds + RW_XD); LAS bf16_t* Xa = (LAS bf16_t*)(F.lds + RW_XA); LAS bf16_t* Wd = (LAS bf16_t*)(F.lds + RW_WD); LAS bf16_t* Wa = (LAS bf16_t*)(F.lds + RW_WA);
    LAS bf16_t* Rt = (LAS bf16_t*)(F.lds + RW_RT); LAS bf16_t* Kx = (LAS bf16_t*)(F.lds + RW_KX); LAS bf16_t* Vt = (LAS bf16_t*)(F.lds + RW_VT);
    LAS bf16_t* Xg = (LAS bf16_t*)(F.lds + RW_XG); LAS bf16_t* Wg = (LAS bf16_t*)(F.lds + RW_WG);
    LAS float* ksq = (LAS float*)(F.lds + RW_EX); LAS float* ctot = ksq + 128;
    const int lt0 = (tid >> 5) * 4, lo8 = (tid & 31) * 8;
    const int wi = tid >> 3, wj8 = (tid & 7) * 8;
    const int rt = tid >> 3, rd8 = (tid & 7) * 8;
    u32x4 lx[4], lprev_b = (u32x4){0u, 0u, 0u, 0u}; f32x4 lprev_f[2], lmu[2];
    f32x4 wdv[2], wav[2], wgv[4];
    u32x4 rx[3], rpv_b[3]; f32x4 rpv_f[3][2], rmu[3][2];
    const bool smp = c >= 256;
    {
        const float* mup = INP(I_RMU) + l * 1024;
        const float* stp = INP(I_SSHIFT) + ((size_t)l * 32 + (smp ? c - 256 : 0)) * 1024;
        const int col = PC_RL + lo8;
        lmu[0] = *(const f32x4*)(mup + 768 + lo8); lmu[1] = *(const f32x4*)(mup + 768 + lo8 + 4);
        if (lt0 > 0) lprev_b = *(const u32x4*)(proj + (row0 + lt0 - 1) * PW + col);
        else if (!smp) { if (c > 0) lprev_b = *(const u32x4*)(F_HSHIFT + (size_t)(c - 1) * 1024 + 768 + lo8); }
        else { lprev_f[0] = *(const f32x4*)(stp + 768 + lo8); lprev_f[1] = *(const f32x4*)(stp + 768 + lo8 + 4); }
#pragma unroll
        for (int q = 0; q < 4; ++q) lx[q] = *(const u32x4*)(proj + (row0 + lt0 + q) * PW + col);
        { const float* p = INP(I_RWUP) + ((size_t)l * 64 + wi) * 256 + h * 64 + wj8; wdv[0] = *(const f32x4*)p; wdv[1] = *(const f32x4*)(p + 4); }
        { const float* p = INP(I_RAUP) + ((size_t)l * 64 + wi) * 256 + h * 64 + wj8; wav[0] = *(const f32x4*)p; wav[1] = *(const f32x4*)(p + 4); }
        if (POST) {
#pragma unroll
            for (int q2 = 0; q2 < 2; ++q2) { const float* p = INP(I_RGUP) + ((size_t)l * 128 + wi + 64 * q2) * 256 + h * 64 + wj8; wgv[2 * q2] = *(const f32x4*)p; wgv[2 * q2 + 1] = *(const f32x4*)(p + 4); }
        }
#pragma unroll
        for (int which = 0; which < 3; ++which) {
            const int pcol = (which == 0 ? PC_R : (which == 1 ? PC_RK : PC_RV)) + h * 64 + rd8, oc = which * 256 + h * 64 + rd8;
            const bf16_t* p = proj + (row0 + rt) * PW + pcol;
            rx[which] = *(const u32x4*)p;
            if (!POST) {
                rmu[which][0] = *(const f32x4*)(mup + oc); rmu[which][1] = *(const f32x4*)(mup + oc + 4);
                rpv_b[which] = (u32x4){0u, 0u, 0u, 0u};
                if (rt > 0) rpv_b[which] = *(const u32x4*)(p - PW);
                else if (!smp) { if (c > 0) rpv_b[which] = *(const u32x4*)(F_HSHIFT + (size_t)(c - 1) * 1024 + oc); }
                else { rpv_f[which][0] = *(const f32x4*)(stp + oc); rpv_f[which][1] = *(const f32x4*)(stp + oc + 4); }
            }
        }
#pragma unroll
        for (int q = 0; q < 2; ++q) { const int jc = l * 256 + h * 64 + 16 * (2 * jh + q) + i16;
            o.w0[q] = INP(I_RW0)[jc]; o.a0[q] = INP(I_RA0)[jc]; o.kkw[q] = INP(I_RKK)[jc]; o.kaw[q] = INP(I_RKA)[jc]; }
    }
    {
        float prev[8], mu[8] = {lmu[0][0], lmu[0][1], lmu[0][2], lmu[0][3], lmu[1][0], lmu[1][1], lmu[1][2], lmu[1][3]};
        if (lt0 == 0 && smp) { prev[0] = lprev_f[0][0]; prev[1] = lprev_f[0][1]; prev[2] = lprev_f[0][2]; prev[3] = lprev_f[0][3]; prev[4] = lprev_f[1][0]; prev[5] = lprev_f[1][1]; prev[6] = lprev_f[1][2]; prev[7] = lprev_f[1][3]; }
        else unpack8(lprev_b, prev);
#pragma unroll
        for (int q = 0; q < 4; ++q) {
            float x[8], y[8]; unpack8(lx[q], x);
#pragma unroll
            for (int i = 0; i < 8; ++i) { const float v = x[i] + (prev[i] - x[i]) * mu[i]; prev[i] = x[i]; y[i] = (lo8 < 64) ? tanhf_(v) : (lo8 >= 128 ? sigmoidf_(v) : v); }
            const u32x4 pk = pack8(y);
            if (lo8 < 64) *(LAS u32x4*)(Xd + (lt0 + q) * RW_LD + lo8) = pk;
            else if (lo8 < 128) *(LAS u32x4*)(Xa + (lt0 + q) * RW_LD + (lo8 - 64)) = pk;
            else if (POST) *(LAS u32x4*)(Xg + (lt0 + q) * 136 + (lo8 - 128)) = pk;
        }
        { const float v[8] = {wdv[0][0], wdv[0][1], wdv[0][2], wdv[0][3], wdv[1][0], wdv[1][1], wdv[1][2], wdv[1][3]}; *(LAS u32x4*)(Wd + wi * RW_LD + wj8) = pack8(v); }
        { const float v[8] = {wav[0][0], wav[0][1], wav[0][2], wav[0][3], wav[1][0], wav[1][1], wav[1][2], wav[1][3]}; *(LAS u32x4*)(Wa + wi * RW_LD + wj8) = pack8(v); }
        if (POST) {
#pragma unroll
            for (int q2 = 0; q2 < 2; ++q2) { const float v[8] = {wgv[2 * q2][0], wgv[2 * q2][1], wgv[2 * q2][2], wgv[2 * q2][3], wgv[2 * q2 + 1][0], wgv[2 * q2 + 1][1], wgv[2 * q2 + 1][2], wgv[2 * q2 + 1][3]};
                *(LAS u32x4*)(Wg + (wi + 64 * q2) * RW_LD + wj8) = pack8(v); }
        }
        u32x4 pk3[3];
#pragma unroll
        for (int which = 0; which < 3; ++which) {
            LAS bf16_t* dst = (which == 0 ? Rt : (which == 1 ? Kx : Vt)) + rt * RW_LD + rd8;
            if (POST) *(LAS u32x4*)dst = rx[which];
            else {
                float x[8], pv[8], y[8];
                unpack8(rx[which], x);
                if (rt == 0 && smp) { pv[0] = rpv_f[which][0][0]; pv[1] = rpv_f[which][0][1]; pv[2] = rpv_f[which][0][2]; pv[3] = rpv_f[which][0][3]; pv[4] = rpv_f[which][1][0]; pv[5] = rpv_f[which][1][1]; pv[6] = rpv_f[which][1][2]; pv[7] = rpv_f[which][1][3]; }
                else unpack8(rpv_b[which], pv);
#pragma unroll
                for (int i = 0; i < 8; ++i) y[i] = x[i] + (pv[i] - x[i]) * rmu[which][i >> 2][i & 3];
                pk3[which] = pack8(y);
                *(LAS u32x4*)dst = pk3[which];
            }
        }
        if (!POST) {
            LDS_BARRIER();
#pragma unroll
            for (int which = 0; which < 3; ++which) *(u32x4*)(proj + (row0 + rt) * PW + (which == 0 ? PC_R : (which == 1 ? PC_RK : PC_RV)) + h * 64 + rd8) = pk3[which];
        }
    }
    LDS_BARRIER();
    f32x4 Zd[2], Za[2];
#pragma unroll
    for (int q = 0; q < 2; ++q) {
        const int jt = 2 * jh + q;
        f32x4 a = (f32x4){0.f, 0.f, 0.f, 0.f}, bq = a, cq = a;
#pragma unroll
        for (int ks = 0; ks < 2; ++ks) {
            a = mma16(frag_nat(Xd, RW_LD, 16 * tt, 32 * ks, i16, g), frag_tr_nat(Wd, RW_LD, 32 * ks, 16 * jt, i16, g), a);
            bq = mma16(frag_nat(Xa, RW_LD, 16 * tt, 32 * ks, i16, g), frag_tr_nat(Wa, RW_LD, 32 * ks, 16 * jt, i16, g), bq);
        }
        if (POST) {
#pragma unroll
            for (int ks = 0; ks < 4; ++ks) cq = mma16(frag_nat(Xg, 136, 16 * tt, 32 * ks, i16, g), frag_tr_nat(Wg, RW_LD, 32 * ks, 16 * jt, i16, g), cq);
        }
        Zd[q] = a; Za[q] = bq; Zg[q] = cq;
    }
    float ksum[4] = {0.f, 0.f, 0.f, 0.f}, csum[2];
#pragma unroll
    for (int q = 0; q < 2; ++q) {
        const int j = 16 * (2 * jh + q) + i16, jc = l * 256 + h * 64 + j;
        const float w0 = o.w0[q], a0 = o.a0[q], kkw = o.kkw[q];
        float run = 0.f;
#pragma unroll
        for (int r = 0; r < 4; ++r) {
            const int t = 16 * tt + 4 * g + r;
            const float wl = -softplusf_(-(w0 + Zd[q][r])) - 0.5f;
            const float lw = -__expf(wl);
            o.lw[q][r] = lw; run += lw; o.cum[q][r] = run;
            o.iclr[q][r] = sigmoidf_(a0 + Za[q][r]);
            const float kr = bf2f(Kx[t * RW_LD + j]); o.kraw[q][r] = kr;
            const float kq = kr * kkw; o.kk[q][r] = kq; ksum[r] += kq * kq;
        }
        float tot = run;
        const float u1 = __shfl_up(tot, 16); if (g >= 1) tot += u1;
        const float u2 = __shfl_up(tot, 32); if (g >= 2) tot += u2;
        const float excl = tot - run;
#pragma unroll
        for (int r = 0; r < 4; ++r) o.cum[q][r] += excl;
        csum[q] = __shfl(tot, 48 + i16);
        if (g == 0) ctot[tt * 64 + j] = csum[q];
    }
#pragma unroll
    for (int r = 0; r < 4; ++r) { float s = ksum[r]; s += __shfl_xor(s, 1); s += __shfl_xor(s, 2); s += __shfl_xor(s, 4); s += __shfl_xor(s, 8); ksum[r] = s; }
    if (i16 == 0) {
#pragma unroll
        for (int r = 0; r < 4; ++r) ksq[jh * 64 + 16 * tt + 4 * g + r] = ksum[r];
    }
    LDS_BARRIER();
#pragma unroll
    for (int q = 0; q < 2; ++q) {
        const int j = 16 * (2 * jh + q) + i16, jc = l * 256 + h * 64 + j;
        const float kaw = o.kaw[q];
        float pre = 0.f, all = 0.f;
#pragma unroll
        for (int t4 = 0; t4 < 4; ++t4) { const float v = ctot[t4 * 64 + j]; all += v; if (t4 < tt) pre += v; }
        o.c63[q] = all;
#pragma unroll
        for (int r = 0; r < 4; ++r) {
            const int t = 16 * tt + 4 * g + r;
            o.cum[q][r] += pre;
            const float kn = rsqrtf(ksq[t] + ksq[64 + t] + EPS);
            o.kk[q][r] *= kn;
            o.kp[q][r] = o.kraw[q][r] * (1.f + (o.iclr[q][r] - 1.f) * kaw);
        }
    }
}
__device__ __forceinline__ void prep_rwkv(Frame& F, int l, int c, int h) {
    PHASE_IDS(F);
    const int lane = F.lane, w = F.wave, i16 = lane & 15, g = lane >> 4, tt = w & 3, jh = w >> 2;
    RwkvTok tk; f32x4 Zg[2];
    rwkv_tokens<false>(F, l, c, h, tk, Zg);
    LAS bf16_t* At = (LAS bf16_t*)(F.lds + RW_XD); LAS bf16_t* Bt = (LAS bf16_t*)(F.lds + RW_XA); LAS bf16_t* Kt = (LAS bf16_t*)(F.lds + RW_WD); LAS bf16_t* Kh = (LAS bf16_t*)(F.lds + RW_WA);
    LAS bf16_t* Vt = (LAS bf16_t*)(F.lds + RW_VT); LAS float* Lm = (LAS float*)(F.lds + RW_L); LAS float* Pm = (LAS float*)(F.lds + RW_P);
    bf16_t* const bh = F_RBH + (((size_t)c * 4 + h) * 64) * 64;
    LDS_BARRIER();
#pragma unroll
    for (int q = 0; q < 2; ++q) {
        const int j = 16 * (2 * jh + q) + i16;
#pragma unroll
        for (int r = 0; r < 4; ++r) {
            const int t = 16 * tt + 4 * g + r;
            const float cum = tk.cum[q][r], b = tk.kk[q][r] * tk.iclr[q][r], einv = __expf(-cum), elast = __expf(tk.c63[q] - cum);
            At[t * RW_LD + j] = f2bf(-tk.kk[q][r] * __expf(cum - tk.lw[q][r]));
            Bt[t * RW_LD + j] = f2bf(b * einv);
            Kt[t * RW_LD + j] = f2bf(tk.kp[q][r] * einv);
            Kh[t * RW_LD + j] = f2bf(tk.kp[q][r] * elast);
            bh[t * 64 + j] = f2bf(b * elast);
        }
        if (tt == 0 && g == 0) F_RDV[((size_t)c * 4 + h) * 64 + j] = __expf(tk.c63[q]);
    }
    LDS_BARRIER();
    if (jh == 0) {
#pragma unroll
        for (int st = 0; st < 4; ++st) if (st <= tt) {
            f32x4 acc = (f32x4){0.f, 0.f, 0.f, 0.f};
#pragma unroll
            for (int ks = 0; ks < 2; ++ks) acc = mma16(frag_nat(At, RW_LD, 16 * tt, 32 * ks, i16, g), frag_nat(Bt, RW_LD, 16 * st, 32 * ks, i16, g), acc);
#pragma unroll
            for (int r = 0; r < 4; ++r) { const int t = 16 * tt + 4 * g + r, s = 16 * st + i16; Lm[t * 68 + s] = (s < t) ? acc[r] : 0.f; }
        }
    }
    {
        f32x4 AK[4];
#pragma unroll
        for (int st = 0; st < 4; ++st) {
            f32x4 acc = (f32x4){0.f, 0.f, 0.f, 0.f};
            if (st <= tt) {
#pragma unroll
                for (int ks = 0; ks < 2; ++ks) acc = mma16(frag_nat(Kt, RW_LD, 16 * st, 32 * ks, i16, g), frag_nat(At, RW_LD, 16 * tt, 32 * ks, i16, g), acc);
#pragma unroll
                for (int r = 0; r < 4; ++r) { const int s = 16 * st + 4 * g + r, t = 16 * tt + i16; if (!(s < t)) acc[r] = 0.f; }
            }
            AK[st] = acc;
        }
#pragma unroll
        for (int q = 0; q < 2; ++q) {
            const int vt = 2 * jh + q;
            f32x4 acc = (f32x4){0.f, 0.f, 0.f, 0.f};
#pragma unroll
            for (int cs = 0; cs < 2; ++cs) if (2 * cs <= tt) acc = mma16(acc_frag(AK[2 * cs], AK[2 * cs + 1]), frag_tr_sig(Vt, RW_LD, 32 * cs, 16 * vt, i16, g), acc);
#pragma unroll
            for (int r = 0; r < 4; ++r) Pm[(16 * tt + 4 * g + r) * 68 + 16 * vt + i16] = acc[r];
            f32x4 kv = (f32x4){0.f, 0.f, 0.f, 0.f};
#pragma unroll
            for (int cs = 0; cs < 2; ++cs) kv = mma16(frag_tr_nat(Kh, RW_LD, 32 * cs, 16 * tt, i16, g), frag_tr_nat(Vt, RW_LD, 32 * cs, 16 * vt, i16, g), kv);
            *(u32x2*)(F_RKV + ((((size_t)c * 4 + h) * 64) + 16 * vt + i16) * 64 + 16 * tt + 4 * g) = pack4(kv);
        }
    }
    LDS_BARRIER();
    if (w < 2) {
        float x[64];
        const float ef = (float)w;
        const LAS float* Lo = opaque_lds(Lm); const LAS float* Po = opaque_lds(Pm + lane); const LAS bf16_t* Ao = opaque_lds(At + lane);
        tri_solve64<68, 1>(Lo, x, [&](int i) { return Po[i * 68] * (1.f - ef) + bf2f(Ao[i * RW_LD]) * ef; });
        if (w == 0) {
            bf16_t* o = F_RU + ((((size_t)c * 4 + h) * 64) + lane) * 64;
#pragma unroll
            for (int q = 0; q < 8; ++q) { float y[8];
#pragma unroll
                for (int i = 0; i < 8; ++i) y[i] = x[8 * q + i];
                *(u32x4*)(o + 8 * q) = pack8(y); }
        } else {
            bf16_t* o = F_RWA + (((size_t)c * 4 + h) * 64) * 64 + lane;
#pragma unroll
            for (int i = 0; i < 64; ++i) o[i * 64] = f2bf(x[i]);
        }
    }
    publish_item((unsigned*)(F.ws + WS_CTL) + CW_RFLAG + 4 * c + h);
    LDS_BARRIER();
}
constexpr int RWS_BUF = 4 * 64 * GDN_LD * 2 + 256;
__device__ __forceinline__ void scan_rwkv2(Frame& F, int l, int s, int h, int vb, int ncw, unsigned* prog, unsigned pbase, unsigned* done, int pm, const unsigned* rdy, int rstride, unsigned rneed) {
    PHASE_IDS(F);
    const int tid = F.tid, lane = F.lane, w = F.wave, i16 = lane & 15, g = lane >> 4;
    const int nch = (s == 0) ? 256 : 1, c0 = (s == 0) ? 0 : 255 + s, b = s - 1;
    const bf16_t* const rwa = F_RWA; bf16_t* const ru = F_RU; const bf16_t* const rbh = F_RBH; const bf16_t* const rkv = F_RKV; const float* const rdv = F_RDV;
    {
        if (w == (ncw < 4 ? ncw : 0)) (void)rdy_block(F, rdy, rstride, rneed, 0, nch < RDY_SLACK ? nch : RDY_SLACK, nch);
        LDS_BARRIER();
    }
    if (w >= 4) {
        const int lt = tid - 256;
        const int umask = 128 * ncw - 1;
        u32x4 r10[2], r20[2], r30[2], r40[2], r11[2], r21[2], r31[2], r41[2], r12[2], r22[2], r32[2], r42[2], r13[2], r23[2], r33[2], r43[2], r14[2], r24[2], r34[2], r44[2], r15[2], r25[2], r35[2], r45[2]; float dv0 = 0.f, dv1 = 0.f, dv2 = 0.f, dv3 = 0.f, dv4 = 0.f, dv5 = 0.f;
        const bf16_t* p1[2]; const bf16_t* p2[2]; const bf16_t* p3[2]; const bf16_t* p4[2]; const float* const pDv = rdv + h * 64 + (lt & 63);
#pragma unroll
        for (int q = 0; q < 2; ++q) { const int idx = q * 256 + lt, off = (idx >> 3) * 64 + (idx & 7) * 8, uoff = (vb + ((idx & umask) >> 3)) * 64 + (idx & 7) * 8;
            p1[q] = rwa + (size_t)h * 4096 + off; p2[q] = ru + (size_t)h * 4096 + uoff; p3[q] = rbh + (size_t)h * 4096 + off; p4[q] = rkv + (size_t)h * 4096 + uoff; }
#define RWS_LOAD(ch, S) do { const size_t o_ = (size_t)(ch) * (4 * 4096); dv##S = ld4_asm(pDv + (size_t)(ch) * 256); \
        _Pragma("unroll") for (int q = 0; q < 2; ++q) { r1##S[q] = ld16_asm(p1[q] + o_); r2##S[q] = ld16_asm(p2[q] + o_); r3##S[q] = ld16_asm(p3[q] + o_); r4##S[q] = ld16_asm(p4[q] + o_); } } while (0)
#define RWS_WAIT(S, N) asm volatile("s_waitcnt vmcnt(%9)" : "+v"(r1##S[0]), "+v"(r1##S[1]), "+v"(r2##S[0]), "+v"(r2##S[1]), "+v"(r3##S[0]), "+v"(r3##S[1]), "+v"(r4##S[0]), "+v"(r4##S[1]), "+v"(dv##S) : "n"(N))
#define RWS_WRITE(bb, S) do { LAS bf16_t* Wn_ = (LAS bf16_t*)(F.lds + (bb) * RWS_BUF); \
        _Pragma("unroll") for (int q = 0; q < 2; ++q) { const int idx = q * 256 + lt, off = (idx >> 3) * GDN_LD + (idx & 7) * 8, uoff = (vb + ((idx & umask) >> 3)) * GDN_LD + (idx & 7) * 8; \
            *(LAS u32x4*)(Wn_ + off) = r1##S[q]; *(LAS u32x4*)(Wn_ + 64 * GDN_LD + uoff) = r2##S[q]; *(LAS u32x4*)(Wn_ + 2 * 64 * GDN_LD + off) = r3##S[q]; *(LAS u32x4*)(Wn_ + 3 * 64 * GDN_LD + uoff) = r4##S[q]; } \
        if (lt < 64) ((LAS float*)(Wn_ + 4 * 64 * GDN_LD))[lt] = dv##S; } while (0)
        SCAN_LOADER6(RWS_LOAD, RWS_WRITE, RWS_WAIT, 9);
#undef RWS_LOAD
#undef RWS_WRITE
#undef RWS_WAIT
    } else if (w >= ncw) {
        int nxt = nch < RDY_SLACK ? nch : RDY_SLACK;
        LDS_BARRIER();
        for (int ci = 0; ci < nch; ++ci) {
            if (w == ncw && nxt < nch) { const int upto = ci + 1 + RDY_SLACK < nch ? ci + 1 + RDY_SLACK : nch; nxt = rdy_block(F, rdy, rstride, rneed, nxt, upto, nch); }
            LDS_BARRIER();
        }
    } else {
        const int n0 = vb + 16 * w;
        f32x4 S[4];
        if (s == 0) {
#pragma unroll
            for (int kt = 0; kt < 4; ++kt) S[kt] = (f32x4){0.f, 0.f, 0.f, 0.f};
        } else {
            const float* st = INP(I_SRWKV) + (((size_t)l * 32 + b) * 4 + h) * 4096 + (n0 + i16) * 64 + 4 * g;
#pragma unroll
            for (int kt = 0; kt < 4; ++kt) S[kt] = *(const f32x4*)(st + 16 * kt);
        }
        LDS_BARRIER();
        for (int ci = 0; ci < nch; ++ci) {
            const size_t b0 = (((size_t)(c0 + ci)) * 4 + h) * 4096;
            const LAS bf16_t* Wn = (const LAS bf16_t*)(F.lds + (ci & 1) * RWS_BUF); const LAS bf16_t* Ut = Wn + 64 * GDN_LD; const LAS bf16_t* Bh = Ut + 64 * GDN_LD; const LAS bf16_t* KVt = Bh + 64 * GDN_LD;
            const LAS float* dvec = (const LAS float*)(KVt + 64 * GDN_LD);
            bf16x8 A1[4][2], A2[4][2]; u32x2 ui[4], kvi[4]; f32x4 dq[4];
#pragma unroll
            for (int m = 0; m < 4; ++m) { ui[m] = *(const LAS u32x2*)(Ut + (n0 + i16) * GDN_LD + 16 * m + 4 * g);
#pragma unroll
                for (int ks = 0; ks < 2; ++ks) A1[m][ks] = frag_sig(Wn, GDN_LD, 16 * m, 32 * ks, i16, g); }
#pragma unroll
            for (int kt = 0; kt < 4; ++kt) { kvi[kt] = *(const LAS u32x2*)(KVt + (n0 + i16) * GDN_LD + 16 * kt + 4 * g); dq[kt] = *(const LAS f32x4*)(dvec + 16 * kt + 4 * g);
#pragma unroll
                for (int cs = 0; cs < 2; ++cs) A2[kt][cs] = frag_tr_sig(Bh, GDN_LD, 32 * cs, 16 * kt, i16, g); }
            __builtin_amdgcn_sched_barrier(0);
            bf16x8 Sb[2];
#pragma unroll
            for (int ks = 0; ks < 2; ++ks) Sb[ks] = acc_frag(S[2 * ks], S[2 * ks + 1]);
            {
                bf16_t* ho = F_RKV + b0 + (n0 + i16) * 64 + 4 * g;
#pragma unroll
                for (int kt = 0; kt < 4; ++kt) st8_wt(ho + 16 * kt, pack4(S[kt]));
            }
            f32x4 V[4];
            bf16_t* vo = ru + b0 + (n0 + i16) * 64 + 4 * g;
#pragma unroll
            for (int m = 0; m < 4; ++m) {
                f32x4 acc = unpack4(ui[m]);
#pragma unroll
                for (int ks = 0; ks < 2; ++ks) acc = mma16(A1[m][ks], Sb[ks], acc);
                V[m] = acc;
            }
#pragma unroll
            for (int m = 0; m < 4; ++m) st8_wt(vo + 16 * m, pack4(V[m]));
            bf16x8 Ub[2];
#pragma unroll
            for (int cs = 0; cs < 2; ++cs) Ub[cs] = acc_frag(V[2 * cs], V[2 * cs + 1]);
#pragma unroll
            for (int kt = 0; kt < 4; ++kt) {
                f32x4 acc = S[kt] * dq[kt] + unpack4(kvi[kt]);
#pragma unroll
                for (int cs = 0; cs < 2; ++cs) acc = mma16(A2[kt][cs], Ub[cs], acc);
                S[kt] = acc;
            }
            if (prog) {
                asm volatile("s_waitcnt vmcnt(48)" ::: "memory");
                if (lane == 0 && ci >= 6) __hip_atomic_store(prog + 64 * w, pbase + (unsigned)(ci - 6) + 1u, __ATOMIC_RELAXED, __HIP_MEMORY_SCOPE_AGENT);
            }
            LDS_BARRIER();
        }
        asm volatile("s_waitcnt vmcnt(0)" ::: "memory");
        if (prog && lane == 0) __hip_atomic_store(prog + 64 * w, pbase + (unsigned)nch, __ATOMIC_RELAXED, __HIP_MEMORY_SCOPE_AGENT);
        if (done && lane == 0) __hip_atomic_fetch_add(done, 1u, __ATOMIC_RELAXED, __HIP_MEMORY_SCOPE_AGENT);
        float* o = F.out + (s == 0 ? O_P_RWKV + ((size_t)l * 4 + h) * 4096 : O_S_RWKV + (((size_t)l * 32 + b) * 4 + h) * 4096) + (n0 + i16) * 64 + 4 * g;
#pragma unroll
        for (int kt = 0; kt < 4; ++kt) *(f32x4*)(o + 16 * kt) = S[kt];
    }
}
__device__ __forceinline__ void post_rwkv(Frame& F, int l, int c, int h) {
    PHASE_IDS(F);
    const int tid = F.tid, lane = F.lane, w = F.wave, i16 = lane & 15, g = lane >> 4, tt = w & 3, jh = w >> 2;
    const size_t row0 = (size_t)c * 64;
    RwkvTok tk; f32x4 Zg[2];
    rwkv_tokens<true>(F, l, c, h, tk, Zg);
    LAS bf16_t* Rd = (LAS bf16_t*)(F.lds + RW_XD); LAS bf16_t* Bt = (LAS bf16_t*)(F.lds + RW_XA); LAS bf16_t* Kt = (LAS bf16_t*)(F.lds + RW_WD); LAS bf16_t* Utl = (LAS bf16_t*)(F.lds + RW_WA);
    LAS bf16_t* Rt = (LAS bf16_t*)(F.lds + RW_RT); LAS bf16_t* Htl = (LAS bf16_t*)(F.lds + RW_KX); LAS bf16_t* Vt = (LAS bf16_t*)(F.lds + RW_VT);
    LAS float* ex = (LAS float*)(F.lds + RW_EX) + 512;
    float rr[2][4];
#pragma unroll
    for (int q = 0; q < 2; ++q)
#pragma unroll
        for (int r = 0; r < 4; ++r) rr[q][r] = bf2f(Rt[(16 * tt + 4 * g + r) * RW_LD + 16 * (2 * jh + q) + i16]);
    LDS_BARRIER();
#pragma unroll
    for (int q = 0; q < 2; ++q) {
        const int j = 16 * (2 * jh + q) + i16;
#pragma unroll
        for (int r = 0; r < 4; ++r) {
            const int t = 16 * tt + 4 * g + r;
            const float cum = tk.cum[q][r], einv = __expf(-cum);
            Rd[t * RW_LD + j] = f2bf(rr[q][r] * __expf(cum));
            Bt[t * RW_LD + j] = f2bf(tk.kk[q][r] * tk.iclr[q][r] * einv);
            Kt[t * RW_LD + j] = f2bf(tk.kp[q][r] * einv);
        }
    }
    {
        const int row = tid >> 3, col8 = (tid & 7) * 8; const size_t b0 = (((size_t)c * 4 + h) * 64 + row) * 64 + col8;
        *(LAS u32x4*)(Utl + row * RW_LD + col8) = *(const u32x4*)(F_RU + b0);
        *(LAS u32x4*)(Htl + row * RW_LD + col8) = *(const u32x4*)(F_RKV + b0);
    }
    LDS_BARRIER();
    f32x4 QB[4], QK[4];
#pragma unroll
    for (int st = 0; st < 4; ++st) {
        f32x4 a = (f32x4){0.f, 0.f, 0.f, 0.f}, bq = a;
        if (st <= tt) {
#pragma unroll
            for (int ks = 0; ks < 2; ++ks) {
                const bf16x8 rf = frag_nat(Rd, RW_LD, 16 * tt, 32 * ks, i16, g);
                a = mma16(frag_nat(Bt, RW_LD, 16 * st, 32 * ks, i16, g), rf, a);
                bq = mma16(frag_nat(Kt, RW_LD, 16 * st, 32 * ks, i16, g), rf, bq);
            }
#pragma unroll
            for (int r = 0; r < 4; ++r) { const int s = 16 * st + 4 * g + r, t = 16 * tt + i16; if (!(s <= t)) { a[r] = 0.f; bq[r] = 0.f; } }
        }
        QB[st] = a; QK[st] = bq;
    }
    f32x4 Y[2]; float s1[4] = {0.f, 0.f, 0.f, 0.f}, s2[4] = {0.f, 0.f, 0.f, 0.f}, bon[4] = {0.f, 0.f, 0.f, 0.f};
#pragma unroll
    for (int q = 0; q < 2; ++q) {
        const int vt = 2 * jh + q;
        f32x4 acc = (f32x4){0.f, 0.f, 0.f, 0.f};
#pragma unroll
        for (int ks = 0; ks < 2; ++ks) acc = mma16(frag_nat(Rd, RW_LD, 16 * tt, 32 * ks, i16, g), frag_nat(Htl, RW_LD, 16 * vt, 32 * ks, i16, g), acc);
#pragma unroll
        for (int cs = 0; cs < 2; ++cs) if (2 * cs <= tt) {
            acc = mma16(acc_frag(QB[2 * cs], QB[2 * cs + 1]), frag_sig(Utl, RW_LD, 16 * vt, 32 * cs, i16, g), acc);
            acc = mma16(acc_frag(QK[2 * cs], QK[2 * cs + 1]), frag_tr_sig(Vt, RW_LD, 32 * cs, 16 * vt, i16, g), acc);
        }
        Y[q] = acc;
        const float rkw = INP(I_RRK)[l * 256 + h * 64 + 16 * vt + i16];
#pragma unroll
        for (int r = 0; r < 4; ++r) { s1[r] += acc[r]; s2[r] += acc[r] * acc[r]; bon[r] += rr[q][r] * tk.kp[q][r] * rkw; }
    }
#pragma unroll
    for (int r = 0; r < 4; ++r) {
        float a = s1[r], bq = s2[r], cq = bon[r];
#pragma unroll
        for (int o = 1; o < 16; o <<= 1) { a += __shfl_xor(a, o); bq += __shfl_xor(bq, o); cq += __shfl_xor(cq, o); }
        if (i16 == 0) { const int t = 16 * tt + 4 * g + r; ex[(0 * 2 + jh) * 64 + t] = a; ex[(1 * 2 + jh) * 64 + t] = bq; ex[(2 * 2 + jh) * 64 + t] = cq; }
    }
    LDS_BARRIER();
    bf16_t* const proj = F_PROJ;
#pragma unroll
    for (int q = 0; q < 2; ++q) {
        const int v = 16 * (2 * jh + q) + i16, vc = l * 256 + h * 64 + v;
        const float lnw = INP(I_RLNW)[vc], lnb = INP(I_RLNB)[vc];
#pragma unroll
        for (int r = 0; r < 4; ++r) {
            const int t = 16 * tt + 4 * g + r;
            const float mean = (ex[t] + ex[64 + t]) * (1.f / 64.f);
            const float var = fmaxf((ex[128 + t] + ex[192 + t]) * (1.f / 64.f) - mean * mean, 0.f);
            const float bonus = (ex[256 + t] + ex[320 + t]) * bf2f(Vt[t * RW_LD + v]);
            const float yn = (Y[q][r] - mean) * rsqrtf(var + 64e-5f) * lnw + lnb;
            proj[(row0 + t) * PW + PC_R + h * 64 + v] = f2bf((yn + bonus) * Zg[q][r]);
        }
    }
    LDS_BARRIER();
}

constexpr int SSD_LDC = 136, SSD_LDX = 72;
constexpr int SSD_BUF = 64 * SSD_LDC * 2 * 2 + 64 * SSD_LDX * 2 + 64;
__device__ __forceinline__ void scan_ssd2(Frame& F, int l, int s, int hd, int vb, int ncw, unsigned* prog, unsigned pbase, unsigned* done, int pm, const unsigned* rdy, int rstride, unsigned rneed) {
    PHASE_IDS(F);
    const int tid = F.tid, lane = F.lane, w = F.wave, i16 = lane & 15, g = lane >> 4;
    const int nch = (s == 0) ? 256 : 1, c0 = (s == 0) ? 0 : 255 + s, b = s - 1, grp = hd >> 2;
    const bf16_t* const proj = F_PROJ; const float* const scal = F_SCAL; const float* const acum = F_ACUM;
    {
        if (w == (ncw < 4 ? ncw : 0)) (void)rdy_block(F, rdy, rstride, rneed, 0, nch < RDY_SLACK ? nch : RDY_SLACK, nch);
        LDS_BARRIER();
    }
    if (w >= 4) {
        const int lt = tid - 256;
        const int umask = 128 * ncw - 1, xsh = (ncw == 4) ? 3 : (ncw == 2 ? 2 : 1);
        u32x4 rc0[4], rb0[4], rx0[2], rc1[4], rb1[4], rx1[2], rc2[4], rb2[4], rx2[2], rc3[4], rb3[4], rx3[2]; float dt0[2], ac0[2], al0, dt1[2], ac1[2], al1, dt2[2], ac2[2], al2, dt3[2], ac3[2], al3;
        const bf16_t* pC[4]; const bf16_t* pB[4]; const bf16_t* pX[2]; const float* pDt[2]; const float* pAc[2]; const float* const pAl = acum + 63 * 8 + hd;
#pragma unroll
        for (int q = 0; q < 4; ++q) { const int idx = q * 256 + lt, row = idx >> 4, col8 = (idx & 15) * 8;
            pC[q] = proj + (size_t)row * PW + PC_SC + grp * 128 + col8; pB[q] = proj + (size_t)row * PW + PC_SB + grp * 128 + col8; }
#pragma unroll
        for (int q = 0; q < 2; ++q) { const int idx = (q * 256 + lt) & umask, row = idx >> xsh, col8 = vb + (idx & ((1 << xsh) - 1)) * 8;
            pX[q] = proj + (size_t)row * PW + PC_SX + hd * 64 + col8; pDt[q] = scal + row * 16 + 8 + hd; pAc[q] = acum + row * 8 + hd; }
#define SSD_LOAD(ch, S) do { const size_t oP_ = (size_t)(ch) * (64 * PW), oS_ = (size_t)(ch) * 1024, oA_ = (size_t)(ch) * 512; al##S = ld4_asm(pAl + oA_); \
        _Pragma("unroll") for (int q = 0; q < 4; ++q) { rc##S[q] = ld16_asm(pC[q] + oP_); rb##S[q] = ld16_asm(pB[q] + oP_); } \
        _Pragma("unroll") for (int q = 0; q < 2; ++q) { rx##S[q] = ld16_asm(pX[q] + oP_); dt##S[q] = ld4_asm(pDt[q] + oS_); ac##S[q] = ld4_asm(pAc[q] + oA_); } } while (0)
#define SSD_WAIT(S, N) asm volatile("s_waitcnt vmcnt(%15)" : "+v"(rc##S[0]), "+v"(rc##S[1]), "+v"(rc##S[2]), "+v"(rc##S[3]), "+v"(rb##S[0]), "+v"(rb##S[1]), "+v"(rb##S[2]), "+v"(rb##S[3]), \
        "+v"(rx##S[0]), "+v"(rx##S[1]), "+v"(dt##S[0]), "+v"(dt##S[1]), "+v"(ac##S[0]), "+v"(ac##S[1]), "+v"(al##S) : "n"(N))
#define SSD_WRITE(bb, S) do { LAS bf16_t* Ct_ = (LAS bf16_t*)(F.lds + (bb) * SSD_BUF); LAS bf16_t* Bt_ = Ct_ + 64 * SSD_LDC; LAS bf16_t* Xt_ = Bt_ + 64 * SSD_LDC; \
        _Pragma("unroll") for (int q = 0; q < 4; ++q) { const int idx = q * 256 + lt, row = idx >> 4, col8 = (idx & 15) * 8; \
            *(LAS u32x4*)(Ct_ + row * SSD_LDC + col8) = rc##S[q]; *(LAS u32x4*)(Bt_ + row * SSD_LDC + col8) = rb##S[q]; } \
        _Pragma("unroll") for (int q = 0; q < 2; ++q) { const int idx = (q * 256 + lt) & umask, row = idx >> xsh, col8 = vb + (idx & ((1 << xsh) - 1)) * 8; float v_[8]; unpack8(rx##S[q], v_); \
            const float sx_ = dt##S[q] * __expf(al##S - ac##S[q]); \
            _Pragma("unroll") for (int i = 0; i < 8; ++i) v_[i] *= sx_; *(LAS u32x4*)(Xt_ + row * SSD_LDX + col8) = pack8(v_); } \
        if (lt == 0) *(LAS float*)(Xt_ + 64 * SSD_LDX) = __expf(al##S); } while (0)
        SCAN_LOADER(SSD_LOAD, SSD_WRITE, SSD_WAIT, 15);
#undef SSD_LOAD
#undef SSD_WRITE
#undef SSD_WAIT
    } else if (w >= ncw) {
        int nxt = nch < RDY_SLACK ? nch : RDY_SLACK;
        LDS_BARRIER();
        for (int ci = 0; ci < nch; ++ci) {
            if (w == ncw && nxt < nch) { const int upto = ci + 1 + RDY_SLACK < nch ? ci + 1 + RDY_SLACK : nch; nxt = rdy_block(F, rdy, rstride, rneed, nxt, upto, nch); }
            LDS_BARRIER();
        }
    } else {
        const int n0 = vb + 16 * w, head = hd;
        f32x4 H[8];
        if (s == 0) {
#pragma unroll
            for (int nt = 0; nt < 8; ++nt) H[nt] = (f32x4){0.f, 0.f, 0.f, 0.f};
        } else {
            const float* st = INP(I_SSSM) + ((((size_t)l * 32 + b) * 8 + head) * 64 + n0 + i16) * 128 + 4 * g;
#pragma unroll
            for (int nt = 0; nt < 8; ++nt) H[nt] = *(const f32x4*)(st + 16 * nt);
        }
        bf16_t* const yoff = F_YOFF;
        LDS_BARRIER();
        for (int ci = 0; ci < nch; ++ci) {
            const LAS bf16_t* Ct = (const LAS bf16_t*)(F.lds + (ci & 1) * SSD_BUF); const LAS bf16_t* Bt = Ct + 64 * SSD_LDC; const LAS bf16_t* Xt = Bt + 64 * SSD_LDC;
            const float cd = *(const LAS float*)(Xt + 64 * SSD_LDX);
            bf16x8 A1[4][4], A2[8][2], Xb[2];
#pragma unroll
            for (int m = 0; m < 4; ++m)
#pragma unroll
                for (int ks = 0; ks < 4; ++ks) A1[m][ks] = frag_sig(Ct, SSD_LDC, 16 * m, 32 * ks, i16, g);
#pragma unroll
            for (int cs = 0; cs < 2; ++cs) Xb[cs] = frag_tr_nat(Xt, SSD_LDX, 32 * cs, n0, i16, g);
#pragma unroll
            for (int nt = 0; nt < 8; ++nt)
#pragma unroll
                for (int cs = 0; cs < 2; ++cs) A2[nt][cs] = frag_tr_nat(Bt, SSD_LDC, 32 * cs, 16 * nt, i16, g);
            __builtin_amdgcn_sched_barrier(0);
            bf16x8 Hb[4];
#pragma unroll
            for (int ks = 0; ks < 4; ++ks) Hb[ks] = acc_frag(H[2 * ks], H[2 * ks + 1]);
            bf16_t* yo = yoff + (((size_t)(c0 + ci) * 8 + head) * 64 + n0 + i16) * 64 + 4 * g;
            f32x4 Yv[4];
#pragma unroll
            for (int m = 0; m < 4; ++m) {
                f32x4 acc = (f32x4){0.f, 0.f, 0.f, 0.f};
#pragma unroll
                for (int ks = 0; ks < 4; ++ks) acc = mma16(A1[m][ks], Hb[ks], acc);
                Yv[m] = acc;
            }
#pragma unroll
            for (int nt = 0; nt < 8; ++nt) {
                f32x4 acc = H[nt] * cd;
#pragma unroll
                for (int cs = 0; cs < 2; ++cs) acc = mma16(A2[nt][cs], Xb[cs], acc);
                H[nt] = acc;
            }
#pragma unroll
            for (int m = 0; m < 4; ++m) st8_wt(yo + 16 * m, pack4(Yv[m]));
            if (prog) {
                asm volatile("s_waitcnt vmcnt(24)" ::: "memory");
                if (lane == 0 && ci >= 6) __hip_atomic_store(prog + 64 * w, pbase + (unsigned)(ci - 6) + 1u, __ATOMIC_RELAXED, __HIP_MEMORY_SCOPE_AGENT);
            }
            LDS_BARRIER();
        }
        asm volatile("s_waitcnt vmcnt(0)" ::: "memory");
        if (prog && lane == 0) __hip_atomic_store(prog + 64 * w, pbase + (unsigned)nch, __ATOMIC_RELAXED, __HIP_MEMORY_SCOPE_AGENT);
        if (done && lane == 0) __hip_atomic_fetch_add(done, 1u, __ATOMIC_RELAXED, __HIP_MEMORY_SCOPE_AGENT);
        float* o = F.out + (s == 0 ? O_P_SSM + (((size_t)l * 8 + head) * 64 + n0 + i16) * 128 : O_S_SSM + ((((size_t)l * 32 + b) * 8 + head) * 64 + n0 + i16) * 128) + 4 * g;
#pragma unroll
        for (int nt = 0; nt < 8; ++nt) *(f32x4*)(o + 16 * nt) = H[nt];
    }
}
__device__ __forceinline__ void post_ssd(Frame& F, int l, int c, int grp) {
    PHASE_IDS(F);
    const int tid = F.tid, lane = F.lane, w = F.wave, i16 = lane & 15, g = lane >> 4;
    const size_t row0 = (size_t)c * 64;
    bf16_t* const proj = F_PROJ;
    LAS bf16_t* Ct = (LAS bf16_t*)F.lds; LAS bf16_t* Bt = Ct + 64 * SSD_LDC; LAS bf16_t* Xt = Bt + 64 * SSD_LDC;
    LAS float* acs = (LAS float*)(Xt + 4 * 64 * SSD_LDX); LAS float* dts = acs + 256; LAS float* ssn = dts + 256;
    {
#pragma unroll
        for (int q = 0; q < 2; ++q) { const int idx = q * 512 + tid, row = idx >> 4, col8 = (idx & 15) * 8;
            *(LAS u32x4*)(Ct + row * SSD_LDC + col8) = *(const u32x4*)(proj + (row0 + row) * PW + PC_SC + grp * 128 + col8);
            *(LAS u32x4*)(Bt + row * SSD_LDC + col8) = *(const u32x4*)(proj + (row0 + row) * PW + PC_SB + grp * 128 + col8); }
#pragma unroll
        for (int q = 0; q < 4; ++q) { const int idx = q * 512 + tid, row = idx >> 5, col8 = (idx & 31) * 8, hh = col8 >> 6, cc = col8 & 63;
            *(LAS u32x4*)(Xt + hh * 64 * SSD_LDX + row * SSD_LDX + cc) = *(const u32x4*)(proj + (row0 + row) * PW + PC_SX + grp * 256 + col8); }
        if (tid < 256) { const int hh = tid >> 6, t = tid & 63; acs[tid] = F_ACUM[(row0 + t) * 8 + grp * 4 + hh]; dts[tid] = F_SCAL[(row0 + t) * 16 + 8 + grp * 4 + hh]; }
    }
    LDS_BARRIER();
    const int hh = w & 3, lh = w >> 2, hd = grp * 4 + hh;
    const LAS bf16_t* Xh = Xt + hh * 64 * SSD_LDX;
    const float Dh = INP(I_SD)[l * 8 + hd];
    float ssrow[2][4];
    f32x4 Y[2][4];
#pragma unroll
    for (int li = 0; li < 2; ++li) {
        const int ltile = 2 * lh + li;
        f32x4 ST[4];
#pragma unroll
        for (int st = 0; st < 4; ++st) {
            f32x4 acc = (f32x4){0.f, 0.f, 0.f, 0.f};
            if (st <= ltile) {
#pragma unroll
                for (int ks = 0; ks < 4; ++ks) acc = mma16(frag_nat(Bt, SSD_LDC, 16 * st, 32 * ks, i16, g), frag_nat(Ct, SSD_LDC, 16 * ltile, 32 * ks, i16, g), acc);
                const int lcol = 16 * ltile + i16; const float acl = acs[hh * 64 + lcol];
#pragma unroll
                for (int r = 0; r < 4; ++r) { const int srow = 16 * st + 4 * g + r; const float f = (srow <= lcol) ? __expf(fminf(acl - acs[hh * 64 + srow], 0.f)) * dts[hh * 64 + srow] : 0.f; acc[r] *= f; }
            }
            ST[st] = acc;
        }
#pragma unroll
        for (int pt = 0; pt < 4; ++pt) {
            f32x4 acc = (f32x4){0.f, 0.f, 0.f, 0.f};
#pragma unroll
            for (int cs = 0; cs < 2; ++cs) if (2 * cs <= ltile) acc = mma16(acc_frag(ST[2 * cs], ST[2 * cs + 1]), frag_tr_sig(Xh, SSD_LDX, 32 * cs, 16 * pt, i16, g), acc);
            const int p = 16 * pt + i16, lr0 = 16 * ltile + 4 * g;
            const f32x4 yo = unpack4(*(const u32x2*)(F_YOFF + (((size_t)c * 8 + hd) * 64 + p) * 64 + lr0));
#pragma unroll
            for (int r = 0; r < 4; ++r) {
                const int lrow = lr0 + r;
                const float x = bf2f(Xh[lrow * SSD_LDX + p]);
                const float z = bf2f(proj[(row0 + lrow) * PW + PC_ZS + hd * 64 + p]);
                acc[r] = (acc[r] + __expf(acs[hh * 64 + lrow]) * yo[r] + Dh * x) * siluf_(z);
            }
            Y[li][pt] = acc;
        }
#pragma unroll
        for (int r = 0; r < 4; ++r) { float ss = 0.f;
#pragma unroll
            for (int pt = 0; pt < 4; ++pt) ss += Y[li][pt][r] * Y[li][pt][r];
            ss += __shfl_xor(ss, 1); ss += __shfl_xor(ss, 2); ss += __shfl_xor(ss, 4); ss += __shfl_xor(ss, 8);
            ssrow[li][r] = ss; }
        if (i16 == 0) {
#pragma unroll
            for (int r = 0; r < 4; ++r) ssn[(16 * ltile + 4 * g + r) * 4 + hh] = ssrow[li][r];
        }
    }
    LDS_BARRIER();
#pragma unroll
    for (int li = 0; li < 2; ++li) {
        const int ltile = 2 * lh + li;
#pragma unroll
        for (int r = 0; r < 4; ++r) {
            const int lrow = 16 * ltile + 4 * g + r;
            const f32x4 sv = *(const LAS f32x4*)(ssn + lrow * 4);
            const float sc = rsqrtf(((sv[0] + sv[1]) + (sv[2] + sv[3])) * (1.f / 256.f) + EPS);
#pragma unroll
            for (int pt = 0; pt < 4; ++pt) { const int p = 16 * pt + i16;
                proj[(row0 + lrow) * PW + PC_ZS + hd * 64 + p] = f2bf(Y[li][pt][r] * sc * INP(I_SNORMW)[l * 512 + hd * 64 + p]); }
        }
    }
    LDS_BARRIER();
}

constexpr int NSL = 2;
constexpr int CW_PROG = 8192;
constexpr int CW_SDONE = 8192 + 64 * 64;
__device__ __forceinline__ void post_wait(Frame& F, int c, int q, unsigned pbase, unsigned sneed) {
    if (F.wave == 0) {
        unsigned* const ctl = (unsigned*)(F.ws + WS_CTL);
        const int lane = F.lane;
        unsigned* wp; unsigned need; bool act;
        if (c >= 256) { wp = ctl + CW_SDONE + 64 * (c - 256); need = sneed; act = lane == 0; }
        else {
            int gq0, ng;
            if (q < 2) { gq0 = 8 + 4 * q; ng = 4; } else if (q < 4) { gq0 = 2 * (q - 2); ng = 2; } else { gq0 = 4 + (q - 4); ng = 1; }
            act = lane < 4 * ng; wp = ctl + CW_PROG + 64 * (4 * gq0 + (act ? lane : 0)); need = pbase + (unsigned)c + 1u;
        }
        unsigned sp = 0;
        for (;;) { const bool ok = !act || (int)(xb_ld(wp) - need) >= 0; if (__all(ok) || ++sp > 2000000u) break; __builtin_amdgcn_s_sleep(4); }
        __builtin_amdgcn_fence(__ATOMIC_ACQUIRE, "agent");
        asm volatile("s_waitcnt vmcnt(0)" ::: "memory");
    }
    LDS_BARRIER();
}
__device__ __forceinline__ void scan_phase(Frame& F, int l, int mode, unsigned epoch) {
    PHASE_IDS(F);
    const int xl = F.vcu >> 5, slot = F.vcu & 31;
    unsigned* const ctl = (unsigned*)(F.ws + WS_CTL);
    const unsigned pbase = 1024u * epoch, sneed = 64u * (epoch + 1u), rneed = epoch + 1u;
    if (slot >= 2 * NSL) {
        const int j = xl * (32 - 2 * NSL) + (slot - 2 * NSL);
        for (int it = j; it < NCH * 5; it += 8 * (32 - 2 * NSL)) {
            int it_ = it; asm volatile("" : "+s"(it_));
            const int c = it_ / 5, q = it_ % 5;
            if (q == 0) act_chunk(F, l, c); else prep_rwkv(F, l, c, q - 1);
        }
    }
    for (int pass = 0; pass < 3; ++pass) {
        int kind, s, h, vb, ncw; unsigned* prog = nullptr; unsigned* done = nullptr;
        if (pass == 0) {
            if (slot >= 2 * NSL) continue;
            const int gq = xl + 8 * (slot / NSL);
            kind = gq < 4 ? 0 : (gq < 8 ? 1 : 2); h = gq < 4 ? gq : (gq < 8 ? gq - 4 : gq - 8); s = 0; ncw = 4 / NSL; vb = 16 * ncw * (slot % NSL);
            prog = ctl + CW_PROG + 64 * (4 * gq + ncw * (slot % NSL));
        } else {
            const int it = F.vcu + (pass - 1) * F.G;
            if (it >= 512) continue;
            if (it < 128) { kind = 0; s = 1 + (it >> 2); h = it & 3; }
            else if (it < 256) { kind = 1; s = 1 + ((it - 128) >> 2); h = (it - 128) & 3; }
            else { kind = 2; s = 1 + ((it - 256) >> 3); h = (it - 256) & 7; }
            vb = 0; ncw = 4; done = ctl + CW_SDONE + 64 * (s - 1);
        }
        const int cfirst = (s == 0) ? 0 : 255 + s;
        if (kind == 0) scan_gdn2(F, l, s, h, vb, ncw, prog, pbase, done, mode, ctl + CW_AFLAG + cfirst, 1, rneed);
        else if (kind == 1) scan_rwkv2(F, l, s, h, vb, ncw, prog, pbase, done, mode, ctl + CW_RFLAG + 4 * cfirst + h, 4, rneed);
        else scan_ssd2(F, l, s, h, vb, ncw, prog, pbase, done, mode, ctl + CW_AFLAG + cfirst, 1, rneed);
        __syncthreads();
    }
    if (slot >= 2 * NSL) {
        const int j = xl * (32 - 2 * NSL) + (slot - 2 * NSL);
        for (int it = j; it < NCH * 8; it += 8 * (32 - 2 * NSL)) {
            int it_ = it; asm volatile("" : "+s"(it_));
            const int c = it_ >> 3, q = it_ & 7;
            post_wait(F, c, q, pbase, sneed);
            if (q < 2) post_ssd(F, l, c, q); else if (q < 4) post_gdn(F, l, c, q - 2); else post_rwkv(F, l, c, q - 4);
        }
    }
}
__device__ __forceinline__ void final_norm(Frame& F) {
    PHASE_IDS(F);
    const int gw = F.vcu * 8 + F.wave, NGW = F.G * 8;
    const float* fw = INP(I_FNORM);
    float wv[16];
#pragma unroll
    for (int i = 0; i < 16; ++i) wv[i] = fw[16 * F.lane + i];
    for (int m = gw; m < T; m += NGW) {
        float s = (F.lane < 16) ? F_SSQA[(size_t)m * 16 + F.lane] : 0.f;
        s = wave_sum(s);
        const float rs = rsqrtf(s * (1.f / 1024.f) + EPS);
        const bf16_t* xr = F_R1 + (size_t)m * DM + 16 * F.lane;
        float x[16]; { float a[8], b[8]; unpack8(*(const u32x4*)xr, a); unpack8(*(const u32x4*)(xr + 8), b);
#pragma unroll
            for (int i = 0; i < 8; ++i) { x[i] = a[i]; x[8 + i] = b[i]; } }
        f32x4* o = (f32x4*)(F.out + (size_t)m * DM + 16 * F.lane);
#pragma unroll
        for (int q = 0; q < 4; ++q) o[q] = (f32x4){x[4 * q] * rs * wv[4 * q], x[4 * q + 1] * rs * wv[4 * q + 1], x[4 * q + 2] * rs * wv[4 * q + 2], x[4 * q + 3] * rs * wv[4 * q + 3]};
    }
}

constexpr int GMT = 3;
constexpr int N_PHASES = 16;
__global__ void __launch_bounds__(512, 2) mk_fwd(Args args) {
    extern __shared__ __attribute__((aligned(16))) unsigned char lds[];
    Frame F;
    F.lds = (LAS unsigned char*)lds;
    F.tid = threadIdx.x; F.lane = F.tid & 63; F.wave = __builtin_amdgcn_readfirstlane(F.tid >> 6);
    F.G = gridDim.x; { const int bx = blockIdx.x; F.vcu = (F.G % 8 == 0) ? (bx % 8) * (F.G / 8) + bx / 8 : bx; }
    F.out = args.out; F.ws = args.ws;
    volatile LAS unsigned* MISC = (volatile LAS unsigned*)(F.lds + MISC_OFF);
    for (int u = F.tid; u < (LDS_BYTES - LDSCTL_OFF) / 4; u += 512) ((LAS unsigned*)(F.lds + LDSCTL_OFF))[u] = 0u;
    __syncthreads();
    if (F.tid == 0) {
#pragma unroll
        for (int i = 0; i < 37; ++i) ((LAS unsigned long long*)(F.lds + PTRTAB_OFF))[i] = (unsigned long long)args.in[i];
    }
    __syncthreads();
    XcdBarrier bar = xcd_barrier_post((unsigned*)(args.ws + WS_CTL) + CW_BAR, MISC + 8);
    const int ns = args.nsched; unsigned nscan = 0;
    for (int si = 0; si < ns; ++si) {
        const int pe = (int)((args.sched[si >> 2] >> (8 * (si & 3))) & 0xffu); const int p = pe & 0x7f; const bool probe = (pe & 0x80) != 0;
        if (p == 0) p0_prologue(F);
        else if (p == 15) final_norm(F);
        else {
            const int l = (p - 1) / 7, sub = (p - 1) % 7;
            if (sub == 0) {
                pg8::Gemm g{F_R1, w_in(F, l), T, PW, DM, DM}; pg8::StaticOrder S; S.init(T, PW, F.G, (int)blockIdx.x);
                pg8::EpiInProj E{F_PROJ, F_SCAL, F_SSQA, F_HCONV, F_HSHIFT, F.out, l};
                pg8::gemm_phase<pg8::EpiInProj, true>(F.lds, g, S, E);
            } else if (sub == 1) { }
            else if (sub == 2) scan_phase(F, l, 0, nscan++);
            else if (sub == 3) { }
            else if (sub == 4) {
                pg8::Gemm g{F_PROJ, w_out(F, l), T, DM, DM, PW}; pg8::StaticOrder S; S.init(T, DM, F.G, (int)blockIdx.x, 64 * GMT);
                if (l == 0) { pg8::EpiResid<true, GMT> E{INP(I_XP), INP(I_XS), F_R1, F_SSQD}; pg8::gemm_phase<pg8::EpiResid<true, GMT>, true, GMT>(F.lds, g, S, E); }
                else { pg8::EpiResid<false, GMT> E{nullptr, nullptr, F_R1, F_SSQD}; pg8::gemm_phase<pg8::EpiResid<false, GMT>, true, GMT>(F.lds, g, S, E); }
            } else if (sub == 5) {
                pg8::Gemm g{F_R1, w_gu(F, l), T, NGU, DM, DM}; pg8::StaticOrder S; S.init(T, NGU, F.G, (int)blockIdx.x);
                pg8::EpiGateUp E{F_PROJ, F_SSQD};
                pg8::gemm_phase<pg8::EpiGateUp, true>(F.lds, g, S, E);
            } else {
                pg8::Gemm g{F_PROJ, w_dn(F, l), T, DM, FF, FF}; pg8::StaticOrder S; S.init(T, DM, F.G, (int)blockIdx.x, 64 * GMT);
                pg8::EpiResid<false, GMT> E{nullptr, nullptr, F_R1, F_SSQA};
                pg8::gemm_phase<pg8::EpiResid<false, GMT>, true, GMT>(F.lds, g, S, E);
            }
        }
        if (si + 1 < ns) xcd_barrier(bar);
    }
}

extern "C" void kernel_launch(void* const* d_in, const int* in_sizes, int n_in, void* d_out, int out_size, void* d_ws, size_t ws_size, hipStream_t stream) {
    static int grid = 0;
    if (grid == 0) {
        if (n_in != 37 || out_size != (int)O_END || ws_size < 268435456) { fprintf(stderr, "kernel_launch: unexpected shapes: n_in %d out %d ws %zu\n", n_in, out_size, ws_size); grid = -1; return; }
        int dev = 0, cus = 0;
        if (hipGetDevice(&dev) != hipSuccess || hipDeviceGetAttribute(&cus, hipDeviceAttributeMultiprocessorCount, dev) != hipSuccess) { grid = -1; return; }
        if (hipFuncSetAttribute((const void*)mk_fwd, hipFuncAttributeMaxDynamicSharedMemorySize, LDS_BYTES) != hipSuccess) { fprintf(stderr, "kernel_launch: hipFuncSetAttribute failed\n"); grid = -1; return; }
        int per_cu = 0;
        if (hipOccupancyMaxActiveBlocksPerMultiprocessor(&per_cu, (const void*)mk_fwd, 512, LDS_BYTES) != hipSuccess || per_cu < 1)
            fprintf(stderr, "kernel_launch: occupancy query reports %d workgroups per CU\n", per_cu);
        (void)hipGetLastError();
        grid = cus;
    }
    if (grid < 0) return;
    (void)hipMemsetAsync((char*)d_ws + WS_CTL, 0, 65536, stream);
    Args a{};
    for (int i = 0; i < 37; ++i) a.in[i] = (const float*)d_in[i];
    a.out = (float*)d_out; a.ws = (unsigned char*)d_ws;
    {
        int n = 0; unsigned char s[32];
#ifndef PROBE_K
#define PROBE_K -1
#endif
        if (PROBE_K >= 0) { s[n++] = 0x80; for (int p = 1; p <= PROBE_K; ++p) if ((p - 1) % 7 != 3 && (p - 1) % 7 != 1) s[n++] = (unsigned char)(0x80 | p); }
        for (int p = 0; p < N_PHASES; ++p) if (p == 0 || p == 15 || ((p - 1) % 7 != 3 && (p - 1) % 7 != 1)) s[n++] = (unsigned char)p;
        for (int i = 0; i < n; ++i) a.sched[i >> 2] |= (unsigned)s[i] << (8 * (i & 3));
        a.nsched = n;
#ifndef PROBE_MODE
#define PROBE_MODE 31
#endif
        a.pmode = PROBE_MODE;
    }
    hipLaunchKernelGGL(mk_fwd, dim3(grid), dim3(512), LDS_BYTES, stream, a);
}
```

```cpp
#include <hip/hip_runtime.h>
#include <cstdio>
#include <cstdint>


#define LAS __attribute__((address_space(3)))
typedef unsigned short bf16_t;
typedef short bf16x8 __attribute__((ext_vector_type(8)));
typedef float f32x4 __attribute__((ext_vector_type(4)));
typedef float f32x2 __attribute__((ext_vector_type(2)));
typedef unsigned u32x4 __attribute__((ext_vector_type(4)));
typedef unsigned u32x2 __attribute__((ext_vector_type(2)));

constexpr int DM = 1024, TP = 16384, NB = 32, T = 18432, NCH = 288, NSEQ = 33;
constexpr int PW = 3584;
constexpr int NIN = 3840;
constexpr int FF = 2816, NGU = 5632;
constexpr float EPS = 1e-6f;
constexpr int PC_ZG = 0, PC_ZS = 256, PC_R = 768, PC_GQ = 1024, PC_GK = 1280, PC_GV = 1536, PC_SX = 1792, PC_SB = 2304, PC_SC = 2560,
              PC_RK = 2816, PC_RV = 3072, PC_RL = 3328;
constexpr size_t O_Y = 0;
constexpr size_t O_P_GDN = (size_t)T * DM;
constexpr size_t O_P_GDNC = O_P_GDN + 2 * 1 * 4 * 64 * 64;
constexpr size_t O_P_SSM = O_P_GDNC + 2 * 1 * 3 * 768;
constexpr size_t O_P_SSMC = O_P_SSM + 2 * 1 * 8 * 64 * 128;
constexpr size_t O_P_RWKV = O_P_SSMC + 2 * 1 * 3 * 1024;
constexpr size_t O_P_SHIFT = O_P_RWKV + 2 * 1 * 4 * 64 * 64;
constexpr size_t O_S_GDN = O_P_SHIFT + 2 * 1 * 1024;
constexpr size_t O_S_GDNC = O_S_GDN + (size_t)2 * 32 * 4 * 64 * 64;
constexpr size_t O_S_SSM = O_S_GDNC + (size_t)2 * 32 * 3 * 768;
constexpr size_t O_S_SSMC = O_S_SSM + (size_t)2 * 32 * 8 * 64 * 128;
constexpr size_t O_S_RWKV = O_S_SSMC + (size_t)2 * 32 * 3 * 1024;
constexpr size_t O_S_SHIFT = O_S_RWKV + (size_t)2 * 32 * 4 * 64 * 64;
constexpr size_t O_END = O_S_SHIFT + (size_t)2 * 32 * 1024;
static_assert(O_END == 25784832, "output size");

constexpr size_t WS_CTL = 0, CTL_BYTES = 1u << 20;
constexpr size_t W_IN_B = (size_t)NIN * DM * 2, W_OUT_B = (size_t)DM * DM * 2, W_GU_B = (size_t)NGU * DM * 2, W_DN_B = (size_t)DM * FF * 2;
constexpr size_t W_LAYER_B = W_IN_B + W_OUT_B + W_GU_B + W_DN_B;
constexpr size_t WS_W = WS_CTL + CTL_BYTES;
constexpr size_t WS_R1 = WS_W + 2 * W_LAYER_B;
constexpr size_t R_BYTES = (size_t)T * DM * 2;
constexpr size_t WS_R2 = WS_R1 + R_BYTES;
constexpr size_t WS_PROJ = WS_R2 + R_BYTES;
constexpr size_t PROJ_BYTES = (size_t)T * PW * 2;
constexpr size_t WS_SSQA = WS_PROJ + PROJ_BYTES;
constexpr size_t SSQ_BYTES = (size_t)T * 16 * 4;
constexpr size_t WS_SSQD = WS_SSQA + SSQ_BYTES;
constexpr size_t WS_END = WS_SSQD + SSQ_BYTES;
static_assert(WS_END <= 268435456, "d_ws map exceeds 256 MiB");
static_assert((size_t)T * FF * 2 <= PROJ_BYTES, "ff overlays proj");
constexpr size_t R2_SCAL = 0;
constexpr size_t R2_HCONV = R2_SCAL + (size_t)T * 16 * 4;
constexpr size_t R2_HSHIFT = R2_HCONV + (size_t)NCH * 3 * 1792 * 2;
constexpr size_t R2_ACUM = R2_HSHIFT + (size_t)NCH * 1024 * 2;
constexpr size_t R2_GCUM = R2_ACUM + (size_t)T * 8 * 4;
constexpr size_t R2_YOFF = R2_GCUM + (size_t)T * 4 * 4;
constexpr size_t R2_GW = R2_YOFF + (size_t)T * 512 * 2;
static_assert(R2_GW + (size_t)T * 256 * 2 <= R_BYTES, "R2 map");
constexpr size_t R1_RWA = 0;
constexpr size_t R1_RU = R1_RWA + (size_t)T * 256 * 2;
constexpr size_t R1_RBH = R1_RU + (size_t)T * 256 * 2;
constexpr size_t R1_RKV = R1_RBH + (size_t)T * 256 * 2;
static_assert(R1_RKV + (size_t)T * 256 * 2 <= R_BYTES, "R1 map");
constexpr size_t R2_RDV = R2_GW + (size_t)T * 256 * 2;
static_assert(R2_RDV + (size_t)NCH * 4 * 64 * 4 <= R_BYTES, "R2 map (dvec)");
constexpr int CW_BAR = 4096;

constexpr int RING_BYTES = 131072;
constexpr int LDSCTL_OFF = 143360, MISC_OFF = LDSCTL_OFF + 320;
constexpr int LDS_BYTES = 147456;

typedef __bf16 bf16x2_t __attribute__((ext_vector_type(2)));
__device__ __forceinline__ unsigned cvt_pk_bf16(float lo, float hi) { const f32x2 v = {lo, hi}; return __builtin_bit_cast(unsigned, __builtin_convertvector(v, bf16x2_t)); }
__device__ __forceinline__ float bf_lo(unsigned w) { return __uint_as_float(w << 16); }
__device__ __forceinline__ float bf_hi(unsigned w) { return __uint_as_float(w & 0xffff0000u); }
__device__ __forceinline__ float bf2f(bf16_t h) { return __uint_as_float(((unsigned)h) << 16); }
__device__ __forceinline__ bf16_t f2bf(float f) { return (bf16_t)(cvt_pk_bf16(f, 0.f) & 0xffffu); }
__device__ __forceinline__ void unpack8(u32x4 w, float (&o)[8]) {
    o[0] = bf_lo(w.x); o[1] = bf_hi(w.x); o[2] = bf_lo(w.y); o[3] = bf_hi(w.y); o[4] = bf_lo(w.z); o[5] = bf_hi(w.z); o[6] = bf_lo(w.w); o[7] = bf_hi(w.w); }
__device__ __forceinline__ u32x4 pack8(const float (&v)[8]) { u32x4 w; w.x = cvt_pk_bf16(v[0], v[1]); w.y = cvt_pk_bf16(v[2], v[3]); w.z = cvt_pk_bf16(v[4], v[5]); w.w = cvt_pk_bf16(v[6], v[7]); return w; }
__device__ __forceinline__ float wave_sum(float v) {
#pragma unroll
    for (int o = 1; o < 64; o <<= 1) v += __shfl_xor(v, o);
    return v;
}
#define LDS_BARRIER() do { asm volatile("s_waitcnt lgkmcnt(0)" ::: "memory"); __builtin_amdgcn_s_barrier(); asm volatile("" ::: "memory"); } while (0)
__device__ __forceinline__ float sigmoidf_(float x) { return __builtin_amdgcn_rcpf(1.f + __expf(-x)); }
__device__ __forceinline__ float siluf_(float x) { return x * __builtin_amdgcn_rcpf(1.f + __expf(-x)); }
__device__ __forceinline__ float tanhf_(float x) { return 1.f - 2.f * __builtin_amdgcn_rcpf(1.f + __expf(2.f * x)); }
__device__ __forceinline__ float softplusf_(float x) { return fmaxf(x, 0.f) + __logf(1.f + __expf(-fabsf(x))); }


typedef short s16x4 __attribute__((ext_vector_type(4)));
__device__ __forceinline__ f32x4 mma16(bf16x8 a, bf16x8 b, f32x4 c) { return __builtin_amdgcn_mfma_f32_16x16x32_bf16(a, b, c, 0, 0, 0); }
__device__ __forceinline__ bf16x8 cat4(s16x4 a, s16x4 b) { return (bf16x8){a[0], a[1], a[2], a[3], b[0], b[1], b[2], b[3]}; }
__device__ __forceinline__ bf16x8 frag_nat(const LAS bf16_t* Tt, int LD, int row0, int k0, int i16, int g) { return *(const LAS bf16x8*)(Tt + (row0 + i16) * LD + k0 + 8 * g); }
__device__ __forceinline__ bf16x8 frag_sig(const LAS bf16_t* Tt, int LD, int row0, int k0, int i16, int g) {
    const LAS bf16_t* p = Tt + (row0 + i16) * LD + k0 + 4 * g; return cat4(*(const LAS s16x4*)p, *(const LAS s16x4*)(p + 16)); }
__device__ __forceinline__ s16x4 tr4(const LAS bf16_t* p) { return __builtin_amdgcn_ds_read_tr16_b64_v4i16((LAS s16x4*)p); }
__device__ __forceinline__ bf16x8 frag_tr_nat(const LAS bf16_t* X, int LD, int k0, int c0, int i16, int g) {
    const LAS bf16_t* p = X + (k0 + 8 * g + (i16 >> 2)) * LD + c0 + 4 * (i16 & 3); return cat4(tr4(p), tr4(p + 4 * LD)); }
__device__ __forceinline__ bf16x8 frag_tr_sig(const LAS bf16_t* X, int LD, int k0, int c0, int i16, int g) {
    const LAS bf16_t* p = X + (k0 + 4 * g + (i16 >> 2)) * LD + c0 + 4 * (i16 & 3); return cat4(tr4(p), tr4(p + 16 * LD)); }
__device__ __forceinline__ bf16x8 acc_frag(f32x4 x0, f32x4 x1) {
    u32x4 w; w.x = cvt_pk_bf16(x0[0], x0[1]); w.y = cvt_pk_bf16(x0[2], x0[3]); w.z = cvt_pk_bf16(x1[0], x1[1]); w.w = cvt_pk_bf16(x1[2], x1[3]);
    return __builtin_bit_cast(bf16x8, w); }
__device__ __forceinline__ u32x2 pack4(f32x4 x) { u32x2 w; w.x = cvt_pk_bf16(x[0], x[1]); w.y = cvt_pk_bf16(x[2], x[3]); return w; }
__device__ __forceinline__ f32x4 unpack4(u32x2 w) { return (f32x4){bf_lo(w.x), bf_hi(w.x), bf_lo(w.y), bf_hi(w.y)}; }

namespace pg8 {
constexpr int BM = 256, BK = 64, HALF = 128, HTB = HALF * BK * 2, STAGE_BYTES = 8 * HTB, NXCD = 8, WGM = 8;
__host__ __device__ __forceinline__ int lds_byte(int r, int c) { const int st = (r >> 4) * 2 + (c >> 5), rr = r & 15, cc = c & 31, ob = rr * 64 + cc * 2; return st * 1024 + (ob ^ (((ob >> 9) & 1) << 5)); }
__host__ __device__ __forceinline__ void stage_rc(int b, int& R, int& C) { const int st = b / 1024, sb = b % 1024, swz = sb ^ (((sb >> 9) & 1) << 5); R = (st >> 1) * 16 + swz / 64; C = (st & 1) * 32 + (swz % 64) / 2; }
__host__ __device__ __forceinline__ int perm32(int rho) { const int n = rho >> 4, i = rho & 15; return 8 * (i >> 2) + 4 * n + (i & 3); }
struct Unit { int pm, pn; };
struct Gemm { const bf16_t* A; const bf16_t* Bt; int M, N, K, lda; };
struct StaticOrder {
    int nM, nN, nwg, G, c;
    __host__ __device__ void init(int M, int N, int G_, int c_, int bm = BM) { nM = M / bm; nN = N / BM; nwg = nM * nN; G = G_; c = c_; }
    __host__ __device__ bool next(int i, Unit& u) const {
        const long L = (long)i * G + c; if (L >= nwg) return false;
        int wgid = (int)L; { const int q = nwg / NXCD, r = nwg % NXCD, xcd = wgid % NXCD, off = wgid / NXCD; wgid = (xcd < r ? xcd * (q + 1) : r * (q + 1) + (xcd - r) * q) + off; }
        const int nig = WGM * nN, gid = wgid / nig, fm = gid * WGM, gsz = (nM - fm) < WGM ? (nM - fm) : WGM;
        u.pm = fm + ((wgid % nig) % gsz); u.pn = (wgid % nig) / gsz; return true;
    }
};
template <class Epi, bool ALIGN_EPI, int MT = 4>
__device__ __forceinline__ void gemm_phase(LAS unsigned char* lds, const Gemm g, const StaticOrder& S, const Epi& E) {
    int tid_ = threadIdx.x; asm volatile("" : "+v"(tid_));
    const int tid = tid_, wid = __builtin_amdgcn_readfirstlane(tid >> 6), lane = tid & 63, wr = wid >> 2, wc = wid & 3, fr = lane & 15, fq = lane >> 4;
    const int K = g.K, nt = K / BK, lda = g.lda;
    unsigned voffA[2], voffB[2];
#pragma unroll
    for (int i = 0; i < 2; ++i) { int R, C; stage_rc(tid * 16 + i * 8192, R, C); const int Rb = Epi::PERM ? ((R & ~31) + perm32(R & 31)) : R;
        voffA[i] = (unsigned)(R * lda + C) * 2u; voffB[i] = (unsigned)(Rb * K + C) * 2u; }
    const size_t kstep = (size_t)(BK * 2);
    const size_t hstepA = (size_t)(32 * MT) * lda * 2, hstepB = (size_t)HALF * K * 2;
    const size_t tstepA = 2 * hstepA, tstepB = 2 * hstepB;
    const unsigned ldsw = (unsigned)wid * 1024u;
    const int aoff = lds_byte(wr * (16 * MT) + fr, fq * 8), boff = lds_byte(wc * 32 + fr, fq * 8);
#define PG8_SA(b, h) (((b) * 2 + (h)) * HTB)
#define PG8_SB(b, h) ((4 + (b) * 2 + (h)) * HTB)
#define PG8_STAGE(bufoff, gbase, voff) do { _Pragma("unroll") for (int _i = 0; _i < 2; ++_i) \
        __builtin_amdgcn_global_load_lds((const unsigned*)((const char*)(gbase) + (voff)[_i]), (LAS unsigned*)(lds + (bufoff) + ldsw + _i * 8192), 16, 0, 0); } while (0)
#define PG8_LDA(dst, b, h) do { _Pragma("unroll") for (int m = 0; m < MT; ++m) _Pragma("unroll") for (int k = 0; k < 2; ++k) dst[m][k] = *(const LAS bf16x8*)(lds + PG8_SA(b, h) + aoff + m * 2048 + k * 1024); } while (0)
#define PG8_LDB(dst, b, h) do { _Pragma("unroll") for (int n = 0; n < 2; ++n) _Pragma("unroll") for (int k = 0; k < 2; ++k) dst[n][k] = *(const LAS bf16x8*)(lds + PG8_SB(b, h) + boff + n * 2048 + k * 1024); } while (0)
#define PG8_MMA(ai, bj, At, Bt) do { __builtin_amdgcn_s_setprio(1); _Pragma("unroll") for (int m = 0; m < MT; ++m) _Pragma("unroll") for (int n = 0; n < 2; ++n) _Pragma("unroll") for (int k = 0; k < 2; ++k) \
        acc[ai][bj][m][n] = __builtin_amdgcn_mfma_f32_16x16x32_bf16(Bt[n][k], At[m][k], acc[ai][bj][m][n], 0, 0, 0); __builtin_amdgcn_s_setprio(0); } while (0)
#define PG8_WAIT_V(n) asm volatile("s_waitcnt vmcnt(" #n ")" ::: "memory")
#define PG8_WAIT_L(n) asm volatile("s_waitcnt lgkmcnt(" #n ")" ::: "memory")
#define PG8_BAR __builtin_amdgcn_s_barrier()
#define PG8_SCHED __builtin_amdgcn_sched_barrier(0)
    Unit cur, nxt; int ui = 0;
    if (!S.next(0, cur)) return;
    f32x4 acc[2][2][4][2];
#pragma unroll
    for (int a = 0; a < 2; ++a)
#pragma unroll
        for (int b = 0; b < 2; ++b)
#pragma unroll
            for (int m = 0; m < 4; ++m)
#pragma unroll
                for (int n = 0; n < 2; ++n) acc[a][b][m][n] = (f32x4){0.f, 0.f, 0.f, 0.f};
    bf16x8 At[4][2], B0[2][2], B1[2][2];
    const char* cA = (const char*)g.A + (size_t)cur.pm * tstepA; const char* cB = (const char*)g.Bt + (size_t)cur.pn * tstepB;
    PG8_STAGE(PG8_SB(0, 0), cB, voffB); PG8_STAGE(PG8_SB(0, 1), cB + hstepB, voffB); PG8_STAGE(PG8_SA(0, 0), cA, voffA); PG8_STAGE(PG8_SA(0, 1), cA + hstepA, voffA);
    if (wr == 1) PG8_BAR;
    PG8_WAIT_V(2); PG8_BAR;
    PG8_STAGE(PG8_SB(1, 0), cB + kstep, voffB); PG8_STAGE(PG8_SA(1, 0), cA + kstep, voffA); PG8_STAGE(PG8_SB(1, 1), cB + hstepB + kstep, voffB);
    PG8_WAIT_V(6); PG8_BAR;
    for (;;) {
        const bool has_next = S.next(ui + 1, nxt);
        const char* nA = has_next ? (const char*)g.A + (size_t)nxt.pm * tstepA : cA; const char* nB = has_next ? (const char*)g.Bt + (size_t)nxt.pn * tstepB : cB;
        for (int t = 0; t < nt; t += 2) {
            const bool last = (t == nt - 2);
            const char* a1 = cA + (size_t)(t + 1) * kstep;
            const char* a2 = last ? nA : cA + (size_t)(t + 2) * kstep; const char* b2 = last ? nB : cB + (size_t)(t + 2) * kstep;
            const char* a3 = a2 + kstep; const char* b3 = b2 + kstep;
            PG8_LDB(B0, 0, 0); PG8_LDB(B1, 0, 1); PG8_SCHED; PG8_LDA(At, 0, 0); PG8_STAGE(PG8_SA(1, 1), a1 + hstepA, voffA);
            PG8_WAIT_V(8); PG8_WAIT_L(0); PG8_BAR; PG8_MMA(0, 0, At, B0); PG8_MMA(0, 1, At, B1); PG8_BAR; PG8_SCHED;
            PG8_LDA(At, 0, 1); PG8_STAGE(PG8_SB(0, 0), b2, voffB); PG8_STAGE(PG8_SB(0, 1), b2 + hstepB, voffB); PG8_STAGE(PG8_SA(0, 0), a2, voffA);
            PG8_WAIT_V(8); PG8_WAIT_L(0); PG8_BAR; PG8_MMA(1, 0, At, B0); PG8_MMA(1, 1, At, B1); PG8_BAR; PG8_SCHED;
            PG8_LDB(B0, 1, 0); PG8_LDB(B1, 1, 1); PG8_SCHED; PG8_LDA(At, 1, 0); PG8_STAGE(PG8_SA(0, 1), a2 + hstepA, voffA);
            PG8_WAIT_V(8); PG8_WAIT_L(0); PG8_BAR; PG8_MMA(0, 0, At, B0); PG8_MMA(0, 1, At, B1); PG8_BAR; PG8_SCHED;
            PG8_LDA(At, 1, 1); PG8_STAGE(PG8_SB(1, 0), b3, voffB); PG8_STAGE(PG8_SB(1, 1), b3 + hstepB, voffB); PG8_STAGE(PG8_SA(1, 0), a3, voffA);
            PG8_WAIT_V(8); PG8_WAIT_L(0); PG8_BAR; PG8_MMA(1, 0, At, B0); PG8_MMA(1, 1, At, B1); PG8_BAR; PG8_SCHED;
        }
        if constexpr (ALIGN_EPI) { if (wr == 0) PG8_BAR; }
        E(acc, cur, wr, wc, fr, fq);
        if (!has_next) break;
#pragma unroll
        for (int a = 0; a < 2; ++a)
#pragma unroll
            for (int b = 0; b < 2; ++b)
#pragma unroll
                for (int m = 0; m < 4; ++m)
#pragma unroll
                    for (int n = 0; n < 2; ++n) acc[a][b][m][n] = (f32x4){0.f, 0.f, 0.f, 0.f};
        cur = nxt; cA = nA; cB = nB; ++ui;
        if constexpr (ALIGN_EPI) { if (wr == 1) PG8_BAR; }
    }
    PG8_WAIT_V(0);
    if constexpr (!ALIGN_EPI) { if (wr == 0) PG8_BAR; }
    PG8_BAR;
#undef PG8_SA
#undef PG8_SB
#undef PG8_STAGE
#undef PG8_LDA
#undef PG8_LDB
#undef PG8_MMA
#undef PG8_WAIT_V
#undef PG8_WAIT_L
#undef PG8_BAR
#undef PG8_SCHED
}

__device__ __forceinline__ float row_rstd(const float* ssq, int row, int fq) {
    const f32x4 p = *(const f32x4*)(ssq + (size_t)row * 16 + 4 * fq);
    float s = (p.x + p.y) + (p.z + p.w);
    s += __shfl_xor(s, 16); s += __shfl_xor(s, 32);
    return rsqrtf(s * (1.0f / 1024.0f) + EPS);
}

struct EpiInProj {
    static constexpr bool PERM = true;
    bf16_t* proj; float* scal; const float* ssq; bf16_t* hconv; bf16_t* hshift; float* out; int layer;
    __device__ __forceinline__ void operator()(const f32x4 (&acc)[2][2][4][2], const Unit& u, int wr, int wc, int fr, int fq) const {
        const int pn = u.pn;
#pragma unroll
        for (int ai = 0; ai < 2; ++ai)
#pragma unroll
            for (int m = 0; m < 4; ++m) {
                const int row = u.pm * BM + ai * HALF + wr * 64 + m * 16 + fr;
                const float rs = row_rstd(ssq, row, fq);
                {
#pragma unroll
                    for (int bj = 0; bj < 2; ++bj) {
                        const int c0 = pn * BM + bj * HALF + wc * 32 + 8 * fq;
                        const f32x4 v0 = acc[ai][bj][m][0] * rs, v1 = acc[ai][bj][m][1] * rs;
                        u32x4 w; w.x = cvt_pk_bf16(v0[0], v0[1]); w.y = cvt_pk_bf16(v0[2], v0[3]); w.z = cvt_pk_bf16(v1[0], v1[1]); w.w = cvt_pk_bf16(v1[2], v1[3]);
                        *(u32x4*)(proj + (size_t)row * PW + c0) = w;
                        if (m == 3) {
                            const int chunk = row >> 6;
                            if (fr >= 13 && pn >= 4 && pn < 11) {
                                const int j = fr - 13;
                                *(u32x4*)(hconv + ((size_t)chunk * 3 + j) * 1792 + (c0 - 1024)) = w;
                                if (chunk >= 255) {
                                    float* o;
                                    if (c0 < PC_SX) o = out + (chunk == 255 ? O_P_GDNC + ((size_t)layer * 3 + j) * 768 : O_S_GDNC + (((size_t)layer * 32 + (chunk - 256)) * 3 + j) * 768) + (c0 - PC_GQ);
                                    else o = out + (chunk == 255 ? O_P_SSMC + ((size_t)layer * 3 + j) * 1024 : O_S_SSMC + (((size_t)layer * 32 + (chunk - 256)) * 3 + j) * 1024) + (c0 - PC_SX);
                                    *(f32x4*)o = v0; *(f32x4*)(o + 4) = v1;
                                }
                            }
                            if (fr == 15 && (pn == 3 || pn >= 11)) {
                                const int oc = (pn == 3) ? (c0 - PC_R) : (c0 - 2560);
                                *(u32x4*)(hshift + (size_t)chunk * 1024 + oc) = w;
                                if (chunk >= 255) {
                                    float* o = out + (chunk == 255 ? O_P_SHIFT + (size_t)layer * 1024 : O_S_SHIFT + ((size_t)layer * 32 + (chunk - 256)) * 1024) + oc;
                                    *(f32x4*)o = v0; *(f32x4*)(o + 4) = v1;
                                }
                            }
                        }
                    }
                }
            }
    }
};
template <bool F32BASE, int MT> struct EpiResid {
    static constexpr bool PERM = true;
    const float* base_p; const float* base_s; bf16_t* xb; float* ssq;
    __device__ __forceinline__ void operator()(const f32x4 (&acc)[2][2][4][2], const Unit& u, int wr, int wc, int fr, int fq) const {
        const int col0 = u.pn * BM + wc * 32 + 8 * fq;
#pragma unroll
        for (int ai = 0; ai < 2; ++ai)
#pragma unroll
            for (int m = 0; m < MT; ++m) {
                const int row = u.pm * (64 * MT) + ai * (32 * MT) + wr * (16 * MT) + m * 16 + fr;
                float ss = 0.f;
#pragma unroll
                for (int bj = 0; bj < 2; ++bj) {
                    const int c = col0 + bj * HALF;
                    float x[8];
                    if (F32BASE) {
                        const float* bp = ((row < TP) ? base_p + (size_t)row * DM : base_s + (size_t)(row - TP) * DM) + c;
                        const f32x4 b0 = *(const f32x4*)bp, b1 = *(const f32x4*)(bp + 4);
                        x[0] = b0[0]; x[1] = b0[1]; x[2] = b0[2]; x[3] = b0[3]; x[4] = b1[0]; x[5] = b1[1]; x[6] = b1[2]; x[7] = b1[3];
                    } else unpack8(*(const u32x4*)(xb + (size_t)row * DM + c), x);
#pragma unroll
                    for (int n = 0; n < 2; ++n)
#pragma unroll
                        for (int i = 0; i < 4; ++i) { const float v = x[4 * n + i] + acc[ai][bj][m][n][i]; x[4 * n + i] = v; ss += v * v; }
                    *(u32x4*)(xb + (size_t)row * DM + c) = pack8(x);
                }
                ss += __shfl_xor(ss, 16); ss += __shfl_xor(ss, 32);
                if (fq == 0) ssq[(size_t)row * 16 + u.pn * 4 + wc] = ss;
            }
    }
};
struct EpiGateUp {
    static constexpr bool PERM = true;
    bf16_t* ff; const float* ssq;
    __device__ __forceinline__ void operator()(const f32x4 (&acc)[2][2][4][2], const Unit& u, int wr, int wc, int fr, int fq) const {
        const int c0 = u.pn * HALF + wc * 32 + 8 * fq;
#pragma unroll
        for (int ai = 0; ai < 2; ++ai)
#pragma unroll
            for (int m = 0; m < 4; ++m) {
                const int row = u.pm * BM + ai * HALF + wr * 64 + m * 16 + fr;
                const float rs = row_rstd(ssq, row, fq);
                float f[8];
#pragma unroll
                for (int n = 0; n < 2; ++n)
#pragma unroll
                    for (int i = 0; i < 4; ++i) { const float gg = acc[ai][0][m][n][i] * rs, uu = acc[ai][1][m][n][i] * rs; f[n * 4 + i] = siluf_(gg) * uu; }
                *(u32x4*)(ff + (size_t)row * FF + c0) = pack8(f);
            }
    }
};
}

#define XB_TMO      128
#define XB_XCNT(j)  (256  + 64 * (j))
#define XB_XSUB(j)  (1280 + 64 * (j))
#define XB_XGEN(j)  (2304 + 64 * (j))
#define XB_TOP      3328
#define XB_TOPGEN   3392
#define XCD_BAR_WORDS 3456
#define XB_SPIN_CAP (1u << 18)
__device__ __forceinline__ unsigned xb_ld(unsigned* p)              { return __hip_atomic_load(p, __ATOMIC_RELAXED, __HIP_MEMORY_SCOPE_AGENT); }
__device__ __forceinline__ unsigned xb_add(unsigned* p, unsigned v) { return __hip_atomic_fetch_add(p, v, __ATOMIC_RELAXED, __HIP_MEMORY_SCOPE_AGENT); }
__device__ __forceinline__ unsigned xb_xcc_id() { return (unsigned)__builtin_amdgcn_s_getreg((3 << 11) | 20) & 0xFu; }
#define XB_SPIN(cond, bar) do { unsigned _sp = 0; while (cond) { __builtin_amdgcn_s_sleep(1); \
    if ((++_sp & 255u) == 0u) { if (xb_ld(&(bar)[XB_TMO])) break; if (_sp > XB_SPIN_CAP) { atomicAdd(&(bar)[XB_TMO], 1u); break; } } } } while (0)
struct XcdBarrier { unsigned* bar; unsigned x; volatile LAS unsigned* st; };
__device__ __forceinline__ XcdBarrier xcd_barrier_post(unsigned* bar, volatile LAS unsigned* st) {
    XcdBarrier b; b.bar = bar; b.x = xb_xcc_id(); b.st = st;
    if (threadIdx.x == 0) (void)xb_add(&bar[XB_XCNT(b.x)], 1u);
    return b;
}
__device__ __forceinline__ void xcd_barrier_complete(unsigned* bar, unsigned x, unsigned& nloc, unsigned& nx) {
    const unsigned G = gridDim.x * gridDim.y * gridDim.z;
    unsigned sum, cnt, mine, sp = 0u;
    for (;;) {
        sum = 0u; cnt = 0u; mine = 0u;
#pragma unroll
        for (unsigned j = 0; j < 16; ++j) { const unsigned c = xb_ld(&bar[XB_XCNT(j)]); sum += c; cnt += (c > 0u) ? 1u : 0u; mine = (j == x) ? c : mine; }
        if (sum == G) break;
        __builtin_amdgcn_s_sleep(1);
        if ((++sp & 255u) == 0u) { if (xb_ld(&bar[XB_TMO])) break; if (sp > XB_SPIN_CAP) { atomicAdd(&bar[XB_TMO], 1u); break; } }
    }
    nloc = mine > 0u ? mine : 1u; nx = cnt > 0u ? cnt : 1u;
}
__device__ __forceinline__ void xcd_barrier(const XcdBarrier& b) {
    asm volatile("s_waitcnt vmcnt(0)" ::: "memory");
    __syncthreads();
    if (threadIdx.x == 0) {
        unsigned* bar = b.bar;
        __builtin_amdgcn_s_waitcnt(0);
        unsigned nloc = b.st[0], nx = b.st[1];
        if (nloc == 0u) { xcd_barrier_complete(bar, b.x, nloc, nx); b.st[0] = nloc; b.st[1] = nx; }
        const unsigned old = xb_add(&bar[XB_XSUB(b.x)], 1u);
        const unsigned gen = old / nloc;
        if (old + 1u == (gen + 1u) * nloc) {
            __builtin_amdgcn_fence(__ATOMIC_RELEASE, "agent");
            asm volatile("s_waitcnt vmcnt(0)" ::: "memory");
            const unsigned og = xb_add(&bar[XB_TOP], 1u);
            const unsigned tg = og / nx;
            if (og + 1u == (tg + 1u) * nx) xb_add(&bar[XB_TOPGEN], 1u);
            else XB_SPIN(xb_ld(&bar[XB_TOPGEN]) == tg, bar);
            __builtin_amdgcn_fence(__ATOMIC_ACQUIRE, "agent");
            xb_add(&bar[XB_XGEN(b.x)], 1u);
            asm volatile("s_waitcnt vmcnt(0)" ::: "memory");
        } else {
            XB_SPIN(xb_ld(&bar[XB_XGEN(b.x)]) == gen, bar);
            __builtin_amdgcn_fence(__ATOMIC_ACQUIRE, "agent");
            asm volatile("s_waitcnt vmcnt(0)" ::: "memory");
        }
    }
    __syncthreads();
}

struct Args { const float* in[37]; float* out; unsigned char* ws; unsigned sched[8]; int nsched, pmode; };
enum { I_XP = 0, I_XS, I_SGDN, I_SGDNC, I_SSSM, I_SSSMC, I_SRWKV, I_SSHIFT, I_NORM1, I_WIN, I_GCONVW, I_GALOG, I_GDTB, I_GNORMW,
       I_SCONVW, I_SCONVB, I_SALOG, I_SDTB, I_SD, I_SNORMW, I_RMU, I_RW0, I_RWUP, I_RA0, I_RAUP, I_RGUP, I_RKK, I_RKA, I_RRK, I_RLNW, I_RLNB,
       I_WOUT, I_NORM2, I_WG, I_WU, I_WD, I_FNORM };

struct Frame {
    LAS unsigned char* lds;
    int tid, lane, wave, vcu, G;
    float* out; unsigned char* ws;
};
constexpr int PTRTAB_OFF = LDSCTL_OFF + 1024;
__device__ __forceinline__ const float* inptr(LAS unsigned char* lds, int i) {
    const unsigned long long v = ((const LAS unsigned long long*)(lds + PTRTAB_OFF))[i];
    const unsigned lo = __builtin_amdgcn_readfirstlane((unsigned)v), hi = __builtin_amdgcn_readfirstlane((unsigned)(v >> 32));
    return (const float*)(((unsigned long long)hi << 32) | lo);
}
#define INP(i) inptr(F.lds, (i))
#define F_R1     ((bf16_t*)(F.ws + WS_R1))
#define F_R2     ((bf16_t*)(F.ws + WS_R2))
#define F_PROJ   ((bf16_t*)(F.ws + WS_PROJ))
#define F_SSQA   ((float*)(F.ws + WS_SSQA))
#define F_SSQD   ((float*)(F.ws + WS_SSQD))
#define F_SCAL   ((float*)(F.ws + WS_R2 + R2_SCAL))
#define F_HCONV  ((bf16_t*)(F.ws + WS_R2 + R2_HCONV))
#define F_HSHIFT ((bf16_t*)(F.ws + WS_R2 + R2_HSHIFT))
#define F_RWA    ((bf16_t*)((unsigned char*)F.out + R1_RWA))
#define F_RU     ((bf16_t*)((unsigned char*)F.out + R1_RU))
#define F_RBH    ((bf16_t*)((unsigned char*)F.out + R1_RBH))
#define F_RKV    ((bf16_t*)((unsigned char*)F.out + R1_RKV))
#define F_RDV    ((float*)(F.ws + WS_R2 + R2_RDV))
#define F_ACUM   ((float*)(F.ws + WS_R2 + R2_ACUM))
#define F_GCUM   ((float*)(F.ws + WS_R2 + R2_GCUM))
#define F_YOFF   ((bf16_t*)(F.ws + WS_R2 + R2_YOFF))
#define F_GW     ((bf16_t*)(F.ws + WS_R2 + R2_GW))
__device__ __forceinline__ bf16_t* w_in(const Frame& F, int l) { return (bf16_t*)(F.ws + WS_W + (size_t)l * W_LAYER_B); }
__device__ __forceinline__ bf16_t* w_out(const Frame& F, int l) { return (bf16_t*)(F.ws + WS_W + (size_t)l * W_LAYER_B + W_IN_B); }
__device__ __forceinline__ bf16_t* w_gu(const Frame& F, int l) { return (bf16_t*)(F.ws + WS_W + (size_t)l * W_LAYER_B + W_IN_B + W_OUT_B); }
__device__ __forceinline__ bf16_t* w_dn(const Frame& F, int l) { return (bf16_t*)(F.ws + WS_W + (size_t)l * W_LAYER_B + W_IN_B + W_OUT_B + W_GU_B); }

template <class Tp> __device__ __forceinline__ LAS Tp* opaque_lds(LAS Tp* p) { unsigned a = (unsigned)(unsigned long long)p; asm volatile("" : "+v"(a)); return (LAS Tp*)(unsigned long long)a; }
constexpr int CW_AFLAG = 14336, CW_RFLAG = 14336 + 288;
__device__ __forceinline__ void publish_item(unsigned* flag) {
    asm volatile("s_waitcnt vmcnt(0)" ::: "memory");
    LDS_BARRIER();
    if (threadIdx.x == 0) {
        __builtin_amdgcn_fence(__ATOMIC_RELEASE, "agent");
        asm volatile("s_waitcnt vmcnt(0)" ::: "memory");
        __hip_atomic_fetch_add(flag, 1u, __ATOMIC_RELAXED, __HIP_MEMORY_SCOPE_AGENT);
    }
}
__device__ __forceinline__ int opaque_tid() { int t = threadIdx.x; asm volatile("" : "+v"(t)); return t; }
#define PHASE_IDS(F) do { (F).tid = opaque_tid(); (F).lane = (F).tid & 63; (F).wave = __builtin_amdgcn_readfirstlane((F).tid >> 6); } while (0)
__device__ __forceinline__ int inproj_dst(int n) {
    if (n < 768) return PC_GQ + n;
    if (n < 1024) return PC_ZG + (n - 768);
    if (n < 1032) return 3584 + (n - 1024);
    if (n < 1544) return PC_ZS + (n - 1032);
    if (n < 2568) return PC_SX + (n - 1544);
    if (n < 2576) return 3592 + (n - 2568);
    if (n < 2832) return PC_R + (n - 2576);
    if (n < 3344) return PC_RK + (n - 2832);
    return PC_RL + (n - 3344);
}
template <int MODE>
__device__ __forceinline__ void p0_transpose_item(const float* W, int K, int N, bf16_t* WT, const float* kscale, LAS float* scr, int item, int lane) {
    const int nblk = (N + 31) / 32, kb = item / nblk, nb = item % nblk, k0 = 64 * kb, n0 = 32 * nb;
    {
        const int rr = lane >> 3, c4 = (lane & 7) * 4;
        f32x4 v[8];
#pragma unroll
        for (int i = 0; i < 8; ++i) { const float* p = W + (size_t)(k0 + 8 * i + rr) * N + n0 + c4;
            if (n0 + c4 + 3 < N) v[i] = *(const f32x4*)p;
            else v[i] = (f32x4){0.f, 0.f, 0.f, 0.f}; }
#pragma unroll
        for (int i = 0; i < 8; ++i) { LAS float* s = scr + (8 * i + rr) * 33 + c4; s[0] = v[i][0]; s[1] = v[i][1]; s[2] = v[i][2]; s[3] = v[i][3]; }
    }
    asm volatile("s_waitcnt lgkmcnt(0)" ::: "memory");
    const int c = lane & 7;
    float ks[8];
#pragma unroll
    for (int i = 0; i < 8; ++i) ks[i] = kscale ? kscale[k0 + 8 * c + i] : 1.f;
#pragma unroll
    for (int j = 0; j < 4; ++j) { const int nl = (lane >> 3) + 8 * j; const int n = n0 + nl; const LAS float* s = scr + (8 * c) * 33 + nl;
        u32x4 o; o.x = cvt_pk_bf16(s[0 * 33] * ks[0], s[1 * 33] * ks[1]); o.y = cvt_pk_bf16(s[2 * 33] * ks[2], s[3 * 33] * ks[3]);
        o.z = cvt_pk_bf16(s[4 * 33] * ks[4], s[5 * 33] * ks[5]); o.w = cvt_pk_bf16(s[6 * 33] * ks[6], s[7 * 33] * ks[7]);
        if (n < N) {
            int d;
            if (MODE == 0) d = n; else if (MODE == 1) d = inproj_dst(n); else if (MODE == 2) d = 256 * (n >> 7) + (n & 127); else d = 256 * (n >> 7) + 128 + (n & 127);
            *(u32x4*)(WT + (size_t)d * K + k0 + 8 * c) = o; } }
    asm volatile("s_waitcnt lgkmcnt(0)" ::: "memory");
}
__device__ __forceinline__ void p0_prologue(Frame& F) {
    PHASE_IDS(F);
    LAS float* scr = (LAS float*)(F.lds + F.wave * 16384);
    const int gw = F.vcu * 8 + F.wave, NGW = F.G * 8;
    constexpr int I_IN = 16 * 113, I_OUT = 16 * 32, I_G = 16 * 88, I_D = 44 * 32;
    constexpr int PER_L = I_IN + I_OUT + 2 * I_G + I_D;
    for (int it = gw; it < 2 * PER_L; it += NGW) {
        const int l = it / PER_L; int r = it % PER_L;
        if (r < I_IN) { p0_transpose_item<1>(INP(I_WIN) + (size_t)l * DM * 3600, DM, 3600, w_in(F, l), INP(I_NORM1) + l * DM, scr, r, F.lane); continue; } r -= I_IN;
        if (r < I_OUT) { p0_transpose_item<0>(INP(I_WOUT) + (size_t)l * DM * DM, DM, DM, w_out(F, l), nullptr, scr, r, F.lane); continue; } r -= I_OUT;
        if (r < I_G) { p0_transpose_item<2>(INP(I_WG) + (size_t)l * DM * FF, DM, FF, w_gu(F, l), INP(I_NORM2) + l * DM, scr, r, F.lane); continue; } r -= I_G;
        if (r < I_G) { p0_transpose_item<3>(INP(I_WU) + (size_t)l * DM * FF, DM, FF, w_gu(F, l), INP(I_NORM2) + l * DM, scr, r, F.lane); continue; } r -= I_G;
        p0_transpose_item<0>(INP(I_WD) + (size_t)l * FF * DM, FF, DM, w_dn(F, l), nullptr, scr, r, F.lane);
    }
    for (int m = gw; m < T; m += NGW) {
        const float* xr = (m < TP) ? INP(I_XP) + (size_t)m * DM : INP(I_XS) + (size_t)(m - TP) * DM;
        f32x4 v[4]; float s = 0.f;
#pragma unroll
        for (int j = 0; j < 4; ++j) { v[j] = *((const f32x4*)xr + F.lane + 64 * j); s += (v[j].x * v[j].x + v[j].y * v[j].y) + (v[j].z * v[j].z + v[j].w * v[j].w); }
        s = wave_sum(s);
#pragma unroll
        for (int j = 0; j < 4; ++j) { u32x2 w; w.x = cvt_pk_bf16(v[j].x, v[j].y); w.y = cvt_pk_bf16(v[j].z, v[j].w); *((u32x2*)(F_R1 + (size_t)m * DM) + F.lane + 64 * j) = w; }
        if (F.lane < 16) F_SSQA[(size_t)m * 16 + F.lane] = (F.lane == 0) ? s : 0.f;
    }
}

template <int LDL, int SGN, class RhsFn>
__device__ __forceinline__ void tri_solve64(const LAS float* Lo, float (&x)[64], RhsFn rhs) {
    f32x4 cur[16], nxt[16];
#pragma unroll
    for (int i = 0; i < 64; ++i) {
        if (i + 1 < 64) {
#pragma unroll
            for (int m4 = 0; m4 < (i + 1 + 3) / 4; ++m4) nxt[m4] = *(const LAS f32x4*)(Lo + (i + 1) * LDL + 4 * m4);
        }
        float a0 = rhs(i), a1 = 0.f, a2 = 0.f, a3 = 0.f;
#pragma unroll
        for (int m4 = 0; m4 < (i + 3) / 4; ++m4) {
            if (4 * m4 + 0 < i) a0 += (SGN > 0 ? cur[m4][0] : -cur[m4][0]) * x[4 * m4 + 0];
            if (4 * m4 + 1 < i) a1 += (SGN > 0 ? cur[m4][1] : -cur[m4][1]) * x[4 * m4 + 1];
            if (4 * m4 + 2 < i) a2 += (SGN > 0 ? cur[m4][2] : -cur[m4][2]) * x[4 * m4 + 2];
            if (4 * m4 + 3 < i) a3 += (SGN > 0 ? cur[m4][3] : -cur[m4][3]) * x[4 * m4 + 3];
        }
        x[i] = (a0 + a1) + (a2 + a3);
        __builtin_amdgcn_sched_barrier(0);
#pragma unroll
        for (int m4 = 0; m4 < 16; ++m4) cur[m4] = nxt[m4];
    }
}
constexpr int ACT_KT = 0, ACT_VT = 33792, ACT_LM = 67584, ACT_SCL = 137216, ACT_GCL = 141312;
constexpr int ACT_LDK = 264, ACT_LDL = 68;
__device__ __forceinline__ void act_chunk(Frame& F, int l, int c) {
    PHASE_IDS(F);
    const int tid = F.tid;
    const size_t row0 = (size_t)c * 64;
    const bool prompt = c < 256; const int b = c - 256;
    bf16_t* const proj = F_PROJ;
    LAS float* inT = (LAS float*)F.lds;
    LAS bf16_t* kx = (LAS bf16_t*)(F.lds + 256 * 68 * 4);
    LAS bf16_t* Kt = (LAS bf16_t*)(F.lds + ACT_KT); LAS bf16_t* Vt = (LAS bf16_t*)(F.lds + ACT_VT); LAS float* Lm = (LAS float*)(F.lds + ACT_LM);
    LAS float* scl = (LAS float*)(F.lds + ACT_SCL); LAS float* gcl = (LAS float*)(F.lds + ACT_GCL);
    LAS float* part = (LAS float*)(F.lds + ACT_LM); LAS float* rsl = part + 2 * 64 * 16;
    {
        const int w = F.wave, lane = F.lane, i16 = lane & 15, g = lane >> 4, rt = w & 3, kh = w >> 2;
        const bf16_t* ap = F_R1 + (row0 + 16 * rt + i16) * DM + kh * 512 + 8 * g;
        const bf16_t* bp = w_in(F, l) + (size_t)(PW + i16) * DM + kh * 512 + 8 * g;
        bf16x8 a[16], b[16];
#pragma unroll
        for (int ks = 0; ks < 16; ++ks) { a[ks] = *(const bf16x8*)(ap + 32 * ks); b[ks] = *(const bf16x8*)(bp + 32 * ks); }
        if (tid < 64) { const f32x4* sp = (const f32x4*)(F_SSQA + (row0 + tid) * 16); const f32x4 p0 = sp[0], p1 = sp[1], p2 = sp[2], p3 = sp[3];
            const float s = ((p0.x + p0.y) + (p0.z + p0.w)) + ((p1.x + p1.y) + (p1.z + p1.w)) + ((p2.x + p2.y) + (p2.z + p2.w)) + ((p3.x + p3.y) + (p3.z + p3.w));
            rsl[tid] = rsqrtf(s * (1.0f / 1024.0f) + EPS); }
        f32x4 acc0 = (f32x4){0.f, 0.f, 0.f, 0.f}, acc1 = (f32x4){0.f, 0.f, 0.f, 0.f};
#pragma unroll
        for (int ks = 0; ks < 16; ks += 2) { acc0 = mma16(a[ks], b[ks], acc0); acc1 = mma16(a[ks + 1], b[ks + 1], acc1); }
#pragma unroll
        for (int r = 0; r < 4; ++r) part[(kh * 64 + 16 * rt + 4 * g + r) * 16 + i16] = acc0[r] + acc1[r];
    }
    LDS_BARRIER();
    for (int e = tid; e < 64 * 16; e += 512) {
        const int t = e >> 4, q = e & 15;
        float* p = F_SCAL + (row0 + t) * 16 + q;
        const float v = (part[e] + part[1024 + e]) * rsl[t]; float r;
        if (q < 4) r = -__expf(INP(I_GALOG)[l * 4 + q]) * softplusf_(v + INP(I_GDTB)[l * 4 + q]);
        else if (q < 8) r = sigmoidf_(v);
        else r = softplusf_(v + INP(I_SDTB)[l * 8 + (q - 8)]);
        *p = r; scl[e] = r;
    }
    LDS_BARRIER();
    {
        const int w = F.wave, lane = F.lane;
        float v = scl[lane * 16 + 8 + w] * (-__expf(INP(I_SALOG)[l * 8 + w]));
#pragma unroll
        for (int o = 1; o < 64; o <<= 1) { const float tt = __shfl_up(v, o); if (lane >= o) v += tt; }
        F_ACUM[(row0 + lane) * 8 + w] = v;
        if (w < 4) {
            float gv = scl[lane * 16 + w];
#pragma unroll
            for (int o = 1; o < 64; o <<= 1) { const float tt = __shfl_up(gv, o); if (lane >= o) gv += tt; }
            F_GCUM[(row0 + lane) * 4 + w] = gv; gcl[w * 64 + lane] = gv;
        }
    }
    {
        const int cg = tid % 224, rh = tid / 224;
        const bool active = tid < 448;
        const int col = 1024 + cg * 8, t0 = 32 * rh;
        const bool gdn = cg < 96;
        const int cc = gdn ? (col - PC_GQ) : (col - PC_SX);
        const int C = gdn ? 768 : 1024;
        const int kind = gdn ? (cg >> 5) : 3;
        float w[4][8], bias[8], p3[8], p2[8], p1[8];
        u32x4 xr[16];
        if (active) {
            const float* cw = gdn ? INP(I_GCONVW) + (size_t)l * 4 * 768 : INP(I_SCONVW) + (size_t)l * 4 * 1024;
#pragma unroll
            for (int j = 0; j < 4; ++j)
#pragma unroll
                for (int i = 0; i < 8; ++i) w[j][i] = cw[j * C + cc + i];
#pragma unroll
            for (int i = 0; i < 8; ++i) bias[i] = gdn ? 0.f : INP(I_SCONVB)[l * 1024 + cc + i];
            if (rh == 1) {
                unpack8(*(const u32x4*)(proj + (row0 + t0 - 3) * PW + col), p3); unpack8(*(const u32x4*)(proj + (row0 + t0 - 2) * PW + col), p2); unpack8(*(const u32x4*)(proj + (row0 + t0 - 1) * PW + col), p1);
            } else if (prompt) {
                if (c == 0) {
#pragma unroll
                    for (int i = 0; i < 8; ++i) { p3[i] = 0.f; p2[i] = 0.f; p1[i] = 0.f; }
                } else {
                    const bf16_t* hp = F_HCONV + (size_t)(c - 1) * 3 * 1792 + (col - 1024);
                    unpack8(*(const u32x4*)(hp), p3); unpack8(*(const u32x4*)(hp + 1792), p2); unpack8(*(const u32x4*)(hp + 2 * 1792), p1);
                }
            } else {
                const float* st = gdn ? INP(I_SGDNC) + ((size_t)l * 32 + b) * 3 * 768 + cc : INP(I_SSSMC) + ((size_t)l * 32 + b) * 3 * 1024 + cc;
#pragma unroll
                for (int i = 0; i < 8; ++i) { p3[i] = st[i]; p2[i] = st[C + i]; p1[i] = st[2 * C + i]; }
            }
#pragma unroll
            for (int t = 0; t < 16; ++t) xr[t] = *(const u32x4*)(proj + (row0 + t0 + t) * PW + col);
        }
        asm volatile("s_waitcnt vmcnt(0)" ::: "memory");
        LDS_BARRIER();
#pragma unroll
        for (int bt = 0; bt < 2; ++bt) {
            if (active) {
#pragma unroll
                for (int t = 0; t < 16; ++t) {
                    const int tr = t0 + 16 * bt + t;
                    bf16_t* p = proj + (row0 + tr) * PW + col;
                    float x[8], y[8];
                    unpack8(xr[t], x);
#pragma unroll
                    for (int i = 0; i < 8; ++i) { float a = w[0][i] * p3[i] + w[1][i] * p2[i] + w[2][i] * p1[i] + w[3][i] * x[i] + bias[i]; y[i] = siluf_(a); p3[i] = p2[i]; p2[i] = p1[i]; p1[i] = x[i]; }
                    if (kind < 2) {
                        float ss = 0.f;
#pragma unroll
                        for (int i = 0; i < 8; ++i) ss += y[i] * y[i];
                        ss += __shfl_xor(ss, 1); ss += __shfl_xor(ss, 2); ss += __shfl_xor(ss, 4);
                        const float sc = rsqrtf(ss + EPS) * (kind == 0 ? 0.125f : 1.f);
#pragma unroll
                        for (int i = 0; i < 8; ++i) y[i] *= sc;
                    }
                    const u32x4 pk = pack8(y);
                    if (kind != 2) *(u32x4*)p = pk;
                    if (kind == 1) *(LAS u32x4*)(Kt + tr * ACT_LDK + (col - PC_GK)) = pk;
                    if (kind == 2) *(LAS u32x4*)(Vt + tr * ACT_LDK + (col - PC_GV)) = pk;
                }
                if (bt == 0) {
#pragma unroll
                    for (int t = 0; t < 16; ++t) xr[t] = *(const u32x4*)(proj + (row0 + t0 + 16 + t) * PW + col);
                }
            }
        }
    }
    LDS_BARRIER();
    {
        const int w = F.wave, lane = F.lane, i16 = lane & 15, g = lane >> 4, h = w >> 1, e = w & 1;
        LAS float* Lh = Lm + h * 64 * ACT_LDL;
#pragma unroll
        for (int ii = 0; ii < 2; ++ii) {
            const int it = e + 2 * ii;
#pragma unroll
            for (int jt = 0; jt < 4; ++jt) {
                if (jt <= it) {
                    f32x4 acc = (f32x4){0.f, 0.f, 0.f, 0.f};
#pragma unroll
                    for (int ks = 0; ks < 2; ++ks) acc = mma16(frag_nat(Kt, ACT_LDK, 16 * it, h * 64 + 32 * ks, i16, g), frag_nat(Kt, ACT_LDK, 16 * jt, h * 64 + 32 * ks, i16, g), acc);
                    const int j = 16 * jt + i16; const float gcj = gcl[h * 64 + j];
#pragma unroll
                    for (int r = 0; r < 4; ++r) { const int i = 16 * it + 4 * g + r;
                        const float f = (j < i) ? scl[i * 16 + 4 + h] * __expf(fminf(gcl[h * 64 + i] - gcj, 0.f)) : 0.f;
                        Lh[i * ACT_LDL + j] = acc[r] * f; }
                }
            }
        }
        LDS_BARRIER();
        float x[64];
        const LAS bf16_t* Rt = opaque_lds((e == 0 ? Vt : Kt) + h * 64 + lane); const float ef = (float)e;
        const LAS float* Lo = opaque_lds(Lh); const LAS float* sclo = opaque_lds(scl + 4 + h); const LAS float* gclo = opaque_lds(gcl + h * 64);
        tri_solve64<ACT_LDL, -1>(Lo, x, [&](int i) { return sclo[i * 16] * __expf(gclo[i] * ef) * bf2f(Rt[i * ACT_LDK]); });
        if (e == 0) {
            bf16_t* o = proj + (row0 + lane) * PW + PC_GV + h * 64;
#pragma unroll
            for (int q = 0; q < 8; ++q) { float y[8];
#pragma unroll
                for (int i = 0; i < 8; ++i) y[i] = x[8 * q + i];
                *(u32x4*)(o + 8 * q) = pack8(y); }
        } else {
            bf16_t* o = F_GW + (((size_t)c * 4 + h) * 64) * 64 + lane;
#pragma unroll
            for (int i = 0; i < 64; ++i) o[i * 64] = f2bf(-x[i]);
        }
    }
    publish_item((unsigned*)(F.ws + WS_CTL) + CW_AFLAG + c);
    LDS_BARRIER();
}

__device__ __forceinline__ void st8_wt(void* p, u32x2 v) { __hip_atomic_store((unsigned long long*)p, __builtin_bit_cast(unsigned long long, v), __ATOMIC_RELAXED, __HIP_MEMORY_SCOPE_AGENT); }
__device__ __forceinline__ u32x4 ld16_asm(const void* p) { u32x4 r; asm volatile("global_load_dwordx4 %0, %1, off sc1" : "=v"(r) : "v"(p)); return r; }
__device__ __forceinline__ float ld4_asm(const float* p) { float r; asm volatile("global_load_dword %0, %1, off sc1" : "=v"(r) : "v"(p)); return r; }
constexpr int RDY_SLACK = 8;
#define RDY_WORD(F) ((volatile LAS int*)((F).lds + MISC_OFF + 64))
__device__ __forceinline__ int rdy_advance(const unsigned* rdy, int rstride, unsigned rneed, int nxt, int nch, int lane) {
    const int k = nxt + (lane & 15);
    const bool ok = k < nch && (int)(__hip_atomic_load(rdy + (size_t)rstride * k, __ATOMIC_RELAXED, __HIP_MEMORY_SCOPE_AGENT) - rneed) >= 0;
    const unsigned long long m = __ballot(ok) & 0xffffull;
    return nxt + __builtin_ctzll(~m);
}
__device__ __forceinline__ int rdy_block(Frame& F, const unsigned* rdy, int rstride, unsigned rneed, int nxt, int upto, int nch) {
    unsigned sp = 0;
    while (nxt < upto && ++sp < 4000000u) { const int n2 = rdy_advance(rdy, rstride, rneed, nxt, nch, F.lane); if (n2 == nxt) __builtin_amdgcn_s_sleep(8); nxt = n2; }
    if (F.lane == 0) *RDY_WORD(F) = nxt - 1;
    return nxt;
}
#define RDY_LOADER_WAIT(F, k) do { const int kk_ = (k) < nch ? (k) : nch - 1; unsigned sp_ = 0; while (*RDY_WORD(F) < kk_ && ++sp_ < 40000000u) __builtin_amdgcn_s_sleep(1); } while (0)
#define SCAN_CL(k) (c0 + ((k) < nch ? (k) : nch - 1))
#define SCAN_LOADER6(LOADM, WRITEM, WAITM, NLD) do {            \
        RDY_LOADER_WAIT(F, 0); LOADM(SCAN_CL(0), 0); WAITM(0, 0); WRITEM(0, 0); \
        RDY_LOADER_WAIT(F, 1); LOADM(SCAN_CL(1), 1); RDY_LOADER_WAIT(F, 2); LOADM(SCAN_CL(2), 2); RDY_LOADER_WAIT(F, 3); LOADM(SCAN_CL(3), 3); RDY_LOADER_WAIT(F, 4); LOADM(SCAN_CL(4), 4); RDY_LOADER_WAIT(F, 5); LOADM(SCAN_CL(5), 5); \
        LDS_BARRIER(); \
        for (int r_ = 0; r_ < nch; r_ += 6) { \
            RDY_LOADER_WAIT(F, r_ + 6); LOADM(SCAN_CL(r_ + 6), 0); WAITM(1, 5 * (NLD)); WRITEM(1, 1); LDS_BARRIER(); if (r_ + 1 >= nch) break; \
            RDY_LOADER_WAIT(F, r_ + 7); LOADM(SCAN_CL(r_ + 7), 1); WAITM(2, 5 * (NLD)); WRITEM(0, 2); LDS_BARRIER(); if (r_ + 2 >= nch) break; \
            RDY_LOADER_WAIT(F, r_ + 8); LOADM(SCAN_CL(r_ + 8), 2); WAITM(3, 5 * (NLD)); WRITEM(1, 3); LDS_BARRIER(); if (r_ + 3 >= nch) break; \
            RDY_LOADER_WAIT(F, r_ + 9); LOADM(SCAN_CL(r_ + 9), 3); WAITM(4, 5 * (NLD)); WRITEM(0, 4); LDS_BARRIER(); if (r_ + 4 >= nch) break; \
            RDY_LOADER_WAIT(F, r_ + 10); LOADM(SCAN_CL(r_ + 10), 4); WAITM(5, 5 * (NLD)); WRITEM(1, 5); LDS_BARRIER(); if (r_ + 5 >= nch) break; \
            RDY_LOADER_WAIT(F, r_ + 11); LOADM(SCAN_CL(r_ + 11), 5); WAITM(0, 5 * (NLD)); WRITEM(0, 0); LDS_BARRIER(); \
        } \
        asm volatile("s_waitcnt vmcnt(0)" ::: "memory"); \
        } while (0)
#define SCAN_LOADER(LOADM, WRITEM, WAITM, NLD) do { \
          \
          \
        RDY_LOADER_WAIT(F, 0); LOADM(SCAN_CL(0), 0); WAITM(0, 0); WRITEM(0, 0); \
        RDY_LOADER_WAIT(F, 1); LOADM(SCAN_CL(1), 1); RDY_LOADER_WAIT(F, 2); LOADM(SCAN_CL(2), 2); RDY_LOADER_WAIT(F, 3); LOADM(SCAN_CL(3), 3); \
        LDS_BARRIER(); \
          \
        for (int r_ = 0; r_ < nch; r_ += 4) { \
            RDY_LOADER_WAIT(F, r_ + 4); LOADM(SCAN_CL(r_ + 4), 0); WAITM(1, 3 * (NLD)); WRITEM(1, 1); LDS_BARRIER(); if (r_ + 1 >= nch) break; \
            RDY_LOADER_WAIT(F, r_ + 5); LOADM(SCAN_CL(r_ + 5), 1); WAITM(2, 3 * (NLD)); WRITEM(0, 2); LDS_BARRIER(); if (r_ + 2 >= nch) break; \
            RDY_LOADER_WAIT(F, r_ + 6); LOADM(SCAN_CL(r_ + 6), 2); WAITM(3, 3 * (NLD)); WRITEM(1, 3); LDS_BARRIER(); if (r_ + 3 >= nch) break; \
            RDY_LOADER_WAIT(F, r_ + 7); LOADM(SCAN_CL(r_ + 7), 3); WAITM(0, 3 * (NLD)); WRITEM(0, 0); LDS_BARRIER(); \
        } \
        asm volatile("s_waitcnt vmcnt(0)" ::: "memory");      \
        } while (0)

constexpr int GDN_LD = 72;
constexpr int GDN_BUF = 3 * 64 * GDN_LD * 2 + 64;
__device__ __forceinline__ void scan_gdn2(Frame& F, int l, int s, int h, int vb, int ncw, unsigned* prog, unsigned pbase, unsigned* done, int pm, const unsigned* rdy, int rstride, unsigned rneed) {
    PHASE_IDS(F);
    const int tid = F.tid, lane = F.lane, w = F.wave, i16 = lane & 15, g = lane >> 4;
    const int nch = (s == 0) ? 256 : 1, c0 = (s == 0) ? 0 : 255 + s, b = s - 1;
    bf16_t* const proj = F_PROJ; bf16_t* const gw = F_GW; const float* const gcum = F_GCUM;
    {
        if (w == (ncw < 4 ? ncw : 0)) (void)rdy_block(F, rdy, rstride, rneed, 0, nch < RDY_SLACK ? nch : RDY_SLACK, nch);
        LDS_BARRIER();
    }
    if (w >= 4) {
        const int lt = tid - 256;
        const int umask = 128 * ncw - 1;
        u32x4 rw0[2], ru0[2], rk0[2], rw1[2], ru1[2], rk1[2], rw2[2], ru2[2], rk2[2], rw3[2], ru3[2], rk3[2], rw4[2], ru4[2], rk4[2], rw5[2], ru5[2], rk5[2]; float gc0[2], gl0, gc1[2], gl1, gc2[2], gl2, gc3[2], gl3, gc4[2], gl4, gc5[2], gl5;
        const bf16_t* pW[2]; const bf16_t* pU[2]; const bf16_t* pK[2]; const float* pG[2]; const float* const pGl = gcum + 63 * 4 + h;
#pragma unroll
        for (int q = 0; q < 2; ++q) { const int idx = q * 256 + lt, row = idx >> 3, col8 = (idx & 7) * 8, urow = vb + ((idx & umask) >> 3);
            pW[q] = gw + ((size_t)h * 64 + row) * 64 + col8; pU[q] = proj + (size_t)urow * PW + PC_GV + h * 64 + col8; pK[q] = proj + (size_t)row * PW + PC_GK + h * 64 + col8; pG[q] = gcum + row * 4 + h; }
#define GDN_LOAD(ch, S) do { const size_t oW_ = (size_t)(ch) * (4 * 4096), oP_ = (size_t)(ch) * (64 * PW), oG_ = (size_t)(ch) * 256; gl##S = ld4_asm(pGl + oG_); \
        _Pragma("unroll") for (int q = 0; q < 2; ++q) { rw##S[q] = ld16_asm(pW[q] + oW_); ru##S[q] = ld16_asm(pU[q] + oP_); rk##S[q] = ld16_asm(pK[q] + oP_); gc##S[q] = ld4_asm(pG[q] + oG_); } } while (0)
#define GDN_WAIT(S, N) asm volatile("s_waitcnt vmcnt(%9)" : "+v"(rw##S[0]), "+v"(rw##S[1]), "+v"(ru##S[0]), "+v"(ru##S[1]), "+v"(rk##S[0]), "+v"(rk##S[1]), "+v"(gc##S[0]), "+v"(gc##S[1]), "+v"(gl##S) : "n"(N))
#define GDN_WRITE(bb, S) do { LAS bf16_t* Wn_ = (LAS bf16_t*)(F.lds + (bb) * GDN_BUF); LAS bf16_t* Ut_ = Wn_ + 64 * GDN_LD; LAS bf16_t* Kd_ = Ut_ + 64 * GDN_LD; \
        _Pragma("unroll") for (int q = 0; q < 2; ++q) { const int idx = q * 256 + lt, row = idx >> 3, col8 = (idx & 7) * 8; \
            *(LAS u32x4*)(Wn_ + row * GDN_LD + col8) = rw##S[q]; *(LAS u32x4*)(Ut_ + (vb + ((idx & umask) >> 3)) * GDN_LD + col8) = ru##S[q]; \
            const float ks_ = __expf(gl##S - gc##S[q]); \
            float v_[8]; unpack8(rk##S[q], v_); _Pragma("unroll") for (int i = 0; i < 8; ++i) v_[i] *= ks_; *(LAS u32x4*)(Kd_ + row * GDN_LD + col8) = pack8(v_); } \
        if (lt == 0) *(LAS float*)(Kd_ + 64 * GDN_LD) = __expf(gl##S); } while (0)
        SCAN_LOADER6(GDN_LOAD, GDN_WRITE, GDN_WAIT, 9);
#undef GDN_LOAD
#undef GDN_WRITE
#undef GDN_WAIT
    } else if (w >= ncw) {
        int nxt = nch < RDY_SLACK ? nch : RDY_SLACK;
        LDS_BARRIER();
        for (int ci = 0; ci < nch; ++ci) {
            if (w == ncw && nxt < nch) { const int upto = ci + 1 + RDY_SLACK < nch ? ci + 1 + RDY_SLACK : nch; nxt = rdy_block(F, rdy, rstride, rneed, nxt, upto, nch); }
            LDS_BARRIER();
        }
    } else {
        const int n0 = vb + 16 * w;
        f32x4 S[4];
        if (s == 0) {
#pragma unroll
            for (int kt = 0; kt < 4; ++kt) S[kt] = (f32x4){0.f, 0.f, 0.f, 0.f};
        } else {
            const float* st = INP(I_SGDN) + (((size_t)l * 32 + b) * 4 + h) * 4096 + n0 + i16;
#pragma unroll
            for (int kt = 0; kt < 4; ++kt)
#pragma unroll
                for (int r = 0; r < 4; ++r) S[kt][r] = st[(16 * kt + 4 * g + r) * 64];
        }
        LDS_BARRIER();
        for (int ci = 0; ci < nch; ++ci) {
            const int chunk = c0 + ci; const size_t row0 = (size_t)chunk * 64;
            const LAS bf16_t* Wn = (const LAS bf16_t*)(F.lds + (ci & 1) * GDN_BUF); const LAS bf16_t* Ut = Wn + 64 * GDN_LD; const LAS bf16_t* Kd = Ut + 64 * GDN_LD;
            const float bd = *(const LAS float*)(Kd + 64 * GDN_LD);
            bf16x8 A1[4][2], A2[4][2]; u32x2 ui[4];
#pragma unroll
            for (int m = 0; m < 4; ++m) { ui[m] = *(const LAS u32x2*)(Ut + (n0 + i16) * GDN_LD + 16 * m + 4 * g);
#pragma unroll
                for (int ks = 0; ks < 2; ++ks) A1[m][ks] = frag_sig(Wn, GDN_LD, 16 * m, 32 * ks, i16, g); }
#pragma unroll
            for (int kt = 0; kt < 4; ++kt)
#pragma unroll
                for (int cs = 0; cs < 2; ++cs) A2[kt][cs] = frag_tr_sig(Kd, GDN_LD, 32 * cs, 16 * kt, i16, g);
            __builtin_amdgcn_sched_barrier(0);
            bf16x8 Sb[2];
#pragma unroll
            for (int ks = 0; ks < 2; ++ks) Sb[ks] = acc_frag(S[2 * ks], S[2 * ks + 1]);
            {
                bf16_t* ho = ((bf16_t*)((unsigned char*)F.out + (size_t)T * 256 * 2 * 4) + (size_t)(chunk) * 16384) + ((size_t)h * 64 + n0 + i16) * 64 + 4 * g;
#pragma unroll
                for (int kt = 0; kt < 4; ++kt) st8_wt(ho + 16 * kt, pack4(S[kt]));
            }
            f32x4 V[4];
            bf16_t* vo = proj + (row0 + n0 + i16) * PW + PC_GV + h * 64 + 4 * g;
#pragma unroll
            for (int m = 0; m < 4; ++m) {
                f32x4 acc = unpack4(ui[m]);
#pragma unroll
                for (int ks = 0; ks < 2; ++ks) acc = mma16(A1[m][ks], Sb[ks], acc);
                V[m] = acc;
            }
#pragma unroll
            for (int m = 0; m < 4; ++m) st8_wt(vo + 16 * m, pack4(V[m]));
            bf16x8 Ub[2];
#pragma unroll
            for (int cs = 0; cs < 2; ++cs) Ub[cs] = acc_frag(V[2 * cs], V[2 * cs + 1]);
#pragma unroll
            for (int kt = 0; kt < 4; ++kt) {
                f32x4 acc = S[kt] * bd;
#pragma unroll
                for (int cs = 0; cs < 2; ++cs) acc = mma16(A2[kt][cs], Ub[cs], acc);
                S[kt] = acc;
            }
            if (prog) {
                asm volatile("s_waitcnt vmcnt(48)" ::: "memory");
                if (lane == 0 && ci >= 6) __hip_atomic_store(prog + 64 * w, pbase + (unsigned)(ci - 6) + 1u, __ATOMIC_RELAXED, __HIP_MEMORY_SCOPE_AGENT);
            }
            LDS_BARRIER();
        }
        asm volatile("s_waitcnt vmcnt(0)" ::: "memory");
        if (prog && lane == 0) __hip_atomic_store(prog + 64 * w, pbase + (unsigned)nch, __ATOMIC_RELAXED, __HIP_MEMORY_SCOPE_AGENT);
        if (done && lane == 0) __hip_atomic_fetch_add(done, 1u, __ATOMIC_RELAXED, __HIP_MEMORY_SCOPE_AGENT);
        float* o = F.out + (s == 0 ? O_P_GDN + ((size_t)l * 4 + h) * 4096 : O_S_GDN + (((size_t)l * 32 + b) * 4 + h) * 4096) + n0 + i16;
#pragma unroll
        for (int kt = 0; kt < 4; ++kt)
#pragma unroll
            for (int r = 0; r < 4; ++r) o[(16 * kt + 4 * g + r) * 64] = S[kt][r];
    }
}
__device__ __forceinline__ void post_gdn(Frame& F, int l, int c, int hp) {
    PHASE_IDS(F);
    const int tid = F.tid, lane = F.lane, w = F.wave, i16 = lane & 15, g = lane >> 4;
    const size_t row0 = (size_t)c * 64;
    bf16_t* const proj = F_PROJ;
    constexpr int LQ = 136;
    LAS bf16_t* Qt = (LAS bf16_t*)F.lds; LAS bf16_t* Kt = Qt + 64 * LQ; LAS bf16_t* Ht = Kt + 64 * LQ; LAS bf16_t* Vn = Ht + 2 * 64 * GDN_LD; LAS float* gcs = (LAS float*)(Vn + 2 * 64 * GDN_LD);
    {
#pragma unroll
        for (int q = 0; q < 2; ++q) { const int idx = q * 512 + tid;
            { const int row = idx >> 4, col8 = (idx & 15) * 8;
              *(LAS u32x4*)(Qt + row * LQ + col8) = *(const u32x4*)(proj + (row0 + row) * PW + PC_GQ + hp * 128 + col8);
              *(LAS u32x4*)(Kt + row * LQ + col8) = *(const u32x4*)(proj + (row0 + row) * PW + PC_GK + hp * 128 + col8); }
            { const int hh = idx >> 9, row = (idx >> 3) & 63, col8 = (idx & 7) * 8;
              *(LAS u32x4*)(Ht + hh * 64 * GDN_LD + row * GDN_LD + col8) = *(const u32x4*)(((bf16_t*)((unsigned char*)F.out + (size_t)T * 256 * 2 * 4) + (size_t)(c) * 16384) + (((size_t)(2 * hp + hh) * 64) + row) * 64 + col8);
              *(LAS u32x4*)(Vn + hh * 64 * GDN_LD + row * GDN_LD + col8) = *(const u32x4*)(proj + (row0 + row) * PW + PC_GV + (2 * hp + hh) * 64 + col8); } }
        if (tid < 128) gcs[tid] = F_GCUM[(row0 + (tid & 63)) * 4 + 2 * hp + (tid >> 6)];
    }
    LDS_BARRIER();
    const int hh = w >> 2, it = w & 3, head = 2 * hp + hh;
    const LAS bf16_t* Hh = Ht + hh * 64 * GDN_LD; const LAS bf16_t* Vh = Vn + hh * 64 * GDN_LD;
    f32x4 AT[4];
    const float gci = gcs[hh * 64 + 16 * it + i16];
#pragma unroll
    for (int jt = 0; jt < 4; ++jt) {
        f32x4 acc = (f32x4){0.f, 0.f, 0.f, 0.f};
        if (jt <= it) {
#pragma unroll
            for (int ks = 0; ks < 2; ++ks) acc = mma16(frag_nat(Kt, LQ, 16 * jt, hh * 64 + 32 * ks, i16, g), frag_nat(Qt, LQ, 16 * it, hh * 64 + 32 * ks, i16, g), acc);
#pragma unroll
            for (int r = 0; r < 4; ++r) { const int j = 16 * jt + 4 * g + r, i = 16 * it + i16; acc[r] *= (j <= i) ? __expf(fminf(gci - gcs[hh * 64 + j], 0.f)) : 0.f; }
        }
        AT[jt] = acc;
    }
    f32x4 O[4]; float ss[4] = {0.f, 0.f, 0.f, 0.f};
#pragma unroll
    for (int vt = 0; vt < 4; ++vt) {
        f32x4 acc = (f32x4){0.f, 0.f, 0.f, 0.f};
#pragma unroll
        for (int ks = 0; ks < 2; ++ks) acc = mma16(frag_nat(Qt, LQ, 16 * it, hh * 64 + 32 * ks, i16, g), frag_nat(Hh, GDN_LD, 16 * vt, 32 * ks, i16, g), acc);
#pragma unroll
        for (int r = 0; r < 4; ++r) acc[r] *= __expf(gcs[hh * 64 + 16 * it + 4 * g + r]);
#pragma unroll
        for (int cs = 0; cs < 2; ++cs) if (2 * cs <= it) acc = mma16(acc_frag(AT[2 * cs], AT[2 * cs + 1]), frag_sig(Vh, GDN_LD, 16 * vt, 32 * cs, i16, g), acc);
        O[vt] = acc;
#pragma unroll
        for (int r = 0; r < 4; ++r) ss[r] += acc[r] * acc[r];
    }
#pragma unroll
    for (int r = 0; r < 4; ++r) { float t = ss[r]; t += __shfl_xor(t, 1); t += __shfl_xor(t, 2); t += __shfl_xor(t, 4); t += __shfl_xor(t, 8); ss[r] = rsqrtf(t * (1.f / 64.f) + EPS); }
#pragma unroll
    for (int vt = 0; vt < 4; ++vt) { const int v = 16 * vt + i16; const float nw = INP(I_GNORMW)[l * 64 + v];
#pragma unroll
        for (int r = 0; r < 4; ++r) { bf16_t* p = proj + (row0 + 16 * it + 4 * g + r) * PW + PC_ZG + head * 64 + v; *p = f2bf(O[vt][r] * ss[r] * nw * siluf_(bf2f(*p))); } }
    LDS_BARRIER();
}

constexpr int RW_LD = 72;
constexpr int RW_XD = 0, RW_XA = 9216, RW_WD = 18432, RW_WA = 27648, RW_RT = 36864, RW_KX = 46080, RW_VT = 55296, RW_XG = 64512, RW_WG = 81920, RW_EX = 100352;
constexpr int RW_L = 64512, RW_P = 81920;
struct RwkvTok { float cum[2][4], lw[2][4], iclr[2][4], kk[2][4], kp[2][4], kraw[2][4], c63[2], w0[2], a0[2], kkw[2], kaw[2]; };
template <bool POST>
__device__ __forceinline__ void rwkv_tokens(Frame& F, int l, int c, int h, RwkvTok& o, f32x4 (&Zg)[2]) {
    const int tid = F.tid, lane = F.lane, w = F.wave, i16 = lane & 15, g = lane >> 4, tt = w & 3, jh = w >> 2;
    const size_t row0 = (size_t)c * 64;
    bf16_t* const proj = F_PROJ;
    LAS bf16_t* Xd = (LAS bf16_t*)(F.lds + RW_XD); LAS bf16_t* Xa = (LAS bf16_t*)(F.lds + RW_XA); LAS bf16_t* Wd = (LAS bf16_t*)(F.lds + RW_WD); LAS bf16_t* Wa = (LAS bf16_t*)(F.lds + RW_WA);
    LAS bf16_t* Rt = (LAS bf16_t*)(F.lds + RW_RT); LAS bf16_t* Kx = (LAS bf16_t*)(F.lds + RW_KX); LAS bf16_t* Vt = (LAS bf16_t*)(F.lds + RW_VT);
    LAS bf16_t* Xg = (LAS bf16_t*)(F.lds + RW_XG); LAS bf16_t* Wg = (LAS bf16_t*)(F.lds + RW_WG);
    LAS float* ksq = (LAS float*)(F.lds + RW_EX); LAS float* ctot = ksq + 128;
    const int lt0 = (tid >> 5) * 4, lo8 = (tid & 31) * 8;
    const int wi = tid >> 3, wj8 = (tid & 7) * 8;
    const int rt = tid >> 3, rd8 = (tid & 7) * 8;
    u32x4 lx[4], lprev_b = (u32x4){0u, 0u, 0u, 0u}; f32x4 lprev_f[2], lmu[2];
    f32x4 wdv[2], wav[2], wgv[4];
    u32x4 rx[3], rpv_b[3]; f32x4 rpv_f[3][2], rmu[3][2];
    const bool smp = c >= 256;
    {
        const float* mup = INP(I_RMU) + l * 1024;
        const float* stp = INP(I_SSHIFT) + ((size_t)l * 32 + (smp ? c - 256 : 0)) * 1024;
        const int col = PC_RL + lo8;
        lmu[0] = *(const f32x4*)(mup + 768 + lo8); lmu[1] = *(const f32x4*)(mup + 768 + lo8 + 4);
        if (lt0 > 0) lprev_b = *(const u32x4*)(proj + (row0 + lt0 - 1) * PW + col);
        else if (!smp) { if (c > 0) lprev_b = *(const u32x4*)(F_HSHIFT + (size_t)(c - 1) * 1024 + 768 + lo8); }
        else { lprev_f[0] = *(const f32x4*)(stp + 768 + lo8); lprev_f[1] = *(const f32x4*)(stp + 768 + lo8 + 4); }
#pragma unroll
        for (int q = 0; q < 4; ++q) lx[q] = *(const u32x4*)(proj + (row0 + lt0 + q) * PW + col);
        { const float* p = INP(I_RWUP) + ((size_t)l * 64 + wi) * 256 + h * 64 + wj8; wdv[0] = *(const f32x4*)p; wdv[1] = *(const f32x4*)(p + 4); }
        { const float* p = INP(I_RAUP) + ((size_t)l * 64 + wi) * 256 + h * 64 + wj8; wav[0] = *(const f32x4*)p; wav[1] = *(const f32x4*)(p + 4); }
        if (POST) {
#pragma unroll
            for (int q2 = 0; q2 < 2; ++q2) { const float* p = INP(I_RGUP) + ((size_t)l * 128 + wi + 64 * q2) * 256 + h * 64 + wj8; wgv[2 * q2] = *(const f32x4*)p; wgv[2 * q2 + 1] = *(const f32x4*)(p + 4); }
        }
#pragma unroll
        for (int which = 0; which < 3; ++which) {
            const int pcol = (which == 0 ? PC_R : (which == 1 ? PC_RK : PC_RV)) + h * 64 + rd8, oc = which * 256 + h * 64 + rd8;
            const bf16_t* p = proj + (row0 + rt) * PW + pcol;
            rx[which] = *(const u32x4*)p;
            if (!POST) {
                rmu[which][0] = *(const f32x4*)(mup + oc); rmu[which][1] = *(const f32x4*)(mup + oc + 4);
                rpv_b[which] = (u32x4){0u, 0u, 0u, 0u};
                if (rt > 0) rpv_b[which] = *(const u32x4*)(p - PW);
                else if (!smp) { if (c > 0) rpv_b[which] = *(const u32x4*)(F_HSHIFT + (size_t)(c - 1) * 1024 + oc); }
                else { rpv_f[which][0] = *(const f32x4*)(stp + oc); rpv_f[which][1] = *(const f32x4*)(stp + oc + 4); }
            }
        }
#pragma unroll
        for (int q = 0; q < 2; ++q) { const int jc = l * 256 + h * 64 + 16 * (2 * jh + q) + i16;
            o.w0[q] = INP(I_RW0)[jc]; o.a0[q] = INP(I_RA0)[jc]; o.kkw[q] = INP(I_RKK)[jc]; o.kaw[q] = INP(I_RKA)[jc]; }
    }
    {
        float prev[8], mu[8] = {lmu[0][0], lmu[0][1], lmu[0][2], lmu[0][3], lmu[1][0], lmu[1][1], lmu[1][2], lmu[1][3]};
        if (lt0 == 0 && smp) { prev[0] = lprev_f[0][0]; prev[1] = lprev_f[0][1]; prev[2] = lprev_f[0][2]; prev[3] = lprev_f[0][3]; prev[4] = lprev_f[1][0]; prev[5] = lprev_f[1][1]; prev[6] = lprev_f[1][2]; prev[7] = lprev_f[1][3]; }
        else unpack8(lprev_b, prev);
#pragma unroll
        for (int q = 0; q < 4; ++q) {
            float x[8], y[8]; unpack8(lx[q], x);
#pragma unroll
            for (int i = 0; i < 8; ++i) { const float v = x[i] + (prev[i] - x[i]) * mu[i]; prev[i] = x[i]; y[i] = (lo8 < 64) ? tanhf_(v) : (lo8 >= 128 ? sigmoidf_(v) : v); }
            const u32x4 pk = pack8(y);
            if (lo8 < 64) *(LAS u32x4*)(Xd + (lt0 + q) * RW_LD + lo8) = pk;
            else if (lo8 < 128) *(LAS u32x4*)(Xa + (lt0 + q) * RW_LD + (lo8 - 64)) = pk;
            else if (POST) *(LAS u32x4*)(Xg + (lt0 + q) * 136 + (lo8 - 128)) = pk;
        }
        { const float v[8] = {wdv[0][0], wdv[0][1], wdv[0][2], wdv[0][3], wdv[1][0], wdv[1][1], wdv[1][2], wdv[1][3]}; *(LAS u32x4*)(Wd + wi * RW_LD + wj8) = pack8(v); }
        { const float v[8] = {wav[0][0], wav[0][1], wav[0][2], wav[0][3], wav[1][0], wav[1][1], wav[1][2], wav[1][3]}; *(LAS u32x4*)(Wa + wi * RW_LD + wj8) = pack8(v); }
        if (POST) {
#pragma unroll
            for (int q2 = 0; q2 < 2; ++q2) { const float v[8] = {wgv[2 * q2][0], wgv[2 * q2][1], wgv[2 * q2][2], wgv[2 * q2][3], wgv[2 * q2 + 1][0], wgv[2 * q2 + 1][1], wgv[2 * q2 + 1][2], wgv[2 * q2 + 1][3]};
                *(LAS u32x4*)(Wg + (wi + 64 * q2) * RW_LD + wj8) = pack8(v); }
        }
        u32x4 pk3[3];
#pragma unroll
        for (int which = 0; which < 3; ++which) {
            LAS bf16_t* dst = (which == 0 ? Rt : (which == 1 ? Kx : Vt)) + rt * RW_LD + rd8;
            if (POST) *(LAS u32x4*)dst = rx[which];
            else {
                float x[8], pv[8], y[8];
                unpack8(rx[which], x);
                if (rt == 0 && smp) { pv[0] = rpv_f[which][0][0]; pv[1] = rpv_f[which][0][1]; pv[2] = rpv_f[which][0][2]; pv[3] = rpv_f[which][0][3]; pv[4] = rpv_f[which][1][0]; pv[5] = rpv_f[which][1][1]; pv[6] = rpv_f[which][1][2]; pv[7] = rpv_f[which][1][3]; }
                else unpack8(rpv_b[which], pv);
#pragma unroll
                for (int i = 0; i < 8; ++i) y[i] = x[i] + (pv[i] - x[i]) * rmu[which][i >> 2][i & 3];
                pk3[which] = pack8(y);
                *(LAS u32x4*)dst = pk3[which];
            }
        }
        if (!POST) {
            LDS_BARRIER();
#pragma unroll
            for (int which = 0; which < 3; ++which) *(u32x4*)(proj + (row0 + rt) * PW + (which == 0 ? PC_R : (which == 1 ? PC_RK : PC_RV)) + h * 64 + rd8) = pk3[which];
        }
    }
    LDS_BARRIER();
    f32x4 Zd[2], Za[2];
#pragma unroll
    for (int q = 0; q < 2; ++q) {
        const int jt = 2 * jh + q;
        f32x4 a = (f32x4){0.f, 0.f, 0.f, 0.f}, bq = a, cq = a;
#pragma unroll
        for (int ks = 0; ks < 2; ++ks) {
            a = mma16(frag_nat(Xd, RW_LD, 16 * tt, 32 * ks, i16, g), frag_tr_nat(Wd, RW_LD, 32 * ks, 16 * jt, i16, g), a);
            bq = mma16(frag_nat(Xa, RW_LD, 16 * tt, 32 * ks, i16, g), frag_tr_nat(Wa, RW_LD, 32 * ks, 16 * jt, i16, g), bq);
        }
        if (POST) {
#pragma unroll
            for (int ks = 0; ks < 4; ++ks) cq = mma16(frag_nat(Xg, 136, 16 * tt, 32 * ks, i16, g), frag_tr_nat(Wg, RW_LD, 32 * ks, 16 * jt, i16, g), cq);
        }
        Zd[q] = a; Za[q] = bq; Zg[q] = cq;
    }
    float ksum[4] = {0.f, 0.f, 0.f, 0.f}, csum[2];
#pragma unroll
    for (int q = 0; q < 2; ++q) {
        const int j = 16 * (2 * jh + q) + i16, jc = l * 256 + h * 64 + j;
        const float w0 = o.w0[q], a0 = o.a0[q], kkw = o.kkw[q];
        float run = 0.f;
#pragma unroll
        for (int r = 0; r < 4; ++r) {
            const int t = 16 * tt + 4 * g + r;
            const float wl = -softplusf_(-(w0 + Zd[q][r])) - 0.5f;
            const float lw = -__expf(wl);
            o.lw[q][r] = lw; run += lw; o.cum[q][r] = run;
            o.iclr[q][r] = sigmoidf_(a0 + Za[q][r]);
            const float kr = bf2f(Kx[t * RW_LD + j]); o.kraw[q][r] = kr;
            const float kq = kr * kkw; o.kk[q][r] = kq; ksum[r] += kq * kq;
        }
        float tot = run;
        const float u1 = __shfl_up(tot, 16); if (g >= 1) tot += u1;
        const float u2 = __shfl_up(tot, 32); if (g >= 2) tot += u2;
        const float excl = tot - run;
#pragma unroll
        for (int r = 0; r < 4; ++r) o.cum[q][r] += excl;
        csum[q] = __shfl(tot, 48 + i16);
        if (g == 0) ctot[tt * 64 + j] = csum[q];
    }
#pragma unroll
    for (int r = 0; r < 4; ++r) { float s = ksum[r]; s += __shfl_xor(s, 1); s += __shfl_xor(s, 2); s += __shfl_xor(s, 4); s += __shfl_xor(s, 8); ksum[r] = s; }
    if (i16 == 0) {
#pragma unroll
        for (int r = 0; r < 4; ++r) ksq[jh * 64 + 16 * tt + 4 * g + r] = ksum[r];
    }
    LDS_BARRIER();
#pragma unroll
    for (int q = 0; q < 2; ++q) {
        const int j = 16 * (2 * jh + q) + i16, jc = l * 256 + h * 64 + j;
        const float kaw = o.kaw[q];
        float pre = 0.f, all = 0.f;
#pragma unroll
        for (int t4 = 0; t4 < 4; ++t4) { const float v = ctot[t4 * 64 + j]; all += v; if (t4 < tt) pre += v; }
        o.c63[q] = all;
#pragma unroll
        for (int r = 0; r < 4; ++r) {
            const int t = 16 * tt + 4 * g + r;
            o.cum[q][r] += pre;
            const float kn = rsqrtf(ksq[t] + ksq[64 + t] + EPS);
            o.kk[q][r] *= kn;
            o.kp[q][r] = o.kraw[q][r] * (1.f + (o.iclr[q][r] - 1.f) * kaw);
        }
    }
}
__device__ __forceinline__ void prep_rwkv(Frame& F, int l, int c, int h) {
    PHASE_IDS(F);
    const int lane = F.lane, w = F.wave, i16 = lane & 15, g = lane >> 4, tt = w & 3, jh = w >> 2;
    RwkvTok tk; f32x4 Zg[2];
    rwkv_tokens<false>(F, l, c, h, tk, Zg);
    LAS bf16_t* At = (LAS bf16_t*)(F.lds + RW_XD); LAS bf16_t* Bt = (LAS bf16_t*)(F.lds + RW_XA); LAS bf16_t* Kt = (LAS bf16_t*)(F.lds + RW_WD); LAS bf16_t* Kh = (LAS bf16_t*)(F.lds + RW_WA);
    LAS bf16_t* Vt = (LAS bf16_t*)(F.lds + RW_VT); LAS float* Lm = (LAS float*)(F.lds + RW_L); LAS float* Pm = (LAS float*)(F.lds + RW_P);
    bf16_t* const bh = F_RBH + (((size_t)c * 4 + h) * 64) * 64;
    LDS_BARRIER();
#pragma unroll
    for (int q = 0; q < 2; ++q) {
        const int j = 16 * (2 * jh + q) + i16;
#pragma unroll
        for (int r = 0; r < 4; ++r) {
            const int t = 16 * tt + 4 * g + r;
            const float cum = tk.cum[q][r], b = tk.kk[q][r] * tk.iclr[q][r], einv = __expf(-cum), elast = __expf(tk.c63[q] - cum);
            At[t * RW_LD + j] = f2bf(-tk.kk[q][r] * __expf(cum - tk.lw[q][r]));
            Bt[t * RW_LD + j] = f2bf(b * einv);
            Kt[t * RW_LD + j] = f2bf(tk.kp[q][r] * einv);
            Kh[t * RW_LD + j] = f2bf(tk.kp[q][r] * elast);
            bh[t * 64 + j] = f2bf(b * elast);
        }
        if (tt == 0 && g == 0) F_RDV[((size_t)c * 4 + h) * 64 + j] = __expf(tk.c63[q]);
    }
    LDS_BARRIER();
    if (jh == 0) {
#pragma unroll
        for (int st = 0; st < 4; ++st) if (st <= tt) {
            f32x4 acc = (f32x4){0.f, 0.f, 0.f, 0.f};
#pragma unroll
            for (int ks = 0; ks < 2; ++ks) acc = mma16(frag_nat(At, RW_LD, 16 * tt, 32 * ks, i16, g), frag_nat(Bt, RW_LD, 16 * st, 32 * ks, i16, g), acc);
#pragma unroll
            for (int r = 0; r < 4; ++r) { const int t = 16 * tt + 4 * g + r, s = 16 * st + i16; Lm[t * 68 + s] = (s < t) ? acc[r] : 0.f; }
        }
    }
    {
        f32x4 AK[4];
#pragma unroll
        for (int st = 0; st < 4; ++st) {
            f32x4 acc = (f32x4){0.f, 0.f, 0.f, 0.f};
            if (st <= tt) {
#pragma unroll
                for (int ks = 0; ks < 2; ++ks) acc = mma16(frag_nat(Kt, RW_LD, 16 * st, 32 * ks, i16, g), frag_nat(At, RW_LD, 16 * tt, 32 * ks, i16, g), acc);
#pragma unroll
                for (int r = 0; r < 4; ++r) { const int s = 16 * st + 4 * g + r, t = 16 * tt + i16; if (!(s < t)) acc[r] = 0.f; }
            }
            AK[st] = acc;
        }
#pragma unroll
        for (int q = 0; q < 2; ++q) {
            const int vt = 2 * jh + q;
            f32x4 acc = (f32x4){0.f, 0.f, 0.f, 0.f};
#pragma unroll
            for (int cs = 0; cs < 2; ++cs) if (2 * cs <= tt) acc = mma16(acc_frag(AK[2 * cs], AK[2 * cs + 1]), frag_tr_sig(Vt, RW_LD, 32 * cs, 16 * vt, i16, g), acc);
#pragma unroll
            for (int r = 0; r < 4; ++r) Pm[(16 * tt + 4 * g + r) * 68 + 16 * vt + i16] = acc[r];
            f32x4 kv = (f32x4){0.f, 0.f, 0.f, 0.f};
#pragma unroll
            for (int cs = 0; cs < 2; ++cs) kv = mma16(frag_tr_nat(Kh, RW_LD, 32 * cs, 16 * tt, i16, g), frag_tr_nat(Vt, RW_LD, 32 * cs, 16 * vt, i16, g), kv);
            *(u32x2*)(F_RKV + ((((size_t)c * 4 + h) * 64) + 16 * vt + i16) * 64 + 16 * tt + 4 * g) = pack4(kv);
        }
    }
    LDS_BARRIER();
    if (w < 2) {
        float x[64];
        const float ef = (float)w;
        const LAS float* Lo = opaque_lds(Lm); const LAS float* Po = opaque_lds(Pm + lane); const LAS bf16_t* Ao = opaque_lds(At + lane);
        tri_solve64<68, 1>(Lo, x, [&](int i) { return Po[i * 68] * (1.f - ef) + bf2f(Ao[i * RW_LD]) * ef; });
        if (w == 0) {
            bf16_t* o = F_RU + ((((size_t)c * 4 + h) * 64) + lane) * 64;
#pragma unroll
            for (int q = 0; q < 8; ++q) { float y[8];
#pragma unroll
                for (int i = 0; i < 8; ++i) y[i] = x[8 * q + i];
                *(u32x4*)(o + 8 * q) = pack8(y); }
        } else {
            bf16_t* o = F_RWA + (((size_t)c * 4 + h) * 64) * 64 + lane;
#pragma unroll
            for (int i = 0; i < 64; ++i) o[i * 64] = f2bf(x[i]);
        }
    }
    publish_item((unsigned*)(F.ws + WS_CTL) + CW_RFLAG + 4 * c + h);
    LDS_BARRIER();
}
constexpr int RWS_BUF = 4 * 64 * GDN_LD * 2 + 256;
__device__ __forceinline__ void scan_rwkv2(Frame& F, int l, int s, int h, int vb, int ncw, unsigned* prog, unsigned pbase, unsigned* done, int pm, const unsigned* rdy, int rstride, unsigned rneed) {
    PHASE_IDS(F);
    const int tid = F.tid, lane = F.lane, w = F.wave, i16 = lane & 15, g = lane >> 4;
    const int nch = (s == 0) ? 256 : 1, c0 = (s == 0) ? 0 : 255 + s, b = s - 1;
    const bf16_t* const rwa = F_RWA; bf16_t* const ru = F_RU; const bf16_t* const rbh = F_RBH; const bf16_t* const rkv = F_RKV; const float* const rdv = F_RDV;
    {
        if (w == (ncw < 4 ? ncw : 0)) (void)rdy_block(F, rdy, rstride, rneed, 0, nch < RDY_SLACK ? nch : RDY_SLACK, nch);
        LDS_BARRIER();
    }
    if (w >= 4) {
        const int lt = tid - 256;
        const int umask = 128 * ncw - 1;
        u32x4 r10[2], r20[2], r30[2], r40[2], r11[2], r21[2], r31[2], r41[2], r12[2], r22[2], r32[2], r42[2], r13[2], r23[2], r33[2], r43[2], r14[2], r24[2], r34[2], r44[2], r15[2], r25[2], r35[2], r45[2]; float dv0 = 0.f, dv1 = 0.f, dv2 = 0.f, dv3 = 0.f, dv4 = 0.f, dv5 = 0.f;
        const bf16_t* p1[2]; const bf16_t* p2[2]; const bf16_t* p3[2]; const bf16_t* p4[2]; const float* const pDv = rdv + h * 64 + (lt & 63);
#pragma unroll
        for (int q = 0; q < 2; ++q) { const int idx = q * 256 + lt, off = (idx >> 3) * 64 + (idx & 7) * 8, uoff = (vb + ((idx & umask) >> 3)) * 64 + (idx & 7) * 8;
            p1[q] = rwa + (size_t)h * 4096 + off; p2[q] = ru + (size_t)h * 4096 + uoff; p3[q] = rbh + (size_t)h * 4096 + off; p4[q] = rkv + (size_t)h * 4096 + uoff; }
#define RWS_LOAD(ch, S) do { const size_t o_ = (size_t)(ch) * (4 * 4096); dv##S = ld4_asm(pDv + (size_t)(ch) * 256); \
        _Pragma("unroll") for (int q = 0; q < 2; ++q) { r1##S[q] = ld16_asm(p1[q] + o_); r2##S[q] = ld16_asm(p2[q] + o_); r3##S[q] = ld16_asm(p3[q] + o_); r4##S[q] = ld16_asm(p4[q] + o_); } } while (0)
#define RWS_WAIT(S, N) asm volatile("s_waitcnt vmcnt(%9)" : "+v"(r1##S[0]), "+v"(r1##S[1]), "+v"(r2##S[0]), "+v"(r2##S[1]), "+v"(r3##S[0]), "+v"(r3##S[1]), "+v"(r4##S[0]), "+v"(r4##S[1]), "+v"(dv##S) : "n"(N))
#define RWS_WRITE(bb, S) do { LAS bf16_t* Wn_ = (LAS bf16_t*)(F.lds + (bb) * RWS_BUF); \
        _Pragma("unroll") for (int q = 0; q < 2; ++q) { const int idx = q * 256 + lt, off = (idx >> 3) * GDN_LD + (idx & 7) * 8, uoff = (vb + ((idx & umask) >> 3)) * GDN_LD + (idx & 7) * 8; \
            *(LAS u32x4*)(Wn_ + off) = r1##S[q]; *(LAS u32x4*)(Wn_ + 64 * GDN_LD + uoff) = r2##S[q]; *(LAS u32x4*)(Wn_ + 2 * 64 * GDN_LD + off) = r3##S[q]; *(LAS u32x4*)(Wn_ + 3 * 64 * GDN_LD + uoff) = r4##S[q]; } \
        if (lt < 64) ((LAS float*)(Wn_ + 4 * 64 * GDN_LD))[lt] = dv##S; } while (0)
        SCAN_LOADER6(RWS_LOAD, RWS_WRITE, RWS_WAIT, 9);
#undef RWS_LOAD
#undef RWS_WRITE
#undef RWS_WAIT
    } else if (w >= ncw) {
        int nxt = nch < RDY_SLACK ? nch : RDY_SLACK;
        LDS_BARRIER();
        for (int ci = 0; ci < nch; ++ci) {
            if (w == ncw && nxt < nch) { const int upto = ci + 1 + RDY_SLACK < nch ? ci + 1 + RDY_SLACK : nch; nxt = rdy_block(F, rdy, rstride, rneed, nxt, upto, nch); }
            LDS_BARRIER();
        }
    } else {
        const int n0 = vb + 16 * w;
        f32x4 S[4];
        if (s == 0) {
#pragma unroll
            for (int kt = 0; kt < 4; ++kt) S[kt] = (f32x4){0.f, 0.f, 0.f, 0.f};
        } else {
            const float* st = INP(I_SRWKV) + (((size_t)l * 32 + b) * 4 + h) * 4096 + (n0 + i16) * 64 + 4 * g;
#pragma unroll
            for (int kt = 0; kt < 4; ++kt) S[kt] = *(const f32x4*)(st + 16 * kt);
        }
        LDS_BARRIER();
        for (int ci = 0; ci < nch; ++ci) {
            const size_t b0 = (((size_t)(c0 + ci)) * 4 + h) * 4096;
            const LAS bf16_t* Wn = (const LAS bf16_t*)(F.lds + (ci & 1) * RWS_BUF); const LAS bf16_t* Ut = Wn + 64 * GDN_LD; const LAS bf16_t* Bh = Ut + 64 * GDN_LD; const LAS bf16_t* KVt = Bh + 64 * GDN_LD;
            const LAS float* dvec = (const LAS float*)(KVt + 64 * GDN_LD);
            bf16x8 A1[4][2], A2[4][2]; u32x2 ui[4], kvi[4]; f32x4 dq[4];
#pragma unroll
            for (int m = 0; m < 4; ++m) { ui[m] = *(const LAS u32x2*)(Ut + (n0 + i16) * GDN_LD + 16 * m + 4 * g);
#pragma unroll
                for (int ks = 0; ks < 2; ++ks) A1[m][ks] = frag_sig(Wn, GDN_LD, 16 * m, 32 * ks, i16, g); }
#pragma unroll
            for (int kt = 0; kt < 4; ++kt) { kvi[kt] = *(const LAS u32x2*)(KVt + (n0 + i16) * GDN_LD + 16 * kt + 4 * g); dq[kt] = *(const LAS f32x4*)(dvec + 16 * kt + 4 * g);
#pragma unroll
                for (int cs = 0; cs < 2; ++cs) A2[kt][cs] = frag_tr_sig(Bh, GDN_LD, 32 * cs, 16 * kt, i16, g); }
            __builtin_amdgcn_sched_barrier(0);
            bf16x8 Sb[2];
#pragma unroll
            for (int ks = 0; ks < 2; ++ks) Sb[ks] = acc_frag(S[2 * ks], S[2 * ks + 1]);
            {
                bf16_t* ho = F_RKV + b0 + (n0 + i16) * 64 + 4 * g;
#pragma unroll
                for (int kt = 0; kt < 4; ++kt) st8_wt(ho + 16 * kt, pack4(S[kt]));
            }
            f32x4 V[4];
            bf16_t* vo = ru + b0 + (n0 + i16) * 64 + 4 * g;
#pragma unroll
            for (int m = 0; m < 4; ++m) {
                f32x4 acc = unpack4(ui[m]);
#pragma unroll
                for (int ks = 0; ks < 2; ++ks) acc = mma16(A1[m][ks], Sb[ks], acc);
                V[m] = acc;
            }
#pragma unroll
            for (int m = 0; m < 4; ++m) st8_wt(vo + 16 * m, pack4(V[m]));
            bf16x8 Ub[2];
#pragma unroll
            for (int cs = 0; cs < 2; ++cs) Ub[cs] = acc_frag(V[2 * cs], V[2 * cs + 1]);
#pragma unroll
            for (int kt = 0; kt < 4; ++kt) {
                f32x4 acc = S[kt] * dq[kt] + unpack4(kvi[kt]);
#pragma unroll
                for (int cs = 0; cs < 2; ++cs) acc = mma16(A2[kt][cs], Ub[cs], acc);
                S[kt] = acc;
            }
            if (prog) {
                asm volatile("s_waitcnt vmcnt(48)" ::: "memory");
                if (lane == 0 && ci >= 6) __hip_atomic_store(prog + 64 * w, pbase + (unsigned)(ci - 6) + 1u, __ATOMIC_RELAXED, __HIP_MEMORY_SCOPE_AGENT);
            }
            LDS_BARRIER();
        }
        asm volatile("s_waitcnt vmcnt(0)" ::: "memory");
        if (prog && lane == 0) __hip_atomic_store(prog + 64 * w, pbase + (unsigned)nch, __ATOMIC_RELAXED, __HIP_MEMORY_SCOPE_AGENT);
        if (done && lane == 0) __hip_atomic_fetch_add(done, 1u, __ATOMIC_RELAXED, __HIP_MEMORY_SCOPE_AGENT);
        float* o = F.out + (s == 0 ? O_P_RWKV + ((size_t)l * 4 + h) * 4096 : O_S_RWKV + (((size_t)l * 32 + b) * 4 + h) * 4096) + (n0 + i16) * 64 + 4 * g;
#pragma unroll
        for (int kt = 0; kt < 4; ++kt) *(f32x4*)(o + 16 * kt) = S[kt];
    }
}
__device__ __forceinline__ void post_rwkv(Frame& F, int l, int c, int h) {
    PHASE_IDS(F);
    const int tid = F.tid, lane = F.lane, w = F.wave, i16 = lane & 15, g = lane >> 4, tt = w & 3, jh = w >> 2;
    const size_t row0 = (size_t)c * 64;
    RwkvTok tk; f32x4 Zg[2];
    rwkv_tokens<true>(F, l, c, h, tk, Zg);
    LAS bf16_t* Rd = (LAS bf16_t*)(F.lds + RW_XD); LAS bf16_t* Bt = (LAS bf16_t*)(F.lds + RW_XA); LAS bf16_t* Kt = (LAS bf16_t*)(F.lds + RW_WD); LAS bf16_t* Utl = (LAS bf16_t*)(F.lds + RW_WA);
    LAS bf16_t* Rt = (LAS bf16_t*)(F.lds + RW_RT); LAS bf16_t* Htl = (LAS bf16_t*)(F.lds + RW_KX); LAS bf16_t* Vt = (LAS bf16_t*)(F.lds + RW_VT);
    LAS float* ex = (LAS float*)(F.lds + RW_EX) + 512;
    float rr[2][4];
#pragma unroll
    for (int q = 0; q < 2; ++q)
#pragma unroll
        for (int r = 0; r < 4; ++r) rr[q][r] = bf2f(Rt[(16 * tt + 4 * g + r) * RW_LD + 16 * (2 * jh + q) + i16]);
    LDS_BARRIER();
#pragma unroll
    for (int q = 0; q < 2; ++q) {
        const int j = 16 * (2 * jh + q) + i16;
#pragma unroll
        for (int r = 0; r < 4; ++r) {
            const int t = 16 * tt + 4 * g + r;
            const float cum = tk.cum[q][r], einv = __expf(-cum);
            Rd[t * RW_LD + j] = f2bf(rr[q][r] * __expf(cum));
            Bt[t * RW_LD + j] = f2bf(tk.kk[q][r] * tk.iclr[q][r] * einv);
            Kt[t * RW_LD + j] = f2bf(tk.kp[q][r] * einv);
        }
    }
    {
        const int row = tid >> 3, col8 = (tid & 7) * 8; const size_t b0 = (((size_t)c * 4 + h) * 64 + row) * 64 + col8;
        *(LAS u32x4*)(Utl + row * RW_LD + col8) = *(const u32x4*)(F_RU + b0);
        *(LAS u32x4*)(Htl + row * RW_LD + col8) = *(const u32x4*)(F_RKV + b0);
    }
    LDS_BARRIER();
    f32x4 QB[4], QK[4];
#pragma unroll
    for (int st = 0; st < 4; ++st) {
        f32x4 a = (f32x4){0.f, 0.f, 0.f, 0.f}, bq = a;
        if (st <= tt) {
#pragma unroll
            for (int ks = 0; ks < 2; ++ks) {
                const bf16x8 rf = frag_nat(Rd, RW_LD, 16 * tt, 32 * ks, i16, g);
                a = mma16(frag_nat(Bt, RW_LD, 16 * st, 32 * ks, i16, g), rf, a);
                bq = mma16(frag_nat(Kt, RW_LD, 16 * st, 32 * ks, i16, g), rf, bq);
            }
#pragma unroll
            for (int r = 0; r < 4; ++r) { const int s = 16 * st + 4 * g + r, t = 16 * tt + i16; if (!(s <= t)) { a[r] = 0.f; bq[r] = 0.f; } }
        }
        QB[st] = a; QK[st] = bq;
    }
    f32x4 Y[2]; float s1[4] = {0.f, 0.f, 0.f, 0.f}, s2[4] = {0.f, 0.f, 0.f, 0.f}, bon[4] = {0.f, 0.f, 0.f, 0.f};
#pragma unroll
    for (int q = 0; q < 2; ++q) {
        const int vt = 2 * jh + q;
        f32x4 acc = (f32x4){0.f, 0.f, 0.f, 0.f};
#pragma unroll
        for (int ks = 0; ks < 2; ++ks) acc = mma16(frag_nat(Rd, RW_LD, 16 * tt, 32 * ks, i16, g), frag_nat(Htl, RW_LD, 16 * vt, 32 * ks, i16, g), acc);
#pragma unroll
        for (int cs = 0; cs < 2; ++cs) if (2 * cs <= tt) {
            acc = mma16(acc_frag(QB[2 * cs], QB[2 * cs + 1]), frag_sig(Utl, RW_LD, 16 * vt, 32 * cs, i16, g), acc);
            acc = mma16(acc_frag(QK[2 * cs], QK[2 * cs + 1]), frag_tr_sig(Vt, RW_LD, 32 * cs, 16 * vt, i16, g), acc);
        }
        Y[q] = acc;
        const float rkw = INP(I_RRK)[l * 256 + h * 64 + 16 * vt + i16];
#pragma unroll
        for (int r = 0; r < 4; ++r) { s1[r] += acc[r]; s2[r] += acc[r] * acc[r]; bon[r] += rr[q][r] * tk.kp[q][r] * rkw; }
    }
#pragma unroll
    for (int r = 0; r < 4; ++r) {
        float a = s1[r], bq = s2[r], cq = bon[r];
#pragma unroll
        for (int o = 1; o < 16; o <<= 1) { a += __shfl_xor(a, o); bq += __shfl_xor(bq, o); cq += __shfl_xor(cq, o); }
        if (i16 == 0) { const int t = 16 * tt + 4 * g + r; ex[(0 * 2 + jh) * 64 + t] = a; ex[(1 * 2 + jh) * 64 + t] = bq; ex[(2 * 2 + jh) * 64 + t] = cq; }
    }
    LDS_BARRIER();
    bf16_t* const proj = F_PROJ;
#pragma unroll
    for (int q = 0; q < 2; ++q) {
        const int v = 16 * (2 * jh + q) + i16, vc = l * 256 + h * 64 + v;
        const float lnw = INP(I_RLNW)[vc], lnb = INP(I_RLNB)[vc];
#pragma unroll
        for (int r = 0; r < 4; ++r) {
            const int t = 16 * tt + 4 * g + r;
            const float mean = (ex[t] + ex[64 + t]) * (1.f / 64.f);
            const float var = fmaxf((ex[128 + t] + ex[192 + t]) * (1.f / 64.f) - mean * mean, 0.f);
            const float bonus = (ex[256 + t] + ex[320 + t]) * bf2f(Vt[t * RW_LD + v]);
            const float yn = (Y[q][r] - mean) * rsqrtf(var + 64e-5f) * lnw + lnb;
            proj[(row0 + t) * PW + PC_R + h * 64 + v] = f2bf((yn + bonus) * Zg[q][r]);
        }
    }
    LDS_BARRIER();
}

constexpr int SSD_LDC = 136, SSD_LDX = 72;
constexpr int SSD_BUF = 64 * SSD_LDC * 2 * 2 + 64 * SSD_LDX * 2 + 64;
__device__ __forceinline__ void scan_ssd2(Frame& F, int l, int s, int hd, int vb, int ncw, unsigned* prog, unsigned pbase, unsigned* done, int pm, const unsigned* rdy, int rstride, unsigned rneed) {
    PHASE_IDS(F);
    const int tid = F.tid, lane = F.lane, w = F.wave, i16 = lane & 15, g = lane >> 4;
    const int nch = (s == 0) ? 256 : 1, c0 = (s == 0) ? 0 : 255 + s, b = s - 1, grp = hd >> 2;
    const bf16_t* const proj = F_PROJ; const float* const scal = F_SCAL; const float* const acum = F_ACUM;
    {
        if (w == (ncw < 4 ? ncw : 0)) (void)rdy_block(F, rdy, rstride, rneed, 0, nch < RDY_SLACK ? nch : RDY_SLACK, nch);
        LDS_BARRIER();
    }
    if (w >= 4) {
        const int lt = tid - 256;
        const int umask = 128 * ncw - 1, xsh = (ncw == 4) ? 3 : (ncw == 2 ? 2 : 1);
        u32x4 rc0[4], rb0[4], rx0[2], rc1[4], rb1[4], rx1[2], rc2[4], rb2[4], rx2[2], rc3[4], rb3[4], rx3[2]; float dt0[2], ac0[2], al0, dt1[2], ac1[2], al1, dt2[2], ac2[2], al2, dt3[2], ac3[2], al3;
        const bf16_t* pC[4]; const bf16_t* pB[4]; const bf16_t* pX[2]; const float* pDt[2]; const float* pAc[2]; const float* const pAl = acum + 63 * 8 + hd;
#pragma unroll
        for (int q = 0; q < 4; ++q) { const int idx = q * 256 + lt, row = idx >> 4, col8 = (idx & 15) * 8;
            pC[q] = proj + (size_t)row * PW + PC_SC + grp * 128 + col8; pB[q] = proj + (size_t)row * PW + PC_SB + grp * 128 + col8; }
#pragma unroll
        for (int q = 0; q < 2; ++q) { const int idx = (q * 256 + lt) & umask, row = idx >> xsh, col8 = vb + (idx & ((1 << xsh) - 1)) * 8;
            pX[q] = proj + (size_t)row * PW + PC_SX + hd * 64 + col8; pDt[q] = scal + row * 16 + 8 + hd; pAc[q] = acum + row * 8 + hd; }
#define SSD_LOAD(ch, S) do { const size_t oP_ = (size_t)(ch) * (64 * PW), oS_ = (size_t)(ch) * 1024, oA_ = (size_t)(ch) * 512; al##S = ld4_asm(pAl + oA_); \
        _Pragma("unroll") for (int q = 0; q < 4; ++q) { rc##S[q] = ld16_asm(pC[q] + oP_); rb##S[q] = ld16_asm(pB[q] + oP_); } \
        _Pragma("unroll") for (int q = 0; q < 2; ++q) { rx##S[q] = ld16_asm(pX[q] + oP_); dt##S[q] = ld4_asm(pDt[q] + oS_); ac##S[q] = ld4_asm(pAc[q] + oA_); } } while (0)
#define SSD_WAIT(S, N) asm volatile("s_waitcnt vmcnt(%15)" : "+v"(rc##S[0]), "+v"(rc##S[1]), "+v"(rc##S[2]), "+v"(rc##S[3]), "+v"(rb##S[0]), "+v"(rb##S[1]), "+v"(rb##S[2]), "+v"(rb##S[3]), \
        "+v"(rx##S[0]), "+v"(rx##S[1]), "+v"(dt##S[0]), "+v"(dt##S[1]), "+v"(ac##S[0]), "+v"(ac##S[1]), "+v"(al##S) : "n"(N))
#define SSD_WRITE(bb, S) do { LAS bf16_t* Ct_ = (LAS bf16_t*)(F.lds + (bb) * SSD_BUF); LAS bf16_t* Bt_ = Ct_ + 64 * SSD_LDC; LAS bf16_t* Xt_ = Bt_ + 64 * SSD_LDC; \
        _Pragma("unroll") for (int q = 0; q < 4; ++q) { const int idx = q * 256 + lt, row = idx >> 4, col8 = (idx & 15) * 8; \
            *(LAS u32x4*)(Ct_ + row * SSD_LDC + col8) = rc##S[q]; *(LAS u32x4*)(Bt_ + row * SSD_LDC + col8) = rb##S[q]; } \
        _Pragma("unroll") for (int q = 0; q < 2; ++q) { const int idx = (q * 256 + lt) & umask, row = idx >> xsh, col8 = vb + (idx & ((1 << xsh) - 1)) * 8; float v_[8]; unpack8(rx##S[q], v_); \
            const float sx_ = dt##S[q] * __expf(al##S - ac##S[q]); \
            _Pragma("unroll") for (int i = 0; i < 8; ++i) v_[i] *= sx_; *(LAS u32x4*)(Xt_ + row * SSD_LDX + col8) = pack8(v_); } \
        if (lt == 0) *(LAS float*)(Xt_ + 64 * SSD_LDX) = __expf(al##S); } while (0)
        SCAN_LOADER(SSD_LOAD, SSD_WRITE, SSD_WAIT, 15);
#undef SSD_LOAD
#undef SSD_WRITE
#undef SSD_WAIT
    } else if (w >= ncw) {
        int nxt = nch < RDY_SLACK ? nch : RDY_SLACK;
        LDS_BARRIER();
        for (int ci = 0; ci < nch; ++ci) {
            if (w == ncw && nxt < nch) { const int upto = ci + 1 + RDY_SLACK < nch ? ci + 1 + RDY_SLACK : nch; nxt = rdy_block(F, rdy, rstride, rneed, nxt, upto, nch); }
            LDS_BARRIER();
        }
    } else {
        const int n0 = vb + 16 * w, head = hd;
        f32x4 H[8];
        if (s == 0) {
#pragma unroll
            for (int nt = 0; nt < 8; ++nt) H[nt] = (f32x4){0.f, 0.f, 0.f, 0.f};
        } else {
            const float* st = INP(I_SSSM) + ((((size_t)l * 32 + b) * 8 + head) * 64 + n0 + i16) * 128 + 4 * g;
#pragma unroll
            for (int nt = 0; nt < 8; ++nt) H[nt] = *(const f32x4*)(st + 16 * nt);
        }
        bf16_t* const yoff = F_YOFF;
        LDS_BARRIER();
        for (int ci = 0; ci < nch; ++ci) {
            const LAS bf16_t* Ct = (const LAS bf16_t*)(F.lds + (ci & 1) * SSD_BUF); const LAS bf16_t* Bt = Ct + 64 * SSD_LDC; const LAS bf16_t* Xt = Bt + 64 * SSD_LDC;
            const float cd = *(const LAS float*)(Xt + 64 * SSD_LDX);
            bf16x8 A1[4][4], A2[8][2], Xb[2];
#pragma unroll
            for (int m = 0; m < 4; ++m)
#pragma unroll
                for (int ks = 0; ks < 4; ++ks) A1[m][ks] = frag_sig(Ct, SSD_LDC, 16 * m, 32 * ks, i16, g);
#pragma unroll
            for (int cs = 0; cs < 2; ++cs) Xb[cs] = frag_tr_nat(Xt, SSD_LDX, 32 * cs, n0, i16, g);
#pragma unroll
            for (int nt = 0; nt < 8; ++nt)
#pragma unroll
                for (int cs = 0; cs < 2; ++cs) A2[nt][cs] = frag_tr_nat(Bt, SSD_LDC, 32 * cs, 16 * nt, i16, g);
            __builtin_amdgcn_sched_barrier(0);
            bf16x8 Hb[4];
#pragma unroll
            for (int ks = 0; ks < 4; ++ks) Hb[ks] = acc_frag(H[2 * ks], H[2 * ks + 1]);
            bf16_t* yo = yoff + (((size_t)(c0 + ci) * 8 + head) * 64 + n0 + i16) * 64 + 4 * g;
            f32x4 Yv[4];
#pragma unroll
            for (int m = 0; m < 4; ++m) {
                f32x4 acc = (f32x4){0.f, 0.f, 0.f, 0.f};
#pragma unroll
                for (int ks = 0; ks < 4; ++ks) acc = mma16(A1[m][ks], Hb[ks], acc);
                Yv[m] = acc;
            }
#pragma unroll
            for (int nt = 0; nt < 8; ++nt) {
                f32x4 acc = H[nt] * cd;
#pragma unroll
                for (int cs = 0; cs < 2; ++cs) acc = mma16(A2[nt][cs], Xb[cs], acc);
                H[nt] = acc;
            }
#pragma unroll
            for (int m = 0; m < 4; ++m) st8_wt(yo + 16 * m, pack4(Yv[m]));
            if (prog) {
                asm volatile("s_waitcnt vmcnt(24)" ::: "memory");
                if (lane == 0 && ci >= 6) __hip_atomic_store(prog + 64 * w, pbase + (unsigned)(ci - 6) + 1u, __ATOMIC_RELAXED, __HIP_MEMORY_SCOPE_AGENT);
            }
            LDS_BARRIER();
        }
        asm volatile("s_waitcnt vmcnt(0)" ::: "memory");
        if (prog && lane == 0) __hip_atomic_store(prog + 64 * w, pbase + (unsigned)nch, __ATOMIC_RELAXED, __HIP_MEMORY_SCOPE_AGENT);
        if (done && lane == 0) __hip_atomic_fetch_add(done, 1u, __ATOMIC_RELAXED, __HIP_MEMORY_SCOPE_AGENT);
        float* o = F.out + (s == 0 ? O_P_SSM + (((size_t)l * 8 + head) * 64 + n0 + i16) * 128 : O_S_SSM + ((((size_t)l * 32 + b) * 8 + head) * 64 + n0 + i16) * 128) + 4 * g;
#pragma unroll
        for (int nt = 0; nt < 8; ++nt) *(f32x4*)(o + 16 * nt) = H[nt];
    }
}
__device__ __forceinline__ void post_ssd(Frame& F, int l, int c, int grp) {
    PHASE_IDS(F);
    const int tid = F.tid, lane = F.lane, w = F.wave, i16 = lane & 15, g = lane >> 4;
    const size_t row0 = (size_t)c * 64;
    bf16_t* const proj = F_PROJ;
    LAS bf16_t* Ct = (LAS bf16_t*)F.lds; LAS bf16_t* Bt = Ct + 64 * SSD_LDC; LAS bf16_t* Xt = Bt + 64 * SSD_LDC;
    LAS float* acs = (LAS float*)(Xt + 4 * 64 * SSD_LDX); LAS float* dts = acs + 256; LAS float* ssn = dts + 256;
    {
#pragma unroll
        for (int q = 0; q < 2; ++q) { const int idx = q * 512 + tid, row = idx >> 4, col8 = (idx & 15) * 8;
            *(LAS u32x4*)(Ct + row * SSD_LDC + col8) = *(const u32x4*)(proj + (row0 + row) * PW + PC_SC + grp * 128 + col8);
            *(LAS u32x4*)(Bt + row * SSD_LDC + col8) = *(const u32x4*)(proj + (row0 + row) * PW + PC_SB + grp * 128 + col8); }
#pragma unroll
        for (int q = 0; q < 4; ++q) { const int idx = q * 512 + tid, row = idx >> 5, col8 = (idx & 31) * 8, hh = col8 >> 6, cc = col8 & 63;
            *(LAS u32x4*)(Xt + hh * 64 * SSD_LDX + row * SSD_LDX + cc) = *(const u32x4*)(proj + (row0 + row) * PW + PC_SX + grp * 256 + col8); }
        if (tid < 256) { const int hh = tid >> 6, t = tid & 63; acs[tid] = F_ACUM[(row0 + t) * 8 + grp * 4 + hh]; dts[tid] = F_SCAL[(row0 + t) * 16 + 8 + grp * 4 + hh]; }
    }
    LDS_BARRIER();
    const int hh = w & 3, lh = w >> 2, hd = grp * 4 + hh;
    const LAS bf16_t* Xh = Xt + hh * 64 * SSD_LDX;
    const float Dh = INP(I_SD)[l * 8 + hd];
    float ssrow[2][4];
    f32x4 Y[2][4];
#pragma unroll
    for (int li = 0; li < 2; ++li) {
        const int ltile = 2 * lh + li;
        f32x4 ST[4];
#pragma unroll
        for (int st = 0; st < 4; ++st) {
            f32x4 acc = (f32x4){0.f, 0.f, 0.f, 0.f};
            if (st <= ltile) {
#pragma unroll
                for (int ks = 0; ks < 4; ++ks) acc = mma16(frag_nat(Bt, SSD_LDC, 16 * st, 32 * ks, i16, g), frag_nat(Ct, SSD_LDC, 16 * ltile, 32 * ks, i16, g), acc);
                const int lcol = 16 * ltile + i16; const float acl = acs[hh * 64 + lcol];
#pragma unroll
                for (int r = 0; r < 4; ++r) { const int srow = 16 * st + 4 * g + r; const float f = (srow <= lcol) ? __expf(fminf(acl - acs[hh * 64 + srow], 0.f)) * dts[hh * 64 + srow] : 0.f; acc[r] *= f; }
            }
            ST[st] = acc;
        }
#pragma unroll
        for (int pt = 0; pt < 4; ++pt) {
            f32x4 acc = (f32x4){0.f, 0.f, 0.f, 0.f};
#pragma unroll
            for (int cs = 0; cs < 2; ++cs) if (2 * cs <= ltile) acc = mma16(acc_frag(ST[2 * cs], ST[2 * cs + 1]), frag_tr_sig(Xh, SSD_LDX, 32 * cs, 16 * pt, i16, g), acc);
            const int p = 16 * pt + i16, lr0 = 16 * ltile + 4 * g;
            const f32x4 yo = unpack4(*(const u32x2*)(F_YOFF + (((size_t)c * 8 + hd) * 64 + p) * 64 + lr0));
#pragma unroll
            for (int r = 0; r < 4; ++r) {
                const int lrow = lr0 + r;
                const float x = bf2f(Xh[lrow * SSD_LDX + p]);
                const float z = bf2f(proj[(row0 + lrow) * PW + PC_ZS + hd * 64 + p]);
                acc[r] = (acc[r] + __expf(acs[hh * 64 + lrow]) * yo[r] + Dh * x) * siluf_(z);
            }
            Y[li][pt] = acc;
        }
#pragma unroll
        for (int r = 0; r < 4; ++r) { float ss = 0.f;
#pragma unroll
            for (int pt = 0; pt < 4; ++pt) ss += Y[li][pt][r] * Y[li][pt][r];
            ss += __shfl_xor(ss, 1); ss += __shfl_xor(ss, 2); ss += __shfl_xor(ss, 4); ss += __shfl_xor(ss, 8);
            ssrow[li][r] = ss; }
        if (i16 == 0) {
#pragma unroll
            for (int r = 0; r < 4; ++r) ssn[(16 * ltile + 4 * g + r) * 4 + hh] = ssrow[li][r];
        }
    }
    LDS_BARRIER();
#pragma unroll
    for (int li = 0; li < 2; ++li) {
        const int ltile = 2 * lh + li;
#pragma unroll
        for (int r = 0; r < 4; ++r) {
            const int lrow = 16 * ltile + 4 * g + r;
            const f32x4 sv = *(const LAS f32x4*)(ssn + lrow * 4);
            const float sc = rsqrtf(((sv[0] + sv[1]) + (sv[2] + sv[3])) * (1.f / 256.f) + EPS);
#pragma unroll
            for (int pt = 0; pt < 4; ++pt) { const int p = 16 * pt + i16;
                proj[(row0 + lrow) * PW + PC_ZS + hd * 64 + p] = f2bf(Y[li][pt][r] * sc * INP(I_SNORMW)[l * 512 + hd * 64 + p]); }
        }
    }
    LDS_BARRIER();
}

constexpr int NSL = 2;
constexpr int CW_PROG = 8192;
constexpr int CW_SDONE = 8192 + 64 * 64;
__device__ __forceinline__ void post_wait(Frame& F, int c, int q, unsigned pbase, unsigned sneed) {
    if (F.wave == 0) {
        unsigned* const ctl = (unsigned*)(F.ws + WS_CTL);
        const int lane = F.lane;
        unsigned* wp; unsigned need; bool act;
        if (c >= 256) { wp = ctl + CW_SDONE + 64 * (c - 256); need = sneed; act = lane == 0; }
        else {
            int gq0, ng;
            if (q < 2) { gq0 = 8 + 4 * q; ng = 4; } else if (q < 4) { gq0 = 2 * (q - 2); ng = 2; } else { gq0 = 4 + (q - 4); ng = 1; }
            act = lane < 4 * ng; wp = ctl + CW_PROG + 64 * (4 * gq0 + (act ? lane : 0)); need = pbase + (unsigned)c + 1u;
        }
        unsigned sp = 0;
        for (;;) { const bool ok = !act || (int)(xb_ld(wp) - need) >= 0; if (__all(ok) || ++sp > 2000000u) break; __builtin_amdgcn_s_sleep(4); }
        __builtin_amdgcn_fence(__ATOMIC_ACQUIRE, "agent");
        asm volatile("s_waitcnt vmcnt(0)" ::: "memory");
    }
    LDS_BARRIER();
}
__device__ __forceinline__ void scan_phase(Frame& F, int l, int mode, unsigned epoch) {
    PHASE_IDS(F);
    const int xl = F.vcu >> 5, slot = F.vcu & 31;
    unsigned* const ctl = (unsigned*)(F.ws + WS_CTL);
    const unsigned pbase = 1024u * epoch, sneed = 64u * (epoch + 1u), rneed = epoch + 1u;
    const int nchain = xl < 2 ? 8 : (xl < 6 ? 4 : 0);
    const int wbase = xl < 2 ? 24 * xl : (xl < 6 ? 48 + 28 * (xl - 2) : 160 + 32 * (xl - 6));
    const bool worker = slot >= nchain;
    const int j = wbase + slot - nchain;
    if (worker) {
        for (int it = j; it < NCH * 5; it += 224) {
            int it_ = it; asm volatile("" : "+s"(it_));
            const int c = it_ / 5, q = it_ % 5;
            if (q == 0) act_chunk(F, l, c); else prep_rwkv(F, l, c, q - 1);
        }
    }
    for (int pass = 0; pass < 3; ++pass) {
        int kind, s, h, vb, ncw; unsigned* prog = nullptr; unsigned* done = nullptr;
        if (pass == 0) {
            if (worker) continue;
            kind = xl < 2 ? 2 : (xl < 4 ? 0 : 1); h = xl < 2 ? 4 * xl + (slot >> 1) : 2 * (xl & 1) + (slot >> 1);
            const int gq = kind == 0 ? h : (kind == 1 ? 4 + h : 8 + h);
            s = 0; ncw = 2; vb = 32 * (slot & 1);
            prog = ctl + CW_PROG + 64 * (4 * gq + 2 * (slot & 1));
        } else {
            const int it = F.vcu + (pass - 1) * F.G;
            if (it >= 512) continue;
            if (it < 128) { kind = 0; s = 1 + (it >> 2); h = it & 3; }
            else if (it < 256) { kind = 1; s = 1 + ((it - 128) >> 2); h = (it - 128) & 3; }
            else { kind = 2; s = 1 + ((it - 256) >> 3); h = (it - 256) & 7; }
            vb = 0; ncw = 4; done = ctl + CW_SDONE + 64 * (s - 1);
        }
        const int cfirst = (s == 0) ? 0 : 255 + s;
        if (kind == 0) scan_gdn2(F, l, s, h, vb, ncw, prog, pbase, done, mode, ctl + CW_AFLAG + cfirst, 1, rneed);
        else if (kind == 1) scan_rwkv2(F, l, s, h, vb, ncw, prog, pbase, done, mode, ctl + CW_RFLAG + 4 * cfirst + h, 4, rneed);
        else scan_ssd2(F, l, s, h, vb, ncw, prog, pbase, done, mode, ctl + CW_AFLAG + cfirst, 1, rneed);
        __syncthreads();
    }
    if (worker) {
        for (int it = j; it < NCH * 8; it += 224) {
            int it_ = it; asm volatile("" : "+s"(it_));
            const int c = it_ >> 3, q = it_ & 7;
            post_wait(F, c, q, pbase, sneed);
            if (q < 2) post_ssd(F, l, c, q); else if (q < 4) post_gdn(F, l, c, q - 2); else post_rwkv(F, l, c, q - 4);
        }
    }
}
__device__ __forceinline__ void final_norm(Frame& F) {
    PHASE_IDS(F);
    const int gw = F.vcu * 8 + F.wave, NGW = F.G * 8;
    const float* fw = INP(I_FNORM);
    float wv[16];
#pragma unroll
    for (int i = 0; i < 16; ++i) wv[i] = fw[16 * F.lane + i];
    for (int m = gw; m < T; m += NGW) {
        float s = (F.lane < 16) ? F_SSQA[(size_t)m * 16 + F.lane] : 0.f;
        s = wave_sum(s);
        const float rs = rsqrtf(s * (1.f / 1024.f) + EPS);
        const bf16_t* xr = F_R1 + (size_t)m * DM + 16 * F.lane;
        float x[16]; { float a[8], b[8]; unpack8(*(const u32x4*)xr, a); unpack8(*(const u32x4*)(xr + 8), b);
#pragma unroll
            for (int i = 0; i < 8; ++i) { x[i] = a[i]; x[8 + i] = b[i]; } }
        f32x4* o = (f32x4*)(F.out + (size_t)m * DM + 16 * F.lane);
#pragma unroll
        for (int q = 0; q < 4; ++q) o[q] = (f32x4){x[4 * q] * rs * wv[4 * q], x[4 * q + 1] * rs * wv[4 * q + 1], x[4 * q + 2] * rs * wv[4 * q + 2], x[4 * q + 3] * rs * wv[4 * q + 3]};
    }
}

constexpr int GMT = 3;
constexpr int N_PHASES = 16;
__global__ void __launch_bounds__(512, 2) mk_fwd(Args args) {
    extern __shared__ __attribute__((aligned(16))) unsigned char lds[];
    Frame F;
    F.lds = (LAS unsigned char*)lds;
    F.tid = threadIdx.x; F.lane = F.tid & 63; F.wave = __builtin_amdgcn_readfirstlane(F.tid >> 6);
    F.G = gridDim.x; { const int bx = blockIdx.x; F.vcu = (F.G % 8 == 0) ? (bx % 8) * (F.G / 8) + bx / 8 : bx; }
    F.out = args.out; F.ws = args.ws;
    volatile LAS unsigned* MISC = (volatile LAS unsigned*)(F.lds + MISC_OFF);
    for (int u = F.tid; u < (LDS_BYTES - LDSCTL_OFF) / 4; u += 512) ((LAS unsigned*)(F.lds + LDSCTL_OFF))[u] = 0u;
    __syncthreads();
    if (F.tid == 0) {
#pragma unroll
        for (int i = 0; i < 37; ++i) ((LAS unsigned long long*)(F.lds + PTRTAB_OFF))[i] = (unsigned long long)args.in[i];
    }
    __syncthreads();
    XcdBarrier bar = xcd_barrier_post((unsigned*)(args.ws + WS_CTL) + CW_BAR, MISC + 8);
    const int ns = args.nsched; unsigned nscan = 0;
    for (int si = 0; si < ns; ++si) {
        const int pe = (int)((args.sched[si >> 2] >> (8 * (si & 3))) & 0xffu); const int p = pe & 0x7f; const bool probe = (pe & 0x80) != 0;
        if (p == 0) p0_prologue(F);
        else if (p == 15) final_norm(F);
        else {
            const int l = (p - 1) / 7, sub = (p - 1) % 7;
            if (sub == 0) {
                pg8::Gemm g{F_R1, w_in(F, l), T, PW, DM, DM}; pg8::StaticOrder S; S.init(T, PW, F.G, (int)blockIdx.x);
                pg8::EpiInProj E{F_PROJ, F_SCAL, F_SSQA, F_HCONV, F_HSHIFT, F.out, l};
                pg8::gemm_phase<pg8::EpiInProj, true>(F.lds, g, S, E);
            } else if (sub == 1) { }
            else if (sub == 2) scan_phase(F, l, 0, nscan++);
            else if (sub == 3) { }
            else if (sub == 4) {
                pg8::Gemm g{F_PROJ, w_out(F, l), T, DM, DM, PW}; pg8::StaticOrder S; S.init(T, DM, F.G, (int)blockIdx.x, 64 * GMT);
                if (l == 0) { pg8::EpiResid<true, GMT> E{INP(I_XP), INP(I_XS), F_R1, F_SSQD}; pg8::gemm_phase<pg8::EpiResid<true, GMT>, true, GMT>(F.lds, g, S, E); }
                else { pg8::EpiResid<false, GMT> E{nullptr, nullptr, F_R1, F_SSQD}; pg8::gemm_phase<pg8::EpiResid<false, GMT>, true, GMT>(F.lds, g, S, E); }
            } else if (sub == 5) {
                pg8::Gemm g{F_R1, w_gu(F, l), T, NGU, DM, DM}; pg8::StaticOrder S; S.init(T, NGU, F.G, (int)blockIdx.x);
                pg8::EpiGateUp E{F_PROJ, F_SSQD};
                pg8::gemm_phase<pg8::EpiGateUp, true>(F.lds, g, S, E);
            } else {
                pg8::Gemm g{F_PROJ, w_dn(F, l), T, DM, FF, FF}; pg8::StaticOrder S; S.init(T, DM, F.G, (int)blockIdx.x, 64 * GMT);
                pg8::EpiResid<false, GMT> E{nullptr, nullptr, F_R1, F_SSQA};
                pg8::gemm_phase<pg8::EpiResid<false, GMT>, true, GMT>(F.lds, g, S, E);
            }
        }
        if (si + 1 < ns) xcd_barrier(bar);
    }
}

extern "C" void kernel_launch(void* const* d_in, const int* in_sizes, int n_in, void* d_out, int out_size, void* d_ws, size_t ws_size, hipStream_t stream) {
    static int grid = 0;
    if (grid == 0) {
        if (n_in != 37 || out_size != (int)O_END || ws_size < 268435456) { fprintf(stderr, "kernel_launch: unexpected shapes: n_in %d out %d ws %zu\n", n_in, out_size, ws_size); grid = -1; return; }
        int dev = 0, cus = 0;
        if (hipGetDevice(&dev) != hipSuccess || hipDeviceGetAttribute(&cus, hipDeviceAttributeMultiprocessorCount, dev) != hipSuccess) { grid = -1; return; }
        if (hipFuncSetAttribute((const void*)mk_fwd, hipFuncAttributeMaxDynamicSharedMemorySize, LDS_BYTES) != hipSuccess) { fprintf(stderr, "kernel_launch: hipFuncSetAttribute failed\n"); grid = -1; return; }
        int per_cu = 0;
        if (hipOccupancyMaxActiveBlocksPerMultiprocessor(&per_cu, (const void*)mk_fwd, 512, LDS_BYTES) != hipSuccess || per_cu < 1)
            fprintf(stderr, "kernel_launch: occupancy query reports %d workgroups per CU\n", per_cu);
        (void)hipGetLastError();
        grid = cus;
    }
    if (grid < 0) return;
    (void)hipMemsetAsync((char*)d_ws + WS_CTL, 0, 65536, stream);
    Args a{};
    for (int i = 0; i < 37; ++i) a.in[i] = (const float*)d_in[i];
    a.out = (float*)d_out; a.ws = (unsigned char*)d_ws;
    {
        int n = 0; unsigned char s[32];
#ifndef PROBE_K
#define PROBE_K -1
#endif
        if (PROBE_K >= 0) { s[n++] = 0x80; for (int p = 1; p <= PROBE_K; ++p) if ((p - 1) % 7 != 3 && (p - 1) % 7 != 1) s[n++] = (unsigned char)(0x80 | p); }
        for (int p = 0; p < N_PHASES; ++p) if (p == 0 || p == 15 || ((p - 1) % 7 != 3 && (p - 1) % 7 != 1)) s[n++] = (unsigned char)p;
        for (int i = 0; i < n; ++i) a.sched[i >> 2] |= (unsigned)s[i] << (8 * (i & 3));
        a.nsched = n;
#ifndef PROBE_MODE
#define PROBE_MODE 31
#endif
        a.pmode = PROBE_MODE;
    }
    hipLaunchKernelGGL(mk_fwd, dim3(grid), dim3(512), LDS_BYTES, stream, a);
}
```

```cpp
#include <hip/hip_runtime.h>
#include <cstdio>
#include <cstdint>


#define LAS __attribute__((address_space(3)))
typedef unsigned short bf16_t;
typedef short bf16x8 __attribute__((ext_vector_type(8)));
typedef float f32x4 __attribute__((ext_vector_type(4)));
typedef float f32x2 __attribute__((ext_vector_type(2)));
typedef unsigned u32x4 __attribute__((ext_vector_type(4)));
typedef unsigned u32x2 __attribute__((ext_vector_type(2)));

constexpr int DM = 1024, TP = 16384, NB = 32, T = 18432, NCH = 288, NSEQ = 33;
constexpr int PW = 3584;
constexpr int NIN = 3840;
constexpr int FF = 2816, NGU = 5632;
constexpr float EPS = 1e-6f;
constexpr int PC_ZG = 0, PC_ZS = 256, PC_R = 768, PC_GQ = 1024, PC_GK = 1280, PC_GV = 1536, PC_SX = 1792, PC_SB = 2304, PC_SC = 2560,
              PC_RK = 2816, PC_RV = 3072, PC_RL = 3328;
constexpr size_t O_Y = 0;
constexpr size_t O_P_GDN = (size_t)T * DM;
constexpr size_t O_P_GDNC = O_P_GDN + 2 * 1 * 4 * 64 * 64;
constexpr size_t O_P_SSM = O_P_GDNC + 2 * 1 * 3 * 768;
constexpr size_t O_P_SSMC = O_P_SSM + 2 * 1 * 8 * 64 * 128;
constexpr size_t O_P_RWKV = O_P_SSMC + 2 * 1 * 3 * 1024;
constexpr size_t O_P_SHIFT = O_P_RWKV + 2 * 1 * 4 * 64 * 64;
constexpr size_t O_S_GDN = O_P_SHIFT + 2 * 1 * 1024;
constexpr size_t O_S_GDNC = O_S_GDN + (size_t)2 * 32 * 4 * 64 * 64;
constexpr size_t O_S_SSM = O_S_GDNC + (size_t)2 * 32 * 3 * 768;
constexpr size_t O_S_SSMC = O_S_SSM + (size_t)2 * 32 * 8 * 64 * 128;
constexpr size_t O_S_RWKV = O_S_SSMC + (size_t)2 * 32 * 3 * 1024;
constexpr size_t O_S_SHIFT = O_S_RWKV + (size_t)2 * 32 * 4 * 64 * 64;
constexpr size_t O_END = O_S_SHIFT + (size_t)2 * 32 * 1024;
static_assert(O_END == 25784832, "output size");

constexpr size_t WS_CTL = 0, CTL_BYTES = 1u << 20;
constexpr size_t W_IN_B = (size_t)NIN * DM * 2, W_OUT_B = (size_t)DM * DM * 2, W_GU_B = (size_t)NGU * DM * 2, W_DN_B = (size_t)DM * FF * 2;
constexpr size_t W_LAYER_B = W_IN_B + W_OUT_B + W_GU_B + W_DN_B;
constexpr size_t WS_W = WS_CTL + CTL_BYTES;
constexpr size_t WS_R1 = WS_W + 2 * W_LAYER_B;
constexpr size_t R_BYTES = (size_t)T * DM * 2;
constexpr size_t WS_R2 = WS_R1 + R_BYTES;
constexpr size_t WS_PROJ = WS_R2 + R_BYTES;
constexpr size_t PROJ_BYTES = (size_t)T * PW * 2;
constexpr size_t WS_SSQA = WS_PROJ + PROJ_BYTES;
constexpr size_t SSQ_BYTES = (size_t)T * 16 * 4;
constexpr size_t WS_SSQD = WS_SSQA + SSQ_BYTES;
constexpr size_t WS_END = WS_SSQD + SSQ_BYTES;
static_assert(WS_END <= 268435456, "d_ws map exceeds 256 MiB");
static_assert((size_t)T * FF * 2 <= PROJ_BYTES, "ff overlays proj");
constexpr size_t R2_SCAL = 0;
constexpr size_t R2_HCONV = R2_SCAL + (size_t)T * 16 * 4;
constexpr size_t R2_HSHIFT = R2_HCONV + (size_t)NCH * 3 * 1792 * 2;
constexpr size_t R2_ACUM = R2_HSHIFT + (size_t)NCH * 1024 * 2;
constexpr size_t R2_GCUM = R2_ACUM + (size_t)T * 8 * 4;
constexpr size_t R2_YOFF = R2_GCUM + (size_t)T * 4 * 4;
constexpr size_t R2_GW = R2_YOFF + (size_t)T * 512 * 2;
static_assert(R2_GW + (size_t)T * 256 * 2 <= R_BYTES, "R2 map");
constexpr size_t R1_RWA = 0;
constexpr size_t R1_RU = R1_RWA + (size_t)T * 256 * 2;
constexpr size_t R1_RBH = R1_RU + (size_t)T * 256 * 2;
constexpr size_t R1_RKV = R1_RBH + (size_t)T * 256 * 2;
static_assert(R1_RKV + (size_t)T * 256 * 2 <= R_BYTES, "R1 map");
constexpr size_t R2_RDV = R2_GW + (size_t)T * 256 * 2;
static_assert(R2_RDV + (size_t)NCH * 4 * 64 * 4 <= R_BYTES, "R2 map (dvec)");
constexpr int CW_BAR = 4096;

constexpr int RING_BYTES = 131072;
constexpr int LDSCTL_OFF = 143360, MISC_OFF = LDSCTL_OFF + 320;
constexpr int LDS_BYTES = 147456;

typedef __bf16 bf16x2_t __attribute__((ext_vector_type(2)));
__device__ __forceinline__ unsigned cvt_pk_bf16(float lo, float hi) { const f32x2 v = {lo, hi}; return __builtin_bit_cast(unsigned, __builtin_convertvector(v, bf16x2_t)); }
__device__ __forceinline__ float bf_lo(unsigned w) { return __uint_as_float(w << 16); }
__device__ __forceinline__ float bf_hi(unsigned w) { return __uint_as_float(w & 0xffff0000u); }
__device__ __forceinline__ float bf2f(bf16_t h) { return __uint_as_float(((unsigned)h) << 16); }
__device__ __forceinline__ bf16_t f2bf(float f) { return (bf16_t)(cvt_pk_bf16(f, 0.f) & 0xffffu); }
__device__ __forceinline__ void unpack8(u32x4 w, float (&o)[8]) {
    o[0] = bf_lo(w.x); o[1] = bf_hi(w.x); o[2] = bf_lo(w.y); o[3] = bf_hi(w.y); o[4] = bf_lo(w.z); o[5] = bf_hi(w.z); o[6] = bf_lo(w.w); o[7] = bf_hi(w.w); }
__device__ __forceinline__ u32x4 pack8(const float (&v)[8]) { u32x4 w; w.x = cvt_pk_bf16(v[0], v[1]); w.y = cvt_pk_bf16(v[2], v[3]); w.z = cvt_pk_bf16(v[4], v[5]); w.w = cvt_pk_bf16(v[6], v[7]); return w; }
__device__ __forceinline__ float wave_sum(float v) {
#pragma unroll
    for (int o = 1; o < 64; o <<= 1) v += __shfl_xor(v, o);
    return v;
}
#define LDS_BARRIER() do { asm volatile("s_waitcnt lgkmcnt(0)" ::: "memory"); __builtin_amdgcn_s_barrier(); asm volatile("" ::: "memory"); } while (0)
__device__ __forceinline__ float sigmoidf_(float x) { return __builtin_amdgcn_rcpf(1.f + __expf(-x)); }
__device__ __forceinline__ float siluf_(float x) { return x * __builtin_amdgcn_rcpf(1.f + __expf(-x)); }
__device__ __forceinline__ float tanhf_(float x) { return 1.f - 2.f * __builtin_amdgcn_rcpf(1.f + __expf(2.f * x)); }
__device__ __forceinline__ float softplusf_(float x) { return fmaxf(x, 0.f) + __logf(1.f + __expf(-fabsf(x))); }


typedef short s16x4 __attribute__((ext_vector_type(4)));
__device__ __forceinline__ f32x4 mma16(bf16x8 a, bf16x8 b, f32x4 c) { return __builtin_amdgcn_mfma_f32_16x16x32_bf16(a, b, c, 0, 0, 0); }
__device__ __forceinline__ bf16x8 cat4(s16x4 a, s16x4 b) { return (bf16x8){a[0], a[1], a[2], a[3], b[0], b[1], b[2], b[3]}; }
__device__ __forceinline__ bf16x8 frag_nat(const LAS bf16_t* Tt, int LD, int row0, int k0, int i16, int g) { return *(const LAS bf16x8*)(Tt + (row0 + i16) * LD + k0 + 8 * g); }
__device__ __forceinline__ bf16x8 frag_sig(const LAS bf16_t* Tt, int LD, int row0, int k0, int i16, int g) {
    const LAS bf16_t* p = Tt + (row0 + i16) * LD + k0 + 4 * g; return cat4(*(const LAS s16x4*)p, *(const LAS s16x4*)(p + 16)); }
__device__ __forceinline__ s16x4 tr4(const LAS bf16_t* p) { return __builtin_amdgcn_ds_read_tr16_b64_v4i16((LAS s16x4*)p); }
__device__ __forceinline__ bf16x8 frag_tr_nat(const LAS bf16_t* X, int LD, int k0, int c0, int i16, int g) {
    const LAS bf16_t* p = X + (k0 + 8 * g + (i16 >> 2)) * LD + c0 + 4 * (i16 & 3); return cat4(tr4(p), tr4(p + 4 * LD)); }
__device__ __forceinline__ bf16x8 frag_tr_sig(const LAS bf16_t* X, int LD, int k0, int c0, int i16, int g) {
    const LAS bf16_t* p = X + (k0 + 4 * g + (i16 >> 2)) * LD + c0 + 4 * (i16 & 3); return cat4(tr4(p), tr4(p + 16 * LD)); }
__device__ __forceinline__ bf16x8 acc_frag(f32x4 x0, f32x4 x1) {
    u32x4 w; w.x = cvt_pk_bf16(x0[0], x0[1]); w.y = cvt_pk_bf16(x0[2], x0[3]); w.z = cvt_pk_bf16(x1[0], x1[1]); w.w = cvt_pk_bf16(x1[2], x1[3]);
    return __builtin_bit_cast(bf16x8, w); }
__device__ __forceinline__ u32x2 pack4(f32x4 x) { u32x2 w; w.x = cvt_pk_bf16(x[0], x[1]); w.y = cvt_pk_bf16(x[2], x[3]); return w; }
__device__ __forceinline__ f32x4 unpack4(u32x2 w) { return (f32x4){bf_lo(w.x), bf_hi(w.x), bf_lo(w.y), bf_hi(w.y)}; }

namespace pg8 {
constexpr int BM = 256, BK = 64, HALF = 128, HTB = HALF * BK * 2, STAGE_BYTES = 8 * HTB, NXCD = 8, WGM = 8;
__host__ __device__ __forceinline__ int lds_byte(int r, int c) { const int st = (r >> 4) * 2 + (c >> 5), rr = r & 15, cc = c & 31, ob = rr * 64 + cc * 2; return st * 1024 + (ob ^ (((ob >> 9) & 1) << 5)); }
__host__ __device__ __forceinline__ void stage_rc(int b, int& R, int& C) { const int st = b / 1024, sb = b % 1024, swz = sb ^ (((sb >> 9) & 1) << 5); R = (st >> 1) * 16 + swz / 64; C = (st & 1) * 32 + (swz % 64) / 2; }
__host__ __device__ __forceinline__ int perm32(int rho) { const int n = rho >> 4, i = rho & 15; return 8 * (i >> 2) + 4 * n + (i & 3); }
struct Unit { int pm, pn; };
struct Gemm { const bf16_t* A; const bf16_t* Bt; int M, N, K, lda; };
struct StaticOrder {
    int nM, nN, nwg, G, c;
    __host__ __device__ void init(int M, int N, int G_, int c_, int bm = BM) { nM = M / bm; nN = N / BM; nwg = nM * nN; G = G_; c = c_; }
    __host__ __device__ bool next(int i, Unit& u) const {
        const long L = (long)i * G + c; if (L >= nwg) return false;
        int wgid = (int)L; { const int q = nwg / NXCD, r = nwg % NXCD, xcd = wgid % NXCD, off = wgid / NXCD; wgid = (xcd < r ? xcd * (q + 1) : r * (q + 1) + (xcd - r) * q) + off; }
        const int nig = WGM * nN, gid = wgid / nig, fm = gid * WGM, gsz = (nM - fm) < WGM ? (nM - fm) : WGM;
        u.pm = fm + ((wgid % nig) % gsz); u.pn = (wgid % nig) / gsz; return true;
    }
};
template <class Epi, bool ALIGN_EPI, int MT = 4>
__device__ __forceinline__ void gemm_phase(LAS unsigned char* lds, const Gemm g, const StaticOrder& S, const Epi& E) {
    int tid_ = threadIdx.x; asm volatile("" : "+v"(tid_));
    const int tid = tid_, wid = __builtin_amdgcn_readfirstlane(tid >> 6), lane = tid & 63, wr = wid >> 2, wc = wid & 3, fr = lane & 15, fq = lane >> 4;
    const int K = g.K, nt = K / BK, lda = g.lda;
    unsigned voffA[2], voffB[2];
#pragma unroll
    for (int i = 0; i < 2; ++i) { int R, C; stage_rc(tid * 16 + i * 8192, R, C); const int Rb = Epi::PERM ? ((R & ~31) + perm32(R & 31)) : R;
        voffA[i] = (unsigned)(R * lda + C) * 2u; voffB[i] = (unsigned)(Rb * K + C) * 2u; }
    const size_t kstep = (size_t)(BK * 2);
    const size_t hstepA = (size_t)(32 * MT) * lda * 2, hstepB = (size_t)HALF * K * 2;
    const size_t tstepA = 2 * hstepA, tstepB = 2 * hstepB;
    const unsigned ldsw = (unsigned)wid * 1024u;
    const int aoff = lds_byte(wr * (16 * MT) + fr, fq * 8), boff = lds_byte(wc * 32 + fr, fq * 8);
#define PG8_SA(b, h) (((b) * 2 + (h)) * HTB)
#define PG8_SB(b, h) ((4 + (b) * 2 + (h)) * HTB)
#define PG8_STAGE(bufoff, gbase, voff) do { _Pragma("unroll") for (int _i = 0; _i < 2; ++_i) \
        __builtin_amdgcn_global_load_lds((const unsigned*)((const char*)(gbase) + (voff)[_i]), (LAS unsigned*)(lds + (bufoff) + ldsw + _i * 8192), 16, 0, 0); } while (0)
#define PG8_LDA(dst, b, h) do { _Pragma("unroll") for (int m = 0; m < MT; ++m) _Pragma("unroll") for (int k = 0; k < 2; ++k) dst[m][k] = *(const LAS bf16x8*)(lds + PG8_SA(b, h) + aoff + m * 2048 + k * 1024); } while (0)
#define PG8_LDB(dst, b, h) do { _Pragma("unroll") for (int n = 0; n < 2; ++n) _Pragma("unroll") for (int k = 0; k < 2; ++k) dst[n][k] = *(const LAS bf16x8*)(lds + PG8_SB(b, h) + boff + n * 2048 + k * 1024); } while (0)
#define PG8_MMA(ai, bj, At, Bt) do { __builtin_amdgcn_s_setprio(1); _Pragma("unroll") for (int m = 0; m < MT; ++m) _Pragma("unroll") for (int n = 0; n < 2; ++n) _Pragma("unroll") for (int k = 0; k < 2; ++k) \
        acc[ai][bj][m][n] = __builtin_amdgcn_mfma_f32_16x16x32_bf16(Bt[n][k], At[m][k], acc[ai][bj][m][n], 0, 0, 0); __builtin_amdgcn_s_setprio(0); } while (0)
#define PG8_WAIT_V(n) asm volatile("s_waitcnt vmcnt(" #n ")" ::: "memory")
#define PG8_WAIT_L(n) asm volatile("s_waitcnt lgkmcnt(" #n ")" ::: "memory")
#define PG8_BAR __builtin_amdgcn_s_barrier()
#define PG8_SCHED __builtin_amdgcn_sched_barrier(0)
    Unit cur, nxt; int ui = 0;
    if (!S.next(0, cur)) return;
    f32x4 acc[2][2][4][2];
#pragma unroll
    for (int a = 0; a < 2; ++a)
#pragma unroll
        for (int b = 0; b < 2; ++b)
#pragma unroll
            for (int m = 0; m < 4; ++m)
#pragma unroll
                for (int n = 0; n < 2; ++n) acc[a][b][m][n] = (f32x4){0.f, 0.f, 0.f, 0.f};
    bf16x8 At[4][2], B0[2][2], B1[2][2];
    const char* cA = (const char*)g.A + (size_t)cur.pm * tstepA; const char* cB = (const char*)g.Bt + (size_t)cur.pn * tstepB;
    PG8_STAGE(PG8_SB(0, 0), cB, voffB); PG8_STAGE(PG8_SB(0, 1), cB + hstepB, voffB); PG8_STAGE(PG8_SA(0, 0), cA, voffA); PG8_STAGE(PG8_SA(0, 1), cA + hstepA, voffA);
    if (wr == 1) PG8_BAR;
    PG8_WAIT_V(2); PG8_BAR;
    PG8_STAGE(PG8_SB(1, 0), cB + kstep, voffB); PG8_STAGE(PG8_SA(1, 0), cA + kstep, voffA); PG8_STAGE(PG8_SB(1, 1), cB + hstepB + kstep, voffB);
    PG8_WAIT_V(6); PG8_BAR;
    for (;;) {
        const bool has_next = S.next(ui + 1, nxt);
        const char* nA = has_next ? (const char*)g.A + (size_t)nxt.pm * tstepA : cA; const char* nB = has_next ? (const char*)g.Bt + (size_t)nxt.pn * tstepB : cB;
        for (int t = 0; t < nt; t += 2) {
            const bool last = (t == nt - 2);
            const char* a1 = cA + (size_t)(t + 1) * kstep;
            const char* a2 = last ? nA : cA + (size_t)(t + 2) * kstep; const char* b2 = last ? nB : cB + (size_t)(t + 2) * kstep;
            const char* a3 = a2 + kstep; const char* b3 = b2 + kstep;
            PG8_LDB(B0, 0, 0); PG8_LDB(B1, 0, 1); PG8_SCHED; PG8_LDA(At, 0, 0); PG8_STAGE(PG8_SA(1, 1), a1 + hstepA, voffA);
            PG8_WAIT_V(8); PG8_WAIT_L(0); PG8_BAR; PG8_MMA(0, 0, At, B0); PG8_MMA(0, 1, At, B1); PG8_BAR; PG8_SCHED;
            PG8_LDA(At, 0, 1); PG8_STAGE(PG8_SB(0, 0), b2, voffB); PG8_STAGE(PG8_SB(0, 1), b2 + hstepB, voffB); PG8_STAGE(PG8_SA(0, 0), a2, voffA);
            PG8_WAIT_V(8); PG8_WAIT_L(0); PG8_BAR; PG8_MMA(1, 0, At, B0); PG8_MMA(1, 1, At, B1); PG8_BAR; PG8_SCHED;
            PG8_LDB(B0, 1, 0); PG8_LDB(B1, 1, 1); PG8_SCHED; PG8_LDA(At, 1, 0); PG8_STAGE(PG8_SA(0, 1), a2 + hstepA, voffA);
            PG8_WAIT_V(8); PG8_WAIT_L(0); PG8_BAR; PG8_MMA(0, 0, At, B0); PG8_MMA(0, 1, At, B1); PG8_BAR; PG8_SCHED;
            PG8_LDA(At, 1, 1); PG8_STAGE(PG8_SB(1, 0), b3, voffB); PG8_STAGE(PG8_SB(1, 1), b3 + hstepB, voffB); PG8_STAGE(PG8_SA(1, 0), a3, voffA);
            PG8_WAIT_V(8); PG8_WAIT_L(0); PG8_BAR; PG8_MMA(1, 0, At, B0); PG8_MMA(1, 1, At, B1); PG8_BAR; PG8_SCHED;
        }
        if constexpr (ALIGN_EPI) { if (wr == 0) PG8_BAR; }
        E(acc, cur, wr, wc, fr, fq);
        if (!has_next) break;
#pragma unroll
        for (int a = 0; a < 2; ++a)
#pragma unroll
            for (int b = 0; b < 2; ++b)
#pragma unroll
                for (int m = 0; m < 4; ++m)
#pragma unroll
                    for (int n = 0; n < 2; ++n) acc[a][b][m][n] = (f32x4){0.f, 0.f, 0.f, 0.f};
        cur = nxt; cA = nA; cB = nB; ++ui;
        if constexpr (ALIGN_EPI) { if (wr == 1) PG8_BAR; }
    }
    PG8_WAIT_V(0);
    if constexpr (!ALIGN_EPI) { if (wr == 0) PG8_BAR; }
    PG8_BAR;
#undef PG8_SA
#undef PG8_SB
#undef PG8_STAGE
#undef PG8_LDA
#undef PG8_LDB
#undef PG8_MMA
#undef PG8_WAIT_V
#undef PG8_WAIT_L
#undef PG8_BAR
#undef PG8_SCHED
}

__device__ __forceinline__ float row_rstd(const float* ssq, int row, int fq) {
    const f32x4 p = *(const f32x4*)(ssq + (size_t)row * 16 + 4 * fq);
    float s = (p.x + p.y) + (p.z + p.w);
    s += __shfl_xor(s, 16); s += __shfl_xor(s, 32);
    return rsqrtf(s * (1.0f / 1024.0f) + EPS);
}

struct EpiInProj {
    static constexpr bool PERM = true;
    bf16_t* proj; float* scal; const float* ssq; bf16_t* hconv; bf16_t* hshift; float* out; int layer;
    __device__ __forceinline__ void operator()(const f32x4 (&acc)[2][2][4][2], const Unit& u, int wr, int wc, int fr, int fq) const {
        const int pn = u.pn;
#pragma unroll
        for (int ai = 0; ai < 2; ++ai)
#pragma unroll
            for (int m = 0; m < 4; ++m) {
                const int row = u.pm * BM + ai * HALF + wr * 64 + m * 16 + fr;
                const float rs = row_rstd(ssq, row, fq);
                {
#pragma unroll
                    for (int bj = 0; bj < 2; ++bj) {
                        const int c0 = pn * BM + bj * HALF + wc * 32 + 8 * fq;
                        const f32x4 v0 = acc[ai][bj][m][0] * rs, v1 = acc[ai][bj][m][1] * rs;
                        u32x4 w; w.x = cvt_pk_bf16(v0[0], v0[1]); w.y = cvt_pk_bf16(v0[2], v0[3]); w.z = cvt_pk_bf16(v1[0], v1[1]); w.w = cvt_pk_bf16(v1[2], v1[3]);
                        *(u32x4*)(proj + (size_t)row * PW + c0) = w;
                        if (m == 3) {
                            const int chunk = row >> 6;
                            if (fr >= 13 && pn >= 4 && pn < 11) {
                                const int j = fr - 13;
                                *(u32x4*)(hconv + ((size_t)chunk * 3 + j) * 1792 + (c0 - 1024)) = w;
                                if (chunk >= 255) {
                                    float* o;
                                    if (c0 < PC_SX) o = out + (chunk == 255 ? O_P_GDNC + ((size_t)layer * 3 + j) * 768 : O_S_GDNC + (((size_t)layer * 32 + (chunk - 256)) * 3 + j) * 768) + (c0 - PC_GQ);
                                    else o = out + (chunk == 255 ? O_P_SSMC + ((size_t)layer * 3 + j) * 1024 : O_S_SSMC + (((size_t)layer * 32 + (chunk - 256)) * 3 + j) * 1024) + (c0 - PC_SX);
                                    *(f32x4*)o = v0; *(f32x4*)(o + 4) = v1;
                                }
                            }
                            if (fr == 15 && (pn == 3 || pn >= 11)) {
                                const int oc = (pn == 3) ? (c0 - PC_R) : (c0 - 2560);
                                *(u32x4*)(hshift + (size_t)chunk * 1024 + oc) = w;
                                if (chunk >= 255) {
                                    float* o = out + (chunk == 255 ? O_P_SHIFT + (size_t)layer * 1024 : O_S_SHIFT + ((size_t)layer * 32 + (chunk - 256)) * 1024) + oc;
                                    *(f32x4*)o = v0; *(f32x4*)(o + 4) = v1;
                                }
                            }
                        }
                    }
                }
            }
    }
};
template <bool F32BASE, int MT> struct EpiResid {
    static constexpr bool PERM = true;
    const float* base_p; const float* base_s; bf16_t* xb; float* ssq;
    __device__ __forceinline__ void operator()(const f32x4 (&acc)[2][2][4][2], const Unit& u, int wr, int wc, int fr, int fq) const {
        const int col0 = u.pn * BM + wc * 32 + 8 * fq;
#pragma unroll
        for (int ai = 0; ai < 2; ++ai)
#pragma unroll
            for (int m = 0; m < MT; ++m) {
                const int row = u.pm * (64 * MT) + ai * (32 * MT) + wr * (16 * MT) + m * 16 + fr;
                float ss = 0.f;
#pragma unroll
                for (int bj = 0; bj < 2; ++bj) {
                    const int c = col0 + bj * HALF;
                    float x[8];
                    if (F32BASE) {
                        const float* bp = ((row < TP) ? base_p + (size_t)row * DM : base_s + (size_t)(row - TP) * DM) + c;
                        const f32x4 b0 = *(const f32x4*)bp, b1 = *(const f32x4*)(bp + 4);
                        x[0] = b0[0]; x[1] = b0[1]; x[2] = b0[2]; x[3] = b0[3]; x[4] = b1[0]; x[5] = b1[1]; x[6] = b1[2]; x[7] = b1[3];
                    } else unpack8(*(const u32x4*)(xb + (size_t)row * DM + c), x);
#pragma unroll
                    for (int n = 0; n < 2; ++n)
#pragma unroll
                        for (int i = 0; i < 4; ++i) { const float v = x[4 * n + i] + acc[ai][bj][m][n][i]; x[4 * n + i] = v; ss += v * v; }
                    *(u32x4*)(xb + (size_t)row * DM + c) = pack8(x);
                }
                ss += __shfl_xor(ss, 16); ss += __shfl_xor(ss, 32);
                if (fq == 0) ssq[(size_t)row * 16 + u.pn * 4 + wc] = ss;
            }
    }
};
struct EpiGateUp {
    static constexpr bool PERM = true;
    bf16_t* ff; const float* ssq;
    __device__ __forceinline__ void operator()(const f32x4 (&acc)[2][2][4][2], const Unit& u, int wr, int wc, int fr, int fq) const {
        const int c0 = u.pn * HALF + wc * 32 + 8 * fq;
#pragma unroll
        for (int ai = 0; ai < 2; ++ai)
#pragma unroll
            for (int m = 0; m < 4; ++m) {
                const int row = u.pm * BM + ai * HALF + wr * 64 + m * 16 + fr;
                const float rs = row_rstd(ssq, row, fq);
                float f[8];
#pragma unroll
                for (int n = 0; n < 2; ++n)
#pragma unroll
                    for (int i = 0; i < 4; ++i) { const float gg = acc[ai][0][m][n][i] * rs, uu = acc[ai][1][m][n][i] * rs; f[n * 4 + i] = siluf_(gg) * uu; }
                *(u32x4*)(ff + (size_t)row * FF + c0) = pack8(f);
            }
    }
};
}

#define XB_TMO      128
#define XB_XCNT(j)  (256  + 64 * (j))
#define XB_XSUB(j)  (1280 + 64 * (j))
#define XB_XGEN(j)  (2304 + 64 * (j))
#define XB_TOP      3328
#define XB_TOPGEN   3392
#define XCD_BAR_WORDS 3456
#define XB_SPIN_CAP (1u << 18)
__device__ __forceinline__ unsigned xb_ld(unsigned* p)              { return __hip_atomic_load(p, __ATOMIC_RELAXED, __HIP_MEMORY_SCOPE_AGENT); }
__device__ __forceinline__ unsigned xb_add(unsigned* p, unsigned v) { return __hip_atomic_fetch_add(p, v, __ATOMIC_RELAXED, __HIP_MEMORY_SCOPE_AGENT); }
__device__ __forceinline__ unsigned xb_xcc_id() { return (unsigned)__builtin_amdgcn_s_getreg((3 << 11) | 20) & 0xFu; }
#define XB_SPIN(cond, bar) do { unsigned _sp = 0; while (cond) { __builtin_amdgcn_s_sleep(1); \
    if ((++_sp & 255u) == 0u) { if (xb_ld(&(bar)[XB_TMO])) break; if (_sp > XB_SPIN_CAP) { atomicAdd(&(bar)[XB_TMO], 1u); break; } } } } while (0)
struct XcdBarrier { unsigned* bar; unsigned x; volatile LAS unsigned* st; };
__device__ __forceinline__ XcdBarrier xcd_barrier_post(unsigned* bar, volatile LAS unsigned* st) {
    XcdBarrier b; b.bar = bar; b.x = xb_xcc_id(); b.st = st;
    if (threadIdx.x == 0) (void)xb_add(&bar[XB_XCNT(b.x)], 1u);
    return b;
}
__device__ __forceinline__ void xcd_barrier_complete(unsigned* bar, unsigned x, unsigned& nloc, unsigned& nx) {
    const unsigned G = gridDim.x * gridDim.y * gridDim.z;
    unsigned sum, cnt, mine, sp = 0u;
    for (;;) {
        sum = 0u; cnt = 0u; mine = 0u;
#pragma unroll
        for (unsigned j = 0; j < 16; ++j) { const unsigned c = xb_ld(&bar[XB_XCNT(j)]); sum += c; cnt += (c > 0u) ? 1u : 0u; mine = (j == x) ? c : mine; }
        if (sum == G) break;
        __builtin_amdgcn_s_sleep(1);
        if ((++sp & 255u) == 0u) { if (xb_ld(&bar[XB_TMO])) break; if (sp > XB_SPIN_CAP) { atomicAdd(&bar[XB_TMO], 1u); break; } }
    }
    nloc = mine > 0u ? mine : 1u; nx = cnt > 0u ? cnt : 1u;
}
__device__ __forceinline__ void xcd_barrier(const XcdBarrier& b) {
    asm volatile("s_waitcnt vmcnt(0)" ::: "memory");
    __syncthreads();
    if (threadIdx.x == 0) {
        unsigned* bar = b.bar;
        __builtin_amdgcn_s_waitcnt(0);
        unsigned nloc = b.st[0], nx = b.st[1];
        if (nloc == 0u) { xcd_barrier_complete(bar, b.x, nloc, nx); b.st[0] = nloc; b.st[1] = nx; }
        const unsigned old = xb_add(&bar[XB_XSUB(b.x)], 1u);
        const unsigned gen = old / nloc;
        if (old + 1u == (gen + 1u) * nloc) {
            __builtin_amdgcn_fence(__ATOMIC_RELEASE, "agent");
            asm volatile("s_waitcnt vmcnt(0)" ::: "memory");
            const unsigned og = xb_add(&bar[XB_TOP], 1u);
            const unsigned tg = og / nx;
            if (og + 1u == (tg + 1u) * nx) xb_add(&bar[XB_TOPGEN], 1u);
            else XB_SPIN(xb_ld(&bar[XB_TOPGEN]) == tg, bar);
            __builtin_amdgcn_fence(__ATOMIC_ACQUIRE, "agent");
            xb_add(&bar[XB_XGEN(b.x)], 1u);
            asm volatile("s_waitcnt vmcnt(0)" ::: "memory");
        } else {
            XB_SPIN(xb_ld(&bar[XB_XGEN(b.x)]) == gen, bar);
            __builtin_amdgcn_fence(__ATOMIC_ACQUIRE, "agent");
            asm volatile("s_waitcnt vmcnt(0)" ::: "memory");
        }
    }
    __syncthreads();
}

struct Args { const float* in[37]; float* out; unsigned char* ws; unsigned sched[8]; int nsched, pmode; };
enum { I_XP = 0, I_XS, I_SGDN, I_SGDNC, I_SSSM, I_SSSMC, I_SRWKV, I_SSHIFT, I_NORM1, I_WIN, I_GCONVW, I_GALOG, I_GDTB, I_GNORMW,
       I_SCONVW, I_SCONVB, I_SALOG, I_SDTB, I_SD, I_SNORMW, I_RMU, I_RW0, I_RWUP, I_RA0, I_RAUP, I_RGUP, I_RKK, I_RKA, I_RRK, I_RLNW, I_RLNB,
       I_WOUT, I_NORM2, I_WG, I_WU, I_WD, I_FNORM };

struct Frame {
    LAS unsigned char* lds;
    int tid, lane, wave, vcu, G;
    float* out; unsigned char* ws;
};
constexpr int PTRTAB_OFF = LDSCTL_OFF + 1024;
__device__ __forceinline__ const float* inptr(LAS unsigned char* lds, int i) {
    const unsigned long long v = ((const LAS unsigned long long*)(lds + PTRTAB_OFF))[i];
    const unsigned lo = __builtin_amdgcn_readfirstlane((unsigned)v), hi = __builtin_amdgcn_readfirstlane((unsigned)(v >> 32));
    return (const float*)(((unsigned long long)hi << 32) | lo);
}
#define INP(i) inptr(F.lds, (i))
#define F_R1     ((bf16_t*)(F.ws + WS_R1))
#define F_R2     ((bf16_t*)(F.ws + WS_R2))
#define F_PROJ   ((bf16_t*)(F.ws + WS_PROJ))
#define F_SSQA   ((float*)(F.ws + WS_SSQA))
#define F_SSQD   ((float*)(F.ws + WS_SSQD))
#define F_SCAL   ((float*)(F.ws + WS_R2 + R2_SCAL))
#define F_HCONV  ((bf16_t*)(F.ws + WS_R2 + R2_HCONV))
#define F_HSHIFT ((bf16_t*)(F.ws + WS_R2 + R2_HSHIFT))
#define F_RWA    ((bf16_t*)((unsigned char*)F.out + R1_RWA))
#define F_RU     ((bf16_t*)((unsigned char*)F.out + R1_RU))
#define F_RBH    ((bf16_t*)((unsigned char*)F.out + R1_RBH))
#define F_RKV    ((bf16_t*)((unsigned char*)F.out + R1_RKV))
#define F_RDV    ((float*)(F.ws + WS_R2 + R2_RDV))
#define F_ACUM   ((float*)(F.ws + WS_R2 + R2_ACUM))
#define F_GCUM   ((float*)(F.ws + WS_R2 + R2_GCUM))
#define F_YOFF   ((bf16_t*)(F.ws + WS_R2 + R2_YOFF))
#define F_GW     ((bf16_t*)(F.ws + WS_R2 + R2_GW))
__device__ __forceinline__ bf16_t* w_in(const Frame& F, int l) { return (bf16_t*)(F.ws + WS_W + (size_t)l * W_LAYER_B); }
__device__ __forceinline__ bf16_t* w_out(const Frame& F, int l) { return (bf16_t*)(F.ws + WS_W + (size_t)l * W_LAYER_B + W_IN_B); }
__device__ __forceinline__ bf16_t* w_gu(const Frame& F, int l) { return (bf16_t*)(F.ws + WS_W + (size_t)l * W_LAYER_B + W_IN_B + W_OUT_B); }
__device__ __forceinline__ bf16_t* w_dn(const Frame& F, int l) { return (bf16_t*)(F.ws + WS_W + (size_t)l * W_LAYER_B + W_IN_B + W_OUT_B + W_GU_B); }

template <class Tp> __device__ __forceinline__ LAS Tp* opaque_lds(LAS Tp* p) { unsigned a = (unsigned)(unsigned long long)p; asm volatile("" : "+v"(a)); return (LAS Tp*)(unsigned long long)a; }
constexpr int CW_AFLAG = 14336, CW_RFLAG = 14336 + 288;
__device__ __forceinline__ void publish_item(unsigned* flag) {
    asm volatile("s_waitcnt vmcnt(0)" ::: "memory");
    LDS_BARRIER();
    if (threadIdx.x == 0) {
        __builtin_amdgcn_fence(__ATOMIC_RELEASE, "agent");
        asm volatile("s_waitcnt vmcnt(0)" ::: "memory");
        __hip_atomic_fetch_add(flag, 1u, __ATOMIC_RELAXED, __HIP_MEMORY_SCOPE_AGENT);
    }
}
__device__ __forceinline__ int opaque_tid() { int t = threadIdx.x; asm volatile("" : "+v"(t)); return t; }
#define PHASE_IDS(F) do { (F).tid = opaque_tid(); (F).lane = (F).tid & 63; (F).wave = __builtin_amdgcn_readfirstlane((F).tid >> 6); } while (0)
__device__ __forceinline__ int inproj_dst(int n) {
    if (n < 768) return PC_GQ + n;
    if (n < 1024) return PC_ZG + (n - 768);
    if (n < 1032) return 3584 + (n - 1024);
    if (n < 1544) return PC_ZS + (n - 1032);
    if (n < 2568) return PC_SX + (n - 1544);
    if (n < 2576) return 3592 + (n - 2568);
    if (n < 2832) return PC_R + (n - 2576);
    if (n < 3344) return PC_RK + (n - 2832);
    return PC_RL + (n - 3344);
}
template <int MODE>
__device__ __forceinline__ void p0_transpose_item(const float* W, int K, int N, bf16_t* WT, const float* kscale, LAS float* scr, int item, int lane) {
    const int nblk = (N + 31) / 32, kb = item / nblk, nb = item % nblk, k0 = 64 * kb, n0 = 32 * nb;
    {
        const int rr = lane >> 3, c4 = (lane & 7) * 4;
        f32x4 v[8];
#pragma unroll
        for (int i = 0; i < 8; ++i) { const float* p = W + (size_t)(k0 + 8 * i + rr) * N + n0 + c4;
            if (n0 + c4 + 3 < N) v[i] = *(const f32x4*)p;
            else v[i] = (f32x4){0.f, 0.f, 0.f, 0.f}; }
#pragma unroll
        for (int i = 0; i < 8; ++i) { LAS float* s = scr + (8 * i + rr) * 33 + c4; s[0] = v[i][0]; s[1] = v[i][1]; s[2] = v[i][2]; s[3] = v[i][3]; }
    }
    asm volatile("s_waitcnt lgkmcnt(0)" ::: "memory");
    const int c = lane & 7;
    float ks[8];
#pragma unroll
    for (int i = 0; i < 8; ++i) ks[i] = kscale ? kscale[k0 + 8 * c + i] : 1.f;
#pragma unroll
    for (int j = 0; j < 4; ++j) { const int nl = (lane >> 3) + 8 * j; const int n = n0 + nl; const LAS float* s = scr + (8 * c) * 33 + nl;
        u32x4 o; o.x = cvt_pk_bf16(s[0 * 33] * ks[0], s[1 * 33] * ks[1]); o.y = cvt_pk_bf16(s[2 * 33] * ks[2], s[3 * 33] * ks[3]);
        o.z = cvt_pk_bf16(s[4 * 33] * ks[4], s[5 * 33] * ks[5]); o.w = cvt_pk_bf16(s[6 * 33] * ks[6], s[7 * 33] * ks[7]);
        if (n < N) {
            int d;
            if (MODE == 0) d = n; else if (MODE == 1) d = inproj_dst(n); else if (MODE == 2) d = 256 * (n >> 7) + (n & 127); else d = 256 * (n >> 7) + 128 + (n & 127);
            *(u32x4*)(WT + (size_t)d * K + k0 + 8 * c) = o; } }
    asm volatile("s_waitcnt lgkmcnt(0)" ::: "memory");
}
__device__ __forceinline__ void p0_prologue(Frame& F) {
    PHASE_IDS(F);
    LAS float* scr = (LAS float*)(F.lds + F.wave * 16384);
    const int gw = F.vcu * 8 + F.wave, NGW = F.G * 8;
    constexpr int I_IN = 16 * 113, I_OUT = 16 * 32, I_G = 16 * 88, I_D = 44 * 32;
    constexpr int PER_L = I_IN + I_OUT + 2 * I_G + I_D;
    for (int it = gw; it < 2 * PER_L; it += NGW) {
        const int l = it / PER_L; int r = it % PER_L;
        if (r < I_IN) { p0_transpose_item<1>(INP(I_WIN) + (size_t)l * DM * 3600, DM, 3600, w_in(F, l), INP(I_NORM1) + l * DM, scr, r, F.lane); continue; } r -= I_IN;
        if (r < I_OUT) { p0_transpose_item<0>(INP(I_WOUT) + (size_t)l * DM * DM, DM, DM, w_out(F, l), nullptr, scr, r, F.lane); continue; } r -= I_OUT;
        if (r < I_G) { p0_transpose_item<2>(INP(I_WG) + (size_t)l * DM * FF, DM, FF, w_gu(F, l), INP(I_NORM2) + l * DM, scr, r, F.lane); continue; } r -= I_G;
        if (r < I_G) { p0_transpose_item<3>(INP(I_WU) + (size_t)l * DM * FF, DM, FF, w_gu(F, l), INP(I_NORM2) + l * DM, scr, r, F.lane); continue; } r -= I_G;
        p0_transpose_item<0>(INP(I_WD) + (size_t)l * FF * DM, FF, DM, w_dn(F, l), nullptr, scr, r, F.lane);
    }
    for (int m = gw; m < T; m += NGW) {
        const float* xr = (m < TP) ? INP(I_XP) + (size_t)m * DM : INP(I_XS) + (size_t)(m - TP) * DM;
        f32x4 v[4]; float s = 0.f;
#pragma unroll
        for (int j = 0; j < 4; ++j) { v[j] = *((const f32x4*)xr + F.lane + 64 * j); s += (v[j].x * v[j].x + v[j].y * v[j].y) + (v[j].z * v[j].z + v[j].w * v[j].w); }
        s = wave_sum(s);
#pragma unroll
        for (int j = 0; j < 4; ++j) { u32x2 w; w.x = cvt_pk_bf16(v[j].x, v[j].y); w.y = cvt_pk_bf16(v[j].z, v[j].w); *((u32x2*)(F_R1 + (size_t)m * DM) + F.lane + 64 * j) = w; }
        if (F.lane < 16) F_SSQA[(size_t)m * 16 + F.lane] = (F.lane == 0) ? s : 0.f;
    }
}

template <int LDL, int SGN, class RhsFn>
__device__ __forceinline__ void tri_solve64(const LAS float* Lo, float (&x)[64], RhsFn rhs) {
    f32x4 cur[16], nxt[16];
#pragma unroll
    for (int i = 0; i < 64; ++i) {
        if (i + 1 < 64) {
#pragma unroll
            for (int m4 = 0; m4 < (i + 1 + 3) / 4; ++m4) nxt[m4] = *(const LAS f32x4*)(Lo + (i + 1) * LDL + 4 * m4);
        }
        float a0 = rhs(i), a1 = 0.f, a2 = 0.f, a3 = 0.f;
#pragma unroll
        for (int m4 = 0; m4 < (i + 3) / 4; ++m4) {
            if (4 * m4 + 0 < i) a0 += (SGN > 0 ? cur[m4][0] : -cur[m4][0]) * x[4 * m4 + 0];
            if (4 * m4 + 1 < i) a1 += (SGN > 0 ? cur[m4][1] : -cur[m4][1]) * x[4 * m4 + 1];
            if (4 * m4 + 2 < i) a2 += (SGN > 0 ? cur[m4][2] : -cur[m4][2]) * x[4 * m4 + 2];
            if (4 * m4 + 3 < i) a3 += (SGN > 0 ? cur[m4][3] : -cur[m4][3]) * x[4 * m4 + 3];
        }
        x[i] = (a0 + a1) + (a2 + a3);
        __builtin_amdgcn_sched_barrier(0);
#pragma unroll
        for (int m4 = 0; m4 < 16; ++m4) cur[m4] = nxt[m4];
    }
}
constexpr int ACT_KT = 0, ACT_VT = 33792, ACT_LM = 67584, ACT_SCL = 137216, ACT_GCL = 141312;
constexpr int ACT_LDK = 264, ACT_LDL = 68;
__device__ __forceinline__ void act_chunk(Frame& F, int l, int c) {
    PHASE_IDS(F);
    const int tid = F.tid;
    const size_t row0 = (size_t)c * 64;
    const bool prompt = c < 256; const int b = c - 256;
    bf16_t* const proj = F_PROJ;
    LAS float* inT = (LAS float*)F.lds;
    LAS bf16_t* kx = (LAS bf16_t*)(F.lds + 256 * 68 * 4);
    LAS bf16_t* Kt = (LAS bf16_t*)(F.lds + ACT_KT); LAS bf16_t* Vt = (LAS bf16_t*)(F.lds + ACT_VT); LAS float* Lm = (LAS float*)(F.lds + ACT_LM);
    LAS float* scl = (LAS float*)(F.lds + ACT_SCL); LAS float* gcl = (LAS float*)(F.lds + ACT_GCL);
    LAS float* part = (LAS float*)(F.lds + ACT_LM); LAS float* rsl = part + 2 * 64 * 16;
    {
        const int w = F.wave, lane = F.lane, i16 = lane & 15, g = lane >> 4, rt = w & 3, kh = w >> 2;
        const bf16_t* ap = F_R1 + (row0 + 16 * rt + i16) * DM + kh * 512 + 8 * g;
        const bf16_t* bp = w_in(F, l) + (size_t)(PW + i16) * DM + kh * 512 + 8 * g;
        bf16x8 a[16], b[16];
#pragma unroll
        for (int ks = 0; ks < 16; ++ks) { a[ks] = *(const bf16x8*)(ap + 32 * ks); b[ks] = *(const bf16x8*)(bp + 32 * ks); }
        if (tid < 64) { const f32x4* sp = (const f32x4*)(F_SSQA + (row0 + tid) * 16); const f32x4 p0 = sp[0], p1 = sp[1], p2 = sp[2], p3 = sp[3];
            const float s = ((p0.x + p0.y) + (p0.z + p0.w)) + ((p1.x + p1.y) + (p1.z + p1.w)) + ((p2.x + p2.y) + (p2.z + p2.w)) + ((p3.x + p3.y) + (p3.z + p3.w));
            rsl[tid] = rsqrtf(s * (1.0f / 1024.0f) + EPS); }
        f32x4 acc0 = (f32x4){0.f, 0.f, 0.f, 0.f}, acc1 = (f32x4){0.f, 0.f, 0.f, 0.f};
#pragma unroll
        for (int ks = 0; ks < 16; ks += 2) { acc0 = mma16(a[ks], b[ks], acc0); acc1 = mma16(a[ks + 1], b[ks + 1], acc1); }
#pragma unroll
        for (int r = 0; r < 4; ++r) part[(kh * 64 + 16 * rt + 4 * g + r) * 16 + i16] = acc0[r] + acc1[r];
    }
    LDS_BARRIER();
    for (int e = tid; e < 64 * 16; e += 512) {
        const int t = e >> 4, q = e & 15;
        float* p = F_SCAL + (row0 + t) * 16 + q;
        const float v = (part[e] + part[1024 + e]) * rsl[t]; float r;
        if (q < 4) r = -__expf(INP(I_GALOG)[l * 4 + q]) * softplusf_(v + INP(I_GDTB)[l * 4 + q]);
        else if (q < 8) r = sigmoidf_(v);
        else r = softplusf_(v + INP(I_SDTB)[l * 8 + (q - 8)]);
        *p = r; scl[e] = r;
    }
    LDS_BARRIER();
    {
        const int w = F.wave, lane = F.lane;
        float v = scl[lane * 16 + 8 + w] * (-__expf(INP(I_SALOG)[l * 8 + w]));
#pragma unroll
        for (int o = 1; o < 64; o <<= 1) { const float tt = __shfl_up(v, o); if (lane >= o) v += tt; }
        F_ACUM[(row0 + lane) * 8 + w] = v;
        if (w < 4) {
            float gv = scl[lane * 16 + w];
#pragma unroll
            for (int o = 1; o < 64; o <<= 1) { const float tt = __shfl_up(gv, o); if (lane >= o) gv += tt; }
            F_GCUM[(row0 + lane) * 4 + w] = gv; gcl[w * 64 + lane] = gv;
        }
    }
    {
        const int cg = tid % 224, rh = tid / 224;
        const bool active = tid < 448;
        const int col = 1024 + cg * 8, t0 = 32 * rh;
        const bool gdn = cg < 96;
        const int cc = gdn ? (col - PC_GQ) : (col - PC_SX);
        const int C = gdn ? 768 : 1024;
        const int kind = gdn ? (cg >> 5) : 3;
        float w[4][8], bias[8], p3[8], p2[8], p1[8];
        u32x4 xr[16];
        if (active) {
            const float* cw = gdn ? INP(I_GCONVW) + (size_t)l * 4 * 768 : INP(I_SCONVW) + (size_t)l * 4 * 1024;
#pragma unroll
            for (int j = 0; j < 4; ++j)
#pragma unroll
                for (int i = 0; i < 8; ++i) w[j][i] = cw[j * C + cc + i];
#pragma unroll
            for (int i = 0; i < 8; ++i) bias[i] = gdn ? 0.f : INP(I_SCONVB)[l * 1024 + cc + i];
            if (rh == 1) {
                unpack8(*(const u32x4*)(proj + (row0 + t0 - 3) * PW + col), p3); unpack8(*(const u32x4*)(proj + (row0 + t0 - 2) * PW + col), p2); unpack8(*(const u32x4*)(proj + (row0 + t0 - 1) * PW + col), p1);
            } else if (prompt) {
                if (c == 0) {
#pragma unroll
                    for (int i = 0; i < 8; ++i) { p3[i] = 0.f; p2[i] = 0.f; p1[i] = 0.f; }
                } else {
                    const bf16_t* hp = F_HCONV + (size_t)(c - 1) * 3 * 1792 + (col - 1024);
                    unpack8(*(const u32x4*)(hp), p3); unpack8(*(const u32x4*)(hp + 1792), p2); unpack8(*(const u32x4*)(hp + 2 * 1792), p1);
                }
            } else {
                const float* st = gdn ? INP(I_SGDNC) + ((size_t)l * 32 + b) * 3 * 768 + cc : INP(I_SSSMC) + ((size_t)l * 32 + b) * 3 * 1024 + cc;
#pragma unroll
                for (int i = 0; i < 8; ++i) { p3[i] = st[i]; p2[i] = st[C + i]; p1[i] = st[2 * C + i]; }
            }
#pragma unroll
            for (int t = 0; t < 16; ++t) xr[t] = *(const u32x4*)(proj + (row0 + t0 + t) * PW + col);
        }
        asm volatile("s_waitcnt vmcnt(0)" ::: "memory");
        LDS_BARRIER();
#pragma unroll
        for (int bt = 0; bt < 2; ++bt) {
            if (active) {
#pragma unroll
                for (int t = 0; t < 16; ++t) {
                    const int tr = t0 + 16 * bt + t;
                    bf16_t* p = proj + (row0 + tr) * PW + col;
                    float x[8], y[8];
                    unpack8(xr[t], x);
#pragma unroll
                    for (int i = 0; i < 8; ++i) { float a = w[0][i] * p3[i] + w[1][i] * p2[i] + w[2][i] * p1[i] + w[3][i] * x[i] + bias[i]; y[i] = siluf_(a); p3[i] = p2[i]; p2[i] = p1[i]; p1[i] = x[i]; }
                    if (kind < 2) {
                        float ss = 0.f;
#pragma unroll
                        for (int i = 0; i < 8; ++i) ss += y[i] * y[i];
                        ss += __shfl_xor(ss, 1); ss += __shfl_xor(ss, 2); ss += __shfl_xor(ss, 4);
                        const float sc = rsqrtf(ss + EPS) * (kind == 0 ? 0.125f : 1.f);
#pragma unroll
                        for (int i = 0; i < 8; ++i) y[i] *= sc;
                    }
                    const u32x4 pk = pack8(y);
                    if (kind != 2) *(u32x4*)p = pk;
                    if (kind == 1) *(LAS u32x4*)(Kt + tr * ACT_LDK + (col - PC_GK)) = pk;
                    if (kind == 2) *(LAS u32x4*)(Vt + tr * ACT_LDK + (col - PC_GV)) = pk;
                }
                if (bt == 0) {
#pragma unroll
                    for (int t = 0; t < 16; ++t) xr[t] = *(const u32x4*)(proj + (row0 + t0 + 16 + t) * PW + col);
                }
            }
        }
    }
    LDS_BARRIER();
    {
        const int w = F.wave, lane = F.lane, i16 = lane & 15, g = lane >> 4, h = w >> 1, e = w & 1;
        LAS float* Lh = Lm + h * 64 * ACT_LDL;
#pragma unroll
        for (int ii = 0; ii < 2; ++ii) {
            const int it = e + 2 * ii;
#pragma unroll
            for (int jt = 0; jt < 4; ++jt) {
                if (jt <= it) {
                    f32x4 acc = (f32x4){0.f, 0.f, 0.f, 0.f};
#pragma unroll
                    for (int ks = 0; ks < 2; ++ks) acc = mma16(frag_nat(Kt, ACT_LDK, 16 * it, h * 64 + 32 * ks, i16, g), frag_nat(Kt, ACT_LDK, 16 * jt, h * 64 + 32 * ks, i16, g), acc);
                    const int j = 16 * jt + i16; const float gcj = gcl[h * 64 + j];
#pragma unroll
                    for (int r = 0; r < 4; ++r) { const int i = 16 * it + 4 * g + r;
                        const float f = (j < i) ? scl[i * 16 + 4 + h] * __expf(fminf(gcl[h * 64 + i] - gcj, 0.f)) : 0.f;
                        Lh[i * ACT_LDL + j] = acc[r] * f; }
                }
            }
        }
        LDS_BARRIER();
        float x[64];
        const LAS bf16_t* Rt = opaque_lds((e == 0 ? Vt : Kt) + h * 64 + lane); const float ef = (float)e;
        const LAS float* Lo = opaque_lds(Lh); const LAS float* sclo = opaque_lds(scl + 4 + h); const LAS float* gclo = opaque_lds(gcl + h * 64);
        tri_solve64<ACT_LDL, -1>(Lo, x, [&](int i) { return sclo[i * 16] * __expf(gclo[i] * ef) * bf2f(Rt[i * ACT_LDK]); });
        if (e == 0) {
            bf16_t* o = proj + (row0 + lane) * PW + PC_GV + h * 64;
#pragma unroll
            for (int q = 0; q < 8; ++q) { float y[8];
#pragma unroll
                for (int i = 0; i < 8; ++i) y[i] = x[8 * q + i];
                *(u32x4*)(o + 8 * q) = pack8(y); }
        } else {
            bf16_t* o = F_GW + (((size_t)c * 4 + h) * 64) * 64 + lane;
#pragma unroll
            for (int i = 0; i < 64; ++i) o[i * 64] = f2bf(-x[i]);
        }
    }
    publish_item((unsigned*)(F.ws + WS_CTL) + CW_AFLAG + c);
    LDS_BARRIER();
}

__device__ __forceinline__ void st8_wt(void* p, u32x2 v) { __hip_atomic_store((unsigned long long*)p, __builtin_bit_cast(unsigned long long, v), __ATOMIC_RELAXED, __HIP_MEMORY_SCOPE_AGENT); }
__device__ __forceinline__ u32x4 ld16_asm(const void* p) { u32x4 r; asm volatile("global_load_dwordx4 %0, %1, off sc1" : "=v"(r) : "v"(p)); return r; }
__device__ __forceinline__ float ld4_asm(const float* p) { float r; asm volatile("global_load_dword %0, %1, off sc1" : "=v"(r) : "v"(p)); return r; }
constexpr int RDY_SLACK = 8;
#define RDY_WORD(F) ((volatile LAS int*)((F).lds + MISC_OFF + 64))
__device__ __forceinline__ int rdy_advance(const unsigned* rdy, int rstride, unsigned rneed, int nxt, int nch, int lane) {
    const int k = nxt + (lane & 15);
    const bool ok = k < nch && (int)(__hip_atomic_load(rdy + (size_t)rstride * k, __ATOMIC_RELAXED, __HIP_MEMORY_SCOPE_AGENT) - rneed) >= 0;
    const unsigned long long m = __ballot(ok) & 0xffffull;
    return nxt + __builtin_ctzll(~m);
}
__device__ __forceinline__ int rdy_block(Frame& F, const unsigned* rdy, int rstride, unsigned rneed, int nxt, int upto, int nch) {
    unsigned sp = 0;
    while (nxt < upto && ++sp < 4000000u) { const int n2 = rdy_advance(rdy, rstride, rneed, nxt, nch, F.lane); if (n2 == nxt) __builtin_amdgcn_s_sleep(8); nxt = n2; }
    if (F.lane == 0) *RDY_WORD(F) = nxt - 1;
    return nxt;
}
#define RDY_LOADER_WAIT(F, k) do { const int kk_ = (k) < nch ? (k) : nch - 1; unsigned sp_ = 0; while (*RDY_WORD(F) < kk_ && ++sp_ < 40000000u) __builtin_amdgcn_s_sleep(1); } while (0)
#define SCAN_CL(k) (c0 + ((k) < nch ? (k) : nch - 1))
#define SCAN_LOADER6(LOADM, WRITEM, WAITM, NLD) do {            \
        RDY_LOADER_WAIT(F, 0); LOADM(SCAN_CL(0), 0); WAITM(0, 0); WRITEM(0, 0); \
        RDY_LOADER_WAIT(F, 1); LOADM(SCAN_CL(1), 1); RDY_LOADER_WAIT(F, 2); LOADM(SCAN_CL(2), 2); RDY_LOADER_WAIT(F, 3); LOADM(SCAN_CL(3), 3); RDY_LOADER_WAIT(F, 4); LOADM(SCAN_CL(4), 4); RDY_LOADER_WAIT(F, 5); LOADM(SCAN_CL(5), 5); \
        LDS_BARRIER(); \
        for (int r_ = 0; r_ < nch; r_ += 6) { \
            RDY_LOADER_WAIT(F, r_ + 6); LOADM(SCAN_CL(r_ + 6), 0); WAITM(1, 5 * (NLD)); WRITEM(1, 1); LDS_BARRIER(); if (r_ + 1 >= nch) break; \
            RDY_LOADER_WAIT(F, r_ + 7); LOADM(SCAN_CL(r_ + 7), 1); WAITM(2, 5 * (NLD)); WRITEM(0, 2); LDS_BARRIER(); if (r_ + 2 >= nch) break; \
            RDY_LOADER_WAIT(F, r_ + 8); LOADM(SCAN_CL(r_ + 8), 2); WAITM(3, 5 * (NLD)); WRITEM(1, 3); LDS_BARRIER(); if (r_ + 3 >= nch) break; \
            RDY_LOADER_WAIT(F, r_ + 9); LOADM(SCAN_CL(r_ + 9), 3); WAITM(4, 5 * (NLD)); WRITEM(0, 4); LDS_BARRIER(); if (r_ + 4 >= nch) break; \
            RDY_LOADER_WAIT(F, r_ + 10); LOADM(SCAN_CL(r_ + 10), 4); WAITM(5, 5 * (NLD)); WRITEM(1, 5); LDS_BARRIER(); if (r_ + 5 >= nch) break; \
            RDY_LOADER_WAIT(F, r_ + 11); LOADM(SCAN_CL(r_ + 11), 5); WAITM(0, 5 * (NLD)); WRITEM(0, 0); LDS_BARRIER(); \
        } \
        asm volatile("s_waitcnt vmcnt(0)" ::: "memory"); \
        } while (0)
#define SCAN_LOADER(LOADM, WRITEM, WAITM, NLD) do { \
          \
          \
        RDY_LOADER_WAIT(F, 0); LOADM(SCAN_CL(0), 0); WAITM(0, 0); WRITEM(0, 0); \
        RDY_LOADER_WAIT(F, 1); LOADM(SCAN_CL(1), 1); RDY_LOADER_WAIT(F, 2); LOADM(SCAN_CL(2), 2); RDY_LOADER_WAIT(F, 3); LOADM(SCAN_CL(3), 3); \
        LDS_BARRIER(); \
          \
        for (int r_ = 0; r_ < nch; r_ += 4) { \
            RDY_LOADER_WAIT(F, r_ + 4); LOADM(SCAN_CL(r_ + 4), 0); WAITM(1, 3 * (NLD)); WRITEM(1, 1); LDS_BARRIER(); if (r_ + 1 >= nch) break; \
            RDY_LOADER_WAIT(F, r_ + 5); LOADM(SCAN_CL(r_ + 5), 1); WAITM(2, 3 * (NLD)); WRITEM(0, 2); LDS_BARRIER(); if (r_ + 2 >= nch) break; \
            RDY_LOADER_WAIT(F, r_ + 6); LOADM(SCAN_CL(r_ + 6), 2); WAITM(3, 3 * (NLD)); WRITEM(1, 3); LDS_BARRIER(); if (r_ + 3 >= nch) break; \
            RDY_LOADER_WAIT(F, r_ + 7); LOADM(SCAN_CL(r_ + 7), 3); WAITM(0, 3 * (NLD)); WRITEM(0, 0); LDS_BARRIER(); \
        } \
        asm volatile("s_waitcnt vmcnt(0)" ::: "memory");      \
        } while (0)

constexpr int GDN_LD = 72;
constexpr int GDN_BUF = 3 * 64 * GDN_LD * 2 + 64;
__device__ __forceinline__ void scan_gdn2(Frame& F, int l, int s, int h, int vb, int ncw, unsigned* prog, unsigned pbase, unsigned* done, int pm, const unsigned* rdy, int rstride, unsigned rneed) {
    PHASE_IDS(F);
    const int tid = F.tid, lane = F.lane, w = F.wave, i16 = lane & 15, g = lane >> 4;
    const int nch = (s == 0) ? 256 : 1, c0 = (s == 0) ? 0 : 255 + s, b = s - 1;
    bf16_t* const proj = F_PROJ; bf16_t* const gw = F_GW; const float* const gcum = F_GCUM;
    {
        if (w == (ncw < 4 ? ncw : 0)) (void)rdy_block(F, rdy, rstride, rneed, 0, nch < RDY_SLACK ? nch : RDY_SLACK, nch);
        LDS_BARRIER();
    }
    if (w >= 4) {
        const int lt = tid - 256;
        const int umask = 128 * ncw - 1;
        u32x4 rw0[2], ru0[2], rk0[2], rw1[2], ru1[2], rk1[2], rw2[2], ru2[2], rk2[2], rw3[2], ru3[2], rk3[2], rw4[2], ru4[2], rk4[2], rw5[2], ru5[2], rk5[2]; float gc0[2], gl0, gc1[2], gl1, gc2[2], gl2, gc3[2], gl3, gc4[2], gl4, gc5[2], gl5;
        const bf16_t* pW[2]; const bf16_t* pU[2]; const bf16_t* pK[2]; const float* pG[2]; const float* const pGl = gcum + 63 * 4 + h;
#pragma unroll
        for (int q = 0; q < 2; ++q) { const int idx = q * 256 + lt, row = idx >> 3, col8 = (idx & 7) * 8, urow = vb + ((idx & umask) >> 3);
            pW[q] = gw + ((size_t)h * 64 + row) * 64 + col8; pU[q] = proj + (size_t)urow * PW + PC_GV + h * 64 + col8; pK[q] = proj + (size_t)row * PW + PC_GK + h * 64 + col8; pG[q] = gcum + row * 4 + h; }
        const bool dupU = ncw < 4;
        if (dupU) pU[1] = proj + PC_GV;
#define GDN_LOAD(ch, S) do { const size_t oW_ = (size_t)(ch) * (4 * 4096), oP_ = (size_t)(ch) * (64 * PW), oG_ = (size_t)(ch) * 256; gl##S = ld4_asm(pGl + oG_); \
        _Pragma("unroll") for (int q = 0; q < 2; ++q) { rw##S[q] = ld16_asm(pW[q] + oW_); ru##S[q] = ld16_asm(pU[q] + oP_); rk##S[q] = ld16_asm(pK[q] + oP_); gc##S[q] = ld4_asm(pG[q] + oG_); } } while (0)
#define GDN_WAIT(S, N) asm volatile("s_waitcnt vmcnt(%9)" : "+v"(rw##S[0]), "+v"(rw##S[1]), "+v"(ru##S[0]), "+v"(ru##S[1]), "+v"(rk##S[0]), "+v"(rk##S[1]), "+v"(gc##S[0]), "+v"(gc##S[1]), "+v"(gl##S) : "n"(N))
#define GDN_WRITE(bb, S) do { LAS bf16_t* Wn_ = (LAS bf16_t*)(F.lds + (bb) * GDN_BUF); LAS bf16_t* Ut_ = Wn_ + 64 * GDN_LD; LAS bf16_t* Kd_ = Ut_ + 64 * GDN_LD; \
        _Pragma("unroll") for (int q = 0; q < 2; ++q) { const int idx = q * 256 + lt, row = idx >> 3, col8 = (idx & 7) * 8; \
            *(LAS u32x4*)(Wn_ + row * GDN_LD + col8) = rw##S[q]; if (q == 0 || !dupU) *(LAS u32x4*)(Ut_ + (vb + ((idx & umask) >> 3)) * GDN_LD + col8) = ru##S[q]; \
            const float ks_ = __expf(gl##S - gc##S[q]); \
            float v_[8]; unpack8(rk##S[q], v_); _Pragma("unroll") for (int i = 0; i < 8; ++i) v_[i] *= ks_; *(LAS u32x4*)(Kd_ + row * GDN_LD + col8) = pack8(v_); } \
        if (lt == 0) *(LAS float*)(Kd_ + 64 * GDN_LD) = __expf(gl##S); } while (0)
        SCAN_LOADER6(GDN_LOAD, GDN_WRITE, GDN_WAIT, 9);
#undef GDN_LOAD
#undef GDN_WRITE
#undef GDN_WAIT
    } else if (w >= ncw) {
        int nxt = nch < RDY_SLACK ? nch : RDY_SLACK;
        LDS_BARRIER();
        for (int ci = 0; ci < nch; ++ci) {
            if (w == ncw && nxt < nch) { const int upto = ci + 1 + RDY_SLACK < nch ? ci + 1 + RDY_SLACK : nch; nxt = rdy_block(F, rdy, rstride, rneed, nxt, upto, nch); }
            LDS_BARRIER();
        }
    } else {
        const int n0 = vb + 16 * w;
        f32x4 S[4];
        if (s == 0) {
#pragma unroll
            for (int kt = 0; kt < 4; ++kt) S[kt] = (f32x4){0.f, 0.f, 0.f, 0.f};
        } else {
            const float* st = INP(I_SGDN) + (((size_t)l * 32 + b) * 4 + h) * 4096 + n0 + i16;
#pragma unroll
            for (int kt = 0; kt < 4; ++kt)
#pragma unroll
                for (int r = 0; r < 4; ++r) S[kt][r] = st[(16 * kt + 4 * g + r) * 64];
        }
        LDS_BARRIER();
        for (int ci = 0; ci < nch; ++ci) {
            const int chunk = c0 + ci; const size_t row0 = (size_t)chunk * 64;
            const LAS bf16_t* Wn = (const LAS bf16_t*)(F.lds + (ci & 1) * GDN_BUF); const LAS bf16_t* Ut = Wn + 64 * GDN_LD; const LAS bf16_t* Kd = Ut + 64 * GDN_LD;
            const float bd = *(const LAS float*)(Kd + 64 * GDN_LD);
            bf16x8 A1[4][2], A2[4][2]; u32x2 ui[4];
#pragma unroll
            for (int m = 0; m < 4; ++m) { ui[m] = *(const LAS u32x2*)(Ut + (n0 + i16) * GDN_LD + 16 * m + 4 * g);
#pragma unroll
                for (int ks = 0; ks < 2; ++ks) A1[m][ks] = frag_sig(Wn, GDN_LD, 16 * m, 32 * ks, i16, g); }
#pragma unroll
            for (int kt = 0; kt < 4; ++kt)
#pragma unroll
                for (int cs = 0; cs < 2; ++cs) A2[kt][cs] = frag_tr_sig(Kd, GDN_LD, 32 * cs, 16 * kt, i16, g);
            __builtin_amdgcn_sched_barrier(0);
            bf16x8 Sb[2];
#pragma unroll
            for (int ks = 0; ks < 2; ++ks) Sb[ks] = acc_frag(S[2 * ks], S[2 * ks + 1]);
            {
                bf16_t* ho = ((bf16_t*)((unsigned char*)F.out + (size_t)T * 256 * 2 * 4) + (size_t)(chunk) * 16384) + ((size_t)h * 64 + n0 + i16) * 64 + 4 * g;
#pragma unroll
                for (int kt = 0; kt < 4; ++kt) st8_wt(ho + 16 * kt, pack4(S[kt]));
            }
            f32x4 V[4];
            bf16_t* vo = proj + (row0 + n0 + i16) * PW + PC_GV + h * 64 + 4 * g;
#pragma unroll
            for (int m = 0; m < 4; ++m) {
                f32x4 acc = unpack4(ui[m]);
#pragma unroll
                for (int ks = 0; ks < 2; ++ks) acc = mma16(A1[m][ks], Sb[ks], acc);
                V[m] = acc;
            }
#pragma unroll
            for (int m = 0; m < 4; ++m) st8_wt(vo + 16 * m, pack4(V[m]));
            bf16x8 Ub[2];
#pragma unroll
            for (int cs = 0; cs < 2; ++cs) Ub[cs] = acc_frag(V[2 * cs], V[2 * cs + 1]);
#pragma unroll
            for (int kt = 0; kt < 4; ++kt) {
                f32x4 acc = S[kt] * bd;
#pragma unroll
                for (int cs = 0; cs < 2; ++cs) acc = mma16(A2[kt][cs], Ub[cs], acc);
                S[kt] = acc;
            }
            if (prog) {
                asm volatile("s_waitcnt vmcnt(48)" ::: "memory");
                if (lane == 0 && ci >= 6) __hip_atomic_store(prog + 64 * w, pbase + (unsigned)(ci - 6) + 1u, __ATOMIC_RELAXED, __HIP_MEMORY_SCOPE_AGENT);
            }
            LDS_BARRIER();
        }
        asm volatile("s_waitcnt vmcnt(0)" ::: "memory");
        if (prog && lane == 0) __hip_atomic_store(prog + 64 * w, pbase + (unsigned)nch, __ATOMIC_RELAXED, __HIP_MEMORY_SCOPE_AGENT);
        if (done && lane == 0) __hip_atomic_fetch_add(done, 1u, __ATOMIC_RELAXED, __HIP_MEMORY_SCOPE_AGENT);
        float* o = F.out + (s == 0 ? O_P_GDN + ((size_t)l * 4 + h) * 4096 : O_S_GDN + (((size_t)l * 32 + b) * 4 + h) * 4096) + n0 + i16;
#pragma unroll
        for (int kt = 0; kt < 4; ++kt)
#pragma unroll
            for (int r = 0; r < 4; ++r) o[(16 * kt + 4 * g + r) * 64] = S[kt][r];
    }
}
__device__ __forceinline__ void post_gdn(Frame& F, int l, int c, int hp) {
    PHASE_IDS(F);
    const int tid = F.tid, lane = F.lane, w = F.wave, i16 = lane & 15, g = lane >> 4;
    const size_t row0 = (size_t)c * 64;
    bf16_t* const proj = F_PROJ;
    constexpr int LQ = 136;
    LAS bf16_t* Qt = (LAS bf16_t*)F.lds; LAS bf16_t* Kt = Qt + 64 * LQ; LAS bf16_t* Ht = Kt + 64 * LQ; LAS bf16_t* Vn = Ht + 2 * 64 * GDN_LD; LAS float* gcs = (LAS float*)(Vn + 2 * 64 * GDN_LD);
    {
#pragma unroll
        for (int q = 0; q < 2; ++q) { const int idx = q * 512 + tid;
            { const int row = idx >> 4, col8 = (idx & 15) * 8;
              *(LAS u32x4*)(Qt + row * LQ + col8) = *(const u32x4*)(proj + (row0 + row) * PW + PC_GQ + hp * 128 + col8);
              *(LAS u32x4*)(Kt + row * LQ + col8) = *(const u32x4*)(proj + (row0 + row) * PW + PC_GK + hp * 128 + col8); }
            { const int hh = idx >> 9, row = (idx >> 3) & 63, col8 = (idx & 7) * 8;
              *(LAS u32x4*)(Ht + hh * 64 * GDN_LD + row * GDN_LD + col8) = *(const u32x4*)(((bf16_t*)((unsigned char*)F.out + (size_t)T * 256 * 2 * 4) + (size_t)(c) * 16384) + (((size_t)(2 * hp + hh) * 64) + row) * 64 + col8);
              *(LAS u32x4*)(Vn + hh * 64 * GDN_LD + row * GDN_LD + col8) = *(const u32x4*)(proj + (row0 + row) * PW + PC_GV + (2 * hp + hh) * 64 + col8); } }
        if (tid < 128) gcs[tid] = F_GCUM[(row0 + (tid & 63)) * 4 + 2 * hp + (tid >> 6)];
    }
    LDS_BARRIER();
    const int hh = w >> 2, it = w & 3, head = 2 * hp + hh;
    const LAS bf16_t* Hh = Ht + hh * 64 * GDN_LD; const LAS bf16_t* Vh = Vn + hh * 64 * GDN_LD;
    f32x4 AT[4];
    const float gci = gcs[hh * 64 + 16 * it + i16];
#pragma unroll
    for (int jt = 0; jt < 4; ++jt) {
        f32x4 acc = (f32x4){0.f, 0.f, 0.f, 0.f};
        if (jt <= it) {
#pragma unroll
            for (int ks = 0; ks < 2; ++ks) acc = mma16(frag_nat(Kt, LQ, 16 * jt, hh * 64 + 32 * ks, i16, g), frag_nat(Qt, LQ, 16 * it, hh * 64 + 32 * ks, i16, g), acc);
#pragma unroll
            for (int r = 0; r < 4; ++r) { const int j = 16 * jt + 4 * g + r, i = 16 * it + i16; acc[r] *= (j <= i) ? __expf(fminf(gci - gcs[hh * 64 + j], 0.f)) : 0.f; }
        }
        AT[jt] = acc;
    }
    f32x4 O[4]; float ss[4] = {0.f, 0.f, 0.f, 0.f};
#pragma unroll
    for (int vt = 0; vt < 4; ++vt) {
        f32x4 acc = (f32x4){0.f, 0.f, 0.f, 0.f};
#pragma unroll
        for (int ks = 0; ks < 2; ++ks) acc = mma16(frag_nat(Qt, LQ, 16 * it, hh * 64 + 32 * ks, i16, g), frag_nat(Hh, GDN_LD, 16 * vt, 32 * ks, i16, g), acc);
#pragma unroll
        for (int r = 0; r < 4; ++r) acc[r] *= __expf(gcs[hh * 64 + 16 * it + 4 * g + r]);
#pragma unroll
        for (int cs = 0; cs < 2; ++cs) if (2 * cs <= it) acc = mma16(acc_frag(AT[2 * cs], AT[2 * cs + 1]), frag_sig(Vh, GDN_LD, 16 * vt, 32 * cs, i16, g), acc);
        O[vt] = acc;
#pragma unroll
        for (int r = 0; r < 4; ++r) ss[r] += acc[r] * acc[r];
    }
#pragma unroll
    for (int r = 0; r < 4; ++r) { float t = ss[r]; t += __shfl_xor(t, 1); t += __shfl_xor(t, 2); t += __shfl_xor(t, 4); t += __shfl_xor(t, 8); ss[r] = rsqrtf(t * (1.f / 64.f) + EPS); }
#pragma unroll
    for (int vt = 0; vt < 4; ++vt) { const int v = 16 * vt + i16; const float nw = INP(I_GNORMW)[l * 64 + v];
#pragma unroll
        for (int r = 0; r < 4; ++r) { bf16_t* p = proj + (row0 + 16 * it + 4 * g + r) * PW + PC_ZG + head * 64 + v; *p = f2bf(O[vt][r] * ss[r] * nw * siluf_(bf2f(*p))); } }
    LDS_BARRIER();
}

constexpr int RW_LD = 72;
constexpr int RW_XD = 0, RW_XA = 9216, RW_WD = 18432, RW_WA = 27648, RW_RT = 36864, RW_KX = 46080, RW_VT = 55296, RW_XG = 64512, RW_WG = 81920, RW_EX = 100352;
constexpr int RW_L = 64512, RW_P = 81920;
struct RwkvTok { float cum[2][4], lw[2][4], iclr[2][4], kk[2][4], kp[2][4], kraw[2][4], c63[2], w0[2], a0[2], kkw[2], kaw[2]; };
template <bool POST>
__device__ __forceinline__ void rwkv_tokens(Frame& F, int l, int c, int h, RwkvTok& o, f32x4 (&Zg)[2]) {
    const int tid = F.tid, lane = F.lane, w = F.wave, i16 = lane & 15, g = lane >> 4, tt = w & 3, jh = w >> 2;
    const size_t row0 = (size_t)c * 64;
    bf16_t* const proj = F_PROJ;
    LAS bf16_t* Xd = (LAS bf16_t*)(F.lds + RW_XD); LAS bf16_t* Xa = (LAS bf16_t*)(F.lds + RW_XA); LAS bf16_t* Wd = (LAS bf16_t*)(F.lds + RW_WD); LAS bf16_t* Wa = (LAS bf16_t*)(F.lds + RW_WA);
    LAS bf16_t* Rt = (LAS bf16_t*)(F.lds + RW_RT); LAS bf16_t* Kx = (LAS bf16_t*)(F.lds + RW_KX); LAS bf16_t* Vt = (LAS bf16_t*)(F.lds + RW_VT);
    LAS bf16_t* Xg = (LAS bf16_t*)(F.lds + RW_XG); LAS bf16_t* Wg = (LAS bf16_t*)(F.lds + RW_WG);
    LAS float* ksq = (LAS float*)(F.lds + RW_EX); LAS float* ctot = ksq + 128;
    const int lt0 = (tid >> 5) * 4, lo8 = (tid & 31) * 8;
    const int wi = tid >> 3, wj8 = (tid & 7) * 8;
    const int rt = tid >> 3, rd8 = (tid & 7) * 8;
    u32x4 lx[4], lprev_b = (u32x4){0u, 0u, 0u, 0u}; f32x4 lprev_f[2], lmu[2];
    f32x4 wdv[2], wav[2], wgv[4];
    u32x4 rx[3], rpv_b[3]; f32x4 rpv_f[3][2], rmu[3][2];
    const bool smp = c >= 256;
    {
        const float* mup = INP(I_RMU) + l * 1024;
        const float* stp = INP(I_SSHIFT) + ((size_t)l * 32 + (smp ? c - 256 : 0)) * 1024;
        const int col = PC_RL + lo8;
        lmu[0] = *(const f32x4*)(mup + 768 + lo8); lmu[1] = *(const f32x4*)(mup + 768 + lo8 + 4);
        if (lt0 > 0) lprev_b = *(const u32x4*)(proj + (row0 + lt0 - 1) * PW + col);
        else if (!smp) { if (c > 0) lprev_b = *(const u32x4*)(F_HSHIFT + (size_t)(c - 1) * 1024 + 768 + lo8); }
        else { lprev_f[0] = *(const f32x4*)(stp + 768 + lo8); lprev_f[1] = *(const f32x4*)(stp + 768 + lo8 + 4); }
#pragma unroll
        for (int q = 0; q < 4; ++q) lx[q] = *(const u32x4*)(proj + (row0 + lt0 + q) * PW + col);
        { const float* p = INP(I_RWUP) + ((size_t)l * 64 + wi) * 256 + h * 64 + wj8; wdv[0] = *(const f32x4*)p; wdv[1] = *(const f32x4*)(p + 4); }
        { const float* p = INP(I_RAUP) + ((size_t)l * 64 + wi) * 256 + h * 64 + wj8; wav[0] = *(const f32x4*)p; wav[1] = *(const f32x4*)(p + 4); }
        if (POST) {
#pragma unroll
            for (int q2 = 0; q2 < 2; ++q2) { const float* p = INP(I_RGUP) + ((size_t)l * 128 + wi + 64 * q2) * 256 + h * 64 + wj8; wgv[2 * q2] = *(const f32x4*)p; wgv[2 * q2 + 1] = *(const f32x4*)(p + 4); }
        }
#pragma unroll
        for (int which = 0; which < 3; ++which) {
            const int pcol = (which == 0 ? PC_R : (which == 1 ? PC_RK : PC_RV)) + h * 64 + rd8, oc = which * 256 + h * 64 + rd8;
            const bf16_t* p = proj + (row0 + rt) * PW + pcol;
            rx[which] = *(const u32x4*)p;
            if (!POST) {
                rmu[which][0] = *(const f32x4*)(mup + oc); rmu[which][1] = *(const f32x4*)(mup + oc + 4);
                rpv_b[which] = (u32x4){0u, 0u, 0u, 0u};
                if (rt > 0) rpv_b[which] = *(const u32x4*)(p - PW);
                else if (!smp) { if (c > 0) rpv_b[which] = *(const u32x4*)(F_HSHIFT + (size_t)(c - 1) * 1024 + oc); }
                else { rpv_f[which][0] = *(const f32x4*)(stp + oc); rpv_f[which][1] = *(const f32x4*)(stp + oc + 4); }
            }
        }
#pragma unroll
        for (int q = 0; q < 2; ++q) { const int jc = l * 256 + h * 64 + 16 * (2 * jh + q) + i16;
            o.w0[q] = INP(I_RW0)[jc]; o.a0[q] = INP(I_RA0)[jc]; o.kkw[q] = INP(I_RKK)[jc]; o.kaw[q] = INP(I_RKA)[jc]; }
    }
    {
        float prev[8], mu[8] = {lmu[0][0], lmu[0][1], lmu[0][2], lmu[0][3], lmu[1][0], lmu[1][1], lmu[1][2], lmu[1][3]};
        if (lt0 == 0 && smp) { prev[0] = lprev_f[0][0]; prev[1] = lprev_f[0][1]; prev[2] = lprev_f[0][2]; prev[3] = lprev_f[0][3]; prev[4] = lprev_f[1][0]; prev[5] = lprev_f[1][1]; prev[6] = lprev_f[1][2]; prev[7] = lprev_f[1][3]; }
        else unpack8(lprev_b, prev);
#pragma unroll
        for (int q = 0; q < 4; ++q) {
            float x[8], y[8]; unpack8(lx[q], x);
#pragma unroll
            for (int i = 0; i < 8; ++i) { const float v = x[i] + (prev[i] - x[i]) * mu[i]; prev[i] = x[i]; y[i] = (lo8 < 64) ? tanhf_(v) : (lo8 >= 128 ? sigmoidf_(v) : v); }
            const u32x4 pk = pack8(y);
            if (lo8 < 64) *(LAS u32x4*)(Xd + (lt0 + q) * RW_LD + lo8) = pk;
            else if (lo8 < 128) *(LAS u32x4*)(Xa + (lt0 + q) * RW_LD + (lo8 - 64)) = pk;
            else if (POST) *(LAS u32x4*)(Xg + (lt0 + q) * 136 + (lo8 - 128)) = pk;
        }
        { const float v[8] = {wdv[0][0], wdv[0][1], wdv[0][2], wdv[0][3], wdv[1][0], wdv[1][1], wdv[1][2], wdv[1][3]}; *(LAS u32x4*)(Wd + wi * RW_LD + wj8) = pack8(v); }
        { const float v[8] = {wav[0][0], wav[0][1], wav[0][2], wav[0][3], wav[1][0], wav[1][1], wav[1][2], wav[1][3]}; *(LAS u32x4*)(Wa + wi * RW_LD + wj8) = pack8(v); }
        if (POST) {
#pragma unroll
            for (int q2 = 0; q2 < 2; ++q2) { const float v[8] = {wgv[2 * q2][0], wgv[2 * q2][1], wgv[2 * q2][2], wgv[2 * q2][3], wgv[2 * q2 + 1][0], wgv[2 * q2 + 1][1], wgv[2 * q2 + 1][2], wgv[2 * q2 + 1][3]};
                *(LAS u32x4*)(Wg + (wi + 64 * q2) * RW_LD + wj8) = pack8(v); }
        }
        u32x4 pk3[3];
#pragma unroll
        for (int which = 0; which < 3; ++which) {
            LAS bf16_t* dst = (which == 0 ? Rt : (which == 1 ? Kx : Vt)) + rt * RW_LD + rd8;
            if (POST) *(LAS u32x4*)dst = rx[which];
            else {
                float x[8], pv[8], y[8];
                unpack8(rx[which], x);
                if (rt == 0 && smp) { pv[0] = rpv_f[which][0][0]; pv[1] = rpv_f[which][0][1]; pv[2] = rpv_f[which][0][2]; pv[3] = rpv_f[which][0][3]; pv[4] = rpv_f[which][1][0]; pv[5] = rpv_f[which][1][1]; pv[6] = rpv_f[which][1][2]; pv[7] = rpv_f[which][1][3]; }
                else unpack8(rpv_b[which], pv);
#pragma unroll
                for (int i = 0; i < 8; ++i) y[i] = x[i] + (pv[i] - x[i]) * rmu[which][i >> 2][i & 3];
                pk3[which] = pack8(y);
                *(LAS u32x4*)dst = pk3[which];
            }
        }
        if (!POST) {
            LDS_BARRIER();
#pragma unroll
            for (int which = 0; which < 3; ++which) *(u32x4*)(proj + (row0 + rt) * PW + (which == 0 ? PC_R : (which == 1 ? PC_RK : PC_RV)) + h * 64 + rd8) = pk3[which];
        }
    }
    LDS_BARRIER();
    f32x4 Zd[2], Za[2];
#pragma unroll
    for (int q = 0; q < 2; ++q) {
        const int jt = 2 * jh + q;
        f32x4 a = (f32x4){0.f, 0.f, 0.f, 0.f}, bq = a, cq = a;
#pragma unroll
        for (int ks = 0; ks < 2; ++ks) {
            a = mma16(frag_nat(Xd, RW_LD, 16 * tt, 32 * ks, i16, g), frag_tr_nat(Wd, RW_LD, 32 * ks, 16 * jt, i16, g), a);
            bq = mma16(frag_nat(Xa, RW_LD, 16 * tt, 32 * ks, i16, g), frag_tr_nat(Wa, RW_LD, 32 * ks, 16 * jt, i16, g), bq);
        }
        if (POST) {
#pragma unroll
            for (int ks = 0; ks < 4; ++ks) cq = mma16(frag_nat(Xg, 136, 16 * tt, 32 * ks, i16, g), frag_tr_nat(Wg, RW_LD, 32 * ks, 16 * jt, i16, g), cq);
        }
        Zd[q] = a; Za[q] = bq; Zg[q] = cq;
    }
    float ksum[4] = {0.f, 0.f, 0.f, 0.f}, csum[2];
#pragma unroll
    for (int q = 0; q < 2; ++q) {
        const int j = 16 * (2 * jh + q) + i16, jc = l * 256 + h * 64 + j;
        const float w0 = o.w0[q], a0 = o.a0[q], kkw = o.kkw[q];
        float run = 0.f;
#pragma unroll
        for (int r = 0; r < 4; ++r) {
            const int t = 16 * tt + 4 * g + r;
            const float wl = -softplusf_(-(w0 + Zd[q][r])) - 0.5f;
            const float lw = -__expf(wl);
            o.lw[q][r] = lw; run += lw; o.cum[q][r] = run;
            o.iclr[q][r] = sigmoidf_(a0 + Za[q][r]);
            const float kr = bf2f(Kx[t * RW_LD + j]); o.kraw[q][r] = kr;
            const float kq = kr * kkw; o.kk[q][r] = kq; ksum[r] += kq * kq;
        }
        float tot = run;
        const float u1 = __shfl_up(tot, 16); if (g >= 1) tot += u1;
        const float u2 = __shfl_up(tot, 32); if (g >= 2) tot += u2;
        const float excl = tot - run;
#pragma unroll
        for (int r = 0; r < 4; ++r) o.cum[q][r] += excl;
        csum[q] = __shfl(tot, 48 + i16);
        if (g == 0) ctot[tt * 64 + j] = csum[q];
    }
#pragma unroll
    for (int r = 0; r < 4; ++r) { float s = ksum[r]; s += __shfl_xor(s, 1); s += __shfl_xor(s, 2); s += __shfl_xor(s, 4); s += __shfl_xor(s, 8); ksum[r] = s; }
    if (i16 == 0) {
#pragma unroll
        for (int r = 0; r < 4; ++r) ksq[jh * 64 + 16 * tt + 4 * g + r] = ksum[r];
    }
    LDS_BARRIER();
#pragma unroll
    for (int q = 0; q < 2; ++q) {
        const int j = 16 * (2 * jh + q) + i16, jc = l * 256 + h * 64 + j;
        const float kaw = o.kaw[q];
        float pre = 0.f, all = 0.f;
#pragma unroll
        for (int t4 = 0; t4 < 4; ++t4) { const float v = ctot[t4 * 64 + j]; all += v; if (t4 < tt) pre += v; }
        o.c63[q] = all;
#pragma unroll
        for (int r = 0; r < 4; ++r) {
            const int t = 16 * tt + 4 * g + r;
            o.cum[q][r] += pre;
            const float kn = rsqrtf(ksq[t] + ksq[64 + t] + EPS);
            o.kk[q][r] *= kn;
            o.kp[q][r] = o.kraw[q][r] * (1.f + (o.iclr[q][r] - 1.f) * kaw);
        }
    }
}
__device__ __forceinline__ void prep_rwkv(Frame& F, int l, int c, int h) {
    PHASE_IDS(F);
    const int lane = F.lane, w = F.wave, i16 = lane & 15, g = lane >> 4, tt = w & 3, jh = w >> 2;
    RwkvTok tk; f32x4 Zg[2];
    rwkv_tokens<false>(F, l, c, h, tk, Zg);
    LAS bf16_t* At = (LAS bf16_t*)(F.lds + RW_XD); LAS bf16_t* Bt = (LAS bf16_t*)(F.lds + RW_XA); LAS bf16_t* Kt = (LAS bf16_t*)(F.lds + RW_WD); LAS bf16_t* Kh = (LAS bf16_t*)(F.lds + RW_WA);
    LAS bf16_t* Vt = (LAS bf16_t*)(F.lds + RW_VT); LAS float* Lm = (LAS float*)(F.lds + RW_L); LAS float* Pm = (LAS float*)(F.lds + RW_P);
    bf16_t* const bh = F_RBH + (((size_t)c * 4 + h) * 64) * 64;
    LDS_BARRIER();
#pragma unroll
    for (int q = 0; q < 2; ++q) {
        const int j = 16 * (2 * jh + q) + i16;
#pragma unroll
        for (int r = 0; r < 4; ++r) {
            const int t = 16 * tt + 4 * g + r;
            const float cum = tk.cum[q][r], b = tk.kk[q][r] * tk.iclr[q][r], einv = __expf(-cum), elast = __expf(tk.c63[q] - cum);
            At[t * RW_LD + j] = f2bf(-tk.kk[q][r] * __expf(cum - tk.lw[q][r]));
            Bt[t * RW_LD + j] = f2bf(b * einv);
            Kt[t * RW_LD + j] = f2bf(tk.kp[q][r] * einv);
            Kh[t * RW_LD + j] = f2bf(tk.kp[q][r] * elast);
            bh[t * 64 + j] = f2bf(b * elast);
        }
        if (tt == 0 && g == 0) F_RDV[((size_t)c * 4 + h) * 64 + j] = __expf(tk.c63[q]);
    }
    LDS_BARRIER();
    if (jh == 0) {
#pragma unroll
        for (int st = 0; st < 4; ++st) if (st <= tt) {
            f32x4 acc = (f32x4){0.f, 0.f, 0.f, 0.f};
#pragma unroll
            for (int ks = 0; ks < 2; ++ks) acc = mma16(frag_nat(At, RW_LD, 16 * tt, 32 * ks, i16, g), frag_nat(Bt, RW_LD, 16 * st, 32 * ks, i16, g), acc);
#pragma unroll
            for (int r = 0; r < 4; ++r) { const int t = 16 * tt + 4 * g + r, s = 16 * st + i16; Lm[t * 68 + s] = (s < t) ? acc[r] : 0.f; }
        }
    }
    {
        f32x4 AK[4];
#pragma unroll
        for (int st = 0; st < 4; ++st) {
            f32x4 acc = (f32x4){0.f, 0.f, 0.f, 0.f};
            if (st <= tt) {
#pragma unroll
                for (int ks = 0; ks < 2; ++ks) acc = mma16(frag_nat(Kt, RW_LD, 16 * st, 32 * ks, i16, g), frag_nat(At, RW_LD, 16 * tt, 32 * ks, i16, g), acc);
#pragma unroll
                for (int r = 0; r < 4; ++r) { const int s = 16 * st + 4 * g + r, t = 16 * tt + i16; if (!(s < t)) acc[r] = 0.f; }
            }
            AK[st] = acc;
        }
#pragma unroll
        for (int q = 0; q < 2; ++q) {
            const int vt = 2 * jh + q;
            f32x4 acc = (f32x4){0.f, 0.f, 0.f, 0.f};
#pragma unroll
            for (int cs = 0; cs < 2; ++cs) if (2 * cs <= tt) acc = mma16(acc_frag(AK[2 * cs], AK[2 * cs + 1]), frag_tr_sig(Vt, RW_LD, 32 * cs, 16 * vt, i16, g), acc);
#pragma unroll
            for (int r = 0; r < 4; ++r) Pm[(16 * tt + 4 * g + r) * 68 + 16 * vt + i16] = acc[r];
            f32x4 kv = (f32x4){0.f, 0.f, 0.f, 0.f};
#pragma unroll
            for (int cs = 0; cs < 2; ++cs) kv = mma16(frag_tr_nat(Kh, RW_LD, 32 * cs, 16 * tt, i16, g), frag_tr_nat(Vt, RW_LD, 32 * cs, 16 * vt, i16, g), kv);
            *(u32x2*)(F_RKV + ((((size_t)c * 4 + h) * 64) + 16 * vt + i16) * 64 + 16 * tt + 4 * g) = pack4(kv);
        }
    }
    LDS_BARRIER();
    if (w < 2) {
        float x[64];
        const float ef = (float)w;
        const LAS float* Lo = opaque_lds(Lm); const LAS float* Po = opaque_lds(Pm + lane); const LAS bf16_t* Ao = opaque_lds(At + lane);
        tri_solve64<68, 1>(Lo, x, [&](int i) { return Po[i * 68] * (1.f - ef) + bf2f(Ao[i * RW_LD]) * ef; });
        if (w == 0) {
            bf16_t* o = F_RU + ((((size_t)c * 4 + h) * 64) + lane) * 64;
#pragma unroll
            for (int q = 0; q < 8; ++q) { float y[8];
#pragma unroll
                for (int i = 0; i < 8; ++i) y[i] = x[8 * q + i];
                *(u32x4*)(o + 8 * q) = pack8(y); }
        } else {
            bf16_t* o = F_RWA + (((size_t)c * 4 + h) * 64) * 64 + lane;
#pragma unroll
            for (int i = 0; i < 64; ++i) o[i * 64] = f2bf(x[i]);
        }
    }
    publish_item((unsigned*)(F.ws + WS_CTL) + CW_RFLAG + 4 * c + h);
    LDS_BARRIER();
}
constexpr int RWS_BUF = 4 * 64 * GDN_LD * 2 + 256;
__device__ __forceinline__ void scan_rwkv2(Frame& F, int l, int s, int h, int vb, int ncw, unsigned* prog, unsigned pbase, unsigned* done, int pm, const unsigned* rdy, int rstride, unsigned rneed) {
    PHASE_IDS(F);
    const int tid = F.tid, lane = F.lane, w = F.wave, i16 = lane & 15, g = lane >> 4;
    const int nch = (s == 0) ? 256 : 1, c0 = (s == 0) ? 0 : 255 + s, b = s - 1;
    const bf16_t* const rwa = F_RWA; bf16_t* const ru = F_RU; const bf16_t* const rbh = F_RBH; const bf16_t* const rkv = F_RKV; const float* const rdv = F_RDV;
    {
        if (w == (ncw < 4 ? ncw : 0)) (void)rdy_block(F, rdy, rstride, rneed, 0, nch < RDY_SLACK ? nch : RDY_SLACK, nch);
        LDS_BARRIER();
    }
    if (w >= 4) {
        const int lt = tid - 256;
        const int umask = 128 * ncw - 1;
        u32x4 r10[2], r20[2], r30[2], r40[2], r11[2], r21[2], r31[2], r41[2], r12[2], r22[2], r32[2], r42[2], r13[2], r23[2], r33[2], r43[2], r14[2], r24[2], r34[2], r44[2], r15[2], r25[2], r35[2], r45[2]; float dv0 = 0.f, dv1 = 0.f, dv2 = 0.f, dv3 = 0.f, dv4 = 0.f, dv5 = 0.f;
        const bf16_t* p1[2]; const bf16_t* p2[2]; const bf16_t* p3[2]; const bf16_t* p4[2]; const float* const pDv = rdv + h * 64 + (lt & 63);
#pragma unroll
        for (int q = 0; q < 2; ++q) { const int idx = q * 256 + lt, off = (idx >> 3) * 64 + (idx & 7) * 8, uoff = (vb + ((idx & umask) >> 3)) * 64 + (idx & 7) * 8;
            p1[q] = rwa + (size_t)h * 4096 + off; p2[q] = ru + (size_t)h * 4096 + uoff; p3[q] = rbh + (size_t)h * 4096 + off; p4[q] = rkv + (size_t)h * 4096 + uoff; }
        const bool dupU = ncw < 4;
        if (dupU) { p2[1] = ru; p4[1] = rkv; }
#define RWS_LOAD(ch, S) do { const size_t o_ = (size_t)(ch) * (4 * 4096); dv##S = ld4_asm(pDv + (size_t)(ch) * 256); \
        _Pragma("unroll") for (int q = 0; q < 2; ++q) { r1##S[q] = ld16_asm(p1[q] + o_); r2##S[q] = ld16_asm(p2[q] + o_); r3##S[q] = ld16_asm(p3[q] + o_); r4##S[q] = ld16_asm(p4[q] + o_); } } while (0)
#define RWS_WAIT(S, N) asm volatile("s_waitcnt vmcnt(%9)" : "+v"(r1##S[0]), "+v"(r1##S[1]), "+v"(r2##S[0]), "+v"(r2##S[1]), "+v"(r3##S[0]), "+v"(r3##S[1]), "+v"(r4##S[0]), "+v"(r4##S[1]), "+v"(dv##S) : "n"(N))
#define RWS_WRITE(bb, S) do { LAS bf16_t* Wn_ = (LAS bf16_t*)(F.lds + (bb) * RWS_BUF); \
        _Pragma("unroll") for (int q = 0; q < 2; ++q) { const int idx = q * 256 + lt, off = (idx >> 3) * GDN_LD + (idx & 7) * 8, uoff = (vb + ((idx & umask) >> 3)) * GDN_LD + (idx & 7) * 8; \
            *(LAS u32x4*)(Wn_ + off) = r1##S[q]; *(LAS u32x4*)(Wn_ + 2 * 64 * GDN_LD + off) = r3##S[q]; \
            if (q == 0 || !dupU) { *(LAS u32x4*)(Wn_ + 64 * GDN_LD + uoff) = r2##S[q]; *(LAS u32x4*)(Wn_ + 3 * 64 * GDN_LD + uoff) = r4##S[q]; } } \
        if (lt < 64) ((LAS float*)(Wn_ + 4 * 64 * GDN_LD))[lt] = dv##S; } while (0)
        SCAN_LOADER6(RWS_LOAD, RWS_WRITE, RWS_WAIT, 9);
#undef RWS_LOAD
#undef RWS_WRITE
#undef RWS_WAIT
    } else if (w >= ncw) {
        int nxt = nch < RDY_SLACK ? nch : RDY_SLACK;
        LDS_BARRIER();
        for (int ci = 0; ci < nch; ++ci) {
            if (w == ncw && nxt < nch) { const int upto = ci + 1 + RDY_SLACK < nch ? ci + 1 + RDY_SLACK : nch; nxt = rdy_block(F, rdy, rstride, rneed, nxt, upto, nch); }
            LDS_BARRIER();
        }
    } else {
        const int n0 = vb + 16 * w;
        f32x4 S[4];
        if (s == 0) {
#pragma unroll
            for (int kt = 0; kt < 4; ++kt) S[kt] = (f32x4){0.f, 0.f, 0.f, 0.f};
        } else {
            const float* st = INP(I_SRWKV) + (((size_t)l * 32 + b) * 4 + h) * 4096 + (n0 + i16) * 64 + 4 * g;
#pragma unroll
            for (int kt = 0; kt < 4; ++kt) S[kt] = *(const f32x4*)(st + 16 * kt);
        }
        LDS_BARRIER();
        for (int ci = 0; ci < nch; ++ci) {
            const size_t b0 = (((size_t)(c0 + ci)) * 4 + h) * 4096;
            const LAS bf16_t* Wn = (const LAS bf16_t*)(F.lds + (ci & 1) * RWS_BUF); const LAS bf16_t* Ut = Wn + 64 * GDN_LD; const LAS bf16_t* Bh = Ut + 64 * GDN_LD; const LAS bf16_t* KVt = Bh + 64 * GDN_LD;
            const LAS float* dvec = (const LAS float*)(KVt + 64 * GDN_LD);
            bf16x8 A1[4][2], A2[4][2]; u32x2 ui[4], kvi[4]; f32x4 dq[4];
#pragma unroll
            for (int m = 0; m < 4; ++m) { ui[m] = *(const LAS u32x2*)(Ut + (n0 + i16) * GDN_LD + 16 * m + 4 * g);
#pragma unroll
                for (int ks = 0; ks < 2; ++ks) A1[m][ks] = frag_sig(Wn, GDN_LD, 16 * m, 32 * ks, i16, g); }
#pragma unroll
            for (int kt = 0; kt < 4; ++kt) { kvi[kt] = *(const LAS u32x2*)(KVt + (n0 + i16) * GDN_LD + 16 * kt + 4 * g); dq[kt] = *(const LAS f32x4*)(dvec + 16 * kt + 4 * g);
#pragma unroll
                for (int cs = 0; cs < 2; ++cs) A2[kt][cs] = frag_tr_sig(Bh, GDN_LD, 32 * cs, 16 * kt, i16, g); }
            __builtin_amdgcn_sched_barrier(0);
            bf16x8 Sb[2];
#pragma unroll
            for (int ks = 0; ks < 2; ++ks) Sb[ks] = acc_frag(S[2 * ks], S[2 * ks + 1]);
            {
                bf16_t* ho = F_RKV + b0 + (n0 + i16) * 64 + 4 * g;
#pragma unroll
                for (int kt = 0; kt < 4; ++kt) st8_wt(ho + 16 * kt, pack4(S[kt]));
            }
            f32x4 V[4];
            bf16_t* vo = ru + b0 + (n0 + i16) * 64 + 4 * g;
#pragma unroll
            for (int m = 0; m < 4; ++m) {
                f32x4 acc = unpack4(ui[m]);
#pragma unroll
                for (int ks = 0; ks < 2; ++ks) acc = mma16(A1[m][ks], Sb[ks], acc);
                V[m] = acc;
            }
#pragma unroll
            for (int m = 0; m < 4; ++m) st8_wt(vo + 16 * m, pack4(V[m]));
            bf16x8 Ub[2];
#pragma unroll
            for (int cs = 0; cs < 2; ++cs) Ub[cs] = acc_frag(V[2 * cs], V[2 * cs + 1]);
#pragma unroll
            for (int kt = 0; kt < 4; ++kt) {
                f32x4 acc = S[kt] * dq[kt] + unpack4(kvi[kt]);
#pragma unroll
                for (int cs = 0; cs < 2; ++cs) acc = mma16(A2[kt][cs], Ub[cs], acc);
                S[kt] = acc;
            }
            if (prog) {
                asm volatile("s_waitcnt vmcnt(48)" ::: "memory");
                if (lane == 0 && ci >= 6) __hip_atomic_store(prog + 64 * w, pbase + (unsigned)(ci - 6) + 1u, __ATOMIC_RELAXED, __HIP_MEMORY_SCOPE_AGENT);
            }
            LDS_BARRIER();
        }
        asm volatile("s_waitcnt vmcnt(0)" ::: "memory");
        if (prog && lane == 0) __hip_atomic_store(prog + 64 * w, pbase + (unsigned)nch, __ATOMIC_RELAXED, __HIP_MEMORY_SCOPE_AGENT);
        if (done && lane == 0) __hip_atomic_fetch_add(done, 1u, __ATOMIC_RELAXED, __HIP_MEMORY_SCOPE_AGENT);
        float* o = F.out + (s == 0 ? O_P_RWKV + ((size_t)l * 4 + h) * 4096 : O_S_RWKV + (((size_t)l * 32 + b) * 4 + h) * 4096) + (n0 + i16) * 64 + 4 * g;
#pragma unroll
        for (int kt = 0; kt < 4; ++kt) *(f32x4*)(o + 16 * kt) = S[kt];
    }
}
__device__ __forceinline__ void post_rwkv(Frame& F, int l, int c, int h) {
    PHASE_IDS(F);
    const int tid = F.tid, lane = F.lane, w = F.wave, i16 = lane & 15, g = lane >> 4, tt = w & 3, jh = w >> 2;
    const size_t row0 = (size_t)c * 64;
    RwkvTok tk; f32x4 Zg[2];
    rwkv_tokens<true>(F, l, c, h, tk, Zg);
    LAS bf16_t* Rd = (LAS bf16_t*)(F.lds + RW_XD); LAS bf16_t* Bt = (LAS bf16_t*)(F.lds + RW_XA); LAS bf16_t* Kt = (LAS bf16_t*)(F.lds + RW_WD); LAS bf16_t* Utl = (LAS bf16_t*)(F.lds + RW_WA);
    LAS bf16_t* Rt = (LAS bf16_t*)(F.lds + RW_RT); LAS bf16_t* Htl = (LAS bf16_t*)(F.lds + RW_KX); LAS bf16_t* Vt = (LAS bf16_t*)(F.lds + RW_VT);
    LAS float* ex = (LAS float*)(F.lds + RW_EX) + 512;
    float rr[2][4];
#pragma unroll
    for (int q = 0; q < 2; ++q)
#pragma unroll
        for (int r = 0; r < 4; ++r) rr[q][r] = bf2f(Rt[(16 * tt + 4 * g + r) * RW_LD + 16 * (2 * jh + q) + i16]);
    LDS_BARRIER();
#pragma unroll
    for (int q = 0; q < 2; ++q) {
        const int j = 16 * (2 * jh + q) + i16;
#pragma unroll
        for (int r = 0; r < 4; ++r) {
            const int t = 16 * tt + 4 * g + r;
            const float cum = tk.cum[q][r], einv = __expf(-cum);
            Rd[t * RW_LD + j] = f2bf(rr[q][r] * __expf(cum));
            Bt[t * RW_LD + j] = f2bf(tk.kk[q][r] * tk.iclr[q][r] * einv);
            Kt[t * RW_LD + j] = f2bf(tk.kp[q][r] * einv);
        }
    }
    {
        const int row = tid >> 3, col8 = (tid & 7) * 8; const size_t b0 = (((size_t)c * 4 + h) * 64 + row) * 64 + col8;
        *(LAS u32x4*)(Utl + row * RW_LD + col8) = *(const u32x4*)(F_RU + b0);
        *(LAS u32x4*)(Htl + row * RW_LD + col8) = *(const u32x4*)(F_RKV + b0);
    }
    LDS_BARRIER();
    f32x4 QB[4], QK[4];
#pragma unroll
    for (int st = 0; st < 4; ++st) {
        f32x4 a = (f32x4){0.f, 0.f, 0.f, 0.f}, bq = a;
        if (st <= tt) {
#pragma unroll
            for (int ks = 0; ks < 2; ++ks) {
                const bf16x8 rf = frag_nat(Rd, RW_LD, 16 * tt, 32 * ks, i16, g);
                a = mma16(frag_nat(Bt, RW_LD, 16 * st, 32 * ks, i16, g), rf, a);
                bq = mma16(frag_nat(Kt, RW_LD, 16 * st, 32 * ks, i16, g), rf, bq);
            }
#pragma unroll
            for (int r = 0; r < 4; ++r) { const int s = 16 * st + 4 * g + r, t = 16 * tt + i16; if (!(s <= t)) { a[r] = 0.f; bq[r] = 0.f; } }
        }
        QB[st] = a; QK[st] = bq;
    }
    f32x4 Y[2]; float s1[4] = {0.f, 0.f, 0.f, 0.f}, s2[4] = {0.f, 0.f, 0.f, 0.f}, bon[4] = {0.f, 0.f, 0.f, 0.f};
#pragma unroll
    for (int q = 0; q < 2; ++q) {
        const int vt = 2 * jh + q;
        f32x4 acc = (f32x4){0.f, 0.f, 0.f, 0.f};
#pragma unroll
        for (int ks = 0; ks < 2; ++ks) acc = mma16(frag_nat(Rd, RW_LD, 16 * tt, 32 * ks, i16, g), frag_nat(Htl, RW_LD, 16 * vt, 32 * ks, i16, g), acc);
#pragma unroll
        for (int cs = 0; cs < 2; ++cs) if (2 * cs <= tt) {
            acc = mma16(acc_frag(QB[2 * cs], QB[2 * cs + 1]), frag_sig(Utl, RW_LD, 16 * vt, 32 * cs, i16, g), acc);
            acc = mma16(acc_frag(QK[2 * cs], QK[2 * cs + 1]), frag_tr_sig(Vt, RW_LD, 32 * cs, 16 * vt, i16, g), acc);
        }
        Y[q] = acc;
        const float rkw = INP(I_RRK)[l * 256 + h * 64 + 16 * vt + i16];
#pragma unroll
        for (int r = 0; r < 4; ++r) { s1[r] += acc[r]; s2[r] += acc[r] * acc[r]; bon[r] += rr[q][r] * tk.kp[q][r] * rkw; }
    }
#pragma unroll
    for (int r = 0; r < 4; ++r) {
        float a = s1[r], bq = s2[r], cq = bon[r];
#pragma unroll
        for (int o = 1; o < 16; o <<= 1) { a += __shfl_xor(a, o); bq += __shfl_xor(bq, o); cq += __shfl_xor(cq, o); }
        if (i16 == 0) { const int t = 16 * tt + 4 * g + r; ex[(0 * 2 + jh) * 64 + t] = a; ex[(1 * 2 + jh) * 64 + t] = bq; ex[(2 * 2 + jh) * 64 + t] = cq; }
    }
    LDS_BARRIER();
    bf16_t* const proj = F_PROJ;
#pragma unroll
    for (int q = 0; q < 2; ++q) {
        const int v = 16 * (2 * jh + q) + i16, vc = l * 256 + h * 64 + v;
        const float lnw = INP(I_RLNW)[vc], lnb = INP(I_RLNB)[vc];
#pragma unroll
        for (int r = 0; r < 4; ++r) {
            const int t = 16 * tt + 4 * g + r;
            const float mean = (ex[t] + ex[64 + t]) * (1.f / 64.f);
            const float var = fmaxf((ex[128 + t] + ex[192 + t]) * (1.f / 64.f) - mean * mean, 0.f);
            const float bonus = (ex[256 + t] + ex[320 + t]) * bf2f(Vt[t * RW_LD + v]);
            const float yn = (Y[q][r] - mean) * rsqrtf(var + 64e-5f) * lnw + lnb;
            proj[(row0 + t) * PW + PC_R + h * 64 + v] = f2bf((yn + bonus) * Zg[q][r]);
        }
    }
    LDS_BARRIER();
}

constexpr int SSD_LDC = 136, SSD_LDX = 72;
constexpr int SSD_BUF = 64 * SSD_LDC * 2 * 2 + 64 * SSD_LDX * 2 + 64;
__device__ __forceinline__ void scan_ssd2(Frame& F, int l, int s, int hd, int vb, int ncw, unsigned* prog, unsigned pbase, unsigned* done, int pm, const unsigned* rdy, int rstride, unsigned rneed) {
    PHASE_IDS(F);
    const int tid = F.tid, lane = F.lane, w = F.wave, i16 = lane & 15, g = lane >> 4;
    const int nch = (s == 0) ? 256 : 1, c0 = (s == 0) ? 0 : 255 + s, b = s - 1, grp = hd >> 2;
    const bf16_t* const proj = F_PROJ; const float* const scal = F_SCAL; const float* const acum = F_ACUM;
    {
        if (w == (ncw < 4 ? ncw : 0)) (void)rdy_block(F, rdy, rstride, rneed, 0, nch < RDY_SLACK ? nch : RDY_SLACK, nch);
        LDS_BARRIER();
    }
    if (w >= 4) {
        const int lt = tid - 256;
        const int umask = 128 * ncw - 1, xsh = (ncw == 4) ? 3 : (ncw == 2 ? 2 : 1);
        u32x4 rc0[4], rb0[4], rx0[2], rc1[4], rb1[4], rx1[2], rc2[4], rb2[4], rx2[2], rc3[4], rb3[4], rx3[2]; float dt0[2], ac0[2], al0, dt1[2], ac1[2], al1, dt2[2], ac2[2], al2, dt3[2], ac3[2], al3;
        const bf16_t* pC[4]; const bf16_t* pB[4]; const bf16_t* pX[2]; const float* pDt[2]; const float* pAc[2]; const float* const pAl = acum + 63 * 8 + hd;
#pragma unroll
        for (int q = 0; q < 4; ++q) { const int idx = q * 256 + lt, row = idx >> 4, col8 = (idx & 15) * 8;
            pC[q] = proj + (size_t)row * PW + PC_SC + grp * 128 + col8; pB[q] = proj + (size_t)row * PW + PC_SB + grp * 128 + col8; }
#pragma unroll
        for (int q = 0; q < 2; ++q) { const int idx = (q * 256 + lt) & umask, row = idx >> xsh, col8 = vb + (idx & ((1 << xsh) - 1)) * 8;
            pX[q] = proj + (size_t)row * PW + PC_SX + hd * 64 + col8; pDt[q] = scal + row * 16 + 8 + hd; pAc[q] = acum + row * 8 + hd; }
        const bool dupX = ncw < 4;
        if (dupX) { pX[1] = proj + PC_SX; pDt[1] = scal; pAc[1] = acum; }
#define SSD_LOAD(ch, S) do { const size_t oP_ = (size_t)(ch) * (64 * PW), oS_ = (size_t)(ch) * 1024, oA_ = (size_t)(ch) * 512; al##S = ld4_asm(pAl + oA_); \
        _Pragma("unroll") for (int q = 0; q < 4; ++q) { rc##S[q] = ld16_asm(pC[q] + oP_); rb##S[q] = ld16_asm(pB[q] + oP_); } \
        _Pragma("unroll") for (int q = 0; q < 2; ++q) { rx##S[q] = ld16_asm(pX[q] + oP_); dt##S[q] = ld4_asm(pDt[q] + oS_); ac##S[q] = ld4_asm(pAc[q] + oA_); } } while (0)
#define SSD_WAIT(S, N) asm volatile("s_waitcnt vmcnt(%15)" : "+v"(rc##S[0]), "+v"(rc##S[1]), "+v"(rc##S[2]), "+v"(rc##S[3]), "+v"(rb##S[0]), "+v"(rb##S[1]), "+v"(rb##S[2]), "+v"(rb##S[3]), \
        "+v"(rx##S[0]), "+v"(rx##S[1]), "+v"(dt##S[0]), "+v"(dt##S[1]), "+v"(ac##S[0]), "+v"(ac##S[1]), "+v"(al##S) : "n"(N))
#define SSD_WRITE(bb, S) do { LAS bf16_t* Ct_ = (LAS bf16_t*)(F.lds + (bb) * SSD_BUF); LAS bf16_t* Bt_ = Ct_ + 64 * SSD_LDC; LAS bf16_t* Xt_ = Bt_ + 64 * SSD_LDC; \
        _Pragma("unroll") for (int q = 0; q < 4; ++q) { const int idx = q * 256 + lt, row = idx >> 4, col8 = (idx & 15) * 8; \
            *(LAS u32x4*)(Ct_ + row * SSD_LDC + col8) = rc##S[q]; *(LAS u32x4*)(Bt_ + row * SSD_LDC + col8) = rb##S[q]; } \
        _Pragma("unroll") for (int q = 0; q < 2; ++q) if (q == 0 || !dupX) { const int idx = (q * 256 + lt) & umask, row = idx >> xsh, col8 = vb + (idx & ((1 << xsh) - 1)) * 8; float v_[8]; unpack8(rx##S[q], v_); \
            const float sx_ = dt##S[q] * __expf(al##S - ac##S[q]); \
            _Pragma("unroll") for (int i = 0; i < 8; ++i) v_[i] *= sx_; *(LAS u32x4*)(Xt_ + row * SSD_LDX + col8) = pack8(v_); } \
        if (lt == 0) *(LAS float*)(Xt_ + 64 * SSD_LDX) = __expf(al##S); } while (0)
        SCAN_LOADER(SSD_LOAD, SSD_WRITE, SSD_WAIT, 15);
#undef SSD_LOAD
#undef SSD_WRITE
#undef SSD_WAIT
    } else if (w >= ncw) {
        int nxt = nch < RDY_SLACK ? nch : RDY_SLACK;
        LDS_BARRIER();
        for (int ci = 0; ci < nch; ++ci) {
            if (w == ncw && nxt < nch) { const int upto = ci + 1 + RDY_SLACK < nch ? ci + 1 + RDY_SLACK : nch; nxt = rdy_block(F, rdy, rstride, rneed, nxt, upto, nch); }
            LDS_BARRIER();
        }
    } else {
        const int n0 = vb + 16 * w, head = hd;
        f32x4 H[8];
        if (s == 0) {
#pragma unroll
            for (int nt = 0; nt < 8; ++nt) H[nt] = (f32x4){0.f, 0.f, 0.f, 0.f};
        } else {
            const float* st = INP(I_SSSM) + ((((size_t)l * 32 + b) * 8 + head) * 64 + n0 + i16) * 128 + 4 * g;
#pragma unroll
            for (int nt = 0; nt < 8; ++nt) H[nt] = *(const f32x4*)(st + 16 * nt);
        }
        bf16_t* const yoff = F_YOFF;
        LDS_BARRIER();
        for (int ci = 0; ci < nch; ++ci) {
            const LAS bf16_t* Ct = (const LAS bf16_t*)(F.lds + (ci & 1) * SSD_BUF); const LAS bf16_t* Bt = Ct + 64 * SSD_LDC; const LAS bf16_t* Xt = Bt + 64 * SSD_LDC;
            const float cd = *(const LAS float*)(Xt + 64 * SSD_LDX);
            bf16x8 A1[4][4], A2[8][2], Xb[2];
#pragma unroll
            for (int m = 0; m < 4; ++m)
#pragma unroll
                for (int ks = 0; ks < 4; ++ks) A1[m][ks] = frag_sig(Ct, SSD_LDC, 16 * m, 32 * ks, i16, g);
#pragma unroll
            for (int cs = 0; cs < 2; ++cs) Xb[cs] = frag_tr_nat(Xt, SSD_LDX, 32 * cs, n0, i16, g);
#pragma unroll
            for (int nt = 0; nt < 8; ++nt)
#pragma unroll
                for (int cs = 0; cs < 2; ++cs) A2[nt][cs] = frag_tr_nat(Bt, SSD_LDC, 32 * cs, 16 * nt, i16, g);
            __builtin_amdgcn_sched_barrier(0);
            bf16x8 Hb[4];
#pragma unroll
            for (int ks = 0; ks < 4; ++ks) Hb[ks] = acc_frag(H[2 * ks], H[2 * ks + 1]);
            bf16_t* yo = yoff + (((size_t)(c0 + ci) * 8 + head) * 64 + n0 + i16) * 64 + 4 * g;
            f32x4 Yv[4];
#pragma unroll
            for (int m = 0; m < 4; ++m) {
                f32x4 acc = (f32x4){0.f, 0.f, 0.f, 0.f};
#pragma unroll
                for (int ks = 0; ks < 4; ++ks) acc = mma16(A1[m][ks], Hb[ks], acc);
                Yv[m] = acc;
            }
#pragma unroll
            for (int nt = 0; nt < 8; ++nt) {
                f32x4 acc = H[nt] * cd;
#pragma unroll
                for (int cs = 0; cs < 2; ++cs) acc = mma16(A2[nt][cs], Xb[cs], acc);
                H[nt] = acc;
            }
#pragma unroll
            for (int m = 0; m < 4; ++m) st8_wt(yo + 16 * m, pack4(Yv[m]));
            if (prog) {
                asm volatile("s_waitcnt vmcnt(24)" ::: "memory");
                if (lane == 0 && ci >= 6) __hip_atomic_store(prog + 64 * w, pbase + (unsigned)(ci - 6) + 1u, __ATOMIC_RELAXED, __HIP_MEMORY_SCOPE_AGENT);
            }
            LDS_BARRIER();
        }
        asm volatile("s_waitcnt vmcnt(0)" ::: "memory");
        if (prog && lane == 0) __hip_atomic_store(prog + 64 * w, pbase + (unsigned)nch, __ATOMIC_RELAXED, __HIP_MEMORY_SCOPE_AGENT);
        if (done && lane == 0) __hip_atomic_fetch_add(done, 1u, __ATOMIC_RELAXED, __HIP_MEMORY_SCOPE_AGENT);
        float* o = F.out + (s == 0 ? O_P_SSM + (((size_t)l * 8 + head) * 64 + n0 + i16) * 128 : O_S_SSM + ((((size_t)l * 32 + b) * 8 + head) * 64 + n0 + i16) * 128) + 4 * g;
#pragma unroll
        for (int nt = 0; nt < 8; ++nt) *(f32x4*)(o + 16 * nt) = H[nt];
    }
}
__device__ __forceinline__ void post_ssd(Frame& F, int l, int c, int grp) {
    PHASE_IDS(F);
    const int tid = F.tid, lane = F.lane, w = F.wave, i16 = lane & 15, g = lane >> 4;
    const size_t row0 = (size_t)c * 64;
    bf16_t* const proj = F_PROJ;
    LAS bf16_t* Ct = (LAS bf16_t*)F.lds; LAS bf16_t* Bt = Ct + 64 * SSD_LDC; LAS bf16_t* Xt = Bt + 64 * SSD_LDC;
    LAS float* acs = (LAS float*)(Xt + 4 * 64 * SSD_LDX); LAS float* dts = acs + 256; LAS float* ssn = dts + 256;
    {
#pragma unroll
        for (int q = 0; q < 2; ++q) { const int idx = q * 512 + tid, row = idx >> 4, col8 = (idx & 15) * 8;
            *(LAS u32x4*)(Ct + row * SSD_LDC + col8) = *(const u32x4*)(proj + (row0 + row) * PW + PC_SC + grp * 128 + col8);
            *(LAS u32x4*)(Bt + row * SSD_LDC + col8) = *(const u32x4*)(proj + (row0 + row) * PW + PC_SB + grp * 128 + col8); }
#pragma unroll
        for (int q = 0; q < 4; ++q) { const int idx = q * 512 + tid, row = idx >> 5, col8 = (idx & 31) * 8, hh = col8 >> 6, cc = col8 & 63;
            *(LAS u32x4*)(Xt + hh * 64 * SSD_LDX + row * SSD_LDX + cc) = *(const u32x4*)(proj + (row0 + row) * PW + PC_SX + grp * 256 + col8); }
        if (tid < 256) { const int hh = tid >> 6, t = tid & 63; acs[tid] = F_ACUM[(row0 + t) * 8 + grp * 4 + hh]; dts[tid] = F_SCAL[(row0 + t) * 16 + 8 + grp * 4 + hh]; }
    }
    LDS_BARRIER();
    const int hh = w & 3, lh = w >> 2, hd = grp * 4 + hh;
    const LAS bf16_t* Xh = Xt + hh * 64 * SSD_LDX;
    const float Dh = INP(I_SD)[l * 8 + hd];
    float ssrow[2][4];
    f32x4 Y[2][4];
#pragma unroll
    for (int li = 0; li < 2; ++li) {
        const int ltile = 2 * lh + li;
        f32x4 ST[4];
#pragma unroll
        for (int st = 0; st < 4; ++st) {
            f32x4 acc = (f32x4){0.f, 0.f, 0.f, 0.f};
            if (st <= ltile) {
#pragma unroll
                for (int ks = 0; ks < 4; ++ks) acc = mma16(frag_nat(Bt, SSD_LDC, 16 * st, 32 * ks, i16, g), frag_nat(Ct, SSD_LDC, 16 * ltile, 32 * ks, i16, g), acc);
                const int lcol = 16 * ltile + i16; const float acl = acs[hh * 64 + lcol];
#pragma unroll
                for (int r = 0; r < 4; ++r) { const int srow = 16 * st + 4 * g + r; const float f = (srow <= lcol) ? __expf(fminf(acl - acs[hh * 64 + srow], 0.f)) * dts[hh * 64 + srow] : 0.f; acc[r] *= f; }
            }
            ST[st] = acc;
        }
#pragma unroll
        for (int pt = 0; pt < 4; ++pt) {
            f32x4 acc = (f32x4){0.f, 0.f, 0.f, 0.f};
#pragma unroll
            for (int cs = 0; cs < 2; ++cs) if (2 * cs <= ltile) acc = mma16(acc_frag(ST[2 * cs], ST[2 * cs + 1]), frag_tr_sig(Xh, SSD_LDX, 32 * cs, 16 * pt, i16, g), acc);
            const int p = 16 * pt + i16, lr0 = 16 * ltile + 4 * g;
            const f32x4 yo = unpack4(*(const u32x2*)(F_YOFF + (((size_t)c * 8 + hd) * 64 + p) * 64 + lr0));
#pragma unroll
            for (int r = 0; r < 4; ++r) {
                const int lrow = lr0 + r;
                const float x = bf2f(Xh[lrow * SSD_LDX + p]);
                const float z = bf2f(proj[(row0 + lrow) * PW + PC_ZS + hd * 64 + p]);
                acc[r] = (acc[r] + __expf(acs[hh * 64 + lrow]) * yo[r] + Dh * x) * siluf_(z);
            }
            Y[li][pt] = acc;
        }
#pragma unroll
        for (int r = 0; r < 4; ++r) { float ss = 0.f;
#pragma unroll
            for (int pt = 0; pt < 4; ++pt) ss += Y[li][pt][r] * Y[li][pt][r];
            ss += __shfl_xor(ss, 1); ss += __shfl_xor(ss, 2); ss += __shfl_xor(ss, 4); ss += __shfl_xor(ss, 8);
            ssrow[li][r] = ss; }
        if (i16 == 0) {
#pragma unroll
            for (int r = 0; r < 4; ++r) ssn[(16 * ltile + 4 * g + r) * 4 + hh] = ssrow[li][r];
        }
    }
    LDS_BARRIER();
#pragma unroll
    for (int li = 0; li < 2; ++li) {
        const int ltile = 2 * lh + li;
#pragma unroll
        for (int r = 0; r < 4; ++r) {
            const int lrow = 16 * ltile + 4 * g + r;
            const f32x4 sv = *(const LAS f32x4*)(ssn + lrow * 4);
            const float sc = rsqrtf(((sv[0] + sv[1]) + (sv[2] + sv[3])) * (1.f / 256.f) + EPS);
#pragma unroll
            for (int pt = 0; pt < 4; ++pt) { const int p = 16 * pt + i16;
                proj[(row0 + lrow) * PW + PC_ZS + hd * 64 + p] = f2bf(Y[li][pt][r] * sc * INP(I_SNORMW)[l * 512 + hd * 64 + p]); }
        }
    }
    LDS_BARRIER();
}

constexpr int NSL = 2;
constexpr int CW_PROG = 8192;
constexpr int CW_SDONE = 8192 + 64 * 64;
__device__ __forceinline__ void post_wait(Frame& F, int c, int q, unsigned pbase, unsigned sneed) {
    if (F.wave == 0) {
        unsigned* const ctl = (unsigned*)(F.ws + WS_CTL);
        const int lane = F.lane;
        unsigned* wp; unsigned need; bool act;
        if (c >= 256) { wp = ctl + CW_SDONE + 64 * (c - 256); need = sneed; act = lane == 0; }
        else {
            int gq0, ng;
            if (q < 2) { gq0 = 8 + 4 * q; ng = 4; } else if (q < 4) { gq0 = 2 * (q - 2); ng = 2; } else { gq0 = 4 + (q - 4); ng = 1; }
            act = lane < 4 * ng; wp = ctl + CW_PROG + 64 * (4 * gq0 + (act ? lane : 0)); need = pbase + (unsigned)c + 1u;
        }
        unsigned sp = 0;
        for (;;) { const bool ok = !act || (int)(xb_ld(wp) - need) >= 0; if (__all(ok) || ++sp > 2000000u) break; __builtin_amdgcn_s_sleep(4); }
        __builtin_amdgcn_fence(__ATOMIC_ACQUIRE, "agent");
        asm volatile("s_waitcnt vmcnt(0)" ::: "memory");
    }
    LDS_BARRIER();
}
__device__ __forceinline__ void scan_phase(Frame& F, int l, int mode, unsigned epoch) {
    PHASE_IDS(F);
    const int xl = F.vcu >> 5, slot = F.vcu & 31;
    unsigned* const ctl = (unsigned*)(F.ws + WS_CTL);
    const unsigned pbase = 1024u * epoch, sneed = 64u * (epoch + 1u), rneed = epoch + 1u;
    const int nchain = xl < 2 ? 8 : (xl < 6 ? 4 : 0);
    const int wbase = xl < 2 ? 24 * xl : (xl < 6 ? 48 + 28 * (xl - 2) : 160 + 32 * (xl - 6));
    const bool worker = slot >= nchain;
    const int j = wbase + slot - nchain;
    if (worker) {
        for (int it = j; it < NCH * 5; it += 224) {
            int it_ = it; asm volatile("" : "+s"(it_));
            const int c = it_ / 5, q = it_ % 5;
            if (q == 0) act_chunk(F, l, c); else prep_rwkv(F, l, c, q - 1);
        }
    }
    for (int pass = 0; pass < 3; ++pass) {
        int kind, s, h, vb, ncw; unsigned* prog = nullptr; unsigned* done = nullptr;
        if (pass == 0) {
            if (worker) continue;
            kind = xl < 2 ? 2 : (xl < 4 ? 0 : 1); h = xl < 2 ? 4 * xl + (slot >> 1) : 2 * (xl & 1) + (slot >> 1);
            const int gq = kind == 0 ? h : (kind == 1 ? 4 + h : 8 + h);
            s = 0; ncw = 2; vb = 32 * (slot & 1);
            prog = ctl + CW_PROG + 64 * (4 * gq + 2 * (slot & 1));
        } else {
            const int it = F.vcu + (pass - 1) * F.G;
            if (it >= 512) continue;
            if (it < 128) { kind = 0; s = 1 + (it >> 2); h = it & 3; }
            else if (it < 256) { kind = 1; s = 1 + ((it - 128) >> 2); h = (it - 128) & 3; }
            else { kind = 2; s = 1 + ((it - 256) >> 3); h = (it - 256) & 7; }
            vb = 0; ncw = 4; done = ctl + CW_SDONE + 64 * (s - 1);
        }
        const int cfirst = (s == 0) ? 0 : 255 + s;
        if (kind == 0) scan_gdn2(F, l, s, h, vb, ncw, prog, pbase, done, mode, ctl + CW_AFLAG + cfirst, 1, rneed);
        else if (kind == 1) scan_rwkv2(F, l, s, h, vb, ncw, prog, pbase, done, mode, ctl + CW_RFLAG + 4 * cfirst + h, 4, rneed);
        else scan_ssd2(F, l, s, h, vb, ncw, prog, pbase, done, mode, ctl + CW_AFLAG + cfirst, 1, rneed);
        __syncthreads();
    }
    if (worker) {
        for (int it = j; it < NCH * 8; it += 224) {
            int it_ = it; asm volatile("" : "+s"(it_));
            const int c = it_ >> 3, q = it_ & 7;
            post_wait(F, c, q, pbase, sneed);
            if (q < 2) post_ssd(F, l, c, q); else if (q < 4) post_gdn(F, l, c, q - 2); else post_rwkv(F, l, c, q - 4);
        }
    }
}
__device__ __forceinline__ void final_norm(Frame& F) {
    PHASE_IDS(F);
    const int gw = F.vcu * 8 + F.wave, NGW = F.G * 8;
    const float* fw = INP(I_FNORM);
    float wv[16];
#pragma unroll
    for (int i = 0; i < 16; ++i) wv[i] = fw[16 * F.lane + i];
    for (int m = gw; m < T; m += NGW) {
        float s = (F.lane < 16) ? F_SSQA[(size_t)m * 16 + F.lane] : 0.f;
        s = wave_sum(s);
        const float rs = rsqrtf(s * (1.f / 1024.f) + EPS);
        const bf16_t* xr = F_R1 + (size_t)m * DM + 16 * F.lane;
        float x[16]; { float a[8], b[8]; unpack8(*(const u32x4*)xr, a); unpack8(*(const u32x4*)(xr + 8), b);
#pragma unroll
            for (int i = 0; i < 8; ++i) { x[i] = a[i]; x[8 + i] = b[i]; } }
        f32x4* o = (f32x4*)(F.out + (size_t)m * DM + 16 * F.lane);
#pragma unroll
        for (int q = 0; q < 4; ++q) o[q] = (f32x4){x[4 * q] * rs * wv[4 * q], x[4 * q + 1] * rs * wv[4 * q + 1], x[4 * q + 2] * rs * wv[4 * q + 2], x[4 * q + 3] * rs * wv[4 * q + 3]};
    }
}

constexpr int GMT = 3;
constexpr int N_PHASES = 16;
__global__ void __launch_bounds__(512, 2) mk_fwd(Args args) {
    extern __shared__ __attribute__((aligned(16))) unsigned char lds[];
    Frame F;
    F.lds = (LAS unsigned char*)lds;
    F.tid = threadIdx.x; F.lane = F.tid & 63; F.wave = __builtin_amdgcn_readfirstlane(F.tid >> 6);
    F.G = gridDim.x; { const int bx = blockIdx.x; F.vcu = (F.G % 8 == 0) ? (bx % 8) * (F.G / 8) + bx / 8 : bx; }
    F.out = args.out; F.ws = args.ws;
    volatile LAS unsigned* MISC = (volatile LAS unsigned*)(F.lds + MISC_OFF);
    for (int u = F.tid; u < (LDS_BYTES - LDSCTL_OFF) / 4; u += 512) ((LAS unsigned*)(F.lds + LDSCTL_OFF))[u] = 0u;
    __syncthreads();
    if (F.tid == 0) {
#pragma unroll
        for (int i = 0; i < 37; ++i) ((LAS unsigned long long*)(F.lds + PTRTAB_OFF))[i] = (unsigned long long)args.in[i];
    }
    __syncthreads();
    XcdBarrier bar = xcd_barrier_post((unsigned*)(args.ws + WS_CTL) + CW_BAR, MISC + 8);
    const int ns = args.nsched; unsigned nscan = 0;
    for (int si = 0; si < ns; ++si) {
        const int pe = (int)((args.sched[si >> 2] >> (8 * (si & 3))) & 0xffu); const int p = pe & 0x7f; const bool probe = (pe & 0x80) != 0;
        if (p == 0) p0_prologue(F);
        else if (p == 15) final_norm(F);
        else {
            const int l = (p - 1) / 7, sub = (p - 1) % 7;
            if (sub == 0) {
                pg8::Gemm g{F_R1, w_in(F, l), T, PW, DM, DM}; pg8::StaticOrder S; S.init(T, PW, F.G, (int)blockIdx.x);
                pg8::EpiInProj E{F_PROJ, F_SCAL, F_SSQA, F_HCONV, F_HSHIFT, F.out, l};
                pg8::gemm_phase<pg8::EpiInProj, true>(F.lds, g, S, E);
            } else if (sub == 1) { }
            else if (sub == 2) scan_phase(F, l, 0, nscan++);
            else if (sub == 3) { }
            else if (sub == 4) {
                pg8::Gemm g{F_PROJ, w_out(F, l), T, DM, DM, PW}; pg8::StaticOrder S; S.init(T, DM, F.G, (int)blockIdx.x, 64 * GMT);
                if (l == 0) { pg8::EpiResid<true, GMT> E{INP(I_XP), INP(I_XS), F_R1, F_SSQD}; pg8::gemm_phase<pg8::EpiResid<true, GMT>, true, GMT>(F.lds, g, S, E); }
                else { pg8::EpiResid<false, GMT> E{nullptr, nullptr, F_R1, F_SSQD}; pg8::gemm_phase<pg8::EpiResid<false, GMT>, true, GMT>(F.lds, g, S, E); }
            } else if (sub == 5) {
                pg8::Gemm g{F_R1, w_gu(F, l), T, NGU, DM, DM}; pg8::StaticOrder S; S.init(T, NGU, F.G, (int)blockIdx.x);
                pg8::EpiGateUp E{F_PROJ, F_SSQD};
                pg8::gemm_phase<pg8::EpiGateUp, true>(F.lds, g, S, E);
            } else {
                pg8::Gemm g{F_PROJ, w_dn(F, l), T, DM, FF, FF}; pg8::StaticOrder S; S.init(T, DM, F.G, (int)blockIdx.x, 64 * GMT);
                pg8::EpiResid<false, GMT> E{nullptr, nullptr, F_R1, F_SSQA};
                pg8::gemm_phase<pg8::EpiResid<false, GMT>, true, GMT>(F.lds, g, S, E);
            }
        }
        if (si + 1 < ns) xcd_barrier(bar);
    }
}

extern "C" void kernel_launch(void* const* d_in, const int* in_sizes, int n_in, void* d_out, int out_size, void* d_ws, size_t ws_size, hipStream_t stream) {
    static int grid = 0;
    if (grid == 0) {
        if (n_in != 37 || out_size != (int)O_END || ws_size < 268435456) { fprintf(stderr, "kernel_launch: unexpected shapes: n_in %d out %d ws %zu\n", n_in, out_size, ws_size); grid = -1; return; }
        int dev = 0, cus = 0;
        if (hipGetDevice(&dev) != hipSuccess || hipDeviceGetAttribute(&cus, hipDeviceAttributeMultiprocessorCount, dev) != hipSuccess) { grid = -1; return; }
        if (hipFuncSetAttribute((const void*)mk_fwd, hipFuncAttributeMaxDynamicSharedMemorySize, LDS_BYTES) != hipSuccess) { fprintf(stderr, "kernel_launch: hipFuncSetAttribute failed\n"); grid = -1; return; }
        int per_cu = 0;
        if (hipOccupancyMaxActiveBlocksPerMultiprocessor(&per_cu, (const void*)mk_fwd, 512, LDS_BYTES) != hipSuccess || per_cu < 1)
            fprintf(stderr, "kernel_launch: occupancy query reports %d workgroups per CU\n", per_cu);
        (void)hipGetLastError();
        grid = cus;
    }
    if (grid < 0) return;
    (void)hipMemsetAsync((char*)d_ws + WS_CTL, 0, 65536, stream);
    Args a{};
    for (int i = 0; i < 37; ++i) a.in[i] = (const float*)d_in[i];
    a.out = (float*)d_out; a.ws = (unsigned char*)d_ws;
    {
        int n = 0; unsigned char s[32];
#ifndef PROBE_K
#define PROBE_K -1
#endif
        if (PROBE_K >= 0) { s[n++] = 0x80; for (int p = 1; p <= PROBE_K; ++p) if ((p - 1) % 7 != 3 && (p - 1) % 7 != 1) s[n++] = (unsigned char)(0x80 | p); }
        for (int p = 0; p < N_PHASES; ++p) if (p == 0 || p == 15 || ((p - 1) % 7 != 3 && (p - 1) % 7 != 1)) s[n++] = (unsigned char)p;
        for (int i = 0; i < n; ++i) a.sched[i >> 2] |= (unsigned)s[i] << (8 * (i & 3));
        a.nsched = n;
#ifndef PROBE_MODE
#define PROBE_MODE 31
#endif
        a.pmode = PROBE_MODE;
    }
    hipLaunchKernelGGL(mk_fwd, dim3(grid), dim3(512), LDS_BYTES, stream, a);
}
```

```cpp
#include <hip/hip_runtime.h>
#include <cstdio>
#include <cstdint>


#define LAS __attribute__((address_space(3)))
typedef unsigned short bf16_t;
typedef short bf16x8 __attribute__((ext_vector_type(8)));
typedef float f32x4 __attribute__((ext_vector_type(4)));
typedef float f32x2 __attribute__((ext_vector_type(2)));
typedef unsigned u32x4 __attribute__((ext_vector_type(4)));
typedef unsigned u32x2 __attribute__((ext_vector_type(2)));

constexpr int DM = 1024, TP = 16384, NB = 32, T = 18432, NCH = 288, NSEQ = 33;
constexpr int PW = 3584;
constexpr int NIN = 3840;
constexpr int FF = 2816, NGU = 5632;
constexpr float EPS = 1e-6f;
constexpr int PC_ZG = 0, PC_ZS = 256, PC_R = 768, PC_GQ = 1024, PC_GK = 1280, PC_GV = 1536, PC_SX = 1792, PC_SB = 2304, PC_SC = 2560,
              PC_RK = 2816, PC_RV = 3072, PC_RL = 3328;
constexpr size_t O_Y = 0;
constexpr size_t O_P_GDN = (size_t)T * DM;
constexpr size_t O_P_GDNC = O_P_GDN + 2 * 1 * 4 * 64 * 64;
constexpr size_t O_P_SSM = O_P_GDNC + 2 * 1 * 3 * 768;
constexpr size_t O_P_SSMC = O_P_SSM + 2 * 1 * 8 * 64 * 128;
constexpr size_t O_P_RWKV = O_P_SSMC + 2 * 1 * 3 * 1024;
constexpr size_t O_P_SHIFT = O_P_RWKV + 2 * 1 * 4 * 64 * 64;
constexpr size_t O_S_GDN = O_P_SHIFT + 2 * 1 * 1024;
constexpr size_t O_S_GDNC = O_S_GDN + (size_t)2 * 32 * 4 * 64 * 64;
constexpr size_t O_S_SSM = O_S_GDNC + (size_t)2 * 32 * 3 * 768;
constexpr size_t O_S_SSMC = O_S_SSM + (size_t)2 * 32 * 8 * 64 * 128;
constexpr size_t O_S_RWKV = O_S_SSMC + (size_t)2 * 32 * 3 * 1024;
constexpr size_t O_S_SHIFT = O_S_RWKV + (size_t)2 * 32 * 4 * 64 * 64;
constexpr size_t O_END = O_S_SHIFT + (size_t)2 * 32 * 1024;
static_assert(O_END == 25784832, "output size");

constexpr size_t WS_CTL = 0, CTL_BYTES = 1u << 20;
constexpr size_t W_IN_B = (size_t)NIN * DM * 2, W_OUT_B = (size_t)DM * DM * 2, W_GU_B = (size_t)NGU * DM * 2, W_DN_B = (size_t)DM * FF * 2;
constexpr size_t W_LAYER_B = W_IN_B + W_OUT_B + W_GU_B + W_DN_B;
constexpr size_t WS_W = WS_CTL + CTL_BYTES;
constexpr size_t WS_R1 = WS_W + 2 * W_LAYER_B;
constexpr size_t R_BYTES = (size_t)T * DM * 2;
constexpr size_t WS_R2 = WS_R1 + R_BYTES;
constexpr size_t WS_PROJ = WS_R2 + R_BYTES;
constexpr size_t PROJ_BYTES = (size_t)T * PW * 2;
constexpr size_t WS_SSQA = WS_PROJ + PROJ_BYTES;
constexpr size_t SSQ_BYTES = (size_t)T * 16 * 4;
constexpr size_t WS_SSQD = WS_SSQA + SSQ_BYTES;
constexpr size_t WS_END = WS_SSQD + SSQ_BYTES;
static_assert(WS_END <= 268435456, "d_ws map exceeds 256 MiB");
static_assert((size_t)T * FF * 2 <= PROJ_BYTES, "ff overlays proj");
constexpr size_t R2_SCAL = 0;
constexpr size_t R2_HCONV = R2_SCAL + (size_t)T * 16 * 4;
constexpr size_t R2_HSHIFT = R2_HCONV + (size_t)NCH * 3 * 1792 * 2;
constexpr size_t R2_ACUM = R2_HSHIFT + (size_t)NCH * 1024 * 2;
constexpr size_t R2_GCUM = R2_ACUM + (size_t)T * 8 * 4;
constexpr size_t R2_YOFF = R2_GCUM + (size_t)T * 4 * 4;
constexpr size_t R2_GW = R2_YOFF + (size_t)T * 512 * 2;
static_assert(R2_GW + (size_t)T * 256 * 2 <= R_BYTES, "R2 map");
constexpr size_t R1_RWA = 0;
constexpr size_t R1_RU = R1_RWA + (size_t)T * 256 * 2;
constexpr size_t R1_RBH = R1_RU + (size_t)T * 256 * 2;
constexpr size_t R1_RKV = R1_RBH + (size_t)T * 256 * 2;
static_assert(R1_RKV + (size_t)T * 256 * 2 <= R_BYTES, "R1 map");
constexpr size_t R2_RDV = R2_GW + (size_t)T * 256 * 2;
static_assert(R2_RDV + (size_t)NCH * 4 * 64 * 4 <= R_BYTES, "R2 map (dvec)");
constexpr int CW_BAR = 4096;

constexpr int RING_BYTES = 131072;
constexpr int LDSCTL_OFF = 143360, MISC_OFF = LDSCTL_OFF + 320;
constexpr int LDS_BYTES = 147456;

typedef __bf16 bf16x2_t __attribute__((ext_vector_type(2)));
__device__ __forceinline__ unsigned cvt_pk_bf16(float lo, float hi) { const f32x2 v = {lo, hi}; return __builtin_bit_cast(unsigned, __builtin_convertvector(v, bf16x2_t)); }
__device__ __forceinline__ float bf_lo(unsigned w) { return __uint_as_float(w << 16); }
__device__ __forceinline__ float bf_hi(unsigned w) { return __uint_as_float(w & 0xffff0000u); }
__device__ __forceinline__ float bf2f(bf16_t h) { return __uint_as_float(((unsigned)h) << 16); }
__device__ __forceinline__ bf16_t f2bf(float f) { return (bf16_t)(cvt_pk_bf16(f, 0.f) & 0xffffu); }
__device__ __forceinline__ void unpack8(u32x4 w, float (&o)[8]) {
    o[0] = bf_lo(w.x); o[1] = bf_hi(w.x); o[2] = bf_lo(w.y); o[3] = bf_hi(w.y); o[4] = bf_lo(w.z); o[5] = bf_hi(w.z); o[6] = bf_lo(w.w); o[7] = bf_hi(w.w); }
__device__ __forceinline__ u32x4 pack8(const float (&v)[8]) { u32x4 w; w.x = cvt_pk_bf16(v[0], v[1]); w.y = cvt_pk_bf16(v[2], v[3]); w.z = cvt_pk_bf16(v[4], v[5]); w.w = cvt_pk_bf16(v[6], v[7]); return w; }
__device__ __forceinline__ float wave_sum(float v) {
#pragma unroll
    for (int o = 1; o < 64; o <<= 1) v += __shfl_xor(v, o);
    return v;
}
#define LDS_BARRIER() do { asm volatile("s_waitcnt lgkmcnt(0)" ::: "memory"); __builtin_amdgcn_s_barrier(); asm volatile("" ::: "memory"); } while (0)
__device__ __forceinline__ float sigmoidf_(float x) { return __builtin_amdgcn_rcpf(1.f + __expf(-x)); }
__device__ __forceinline__ float siluf_(float x) { return x * __builtin_amdgcn_rcpf(1.f + __expf(-x)); }
__device__ __forceinline__ float tanhf_(float x) { return 1.f - 2.f * __builtin_amdgcn_rcpf(1.f + __expf(2.f * x)); }
__device__ __forceinline__ float softplusf_(float x) { return fmaxf(x, 0.f) + __logf(1.f + __expf(-fabsf(x))); }


typedef short s16x4 __attribute__((ext_vector_type(4)));
__device__ __forceinline__ f32x4 mma16(bf16x8 a, bf16x8 b, f32x4 c) { return __builtin_amdgcn_mfma_f32_16x16x32_bf16(a, b, c, 0, 0, 0); }
__device__ __forceinline__ bf16x8 cat4(s16x4 a, s16x4 b) { return (bf16x8){a[0], a[1], a[2], a[3], b[0], b[1], b[2], b[3]}; }
__device__ __forceinline__ bf16x8 frag_nat(const LAS bf16_t* Tt, int LD, int row0, int k0, int i16, int g) { return *(const LAS bf16x8*)(Tt + (row0 + i16) * LD + k0 + 8 * g); }
__device__ __forceinline__ bf16x8 frag_sig(const LAS bf16_t* Tt, int LD, int row0, int k0, int i16, int g) {
    const LAS bf16_t* p = Tt + (row0 + i16) * LD + k0 + 4 * g; return cat4(*(const LAS s16x4*)p, *(const LAS s16x4*)(p + 16)); }
__device__ __forceinline__ s16x4 tr4(const LAS bf16_t* p) { return __builtin_amdgcn_ds_read_tr16_b64_v4i16((LAS s16x4*)p); }
__device__ __forceinline__ bf16x8 frag_tr_nat(const LAS bf16_t* X, int LD, int k0, int c0, int i16, int g) {
    const LAS bf16_t* p = X + (k0 + 8 * g + (i16 >> 2)) * LD + c0 + 4 * (i16 & 3); return cat4(tr4(p), tr4(p + 4 * LD)); }
__device__ __forceinline__ bf16x8 frag_tr_sig(const LAS bf16_t* X, int LD, int k0, int c0, int i16, int g) {
    const LAS bf16_t* p = X + (k0 + 4 * g + (i16 >> 2)) * LD + c0 + 4 * (i16 & 3); return cat4(tr4(p), tr4(p + 16 * LD)); }
__device__ __forceinline__ bf16x8 acc_frag(f32x4 x0, f32x4 x1) {
    u32x4 w; w.x = cvt_pk_bf16(x0[0], x0[1]); w.y = cvt_pk_bf16(x0[2], x0[3]); w.z = cvt_pk_bf16(x1[0], x1[1]); w.w = cvt_pk_bf16(x1[2], x1[3]);
    return __builtin_bit_cast(bf16x8, w); }
__device__ __forceinline__ u32x2 pack4(f32x4 x) { u32x2 w; w.x = cvt_pk_bf16(x[0], x[1]); w.y = cvt_pk_bf16(x[2], x[3]); return w; }
__device__ __forceinline__ f32x4 unpack4(u32x2 w) { return (f32x4){bf_lo(w.x), bf_hi(w.x), bf_lo(w.y), bf_hi(w.y)}; }

namespace pg8 {
constexpr int BM = 256, BK = 64, HALF = 128, HTB = HALF * BK * 2, STAGE_BYTES = 8 * HTB, NXCD = 8, WGM = 8;
__host__ __device__ __forceinline__ int lds_byte(int r, int c) { const int st = (r >> 4) * 2 + (c >> 5), rr = r & 15, cc = c & 31, ob = rr * 64 + cc * 2; return st * 1024 + (ob ^ (((ob >> 9) & 1) << 5)); }
__host__ __device__ __forceinline__ void stage_rc(int b, int& R, int& C) { const int st = b / 1024, sb = b % 1024, swz = sb ^ (((sb >> 9) & 1) << 5); R = (st >> 1) * 16 + swz / 64; C = (st & 1) * 32 + (swz % 64) / 2; }
__host__ __device__ __forceinline__ int perm32(int rho) { const int n = rho >> 4, i = rho & 15; return 8 * (i >> 2) + 4 * n + (i & 3); }
struct Unit { int pm, pn; };
struct Gemm { const bf16_t* A; const bf16_t* Bt; int M, N, K, lda; };
struct StaticOrder {
    int nM, nN, nwg, G, c;
    __host__ __device__ void init(int M, int N, int G_, int c_, int bm = BM) { nM = M / bm; nN = N / BM; nwg = nM * nN; G = G_; c = c_; }
    __host__ __device__ bool next(int i, Unit& u) const {
        const long L = (long)i * G + c; if (L >= nwg) return false;
        int wgid = (int)L; { const int q = nwg / NXCD, r = nwg % NXCD, xcd = wgid % NXCD, off = wgid / NXCD; wgid = (xcd < r ? xcd * (q + 1) : r * (q + 1) + (xcd - r) * q) + off; }
        const int nig = WGM * nN, gid = wgid / nig, fm = gid * WGM, gsz = (nM - fm) < WGM ? (nM - fm) : WGM;
        u.pm = fm + ((wgid % nig) % gsz); u.pn = (wgid % nig) / gsz; return true;
    }
};
template <class Epi, bool ALIGN_EPI, int MT = 4>
__device__ __forceinline__ void gemm_phase(LAS unsigned char* lds, const Gemm g, const StaticOrder& S, const Epi& E) {
    int tid_ = threadIdx.x; asm volatile("" : "+v"(tid_));
    const int tid = tid_, wid = __builtin_amdgcn_readfirstlane(tid >> 6), lane = tid & 63, wr = wid >> 2, wc = wid & 3, fr = lane & 15, fq = lane >> 4;
    const int K = g.K, nt = K / BK, lda = g.lda;
    unsigned voffA[2], voffB[2];
#pragma unroll
    for (int i = 0; i < 2; ++i) { int R, C; stage_rc(tid * 16 + i * 8192, R, C); const int Rb = Epi::PERM ? ((R & ~31) + perm32(R & 31)) : R;
        voffA[i] = (unsigned)(R * lda + C) * 2u; voffB[i] = (unsigned)(Rb * K + C) * 2u; }
    const size_t kstep = (size_t)(BK * 2);
    const size_t hstepA = (size_t)(32 * MT) * lda * 2, hstepB = (size_t)HALF * K * 2;
    const size_t tstepA = 2 * hstepA, tstepB = 2 * hstepB;
    const unsigned ldsw = (unsigned)wid * 1024u;
    const int aoff = lds_byte(wr * (16 * MT) + fr, fq * 8), boff = lds_byte(wc * 32 + fr, fq * 8);
#define PG8_SA(b, h) (((b) * 2 + (h)) * HTB)
#define PG8_SB(b, h) ((4 + (b) * 2 + (h)) * HTB)
#define PG8_STAGE(bufoff, gbase, voff) do { _Pragma("unroll") for (int _i = 0; _i < 2; ++_i) \
        __builtin_amdgcn_global_load_lds((const unsigned*)((const char*)(gbase) + (voff)[_i]), (LAS unsigned*)(lds + (bufoff) + ldsw + _i * 8192), 16, 0, 0); } while (0)
#define PG8_LDA(dst, b, h) do { _Pragma("unroll") for (int m = 0; m < MT; ++m) _Pragma("unroll") for (int k = 0; k < 2; ++k) dst[m][k] = *(const LAS bf16x8*)(lds + PG8_SA(b, h) + aoff + m * 2048 + k * 1024); } while (0)
#define PG8_LDB(dst, b, h) do { _Pragma("unroll") for (int n = 0; n < 2; ++n) _Pragma("unroll") for (int k = 0; k < 2; ++k) dst[n][k] = *(const LAS bf16x8*)(lds + PG8_SB(b, h) + boff + n * 2048 + k * 1024); } while (0)
#define PG8_MMA(ai, bj, At, Bt) do { __builtin_amdgcn_s_setprio(1); _Pragma("unroll") for (int m = 0; m < MT; ++m) _Pragma("unroll") for (int n = 0; n < 2; ++n) _Pragma("unroll") for (int k = 0; k < 2; ++k) \
        acc[ai][bj][m][n] = __builtin_amdgcn_mfma_f32_16x16x32_bf16(Bt[n][k], At[m][k], acc[ai][bj][m][n], 0, 0, 0); __builtin_amdgcn_s_setprio(0); } while (0)
#define PG8_WAIT_V(n) asm volatile("s_waitcnt vmcnt(" #n ")" ::: "memory")
#define PG8_WAIT_L(n) asm volatile("s_waitcnt lgkmcnt(" #n ")" ::: "memory")
#define PG8_BAR __builtin_amdgcn_s_barrier()
#define PG8_SCHED __builtin_amdgcn_sched_barrier(0)
    Unit cur, nxt; int ui = 0;
    if (!S.next(0, cur)) return;
    f32x4 acc[2][2][4][2];
#pragma unroll
    for (int a = 0; a < 2; ++a)
#pragma unroll
        for (int b = 0; b < 2; ++b)
#pragma unroll
            for (int m = 0; m < 4; ++m)
#pragma unroll
                for (int n = 0; n < 2; ++n) acc[a][b][m][n] = (f32x4){0.f, 0.f, 0.f, 0.f};
    bf16x8 At[4][2], B0[2][2], B1[2][2];
    const char* cA = (const char*)g.A + (size_t)cur.pm * tstepA; const char* cB = (const char*)g.Bt + (size_t)cur.pn * tstepB;
    PG8_STAGE(PG8_SB(0, 0), cB, voffB); PG8_STAGE(PG8_SB(0, 1), cB + hstepB, voffB); PG8_STAGE(PG8_SA(0, 0), cA, voffA); PG8_STAGE(PG8_SA(0, 1), cA + hstepA, voffA);
    if (wr == 1) PG8_BAR;
    PG8_WAIT_V(2); PG8_BAR;
    PG8_STAGE(PG8_SB(1, 0), cB + kstep, voffB); PG8_STAGE(PG8_SA(1, 0), cA + kstep, voffA); PG8_STAGE(PG8_SB(1, 1), cB + hstepB + kstep, voffB);
    PG8_WAIT_V(6); PG8_BAR;
    for (;;) {
        const bool has_next = S.next(ui + 1, nxt);
        const char* nA = has_next ? (const char*)g.A + (size_t)nxt.pm * tstepA : cA; const char* nB = has_next ? (const char*)g.Bt + (size_t)nxt.pn * tstepB : cB;
        for (int t = 0; t < nt; t += 2) {
            const bool last = (t == nt - 2);
            const char* a1 = cA + (size_t)(t + 1) * kstep;
            const char* a2 = last ? nA : cA + (size_t)(t + 2) * kstep; const char* b2 = last ? nB : cB + (size_t)(t + 2) * kstep;
            const char* a3 = a2 + kstep; const char* b3 = b2 + kstep;
            PG8_LDB(B0, 0, 0); PG8_LDB(B1, 0, 1); PG8_SCHED; PG8_LDA(At, 0, 0); PG8_STAGE(PG8_SA(1, 1), a1 + hstepA, voffA);
            PG8_WAIT_V(8); PG8_WAIT_L(0); PG8_BAR; PG8_MMA(0, 0, At, B0); PG8_MMA(0, 1, At, B1); PG8_BAR; PG8_SCHED;
            PG8_LDA(At, 0, 1); PG8_STAGE(PG8_SB(0, 0), b2, voffB); PG8_STAGE(PG8_SB(0, 1), b2 + hstepB, voffB); PG8_STAGE(PG8_SA(0, 0), a2, voffA);
            PG8_WAIT_V(8); PG8_WAIT_L(0); PG8_BAR; PG8_MMA(1, 0, At, B0); PG8_MMA(1, 1, At, B1); PG8_BAR; PG8_SCHED;
            PG8_LDB(B0, 1, 0); PG8_LDB(B1, 1, 1); PG8_SCHED; PG8_LDA(At, 1, 0); PG8_STAGE(PG8_SA(0, 1), a2 + hstepA, voffA);
            PG8_WAIT_V(8); PG8_WAIT_L(0); PG8_BAR; PG8_MMA(0, 0, At, B0); PG8_MMA(0, 1, At, B1); PG8_BAR; PG8_SCHED;
            PG8_LDA(At, 1, 1); PG8_STAGE(PG8_SB(1, 0), b3, voffB); PG8_STAGE(PG8_SB(1, 1), b3 + hstepB, voffB); PG8_STAGE(PG8_SA(1, 0), a3, voffA);
            PG8_WAIT_V(8); PG8_WAIT_L(0); PG8_BAR; PG8_MMA(1, 0, At, B0); PG8_MMA(1, 1, At, B1); PG8_BAR; PG8_SCHED;
        }
        if constexpr (ALIGN_EPI) { if (wr == 0) PG8_BAR; }
        E(acc, cur, wr, wc, fr, fq);
        if (!has_next) break;
#pragma unroll
        for (int a = 0; a < 2; ++a)
#pragma unroll
            for (int b = 0; b < 2; ++b)
#pragma unroll
                for (int m = 0; m < 4; ++m)
#pragma unroll
                    for (int n = 0; n < 2; ++n) acc[a][b][m][n] = (f32x4){0.f, 0.f, 0.f, 0.f};
        cur = nxt; cA = nA; cB = nB; ++ui;
        if constexpr (ALIGN_EPI) { if (wr == 1) PG8_BAR; }
    }
    PG8_WAIT_V(0);
    if constexpr (!ALIGN_EPI) { if (wr == 0) PG8_BAR; }
    PG8_BAR;
#undef PG8_SA
#undef PG8_SB
#undef PG8_STAGE
#undef PG8_LDA
#undef PG8_LDB
#undef PG8_MMA
#undef PG8_WAIT_V
#undef PG8_WAIT_L
#undef PG8_BAR
#undef PG8_SCHED
}

__device__ __forceinline__ float row_rstd(const float* ssq, int row, int fq) {
    const f32x4 p = *(const f32x4*)(ssq + (size_t)row * 16 + 4 * fq);
    float s = (p.x + p.y) + (p.z + p.w);
    s += __shfl_xor(s, 16); s += __shfl_xor(s, 32);
    return rsqrtf(s * (1.0f / 1024.0f) + EPS);
}

struct EpiInProj {
    static constexpr bool PERM = true;
    bf16_t* proj; float* scal; const float* ssq; bf16_t* hconv; bf16_t* hshift; float* out; int layer;
    __device__ __forceinline__ void operator()(const f32x4 (&acc)[2][2][4][2], const Unit& u, int wr, int wc, int fr, int fq) const {
        const int pn = u.pn;
#pragma unroll
        for (int ai = 0; ai < 2; ++ai)
#pragma unroll
            for (int m = 0; m < 4; ++m) {
                const int row = u.pm * BM + ai * HALF + wr * 64 + m * 16 + fr;
                const float rs = row_rstd(ssq, row, fq);
                {
#pragma unroll
                    for (int bj = 0; bj < 2; ++bj) {
                        const int c0 = pn * BM + bj * HALF + wc * 32 + 8 * fq;
                        const f32x4 v0 = acc[ai][bj][m][0] * rs, v1 = acc[ai][bj][m][1] * rs;
                        u32x4 w; w.x = cvt_pk_bf16(v0[0], v0[1]); w.y = cvt_pk_bf16(v0[2], v0[3]); w.z = cvt_pk_bf16(v1[0], v1[1]); w.w = cvt_pk_bf16(v1[2], v1[3]);
                        *(u32x4*)(proj + (size_t)row * PW + c0) = w;
                        if (m == 3) {
                            const int chunk = row >> 6;
                            if (fr >= 13 && pn >= 4 && pn < 11) {
                                const int j = fr - 13;
                                *(u32x4*)(hconv + ((size_t)chunk * 3 + j) * 1792 + (c0 - 1024)) = w;
                                if (chunk >= 255) {
                                    float* o;
                                    if (c0 < PC_SX) o = out + (chunk == 255 ? O_P_GDNC + ((size_t)layer * 3 + j) * 768 : O_S_GDNC + (((size_t)layer * 32 + (chunk - 256)) * 3 + j) * 768) + (c0 - PC_GQ);
                                    else o = out + (chunk == 255 ? O_P_SSMC + ((size_t)layer * 3 + j) * 1024 : O_S_SSMC + (((size_t)layer * 32 + (chunk - 256)) * 3 + j) * 1024) + (c0 - PC_SX);
                                    *(f32x4*)o = v0; *(f32x4*)(o + 4) = v1;
                                }
                            }
                            if (fr == 15 && (pn == 3 || pn >= 11)) {
                                const int oc = (pn == 3) ? (c0 - PC_R) : (c0 - 2560);
                                *(u32x4*)(hshift + (size_t)chunk * 1024 + oc) = w;
                                if (chunk >= 255) {
                                    float* o = out + (chunk == 255 ? O_P_SHIFT + (size_t)layer * 1024 : O_S_SHIFT + ((size_t)layer * 32 + (chunk - 256)) * 1024) + oc;
                                    *(f32x4*)o = v0; *(f32x4*)(o + 4) = v1;
                                }
                            }
                        }
                    }
                }
            }
    }
};
template <bool F32BASE, int MT> struct EpiResid {
    static constexpr bool PERM = true;
    const float* base_p; const float* base_s; bf16_t* xb; float* ssq;
    __device__ __forceinline__ void operator()(const f32x4 (&acc)[2][2][4][2], const Unit& u, int wr, int wc, int fr, int fq) const {
        const int col0 = u.pn * BM + wc * 32 + 8 * fq;
#pragma unroll
        for (int ai = 0; ai < 2; ++ai)
#pragma unroll
            for (int m = 0; m < MT; ++m) {
                const int row = u.pm * (64 * MT) + ai * (32 * MT) + wr * (16 * MT) + m * 16 + fr;
                float ss = 0.f;
#pragma unroll
                for (int bj = 0; bj < 2; ++bj) {
                    const int c = col0 + bj * HALF;
                    float x[8];
                    if (F32BASE) {
                        const float* bp = ((row < TP) ? base_p + (size_t)row * DM : base_s + (size_t)(row - TP) * DM) + c;
                        const f32x4 b0 = *(const f32x4*)bp, b1 = *(const f32x4*)(bp + 4);
                        x[0] = b0[0]; x[1] = b0[1]; x[2] = b0[2]; x[3] = b0[3]; x[4] = b1[0]; x[5] = b1[1]; x[6] = b1[2]; x[7] = b1[3];
                    } else unpack8(*(const u32x4*)(xb + (size_t)row * DM + c), x);
#pragma unroll
                    for (int n = 0; n < 2; ++n)
#pragma unroll
                        for (int i = 0; i < 4; ++i) { const float v = x[4 * n + i] + acc[ai][bj][m][n][i]; x[4 * n + i] = v; ss += v * v; }
                    *(u32x4*)(xb + (size_t)row * DM + c) = pack8(x);
                }
                ss += __shfl_xor(ss, 16); ss += __shfl_xor(ss, 32);
                if (fq == 0) ssq[(size_t)row * 16 + u.pn * 4 + wc] = ss;
            }
    }
};
struct EpiGateUp {
    static constexpr bool PERM = true;
    bf16_t* ff; const float* ssq;
    __device__ __forceinline__ void operator()(const f32x4 (&acc)[2][2][4][2], const Unit& u, int wr, int wc, int fr, int fq) const {
        const int c0 = u.pn * HALF + wc * 32 + 8 * fq;
#pragma unroll
        for (int ai = 0; ai < 2; ++ai)
#pragma unroll
            for (int m = 0; m < 4; ++m) {
                const int row = u.pm * BM + ai * HALF + wr * 64 + m * 16 + fr;
                const float rs = row_rstd(ssq, row, fq);
                float f[8];
#pragma unroll
                for (int n = 0; n < 2; ++n)
#pragma unroll
                    for (int i = 0; i < 4; ++i) { const float gg = acc[ai][0][m][n][i] * rs, uu = acc[ai][1][m][n][i] * rs; f[n * 4 + i] = siluf_(gg) * uu; }
                *(u32x4*)(ff + (size_t)row * FF + c0) = pack8(f);
            }
    }
};
}

#define XB_TMO      128
#define XB_XCNT(j)  (256  + 64 * (j))
#define XB_XSUB(j)  (1280 + 64 * (j))
#define XB_XGEN(j)  (2304 + 64 * (j))
#define XB_TOP      3328
#define XB_TOPGEN   3392
#define XCD_BAR_WORDS 3456
#define XB_SPIN_CAP (1u << 18)
__device__ __forceinline__ unsigned xb_ld(unsigned* p)              { return __hip_atomic_load(p, __ATOMIC_RELAXED, __HIP_MEMORY_SCOPE_AGENT); }
__device__ __forceinline__ unsigned xb_add(unsigned* p, unsigned v) { return __hip_atomic_fetch_add(p, v, __ATOMIC_RELAXED, __HIP_MEMORY_SCOPE_AGENT); }
__device__ __forceinline__ unsigned xb_xcc_id() { return (unsigned)__builtin_amdgcn_s_getreg((3 << 11) | 20) & 0xFu; }
#define XB_SPIN(cond, bar) do { unsigned _sp = 0; while (cond) { __builtin_amdgcn_s_sleep(1); \
    if ((++_sp & 255u) == 0u) { if (xb_ld(&(bar)[XB_TMO])) break; if (_sp > XB_SPIN_CAP) { atomicAdd(&(bar)[XB_TMO], 1u); break; } } } } while (0)
struct XcdBarrier { unsigned* bar; unsigned x; volatile LAS unsigned* st; };
__device__ __forceinline__ XcdBarrier xcd_barrier_post(unsigned* bar, volatile LAS unsigned* st) {
    XcdBarrier b; b.bar = bar; b.x = xb_xcc_id(); b.st = st;
    if (threadIdx.x == 0) (void)xb_add(&bar[XB_XCNT(b.x)], 1u);
    return b;
}
__device__ __forceinline__ void xcd_barrier_complete(unsigned* bar, unsigned x, unsigned& nloc, unsigned& nx) {
    const unsigned G = gridDim.x * gridDim.y * gridDim.z;
    unsigned sum, cnt, mine, sp = 0u;
    for (;;) {
        sum = 0u; cnt = 0u; mine = 0u;
#pragma unroll
        for (unsigned j = 0; j < 16; ++j) { const unsigned c = xb_ld(&bar[XB_XCNT(j)]); sum += c; cnt += (c > 0u) ? 1u : 0u; mine = (j == x) ? c : mine; }
        if (sum == G) break;
        __builtin_amdgcn_s_sleep(1);
        if ((++sp & 255u) == 0u) { if (xb_ld(&bar[XB_TMO])) break; if (sp > XB_SPIN_CAP) { atomicAdd(&bar[XB_TMO], 1u); break; } }
    }
    nloc = mine > 0u ? mine : 1u; nx = cnt > 0u ? cnt : 1u;
}
__device__ __forceinline__ void xcd_barrier(const XcdBarrier& b) {
    asm volatile("s_waitcnt vmcnt(0)" ::: "memory");
    __syncthreads();
    if (threadIdx.x == 0) {
        unsigned* bar = b.bar;
        __builtin_amdgcn_s_waitcnt(0);
        unsigned nloc = b.st[0], nx = b.st[1];
        if (nloc == 0u) { xcd_barrier_complete(bar, b.x, nloc, nx); b.st[0] = nloc; b.st[1] = nx; }
        const unsigned old = xb_add(&bar[XB_XSUB(b.x)], 1u);
        const unsigned gen = old / nloc;
        if (old + 1u == (gen + 1u) * nloc) {
            __builtin_amdgcn_fence(__ATOMIC_RELEASE, "agent");
            asm volatile("s_waitcnt vmcnt(0)" ::: "memory");
            const unsigned og = xb_add(&bar[XB_TOP], 1u);
            const unsigned tg = og / nx;
            if (og + 1u == (tg + 1u) * nx) xb_add(&bar[XB_TOPGEN], 1u);
            else XB_SPIN(xb_ld(&bar[XB_TOPGEN]) == tg, bar);
            __builtin_amdgcn_fence(__ATOMIC_ACQUIRE, "agent");
            xb_add(&bar[XB_XGEN(b.x)], 1u);
            asm volatile("s_waitcnt vmcnt(0)" ::: "memory");
        } else {
            XB_SPIN(xb_ld(&bar[XB_XGEN(b.x)]) == gen, bar);
            __builtin_amdgcn_fence(__ATOMIC_ACQUIRE, "agent");
            asm volatile("s_waitcnt vmcnt(0)" ::: "memory");
        }
    }
    __syncthreads();
}

struct Args { const float* in[37]; float* out; unsigned char* ws; unsigned sched[8]; int nsched, pmode; };
enum { I_XP = 0, I_XS, I_SGDN, I_SGDNC, I_SSSM, I_SSSMC, I_SRWKV, I_SSHIFT, I_NORM1, I_WIN, I_GCONVW, I_GALOG, I_GDTB, I_GNORMW,
       I_SCONVW, I_SCONVB, I_SALOG, I_SDTB, I_SD, I_SNORMW, I_RMU, I_RW0, I_RWUP, I_RA0, I_RAUP, I_RGUP, I_RKK, I_RKA, I_RRK, I_RLNW, I_RLNB,
       I_WOUT, I_NORM2, I_WG, I_WU, I_WD, I_FNORM };

struct Frame {
    LAS unsigned char* lds;
    int tid, lane, wave, vcu, G;
    float* out; unsigned char* ws;
};
constexpr int PTRTAB_OFF = LDSCTL_OFF + 1024;
__device__ __forceinline__ const float* inptr(LAS unsigned char* lds, int i) {
    const unsigned long long v = ((const LAS unsigned long long*)(lds + PTRTAB_OFF))[i];
    const unsigned lo = __builtin_amdgcn_readfirstlane((unsigned)v), hi = __builtin_amdgcn_readfirstlane((unsigned)(v >> 32));
    return (const float*)(((unsigned long long)hi << 32) | lo);
}
#define INP(i) inptr(F.lds, (i))
#define F_R1     ((bf16_t*)(F.ws + WS_R1))
#define F_R2     ((bf16_t*)(F.ws + WS_R2))
#define F_PROJ   ((bf16_t*)(F.ws + WS_PROJ))
#define F_SSQA   ((float*)(F.ws + WS_SSQA))
#define F_SSQD   ((float*)(F.ws + WS_SSQD))
#define F_SCAL   ((float*)(F.ws + WS_R2 + R2_SCAL))
#define F_HCONV  ((bf16_t*)(F.ws + WS_R2 + R2_HCONV))
#define F_HSHIFT ((bf16_t*)(F.ws + WS_R2 + R2_HSHIFT))
#define F_RWA    ((bf16_t*)((unsigned char*)F.out + R1_RWA))
#define F_RU     ((bf16_t*)((unsigned char*)F.out + R1_RU))
#define F_RBH    ((bf16_t*)((unsigned char*)F.out + R1_RBH))
#define F_RKV    ((bf16_t*)((unsigned char*)F.out + R1_RKV))
#define F_RDV    ((float*)(F.ws + WS_R2 + R2_RDV))
#define F_ACUM   ((float*)(F.ws + WS_R2 + R2_ACUM))
#define F_GCUM   ((float*)(F.ws + WS_R2 + R2_GCUM))
#define F_YOFF   ((bf16_t*)(F.ws + WS_R2 + R2_YOFF))
#define F_GW     ((bf16_t*)(F.ws + WS_R2 + R2_GW))
__device__ __forceinline__ bf16_t* w_in(const Frame& F, int l) { return (bf16_t*)(F.ws + WS_W + (size_t)l * W_LAYER_B); }
__device__ __forceinline__ bf16_t* w_out(const Frame& F, int l) { return (bf16_t*)(F.ws + WS_W + (size_t)l * W_LAYER_B + W_IN_B); }
__device__ __forceinline__ bf16_t* w_gu(const Frame& F, int l) { return (bf16_t*)(F.ws + WS_W + (size_t)l * W_LAYER_B + W_IN_B + W_OUT_B); }
__device__ __forceinline__ bf16_t* w_dn(const Frame& F, int l) { return (bf16_t*)(F.ws + WS_W + (size_t)l * W_LAYER_B + W_IN_B + W_OUT_B + W_GU_B); }

template <class Tp> __device__ __forceinline__ LAS Tp* opaque_lds(LAS Tp* p) { unsigned a = (unsigned)(unsigned long long)p; asm volatile("" : "+v"(a)); return (LAS Tp*)(unsigned long long)a; }
constexpr int CW_AFLAG = 14336, CW_RFLAG = 14336 + 288;
__device__ __forceinline__ void publish_item(unsigned* flag) {
    asm volatile("s_waitcnt vmcnt(0)" ::: "memory");
    LDS_BARRIER();
    if (threadIdx.x == 0) {
        __builtin_amdgcn_fence(__ATOMIC_RELEASE, "agent");
        asm volatile("s_waitcnt vmcnt(0)" ::: "memory");
        __hip_atomic_fetch_add(flag, 1u, __ATOMIC_RELAXED, __HIP_MEMORY_SCOPE_AGENT);
    }
}
__device__ __forceinline__ int opaque_tid() { int t = threadIdx.x; asm volatile("" : "+v"(t)); return t; }
#define PHASE_IDS(F) do { (F).tid = opaque_tid(); (F).lane = (F).tid & 63; (F).wave = __builtin_amdgcn_readfirstlane((F).tid >> 6); } while (0)
__device__ __forceinline__ int inproj_dst(int n) {
    if (n < 768) return PC_GQ + n;
    if (n < 1024) return PC_ZG + (n - 768);
    if (n < 1032) return 3584 + (n - 1024);
    if (n < 1544) return PC_ZS + (n - 1032);
    if (n < 2568) return PC_SX + (n - 1544);
    if (n < 2576) return 3592 + (n - 2568);
    if (n < 2832) return PC_R + (n - 2576);
    if (n < 3344) return PC_RK + (n - 2832);
    return PC_RL + (n - 3344);
}
template <int MODE>
__device__ __forceinline__ void p0_transpose_item(const float* W, int K, int N, bf16_t* WT, const float* kscale, LAS float* scr, int item, int lane) {
    const int nblk = (N + 31) / 32, kb = item / nblk, nb = item % nblk, k0 = 64 * kb, n0 = 32 * nb;
    {
        const int rr = lane >> 3, c4 = (lane & 7) * 4;
        f32x4 v[8];
#pragma unroll
        for (int i = 0; i < 8; ++i) { const float* p = W + (size_t)(k0 + 8 * i + rr) * N + n0 + c4;
            if (n0 + c4 + 3 < N) v[i] = *(const f32x4*)p;
            else v[i] = (f32x4){0.f, 0.f, 0.f, 0.f}; }
#pragma unroll
        for (int i = 0; i < 8; ++i) { LAS float* s = scr + (8 * i + rr) * 33 + c4; s[0] = v[i][0]; s[1] = v[i][1]; s[2] = v[i][2]; s[3] = v[i][3]; }
    }
    asm volatile("s_waitcnt lgkmcnt(0)" ::: "memory");
    const int c = lane & 7;
    float ks[8];
#pragma unroll
    for (int i = 0; i < 8; ++i) ks[i] = kscale ? kscale[k0 + 8 * c + i] : 1.f;
#pragma unroll
    for (int j = 0; j < 4; ++j) { const int nl = (lane >> 3) + 8 * j; const int n = n0 + nl; const LAS float* s = scr + (8 * c) * 33 + nl;
        u32x4 o; o.x = cvt_pk_bf16(s[0 * 33] * ks[0], s[1 * 33] * ks[1]); o.y = cvt_pk_bf16(s[2 * 33] * ks[2], s[3 * 33] * ks[3]);
        o.z = cvt_pk_bf16(s[4 * 33] * ks[4], s[5 * 33] * ks[5]); o.w = cvt_pk_bf16(s[6 * 33] * ks[6], s[7 * 33] * ks[7]);
        if (n < N) {
            int d;
            if (MODE == 0) d = n; else if (MODE == 1) d = inproj_dst(n); else if (MODE == 2) d = 256 * (n >> 7) + (n & 127); else d = 256 * (n >> 7) + 128 + (n & 127);
            *(u32x4*)(WT + (size_t)d * K + k0 + 8 * c) = o; } }
    asm volatile("s_waitcnt lgkmcnt(0)" ::: "memory");
}
__device__ __forceinline__ void p0_prologue(Frame& F) {
    PHASE_IDS(F);
    LAS float* scr = (LAS float*)(F.lds + F.wave * 16384);
    const int gw = F.vcu * 8 + F.wave, NGW = F.G * 8;
    constexpr int I_IN = 16 * 113, I_OUT = 16 * 32, I_G = 16 * 88, I_D = 44 * 32;
    constexpr int PER_L = I_IN + I_OUT + 2 * I_G + I_D;
    for (int it = gw; it < 2 * PER_L; it += NGW) {
        const int l = it / PER_L; int r = it % PER_L;
        if (r < I_IN) { p0_transpose_item<1>(INP(I_WIN) + (size_t)l * DM * 3600, DM, 3600, w_in(F, l), INP(I_NORM1) + l * DM, scr, r, F.lane); continue; } r -= I_IN;
        if (r < I_OUT) { p0_transpose_item<0>(INP(I_WOUT) + (size_t)l * DM * DM, DM, DM, w_out(F, l), nullptr, scr, r, F.lane); continue; } r -= I_OUT;
        if (r < I_G) { p0_transpose_item<2>(INP(I_WG) + (size_t)l * DM * FF, DM, FF, w_gu(F, l), INP(I_NORM2) + l * DM, scr, r, F.lane); continue; } r -= I_G;
        if (r < I_G) { p0_transpose_item<3>(INP(I_WU) + (size_t)l * DM * FF, DM, FF, w_gu(F, l), INP(I_NORM2) + l * DM, scr, r, F.lane); continue; } r -= I_G;
        p0_transpose_item<0>(INP(I_WD) + (size_t)l * FF * DM, FF, DM, w_dn(F, l), nullptr, scr, r, F.lane);
    }
    for (int m = gw; m < T; m += NGW) {
        const float* xr = (m < TP) ? INP(I_XP) + (size_t)m * DM : INP(I_XS) + (size_t)(m - TP) * DM;
        f32x4 v[4]; float s = 0.f;
#pragma unroll
        for (int j = 0; j < 4; ++j) { v[j] = *((const f32x4*)xr + F.lane + 64 * j); s += (v[j].x * v[j].x + v[j].y * v[j].y) + (v[j].z * v[j].z + v[j].w * v[j].w); }
        s = wave_sum(s);
#pragma unroll
        for (int j = 0; j < 4; ++j) { u32x2 w; w.x = cvt_pk_bf16(v[j].x, v[j].y); w.y = cvt_pk_bf16(v[j].z, v[j].w); *((u32x2*)(F_R1 + (size_t)m * DM) + F.lane + 64 * j) = w; }
        if (F.lane < 16) F_SSQA[(size_t)m * 16 + F.lane] = (F.lane == 0) ? s : 0.f;
    }
}

template <int LDL, int SGN, class RhsFn>
__device__ __forceinline__ void tri_solve64(const LAS float* Lo, float (&x)[64], RhsFn rhs) {
    f32x4 cur[16], nxt[16];
#pragma unroll
    for (int i = 0; i < 64; ++i) {
        if (i + 1 < 64) {
#pragma unroll
            for (int m4 = 0; m4 < (i + 1 + 3) / 4; ++m4) nxt[m4] = *(const LAS f32x4*)(Lo + (i + 1) * LDL + 4 * m4);
        }
        float a0 = rhs(i), a1 = 0.f, a2 = 0.f, a3 = 0.f;
#pragma unroll
        for (int m4 = 0; m4 < (i + 3) / 4; ++m4) {
            if (4 * m4 + 0 < i) a0 += (SGN > 0 ? cur[m4][0] : -cur[m4][0]) * x[4 * m4 + 0];
            if (4 * m4 + 1 < i) a1 += (SGN > 0 ? cur[m4][1] : -cur[m4][1]) * x[4 * m4 + 1];
            if (4 * m4 + 2 < i) a2 += (SGN > 0 ? cur[m4][2] : -cur[m4][2]) * x[4 * m4 + 2];
            if (4 * m4 + 3 < i) a3 += (SGN > 0 ? cur[m4][3] : -cur[m4][3]) * x[4 * m4 + 3];
        }
        x[i] = (a0 + a1) + (a2 + a3);
        __builtin_amdgcn_sched_barrier(0);
#pragma unroll
        for (int m4 = 0; m4 < 16; ++m4) cur[m4] = nxt[m4];
    }
}
constexpr int ACT_KT = 0, ACT_VT = 33792, ACT_LM = 67584, ACT_SCL = 137216, ACT_GCL = 141312;
constexpr int ACT_LDK = 264, ACT_LDL = 68;
__device__ __forceinline__ void act_chunk(Frame& F, int l, int c) {
    PHASE_IDS(F);
    const int tid = F.tid;
    const size_t row0 = (size_t)c * 64;
    const bool prompt = c < 256; const int b = c - 256;
    bf16_t* const proj = F_PROJ;
    LAS float* inT = (LAS float*)F.lds;
    LAS bf16_t* kx = (LAS bf16_t*)(F.lds + 256 * 68 * 4);
    LAS bf16_t* Kt = (LAS bf16_t*)(F.lds + ACT_KT); LAS bf16_t* Vt = (LAS bf16_t*)(F.lds + ACT_VT); LAS float* Lm = (LAS float*)(F.lds + ACT_LM);
    LAS float* scl = (LAS float*)(F.lds + ACT_SCL); LAS float* gcl = (LAS float*)(F.lds + ACT_GCL);
    LAS float* part = (LAS float*)(F.lds + ACT_LM); LAS float* rsl = part + 2 * 64 * 16;
    {
        const int w = F.wave, lane = F.lane, i16 = lane & 15, g = lane >> 4, rt = w & 3, kh = w >> 2;
        const bf16_t* ap = F_R1 + (row0 + 16 * rt + i16) * DM + kh * 512 + 8 * g;
        const bf16_t* bp = w_in(F, l) + (size_t)(PW + i16) * DM + kh * 512 + 8 * g;
        bf16x8 a[16], b[16];
#pragma unroll
        for (int ks = 0; ks < 16; ++ks) { a[ks] = *(const bf16x8*)(ap + 32 * ks); b[ks] = *(const bf16x8*)(bp + 32 * ks); }
        if (tid < 64) { const f32x4* sp = (const f32x4*)(F_SSQA + (row0 + tid) * 16); const f32x4 p0 = sp[0], p1 = sp[1], p2 = sp[2], p3 = sp[3];
            const float s = ((p0.x + p0.y) + (p0.z + p0.w)) + ((p1.x + p1.y) + (p1.z + p1.w)) + ((p2.x + p2.y) + (p2.z + p2.w)) + ((p3.x + p3.y) + (p3.z + p3.w));
            rsl[tid] = rsqrtf(s * (1.0f / 1024.0f) + EPS); }
        f32x4 acc0 = (f32x4){0.f, 0.f, 0.f, 0.f}, acc1 = (f32x4){0.f, 0.f, 0.f, 0.f};
#pragma unroll
        for (int ks = 0; ks < 16; ks += 2) { acc0 = mma16(a[ks], b[ks], acc0); acc1 = mma16(a[ks + 1], b[ks + 1], acc1); }
#pragma unroll
        for (int r = 0; r < 4; ++r) part[(kh * 64 + 16 * rt + 4 * g + r) * 16 + i16] = acc0[r] + acc1[r];
    }
    LDS_BARRIER();
    for (int e = tid; e < 64 * 16; e += 512) {
        const int t = e >> 4, q = e & 15;
        float* p = F_SCAL + (row0 + t) * 16 + q;
        const float v = (part[e] + part[1024 + e]) * rsl[t]; float r;
        if (q < 4) r = -__expf(INP(I_GALOG)[l * 4 + q]) * softplusf_(v + INP(I_GDTB)[l * 4 + q]);
        else if (q < 8) r = sigmoidf_(v);
        else r = softplusf_(v + INP(I_SDTB)[l * 8 + (q - 8)]);
        *p = r; scl[e] = r;
    }
    LDS_BARRIER();
    {
        const int w = F.wave, lane = F.lane;
        float v = scl[lane * 16 + 8 + w] * (-__expf(INP(I_SALOG)[l * 8 + w]));
#pragma unroll
        for (int o = 1; o < 64; o <<= 1) { const float tt = __shfl_up(v, o); if (lane >= o) v += tt; }
        F_ACUM[(row0 + lane) * 8 + w] = v;
        if (w < 4) {
            float gv = scl[lane * 16 + w];
#pragma unroll
            for (int o = 1; o < 64; o <<= 1) { const float tt = __shfl_up(gv, o); if (lane >= o) gv += tt; }
            F_GCUM[(row0 + lane) * 4 + w] = gv; gcl[w * 64 + lane] = gv;
        }
    }
    {
        const int cg = tid % 224, rh = tid / 224;
        const bool active = tid < 448;
        const int col = 1024 + cg * 8, t0 = 32 * rh;
        const bool gdn = cg < 96;
        const int cc = gdn ? (col - PC_GQ) : (col - PC_SX);
        const int C = gdn ? 768 : 1024;
        const int kind = gdn ? (cg >> 5) : 3;
        float w[4][8], bias[8], p3[8], p2[8], p1[8];
        u32x4 xr[16];
        if (active) {
            const float* cw = gdn ? INP(I_GCONVW) + (size_t)l * 4 * 768 : INP(I_SCONVW) + (size_t)l * 4 * 1024;
#pragma unroll
            for (int j = 0; j < 4; ++j)
#pragma unroll
                for (int i = 0; i < 8; ++i) w[j][i] = cw[j * C + cc + i];
#pragma unroll
            for (int i = 0; i < 8; ++i) bias[i] = gdn ? 0.f : INP(I_SCONVB)[l * 1024 + cc + i];
            if (rh == 1) {
                unpack8(*(const u32x4*)(proj + (row0 + t0 - 3) * PW + col), p3); unpack8(*(const u32x4*)(proj + (row0 + t0 - 2) * PW + col), p2); unpack8(*(const u32x4*)(proj + (row0 + t0 - 1) * PW + col), p1);
            } else if (prompt) {
                if (c == 0) {
#pragma unroll
                    for (int i = 0; i < 8; ++i) { p3[i] = 0.f; p2[i] = 0.f; p1[i] = 0.f; }
                } else {
                    const bf16_t* hp = F_HCONV + (size_t)(c - 1) * 3 * 1792 + (col - 1024);
                    unpack8(*(const u32x4*)(hp), p3); unpack8(*(const u32x4*)(hp + 1792), p2); unpack8(*(const u32x4*)(hp + 2 * 1792), p1);
                }
            } else {
                const float* st = gdn ? INP(I_SGDNC) + ((size_t)l * 32 + b) * 3 * 768 + cc : INP(I_SSSMC) + ((size_t)l * 32 + b) * 3 * 1024 + cc;
#pragma unroll
                for (int i = 0; i < 8; ++i) { p3[i] = st[i]; p2[i] = st[C + i]; p1[i] = st[2 * C + i]; }
            }
#pragma unroll
            for (int t = 0; t < 16; ++t) xr[t] = *(const u32x4*)(proj + (row0 + t0 + t) * PW + col);
        }
        asm volatile("s_waitcnt vmcnt(0)" ::: "memory");
        LDS_BARRIER();
#pragma unroll
        for (int bt = 0; bt < 2; ++bt) {
            if (active) {
#pragma unroll
                for (int t = 0; t < 16; ++t) {
                    const int tr = t0 + 16 * bt + t;
                    bf16_t* p = proj + (row0 + tr) * PW + col;
                    float x[8], y[8];
                    unpack8(xr[t], x);
#pragma unroll
                    for (int i = 0; i < 8; ++i) { float a = w[0][i] * p3[i] + w[1][i] * p2[i] + w[2][i] * p1[i] + w[3][i] * x[i] + bias[i]; y[i] = siluf_(a); p3[i] = p2[i]; p2[i] = p1[i]; p1[i] = x[i]; }
                    if (kind < 2) {
                        float ss = 0.f;
#pragma unroll
                        for (int i = 0; i < 8; ++i) ss += y[i] * y[i];
                        ss += __shfl_xor(ss, 1); ss += __shfl_xor(ss, 2); ss += __shfl_xor(ss, 4);
                        const float sc = rsqrtf(ss + EPS) * (kind == 0 ? 0.125f : 1.f);
#pragma unroll
                        for (int i = 0; i < 8; ++i) y[i] *= sc;
                    }
                    const u32x4 pk = pack8(y);
                    if (kind != 2) *(u32x4*)p = pk;
                    if (kind == 1) *(LAS u32x4*)(Kt + tr * ACT_LDK + (col - PC_GK)) = pk;
                    if (kind == 2) *(LAS u32x4*)(Vt + tr * ACT_LDK + (col - PC_GV)) = pk;
                }
                if (bt == 0) {
#pragma unroll
                    for (int t = 0; t < 16; ++t) xr[t] = *(const u32x4*)(proj + (row0 + t0 + 16 + t) * PW + col);
                }
            }
        }
    }
    LDS_BARRIER();
    {
        const int w = F.wave, lane = F.lane, i16 = lane & 15, g = lane >> 4, h = w >> 1, e = w & 1;
        LAS float* Lh = Lm + h * 64 * ACT_LDL;
#pragma unroll
        for (int ii = 0; ii < 2; ++ii) {
            const int it = e + 2 * ii;
#pragma unroll
            for (int jt = 0; jt < 4; ++jt) {
                if (jt <= it) {
                    f32x4 acc = (f32x4){0.f, 0.f, 0.f, 0.f};
#pragma unroll
                    for (int ks = 0; ks < 2; ++ks) acc = mma16(frag_nat(Kt, ACT_LDK, 16 * it, h * 64 + 32 * ks, i16, g), frag_nat(Kt, ACT_LDK, 16 * jt, h * 64 + 32 * ks, i16, g), acc);
                    const int j = 16 * jt + i16; const float gcj = gcl[h * 64 + j];
#pragma unroll
                    for (int r = 0; r < 4; ++r) { const int i = 16 * it + 4 * g + r;
                        const float f = (j < i) ? scl[i * 16 + 4 + h] * __expf(fminf(gcl[h * 64 + i] - gcj, 0.f)) : 0.f;
                        Lh[i * ACT_LDL + j] = acc[r] * f; }
                }
            }
        }
        LDS_BARRIER();
        float x[64];
        const LAS bf16_t* Rt = opaque_lds((e == 0 ? Vt : Kt) + h * 64 + lane); const float ef = (float)e;
        const LAS float* Lo = opaque_lds(Lh); const LAS float* sclo = opaque_lds(scl + 4 + h); const LAS float* gclo = opaque_lds(gcl + h * 64);
        tri_solve64<ACT_LDL, -1>(Lo, x, [&](int i) { return sclo[i * 16] * __expf(gclo[i] * ef) * bf2f(Rt[i * ACT_LDK]); });
        if (e == 0) {
            bf16_t* o = proj + (row0 + lane) * PW + PC_GV + h * 64;
#pragma unroll
            for (int q = 0; q < 8; ++q) { float y[8];
#pragma unroll
                for (int i = 0; i < 8; ++i) y[i] = x[8 * q + i];
                *(u32x4*)(o + 8 * q) = pack8(y); }
        } else {
            bf16_t* o = F_GW + (((size_t)c * 4 + h) * 64) * 64 + lane;
#pragma unroll
            for (int i = 0; i < 64; ++i) o[i * 64] = f2bf(-x[i]);
        }
    }
    publish_item((unsigned*)(F.ws + WS_CTL) + CW_AFLAG + c);
    LDS_BARRIER();
}

__device__ __forceinline__ void st8_wt(void* p, u32x2 v) { __hip_atomic_store((unsigned long long*)p, __builtin_bit_cast(unsigned long long, v), __ATOMIC_RELAXED, __HIP_MEMORY_SCOPE_AGENT); }
__device__ __forceinline__ void st16_wt(void* p, u32x4 v) { asm volatile("global_store_dwordx4 %0, %1, off sc1\n\ts_nop 2" :: "v"(p), "v"(v) : "memory"); }
constexpr int OUT_OFF = 90112, OUT_LD = 72, OUT_TILE = 32 * OUT_LD * 2, OUT_BUF = 2 * OUT_TILE;
__device__ __forceinline__ u32x4 ld16_asm(const void* p) { u32x4 r; asm volatile("global_load_dwordx4 %0, %1, off sc1" : "=v"(r) : "v"(p)); return r; }
__device__ __forceinline__ float ld4_asm(const float* p) { float r; asm volatile("global_load_dword %0, %1, off sc1" : "=v"(r) : "v"(p)); return r; }
constexpr int RDY_SLACK = 8;
#define RDY_WORD(F) ((volatile LAS int*)((F).lds + MISC_OFF + 64))
__device__ __forceinline__ int rdy_advance(const unsigned* rdy, int rstride, unsigned rneed, int nxt, int nch, int lane) {
    const int k = nxt + (lane & 15);
    const bool ok = k < nch && (int)(__hip_atomic_load(rdy + (size_t)rstride * k, __ATOMIC_RELAXED, __HIP_MEMORY_SCOPE_AGENT) - rneed) >= 0;
    const unsigned long long m = __ballot(ok) & 0xffffull;
    return nxt + __builtin_ctzll(~m);
}
__device__ __forceinline__ int rdy_block(Frame& F, const unsigned* rdy, int rstride, unsigned rneed, int nxt, int upto, int nch) {
    unsigned sp = 0;
    while (nxt < upto && ++sp < 4000000u) { const int n2 = rdy_advance(rdy, rstride, rneed, nxt, nch, F.lane); if (n2 == nxt) __builtin_amdgcn_s_sleep(8); nxt = n2; }
    if (F.lane == 0) *RDY_WORD(F) = nxt - 1;
    return nxt;
}
#define RDY_LOADER_WAIT(F, k) do { const int kk_ = (k) < nch ? (k) : nch - 1; unsigned sp_ = 0; while (*RDY_WORD(F) < kk_ && ++sp_ < 40000000u) __builtin_amdgcn_s_sleep(1); } while (0)
#define SCAN_CL(k) (c0 + ((k) < nch ? (k) : nch - 1))
#define SCAN_LOADER6(LOADM, WRITEM, WAITM, NLD) do {            \
        RDY_LOADER_WAIT(F, 0); LOADM(SCAN_CL(0), 0); WAITM(0, 0); WRITEM(0, 0); \
        RDY_LOADER_WAIT(F, 1); LOADM(SCAN_CL(1), 1); RDY_LOADER_WAIT(F, 2); LOADM(SCAN_CL(2), 2); RDY_LOADER_WAIT(F, 3); LOADM(SCAN_CL(3), 3); RDY_LOADER_WAIT(F, 4); LOADM(SCAN_CL(4), 4); RDY_LOADER_WAIT(F, 5); LOADM(SCAN_CL(5), 5); \
        LDS_BARRIER(); \
        for (int r_ = 0; r_ < nch; r_ += 6) { \
            RDY_LOADER_WAIT(F, r_ + 6); LOADM(SCAN_CL(r_ + 6), 0); WAITM(1, 5 * (NLD)); WRITEM(1, 1); LDS_BARRIER(); if (r_ + 1 >= nch) break; \
            RDY_LOADER_WAIT(F, r_ + 7); LOADM(SCAN_CL(r_ + 7), 1); WAITM(2, 5 * (NLD)); WRITEM(0, 2); LDS_BARRIER(); if (r_ + 2 >= nch) break; \
            RDY_LOADER_WAIT(F, r_ + 8); LOADM(SCAN_CL(r_ + 8), 2); WAITM(3, 5 * (NLD)); WRITEM(1, 3); LDS_BARRIER(); if (r_ + 3 >= nch) break; \
            RDY_LOADER_WAIT(F, r_ + 9); LOADM(SCAN_CL(r_ + 9), 3); WAITM(4, 5 * (NLD)); WRITEM(0, 4); LDS_BARRIER(); if (r_ + 4 >= nch) break; \
            RDY_LOADER_WAIT(F, r_ + 10); LOADM(SCAN_CL(r_ + 10), 4); WAITM(5, 5 * (NLD)); WRITEM(1, 5); LDS_BARRIER(); if (r_ + 5 >= nch) break; \
            RDY_LOADER_WAIT(F, r_ + 11); LOADM(SCAN_CL(r_ + 11), 5); WAITM(0, 5 * (NLD)); WRITEM(0, 0); LDS_BARRIER(); \
        } \
        asm volatile("s_waitcnt vmcnt(0)" ::: "memory"); \
        } while (0)
#define SCAN_LOADER(LOADM, WRITEM, WAITM, NLD) do { \
          \
          \
        RDY_LOADER_WAIT(F, 0); LOADM(SCAN_CL(0), 0); WAITM(0, 0); WRITEM(0, 0); \
        RDY_LOADER_WAIT(F, 1); LOADM(SCAN_CL(1), 1); RDY_LOADER_WAIT(F, 2); LOADM(SCAN_CL(2), 2); RDY_LOADER_WAIT(F, 3); LOADM(SCAN_CL(3), 3); \
        LDS_BARRIER(); \
          \
        for (int r_ = 0; r_ < nch; r_ += 4) { \
            RDY_LOADER_WAIT(F, r_ + 4); LOADM(SCAN_CL(r_ + 4), 0); WAITM(1, 3 * (NLD)); WRITEM(1, 1); LDS_BARRIER(); if (r_ + 1 >= nch) break; \
            RDY_LOADER_WAIT(F, r_ + 5); LOADM(SCAN_CL(r_ + 5), 1); WAITM(2, 3 * (NLD)); WRITEM(0, 2); LDS_BARRIER(); if (r_ + 2 >= nch) break; \
            RDY_LOADER_WAIT(F, r_ + 6); LOADM(SCAN_CL(r_ + 6), 2); WAITM(3, 3 * (NLD)); WRITEM(1, 3); LDS_BARRIER(); if (r_ + 3 >= nch) break; \
            RDY_LOADER_WAIT(F, r_ + 7); LOADM(SCAN_CL(r_ + 7), 3); WAITM(0, 3 * (NLD)); WRITEM(0, 0); LDS_BARRIER(); \
        } \
        asm volatile("s_waitcnt vmcnt(0)" ::: "memory");      \
        } while (0)

constexpr int GDN_LD = 72;
constexpr int GDN_BUF = 3 * 64 * GDN_LD * 2 + 64;
__device__ __forceinline__ void scan_gdn2(Frame& F, int l, int s, int h, int vb, int ncw, unsigned* prog, unsigned pbase, unsigned* done, int pm, const unsigned* rdy, int rstride, unsigned rneed) {
    PHASE_IDS(F);
    const int tid = F.tid, lane = F.lane, w = F.wave, i16 = lane & 15, g = lane >> 4;
    const int nch = (s == 0) ? 256 : 1, c0 = (s == 0) ? 0 : 255 + s, b = s - 1;
    bf16_t* const proj = F_PROJ; bf16_t* const gw = F_GW; const float* const gcum = F_GCUM;
    {
        if (w == (ncw < 4 ? ncw : 0)) (void)rdy_block(F, rdy, rstride, rneed, 0, nch < RDY_SLACK ? nch : RDY_SLACK, nch);
        LDS_BARRIER();
    }
    if (w >= 4) {
        const int lt = tid - 256;
        const int umask = 128 * ncw - 1;
        u32x4 rw0[2], ru0[2], rk0[2], rw1[2], ru1[2], rk1[2], rw2[2], ru2[2], rk2[2], rw3[2], ru3[2], rk3[2], rw4[2], ru4[2], rk4[2], rw5[2], ru5[2], rk5[2]; float gc0[2], gl0, gc1[2], gl1, gc2[2], gl2, gc3[2], gl3, gc4[2], gl4, gc5[2], gl5;
        const bf16_t* pW[2]; const bf16_t* pU[2]; const bf16_t* pK[2]; const float* pG[2]; const float* const pGl = gcum + 63 * 4 + h;
#pragma unroll
        for (int q = 0; q < 2; ++q) { const int idx = q * 256 + lt, row = idx >> 3, col8 = (idx & 7) * 8, urow = vb + ((idx & umask) >> 3);
            pW[q] = gw + ((size_t)h * 64 + row) * 64 + col8; pU[q] = proj + (size_t)urow * PW + PC_GV + h * 64 + col8; pK[q] = proj + (size_t)row * PW + PC_GK + h * 64 + col8; pG[q] = gcum + row * 4 + h; }
        const bool dupU = ncw < 4;
        if (dupU) pU[1] = proj + PC_GV;
#define GDN_LOAD(ch, S) do { const size_t oW_ = (size_t)(ch) * (4 * 4096), oP_ = (size_t)(ch) * (64 * PW), oG_ = (size_t)(ch) * 256; gl##S = ld4_asm(pGl + oG_); \
        _Pragma("unroll") for (int q = 0; q < 2; ++q) { rw##S[q] = ld16_asm(pW[q] + oW_); ru##S[q] = ld16_asm(pU[q] + oP_); rk##S[q] = ld16_asm(pK[q] + oP_); gc##S[q] = ld4_asm(pG[q] + oG_); } } while (0)
#define GDN_WAIT(S, N) asm volatile("s_waitcnt vmcnt(%9)" : "+v"(rw##S[0]), "+v"(rw##S[1]), "+v"(ru##S[0]), "+v"(ru##S[1]), "+v"(rk##S[0]), "+v"(rk##S[1]), "+v"(gc##S[0]), "+v"(gc##S[1]), "+v"(gl##S) : "n"(N))
#define GDN_WRITE(bb, S) do { LAS bf16_t* Wn_ = (LAS bf16_t*)(F.lds + (bb) * GDN_BUF); LAS bf16_t* Ut_ = Wn_ + 64 * GDN_LD; LAS bf16_t* Kd_ = Ut_ + 64 * GDN_LD; \
        _Pragma("unroll") for (int q = 0; q < 2; ++q) { const int idx = q * 256 + lt, row = idx >> 3, col8 = (idx & 7) * 8; \
            *(LAS u32x4*)(Wn_ + row * GDN_LD + col8) = rw##S[q]; if (q == 0 || !dupU) *(LAS u32x4*)(Ut_ + (vb + ((idx & umask) >> 3)) * GDN_LD + col8) = ru##S[q]; \
            const float ks_ = __expf(gl##S - gc##S[q]); \
            float v_[8]; unpack8(rk##S[q], v_); _Pragma("unroll") for (int i = 0; i < 8; ++i) v_[i] *= ks_; *(LAS u32x4*)(Kd_ + row * GDN_LD + col8) = pack8(v_); } \
        if (lt == 0) *(LAS float*)(Kd_ + 64 * GDN_LD) = __expf(gl##S); } while (0)
        SCAN_LOADER6(GDN_LOAD, GDN_WRITE, GDN_WAIT, 9);
#undef GDN_LOAD
#undef GDN_WRITE
#undef GDN_WAIT
    } else if (w >= ncw) {
        int nxt = nch < RDY_SLACK ? nch : RDY_SLACK;
        LDS_BARRIER();
#define GDN_STORE_OUT(cc) do { const int ch_ = c0 + (cc); const LAS bf16_t* Os_ = (const LAS bf16_t*)(F.lds + OUT_OFF + ((cc) & 1) * OUT_BUF); \
            bf16_t* hb_ = ((bf16_t*)((unsigned char*)F.out + (size_t)T * 256 * 2 * 4) + (size_t)ch_ * 16384) + ((size_t)h * 64 + vb) * 64; bf16_t* vb_ = proj + ((size_t)ch_ * 64 + vb) * PW + PC_GV + h * 64; \
            _Pragma("unroll") for (int it_ = 0; it_ < 4; ++it_) { const int idx_ = it_ * 64 + lane, row_ = idx_ >> 3, c8_ = (idx_ & 7) * 8; \
                const u32x4 hv_ = *(const LAS u32x4*)(Os_ + row_ * OUT_LD + c8_), vv_ = *(const LAS u32x4*)(Os_ + 32 * OUT_LD + row_ * OUT_LD + c8_); \
                st16_wt(hb_ + row_ * 64 + c8_, hv_); st16_wt(vb_ + (size_t)row_ * PW + c8_, vv_); } } while (0)
        const bool storer = prog != nullptr && w == ncw + 1;
        for (int ci = 0; ci < nch; ++ci) {
            if (w == ncw && nxt < nch) { const int upto = ci + 1 + RDY_SLACK < nch ? ci + 1 + RDY_SLACK : nch; nxt = rdy_block(F, rdy, rstride, rneed, nxt, upto, nch); }
            if (storer) {
                if (ci > 0) GDN_STORE_OUT(ci - 1);
                asm volatile("s_waitcnt vmcnt(48)" ::: "memory");
                if (lane < ncw && ci >= 7) __hip_atomic_store(prog + 64 * lane, pbase + (unsigned)(ci - 7) + 1u, __ATOMIC_RELAXED, __HIP_MEMORY_SCOPE_AGENT);
            }
            LDS_BARRIER();
        }
        if (storer) {
            GDN_STORE_OUT(nch - 1);
            asm volatile("s_waitcnt vmcnt(0)" ::: "memory");
            if (lane < ncw) __hip_atomic_store(prog + 64 * lane, pbase + (unsigned)nch, __ATOMIC_RELAXED, __HIP_MEMORY_SCOPE_AGENT);
        }
#undef GDN_STORE_OUT
    } else {
        const int n0 = vb + 16 * w;
        f32x4 S[4];
        if (s == 0) {
#pragma unroll
            for (int kt = 0; kt < 4; ++kt) S[kt] = (f32x4){0.f, 0.f, 0.f, 0.f};
        } else {
            const float* st = INP(I_SGDN) + (((size_t)l * 32 + b) * 4 + h) * 4096 + n0 + i16;
#pragma unroll
            for (int kt = 0; kt < 4; ++kt)
#pragma unroll
                for (int r = 0; r < 4; ++r) S[kt][r] = st[(16 * kt + 4 * g + r) * 64];
        }
        LDS_BARRIER();
        for (int ci = 0; ci < nch; ++ci) {
            const int chunk = c0 + ci; const size_t row0 = (size_t)chunk * 64;
            const LAS bf16_t* Wn = (const LAS bf16_t*)(F.lds + (ci & 1) * GDN_BUF); const LAS bf16_t* Ut = Wn + 64 * GDN_LD; const LAS bf16_t* Kd = Ut + 64 * GDN_LD;
            const float bd = *(const LAS float*)(Kd + 64 * GDN_LD);
            bf16x8 A1[4][2], A2[4][2]; u32x2 ui[4];
#pragma unroll
            for (int m = 0; m < 4; ++m) { ui[m] = *(const LAS u32x2*)(Ut + (n0 + i16) * GDN_LD + 16 * m + 4 * g);
#pragma unroll
                for (int ks = 0; ks < 2; ++ks) A1[m][ks] = frag_sig(Wn, GDN_LD, 16 * m, 32 * ks, i16, g); }
#pragma unroll
            for (int kt = 0; kt < 4; ++kt)
#pragma unroll
                for (int cs = 0; cs < 2; ++cs) A2[kt][cs] = frag_tr_sig(Kd, GDN_LD, 32 * cs, 16 * kt, i16, g);
            __builtin_amdgcn_sched_barrier(0);
            bf16x8 Sb[2];
#pragma unroll
            for (int ks = 0; ks < 2; ++ks) Sb[ks] = acc_frag(S[2 * ks], S[2 * ks + 1]);
            LAS bf16_t* const Os = (LAS bf16_t*)(F.lds + OUT_OFF + (ci & 1) * OUT_BUF) + (16 * w + i16) * OUT_LD + 4 * g;
            if (prog) {
#pragma unroll
                for (int kt = 0; kt < 4; ++kt) *(LAS u32x2*)(Os + 16 * kt) = pack4(S[kt]);
            } else {
                bf16_t* ho = ((bf16_t*)((unsigned char*)F.out + (size_t)T * 256 * 2 * 4) + (size_t)(chunk) * 16384) + ((size_t)h * 64 + n0 + i16) * 64 + 4 * g;
#pragma unroll
                for (int kt = 0; kt < 4; ++kt) st8_wt(ho + 16 * kt, pack4(S[kt]));
            }
            f32x4 V[4];
            bf16_t* vo = proj + (row0 + n0 + i16) * PW + PC_GV + h * 64 + 4 * g;
#pragma unroll
            for (int m = 0; m < 4; ++m) {
                f32x4 acc = unpack4(ui[m]);
#pragma unroll
                for (int ks = 0; ks < 2; ++ks) acc = mma16(A1[m][ks], Sb[ks], acc);
                V[m] = acc;
            }
            if (prog) {
#pragma unroll
                for (int m = 0; m < 4; ++m) *(LAS u32x2*)(Os + 32 * OUT_LD + 16 * m) = pack4(V[m]);
            } else {
#pragma unroll
                for (int m = 0; m < 4; ++m) st8_wt(vo + 16 * m, pack4(V[m]));
            }
            bf16x8 Ub[2];
#pragma unroll
            for (int cs = 0; cs < 2; ++cs) Ub[cs] = acc_frag(V[2 * cs], V[2 * cs + 1]);
#pragma unroll
            for (int kt = 0; kt < 4; ++kt) {
                f32x4 acc = S[kt] * bd;
#pragma unroll
                for (int cs = 0; cs < 2; ++cs) acc = mma16(A2[kt][cs], Ub[cs], acc);
                S[kt] = acc;
            }
            LDS_BARRIER();
        }
        asm volatile("s_waitcnt vmcnt(0)" ::: "memory");
        if (done && lane == 0) __hip_atomic_fetch_add(done, 1u, __ATOMIC_RELAXED, __HIP_MEMORY_SCOPE_AGENT);
        float* o = F.out + (s == 0 ? O_P_GDN + ((size_t)l * 4 + h) * 4096 : O_S_GDN + (((size_t)l * 32 + b) * 4 + h) * 4096) + n0 + i16;
#pragma unroll
        for (int kt = 0; kt < 4; ++kt)
#pragma unroll
            for (int r = 0; r < 4; ++r) o[(16 * kt + 4 * g + r) * 64] = S[kt][r];
    }
}
__device__ __forceinline__ void post_gdn(Frame& F, int l, int c, int hp) {
    PHASE_IDS(F);
    const int tid = F.tid, lane = F.lane, w = F.wave, i16 = lane & 15, g = lane >> 4;
    const size_t row0 = (size_t)c * 64;
    bf16_t* const proj = F_PROJ;
    constexpr int LQ = 136;
    LAS bf16_t* Qt = (LAS bf16_t*)F.lds; LAS bf16_t* Kt = Qt + 64 * LQ; LAS bf16_t* Ht = Kt + 64 * LQ; LAS bf16_t* Vn = Ht + 2 * 64 * GDN_LD; LAS float* gcs = (LAS float*)(Vn + 2 * 64 * GDN_LD);
    {
#pragma unroll
        for (int q = 0; q < 2; ++q) { const int idx = q * 512 + tid;
            { const int row = idx >> 4, col8 = (idx & 15) * 8;
              *(LAS u32x4*)(Qt + row * LQ + col8) = *(const u32x4*)(proj + (row0 + row) * PW + PC_GQ + hp * 128 + col8);
              *(LAS u32x4*)(Kt + row * LQ + col8) = *(const u32x4*)(proj + (row0 + row) * PW + PC_GK + hp * 128 + col8); }
            { const int hh = idx >> 9, row = (idx >> 3) & 63, col8 = (idx & 7) * 8;
              *(LAS u32x4*)(Ht + hh * 64 * GDN_LD + row * GDN_LD + col8) = *(const u32x4*)(((bf16_t*)((unsigned char*)F.out + (size_t)T * 256 * 2 * 4) + (size_t)(c) * 16384) + (((size_t)(2 * hp + hh) * 64) + row) * 64 + col8);
              *(LAS u32x4*)(Vn + hh * 64 * GDN_LD + row * GDN_LD + col8) = *(const u32x4*)(proj + (row0 + row) * PW + PC_GV + (2 * hp + hh) * 64 + col8); } }
        if (tid < 128) gcs[tid] = F_GCUM[(row0 + (tid & 63)) * 4 + 2 * hp + (tid >> 6)];
    }
    LDS_BARRIER();
    const int hh = w >> 2, it = w & 3, head = 2 * hp + hh;
    const LAS bf16_t* Hh = Ht + hh * 64 * GDN_LD; const LAS bf16_t* Vh = Vn + hh * 64 * GDN_LD;
    f32x4 AT[4];
    const float gci = gcs[hh * 64 + 16 * it + i16];
#pragma unroll
    for (int jt = 0; jt < 4; ++jt) {
        f32x4 acc = (f32x4){0.f, 0.f, 0.f, 0.f};
        if (jt <= it) {
#pragma unroll
            for (int ks = 0; ks < 2; ++ks) acc = mma16(frag_nat(Kt, LQ, 16 * jt, hh * 64 + 32 * ks, i16, g), frag_nat(Qt, LQ, 16 * it, hh * 64 + 32 * ks, i16, g), acc);
#pragma unroll
            for (int r = 0; r < 4; ++r) { const int j = 16 * jt + 4 * g + r, i = 16 * it + i16; acc[r] *= (j <= i) ? __expf(fminf(gci - gcs[hh * 64 + j], 0.f)) : 0.f; }
        }
        AT[jt] = acc;
    }
    f32x4 O[4]; float ss[4] = {0.f, 0.f, 0.f, 0.f};
#pragma unroll
    for (int vt = 0; vt < 4; ++vt) {
        f32x4 acc = (f32x4){0.f, 0.f, 0.f, 0.f};
#pragma unroll
        for (int ks = 0; ks < 2; ++ks) acc = mma16(frag_nat(Qt, LQ, 16 * it, hh * 64 + 32 * ks, i16, g), frag_nat(Hh, GDN_LD, 16 * vt, 32 * ks, i16, g), acc);
#pragma unroll
        for (int r = 0; r < 4; ++r) acc[r] *= __expf(gcs[hh * 64 + 16 * it + 4 * g + r]);
#pragma unroll
        for (int cs = 0; cs < 2; ++cs) if (2 * cs <= it) acc = mma16(acc_frag(AT[2 * cs], AT[2 * cs + 1]), frag_sig(Vh, GDN_LD, 16 * vt, 32 * cs, i16, g), acc);
        O[vt] = acc;
#pragma unroll
        for (int r = 0; r < 4; ++r) ss[r] += acc[r] * acc[r];
    }
#pragma unroll
    for (int r = 0; r < 4; ++r) { float t = ss[r]; t += __shfl_xor(t, 1); t += __shfl_xor(t, 2); t += __shfl_xor(t, 4); t += __shfl_xor(t, 8); ss[r] = rsqrtf(t * (1.f / 64.f) + EPS); }
#pragma unroll
    for (int vt = 0; vt < 4; ++vt) { const int v = 16 * vt + i16; const float nw = INP(I_GNORMW)[l * 64 + v];
#pragma unroll
        for (int r = 0; r < 4; ++r) { bf16_t* p = proj + (row0 + 16 * it + 4 * g + r) * PW + PC_ZG + head * 64 + v; *p = f2bf(O[vt][r] * ss[r] * nw * siluf_(bf2f(*p))); } }
    LDS_BARRIER();
}

constexpr int RW_LD = 72;
constexpr int RW_XD = 0, RW_XA = 9216, RW_WD = 18432, RW_WA = 27648, RW_RT = 36864, RW_KX = 46080, RW_VT = 55296, RW_XG = 64512, RW_WG = 81920, RW_EX = 100352;
constexpr int RW_L = 64512, RW_P = 81920;
struct RwkvTok { float cum[2][4], lw[2][4], iclr[2][4], kk[2][4], kp[2][4], kraw[2][4], c63[2], w0[2], a0[2], kkw[2], kaw[2]; };
template <bool POST>
__device__ __forceinline__ void rwkv_tokens(Frame& F, int l, int c, int h, RwkvTok& o, f32x4 (&Zg)[2]) {
    const int tid = F.tid, lane = F.lane, w = F.wave, i16 = lane & 15, g = lane >> 4, tt = w & 3, jh = w >> 2;
    const size_t row0 = (size_t)c * 64;
    bf16_t* const proj = F_PROJ;
    LAS bf16_t* Xd = (LAS bf16_t*)(F.lds + RW_XD); LAS bf16_t* Xa = (LAS bf16_t*)(F.lds + RW_XA); LAS bf16_t* Wd = (LAS bf16_t*)(F.lds + RW_WD); LAS bf16_t* Wa = (LAS bf16_t*)(F.lds + RW_WA);
    LAS bf16_t* Rt = (LAS bf16_t*)(F.lds + RW_RT); LAS bf16_t* Kx = (LAS bf16_t*)(F.lds + RW_KX); LAS bf16_t* Vt = (LAS bf16_t*)(F.lds + RW_VT);
    LAS bf16_t* Xg = (LAS bf16_t*)(F.lds + RW_XG); LAS bf16_t* Wg = (LAS bf16_t*)(F.lds + RW_WG);
    LAS float* ksq = (LAS float*)(F.lds + RW_EX); LAS float* ctot = ksq + 128;
    const int lt0 = (tid >> 5) * 4, lo8 = (tid & 31) * 8;
    const int wi = tid >> 3, wj8 = (tid & 7) * 8;
    const int rt = tid >> 3, rd8 = (tid & 7) * 8;
    u32x4 lx[4], lprev_b = (u32x4){0u, 0u, 0u, 0u}; f32x4 lprev_f[2], lmu[2];
    f32x4 wdv[2], wav[2], wgv[4];
    u32x4 rx[3], rpv_b[3]; f32x4 rpv_f[3][2], rmu[3][2];
    const bool smp = c >= 256;
    {
        const float* mup = INP(I_RMU) + l * 1024;
        const float* stp = INP(I_SSHIFT) + ((size_t)l * 32 + (smp ? c - 256 : 0)) * 1024;
        const int col = PC_RL + lo8;
        lmu[0] = *(const f32x4*)(mup + 768 + lo8); lmu[1] = *(const f32x4*)(mup + 768 + lo8 + 4);
        if (lt0 > 0) lprev_b = *(const u32x4*)(proj + (row0 + lt0 - 1) * PW + col);
        else if (!smp) { if (c > 0) lprev_b = *(const u32x4*)(F_HSHIFT + (size_t)(c - 1) * 1024 + 768 + lo8); }
        else { lprev_f[0] = *(const f32x4*)(stp + 768 + lo8); lprev_f[1] = *(const f32x4*)(stp + 768 + lo8 + 4); }
#pragma unroll
        for (int q = 0; q < 4; ++q) lx[q] = *(const u32x4*)(proj + (row0 + lt0 + q) * PW + col);
        { const float* p = INP(I_RWUP) + ((size_t)l * 64 + wi) * 256 + h * 64 + wj8; wdv[0] = *(const f32x4*)p; wdv[1] = *(const f32x4*)(p + 4); }
        { const float* p = INP(I_RAUP) + ((size_t)l * 64 + wi) * 256 + h * 64 + wj8; wav[0] = *(const f32x4*)p; wav[1] = *(const f32x4*)(p + 4); }
        if (POST) {
#pragma unroll
            for (int q2 = 0; q2 < 2; ++q2) { const float* p = INP(I_RGUP) + ((size_t)l * 128 + wi + 64 * q2) * 256 + h * 64 + wj8; wgv[2 * q2] = *(const f32x4*)p; wgv[2 * q2 + 1] = *(const f32x4*)(p + 4); }
        }
#pragma unroll
        for (int which = 0; which < 3; ++which) {
            const int pcol = (which == 0 ? PC_R : (which == 1 ? PC_RK : PC_RV)) + h * 64 + rd8, oc = which * 256 + h * 64 + rd8;
            const bf16_t* p = proj + (row0 + rt) * PW + pcol;
            rx[which] = *(const u32x4*)p;
            if (!POST) {
                rmu[which][0] = *(const f32x4*)(mup + oc); rmu[which][1] = *(const f32x4*)(mup + oc + 4);
                rpv_b[which] = (u32x4){0u, 0u, 0u, 0u};
                if (rt > 0) rpv_b[which] = *(const u32x4*)(p - PW);
                else if (!smp) { if (c > 0) rpv_b[which] = *(const u32x4*)(F_HSHIFT + (size_t)(c - 1) * 1024 + oc); }
                else { rpv_f[which][0] = *(const f32x4*)(stp + oc); rpv_f[which][1] = *(const f32x4*)(stp + oc + 4); }
            }
        }
#pragma unroll
        for (int q = 0; q < 2; ++q) { const int jc = l * 256 + h * 64 + 16 * (2 * jh + q) + i16;
            o.w0[q] = INP(I_RW0)[jc]; o.a0[q] = INP(I_RA0)[jc]; o.kkw[q] = INP(I_RKK)[jc]; o.kaw[q] = INP(I_RKA)[jc]; }
    }
    {
        float prev[8], mu[8] = {lmu[0][0], lmu[0][1], lmu[0][2], lmu[0][3], lmu[1][0], lmu[1][1], lmu[1][2], lmu[1][3]};
        if (lt0 == 0 && smp) { prev[0] = lprev_f[0][0]; prev[1] = lprev_f[0][1]; prev[2] = lprev_f[0][2]; prev[3] = lprev_f[0][3]; prev[4] = lprev_f[1][0]; prev[5] = lprev_f[1][1]; prev[6] = lprev_f[1][2]; prev[7] = lprev_f[1][3]; }
        else unpack8(lprev_b, prev);
#pragma unroll
        for (int q = 0; q < 4; ++q) {
            float x[8], y[8]; unpack8(lx[q], x);
#pragma unroll
            for (int i = 0; i < 8; ++i) { const float v = x[i] + (prev[i] - x[i]) * mu[i]; prev[i] = x[i]; y[i] = (lo8 < 64) ? tanhf_(v) : (lo8 >= 128 ? sigmoidf_(v) : v); }
            const u32x4 pk = pack8(y);
            if (lo8 < 64) *(LAS u32x4*)(Xd + (lt0 + q) * RW_LD + lo8) = pk;
            else if (lo8 < 128) *(LAS u32x4*)(Xa + (lt0 + q) * RW_LD + (lo8 - 64)) = pk;
            else if (POST) *(LAS u32x4*)(Xg + (lt0 + q) * 136 + (lo8 - 128)) = pk;
        }
        { const float v[8] = {wdv[0][0], wdv[0][1], wdv[0][2], wdv[0][3], wdv[1][0], wdv[1][1], wdv[1][2], wdv[1][3]}; *(LAS u32x4*)(Wd + wi * RW_LD + wj8) = pack8(v); }
        { const float v[8] = {wav[0][0], wav[0][1], wav[0][2], wav[0][3], wav[1][0], wav[1][1], wav[1][2], wav[1][3]}; *(LAS u32x4*)(Wa + wi * RW_LD + wj8) = pack8(v); }
        if (POST) {
#pragma unroll
            for (int q2 = 0; q2 < 2; ++q2) { const float v[8] = {wgv[2 * q2][0], wgv[2 * q2][1], wgv[2 * q2][2], wgv[2 * q2][3], wgv[2 * q2 + 1][0], wgv[2 * q2 + 1][1], wgv[2 * q2 + 1][2], wgv[2 * q2 + 1][3]};
                *(LAS u32x4*)(Wg + (wi + 64 * q2) * RW_LD + wj8) = pack8(v); }
        }
        u32x4 pk3[3];
#pragma unroll
        for (int which = 0; which < 3; ++which) {
            LAS bf16_t* dst = (which == 0 ? Rt : (which == 1 ? Kx : Vt)) + rt * RW_LD + rd8;
            if (POST) *(LAS u32x4*)dst = rx[which];
            else {
                float x[8], pv[8], y[8];
                unpack8(rx[which], x);
                if (rt == 0 && smp) { pv[0] = rpv_f[which][0][0]; pv[1] = rpv_f[which][0][1]; pv[2] = rpv_f[which][0][2]; pv[3] = rpv_f[which][0][3]; pv[4] = rpv_f[which][1][0]; pv[5] = rpv_f[which][1][1]; pv[6] = rpv_f[which][1][2]; pv[7] = rpv_f[which][1][3]; }
                else unpack8(rpv_b[which], pv);
#pragma unroll
                for (int i = 0; i < 8; ++i) y[i] = x[i] + (pv[i] - x[i]) * rmu[which][i >> 2][i & 3];
                pk3[which] = pack8(y);
                *(LAS u32x4*)dst = pk3[which];
            }
        }
        if (!POST) {
            LDS_BARRIER();
#pragma unroll
            for (int which = 0; which < 3; ++which) *(u32x4*)(proj + (row0 + rt) * PW + (which == 0 ? PC_R : (which == 1 ? PC_RK : PC_RV)) + h * 64 + rd8) = pk3[which];
        }
    }
    LDS_BARRIER();
    f32x4 Zd[2], Za[2];
#pragma unroll
    for (int q = 0; q < 2; ++q) {
        const int jt = 2 * jh + q;
        f32x4 a = (f32x4){0.f, 0.f, 0.f, 0.f}, bq = a, cq = a;
#pragma unroll
        for (int ks = 0; ks < 2; ++ks) {
            a = mma16(frag_nat(Xd, RW_LD, 16 * tt, 32 * ks, i16, g), frag_tr_nat(Wd, RW_LD, 32 * ks, 16 * jt, i16, g), a);
            bq = mma16(frag_nat(Xa, RW_LD, 16 * tt, 32 * ks, i16, g), frag_tr_nat(Wa, RW_LD, 32 * ks, 16 * jt, i16, g), bq);
        }
        if (POST) {
#pragma unroll
            for (int ks = 0; ks < 4; ++ks) cq = mma16(frag_nat(Xg, 136, 16 * tt, 32 * ks, i16, g), frag_tr_nat(Wg, RW_LD, 32 * ks, 16 * jt, i16, g), cq);
        }
        Zd[q] = a; Za[q] = bq; Zg[q] = cq;
    }
    float ksum[4] = {0.f, 0.f, 0.f, 0.f}, csum[2];
#pragma unroll
    for (int q = 0; q < 2; ++q) {
        const int j = 16 * (2 * jh + q) + i16, jc = l * 256 + h * 64 + j;
        const float w0 = o.w0[q], a0 = o.a0[q], kkw = o.kkw[q];
        float run = 0.f;
#pragma unroll
        for (int r = 0; r < 4; ++r) {
            const int t = 16 * tt + 4 * g + r;
            const float wl = -softplusf_(-(w0 + Zd[q][r])) - 0.5f;
            const float lw = -__expf(wl);
            o.lw[q][r] = lw; run += lw; o.cum[q][r] = run;
            o.iclr[q][r] = sigmoidf_(a0 + Za[q][r]);
            const float kr = bf2f(Kx[t * RW_LD + j]); o.kraw[q][r] = kr;
            const float kq = kr * kkw; o.kk[q][r] = kq; ksum[r] += kq * kq;
        }
        float tot = run;
        const float u1 = __shfl_up(tot, 16); if (g >= 1) tot += u1;
        const float u2 = __shfl_up(tot, 32); if (g >= 2) tot += u2;
        const float excl = tot - run;
#pragma unroll
        for (int r = 0; r < 4; ++r) o.cum[q][r] += excl;
        csum[q] = __shfl(tot, 48 + i16);
        if (g == 0) ctot[tt * 64 + j] = csum[q];
    }
#pragma unroll
    for (int r = 0; r < 4; ++r) { float s = ksum[r]; s += __shfl_xor(s, 1); s += __shfl_xor(s, 2); s += __shfl_xor(s, 4); s += __shfl_xor(s, 8); ksum[r] = s; }
    if (i16 == 0) {
#pragma unroll
        for (int r = 0; r < 4; ++r) ksq[jh * 64 + 16 * tt + 4 * g + r] = ksum[r];
    }
    LDS_BARRIER();
#pragma unroll
    for (int q = 0; q < 2; ++q) {
        const int j = 16 * (2 * jh + q) + i16, jc = l * 256 + h * 64 + j;
        const float kaw = o.kaw[q];
        float pre = 0.f, all = 0.f;
#pragma unroll
        for (int t4 = 0; t4 < 4; ++t4) { const float v = ctot[t4 * 64 + j]; all += v; if (t4 < tt) pre += v; }
        o.c63[q] = all;
#pragma unroll
        for (int r = 0; r < 4; ++r) {
            const int t = 16 * tt + 4 * g + r;
            o.cum[q][r] += pre;
            const float kn = rsqrtf(ksq[t] + ksq[64 + t] + EPS);
            o.kk[q][r] *= kn;
            o.kp[q][r] = o.kraw[q][r] * (1.f + (o.iclr[q][r] - 1.f) * kaw);
        }
    }
}
__device__ __forceinline__ void prep_rwkv(Frame& F, int l, int c, int h) {
    PHASE_IDS(F);
    const int lane = F.lane, w = F.wave, i16 = lane & 15, g = lane >> 4, tt = w & 3, jh = w >> 2;
    RwkvTok tk; f32x4 Zg[2];
    rwkv_tokens<false>(F, l, c, h, tk, Zg);
    LAS bf16_t* At = (LAS bf16_t*)(F.lds + RW_XD); LAS bf16_t* Bt = (LAS bf16_t*)(F.lds + RW_XA); LAS bf16_t* Kt = (LAS bf16_t*)(F.lds + RW_WD); LAS bf16_t* Kh = (LAS bf16_t*)(F.lds + RW_WA);
    LAS bf16_t* Vt = (LAS bf16_t*)(F.lds + RW_VT); LAS float* Lm = (LAS float*)(F.lds + RW_L); LAS float* Pm = (LAS float*)(F.lds + RW_P);
    bf16_t* const bh = F_RBH + (((size_t)c * 4 + h) * 64) * 64;
    LDS_BARRIER();
#pragma unroll
    for (int q = 0; q < 2; ++q) {
        const int j = 16 * (2 * jh + q) + i16;
#pragma unroll
        for (int r = 0; r < 4; ++r) {
            const int t = 16 * tt + 4 * g + r;
            const float cum = tk.cum[q][r], b = tk.kk[q][r] * tk.iclr[q][r], einv = __expf(-cum), elast = __expf(tk.c63[q] - cum);
            At[t * RW_LD + j] = f2bf(-tk.kk[q][r] * __expf(cum - tk.lw[q][r]));
            Bt[t * RW_LD + j] = f2bf(b * einv);
            Kt[t * RW_LD + j] = f2bf(tk.kp[q][r] * einv);
            Kh[t * RW_LD + j] = f2bf(tk.kp[q][r] * elast);
            bh[t * 64 + j] = f2bf(b * elast);
        }
        if (tt == 0 && g == 0) F_RDV[((size_t)c * 4 + h) * 64 + j] = __expf(tk.c63[q]);
    }
    LDS_BARRIER();
    if (jh == 0) {
#pragma unroll
        for (int st = 0; st < 4; ++st) if (st <= tt) {
            f32x4 acc = (f32x4){0.f, 0.f, 0.f, 0.f};
#pragma unroll
            for (int ks = 0; ks < 2; ++ks) acc = mma16(frag_nat(At, RW_LD, 16 * tt, 32 * ks, i16, g), frag_nat(Bt, RW_LD, 16 * st, 32 * ks, i16, g), acc);
#pragma unroll
            for (int r = 0; r < 4; ++r) { const int t = 16 * tt + 4 * g + r, s = 16 * st + i16; Lm[t * 68 + s] = (s < t) ? acc[r] : 0.f; }
        }
    }
    {
        f32x4 AK[4];
#pragma unroll
        for (int st = 0; st < 4; ++st) {
            f32x4 acc = (f32x4){0.f, 0.f, 0.f, 0.f};
            if (st <= tt) {
#pragma unroll
                for (int ks = 0; ks < 2; ++ks) acc = mma16(frag_nat(Kt, RW_LD, 16 * st, 32 * ks, i16, g), frag_nat(At, RW_LD, 16 * tt, 32 * ks, i16, g), acc);
#pragma unroll
                for (int r = 0; r < 4; ++r) { const int s = 16 * st + 4 * g + r, t = 16 * tt + i16; if (!(s < t)) acc[r] = 0.f; }
            }
            AK[st] = acc;
        }
#pragma unroll
        for (int q = 0; q < 2; ++q) {
            const int vt = 2 * jh + q;
            f32x4 acc = (f32x4){0.f, 0.f, 0.f, 0.f};
#pragma unroll
            for (int cs = 0; cs < 2; ++cs) if (2 * cs <= tt) acc = mma16(acc_frag(AK[2 * cs], AK[2 * cs + 1]), frag_tr_sig(Vt, RW_LD, 32 * cs, 16 * vt, i16, g), acc);
#pragma unroll
            for (int r = 0; r < 4; ++r) Pm[(16 * tt + 4 * g + r) * 68 + 16 * vt + i16] = acc[r];
            f32x4 kv = (f32x4){0.f, 0.f, 0.f, 0.f};
#pragma unroll
            for (int cs = 0; cs < 2; ++cs) kv = mma16(frag_tr_nat(Kh, RW_LD, 32 * cs, 16 * tt, i16, g), frag_tr_nat(Vt, RW_LD, 32 * cs, 16 * vt, i16, g), kv);
            *(u32x2*)(F_RKV + ((((size_t)c * 4 + h) * 64) + 16 * vt + i16) * 64 + 16 * tt + 4 * g) = pack4(kv);
        }
    }
    LDS_BARRIER();
    if (w < 2) {
        float x[64];
        const float ef = (float)w;
        const LAS float* Lo = opaque_lds(Lm); const LAS float* Po = opaque_lds(Pm + lane); const LAS bf16_t* Ao = opaque_lds(At + lane);
        tri_solve64<68, 1>(Lo, x, [&](int i) { return Po[i * 68] * (1.f - ef) + bf2f(Ao[i * RW_LD]) * ef; });
        if (w == 0) {
            bf16_t* o = F_RU + ((((size_t)c * 4 + h) * 64) + lane) * 64;
#pragma unroll
            for (int q = 0; q < 8; ++q) { float y[8];
#pragma unroll
                for (int i = 0; i < 8; ++i) y[i] = x[8 * q + i];
                *(u32x4*)(o + 8 * q) = pack8(y); }
        } else {
            bf16_t* o = F_RWA + (((size_t)c * 4 + h) * 64) * 64 + lane;
#pragma unroll
            for (int i = 0; i < 64; ++i) o[i * 64] = f2bf(x[i]);
        }
    }
    publish_item((unsigned*)(F.ws + WS_CTL) + CW_RFLAG + 4 * c + h);
    LDS_BARRIER();
}
constexpr int RWS_BUF = 4 * 64 * GDN_LD * 2 + 256;
__device__ __forceinline__ void scan_rwkv2(Frame& F, int l, int s, int h, int vb, int ncw, unsigned* prog, unsigned pbase, unsigned* done, int pm, const unsigned* rdy, int rstride, unsigned rneed) {
    PHASE_IDS(F);
    const int tid = F.tid, lane = F.lane, w = F.wave, i16 = lane & 15, g = lane >> 4;
    const int nch = (s == 0) ? 256 : 1, c0 = (s == 0) ? 0 : 255 + s, b = s - 1;
    const bf16_t* const rwa = F_RWA; bf16_t* const ru = F_RU; const bf16_t* const rbh = F_RBH; const bf16_t* const rkv = F_RKV; const float* const rdv = F_RDV;
    {
        if (w == (ncw < 4 ? ncw : 0)) (void)rdy_block(F, rdy, rstride, rneed, 0, nch < RDY_SLACK ? nch : RDY_SLACK, nch);
        LDS_BARRIER();
    }
    if (w >= 4) {
        const int lt = tid - 256;
        const int umask = 128 * ncw - 1;
        u32x4 r10[2], r20[2], r30[2], r40[2], r11[2], r21[2], r31[2], r41[2], r12[2], r22[2], r32[2], r42[2], r13[2], r23[2], r33[2], r43[2], r14[2], r24[2], r34[2], r44[2], r15[2], r25[2], r35[2], r45[2]; float dv0 = 0.f, dv1 = 0.f, dv2 = 0.f, dv3 = 0.f, dv4 = 0.f, dv5 = 0.f;
        const bf16_t* p1[2]; const bf16_t* p2[2]; const bf16_t* p3[2]; const bf16_t* p4[2]; const float* const pDv = rdv + h * 64 + (lt & 63);
#pragma unroll
        for (int q = 0; q < 2; ++q) { const int idx = q * 256 + lt, off = (idx >> 3) * 64 + (idx & 7) * 8, uoff = (vb + ((idx & umask) >> 3)) * 64 + (idx & 7) * 8;
            p1[q] = rwa + (size_t)h * 4096 + off; p2[q] = ru + (size_t)h * 4096 + uoff; p3[q] = rbh + (size_t)h * 4096 + off; p4[q] = rkv + (size_t)h * 4096 + uoff; }
        const bool dupU = ncw < 4;
        if (dupU) { p2[1] = ru; p4[1] = rkv; }
#define RWS_LOAD(ch, S) do { const size_t o_ = (size_t)(ch) * (4 * 4096); dv##S = ld4_asm(pDv + (size_t)(ch) * 256); \
        _Pragma("unroll") for (int q = 0; q < 2; ++q) { r1##S[q] = ld16_asm(p1[q] + o_); r2##S[q] = ld16_asm(p2[q] + o_); r3##S[q] = ld16_asm(p3[q] + o_); r4##S[q] = ld16_asm(p4[q] + o_); } } while (0)
#define RWS_WAIT(S, N) asm volatile("s_waitcnt vmcnt(%9)" : "+v"(r1##S[0]), "+v"(r1##S[1]), "+v"(r2##S[0]), "+v"(r2##S[1]), "+v"(r3##S[0]), "+v"(r3##S[1]), "+v"(r4##S[0]), "+v"(r4##S[1]), "+v"(dv##S) : "n"(N))
#define RWS_WRITE(bb, S) do { LAS bf16_t* Wn_ = (LAS bf16_t*)(F.lds + (bb) * RWS_BUF); \
        _Pragma("unroll") for (int q = 0; q < 2; ++q) { const int idx = q * 256 + lt, off = (idx >> 3) * GDN_LD + (idx & 7) * 8, uoff = (vb + ((idx & umask) >> 3)) * GDN_LD + (idx & 7) * 8; \
            *(LAS u32x4*)(Wn_ + off) = r1##S[q]; *(LAS u32x4*)(Wn_ + 2 * 64 * GDN_LD + off) = r3##S[q]; \
            if (q == 0 || !dupU) { *(LAS u32x4*)(Wn_ + 64 * GDN_LD + uoff) = r2##S[q]; *(LAS u32x4*)(Wn_ + 3 * 64 * GDN_LD + uoff) = r4##S[q]; } } \
        if (lt < 64) ((LAS float*)(Wn_ + 4 * 64 * GDN_LD))[lt] = dv##S; } while (0)
        SCAN_LOADER6(RWS_LOAD, RWS_WRITE, RWS_WAIT, 9);
#undef RWS_LOAD
#undef RWS_WRITE
#undef RWS_WAIT
    } else if (w >= ncw) {
        int nxt = nch < RDY_SLACK ? nch : RDY_SLACK;
        LDS_BARRIER();
#define RWS_STORE_OUT(cc) do { const size_t b0_ = (((size_t)(c0 + (cc))) * 4 + h) * 4096 + (size_t)vb * 64; const LAS bf16_t* Os_ = (const LAS bf16_t*)(F.lds + OUT_OFF + ((cc) & 1) * OUT_BUF); \
            _Pragma("unroll") for (int it_ = 0; it_ < 4; ++it_) { const int idx_ = it_ * 64 + lane, row_ = idx_ >> 3, c8_ = (idx_ & 7) * 8; \
                const u32x4 hv_ = *(const LAS u32x4*)(Os_ + row_ * OUT_LD + c8_), vv_ = *(const LAS u32x4*)(Os_ + 32 * OUT_LD + row_ * OUT_LD + c8_); \
                st16_wt((bf16_t*)rkv + b0_ + row_ * 64 + c8_, hv_); st16_wt(ru + b0_ + row_ * 64 + c8_, vv_); } } while (0)
        const bool storer = prog != nullptr && w == ncw + 1;
        for (int ci = 0; ci < nch; ++ci) {
            if (w == ncw && nxt < nch) { const int upto = ci + 1 + RDY_SLACK < nch ? ci + 1 + RDY_SLACK : nch; nxt = rdy_block(F, rdy, rstride, rneed, nxt, upto, nch); }
            if (storer) {
                if (ci > 0) RWS_STORE_OUT(ci - 1);
                asm volatile("s_waitcnt vmcnt(48)" ::: "memory");
                if (lane < ncw && ci >= 7) __hip_atomic_store(prog + 64 * lane, pbase + (unsigned)(ci - 7) + 1u, __ATOMIC_RELAXED, __HIP_MEMORY_SCOPE_AGENT);
            }
            LDS_BARRIER();
        }
        if (storer) {
            RWS_STORE_OUT(nch - 1);
            asm volatile("s_waitcnt vmcnt(0)" ::: "memory");
            if (lane < ncw) __hip_atomic_store(prog + 64 * lane, pbase + (unsigned)nch, __ATOMIC_RELAXED, __HIP_MEMORY_SCOPE_AGENT);
        }
#undef RWS_STORE_OUT
    } else {
        const int n0 = vb + 16 * w;
        f32x4 S[4];
        if (s == 0) {
#pragma unroll
            for (int kt = 0; kt < 4; ++kt) S[kt] = (f32x4){0.f, 0.f, 0.f, 0.f};
        } else {
            const float* st = INP(I_SRWKV) + (((size_t)l * 32 + b) * 4 + h) * 4096 + (n0 + i16) * 64 + 4 * g;
#pragma unroll
            for (int kt = 0; kt < 4; ++kt) S[kt] = *(const f32x4*)(st + 16 * kt);
        }
        LDS_BARRIER();
        for (int ci = 0; ci < nch; ++ci) {
            const size_t b0 = (((size_t)(c0 + ci)) * 4 + h) * 4096;
            const LAS bf16_t* Wn = (const LAS bf16_t*)(F.lds + (ci & 1) * RWS_BUF); const LAS bf16_t* Ut = Wn + 64 * GDN_LD; const LAS bf16_t* Bh = Ut + 64 * GDN_LD; const LAS bf16_t* KVt = Bh + 64 * GDN_LD;
            const LAS float* dvec = (const LAS float*)(KVt + 64 * GDN_LD);
            bf16x8 A1[4][2], A2[4][2]; u32x2 ui[4], kvi[4]; f32x4 dq[4];
#pragma unroll
            for (int m = 0; m < 4; ++m) { ui[m] = *(const LAS u32x2*)(Ut + (n0 + i16) * GDN_LD + 16 * m + 4 * g);
#pragma unroll
                for (int ks = 0; ks < 2; ++ks) A1[m][ks] = frag_sig(Wn, GDN_LD, 16 * m, 32 * ks, i16, g); }
#pragma unroll
            for (int kt = 0; kt < 4; ++kt) { kvi[kt] = *(const LAS u32x2*)(KVt + (n0 + i16) * GDN_LD + 16 * kt + 4 * g); dq[kt] = *(const LAS f32x4*)(dvec + 16 * kt + 4 * g);
#pragma unroll
                for (int cs = 0; cs < 2; ++cs) A2[kt][cs] = frag_tr_sig(Bh, GDN_LD, 32 * cs, 16 * kt, i16, g); }
            __builtin_amdgcn_sched_barrier(0);
            bf16x8 Sb[2];
#pragma unroll
            for (int ks = 0; ks < 2; ++ks) Sb[ks] = acc_frag(S[2 * ks], S[2 * ks + 1]);
            LAS bf16_t* const Os = (LAS bf16_t*)(F.lds + OUT_OFF + (ci & 1) * OUT_BUF) + (16 * w + i16) * OUT_LD + 4 * g;
            if (prog) {
#pragma unroll
                for (int kt = 0; kt < 4; ++kt) *(LAS u32x2*)(Os + 16 * kt) = pack4(S[kt]);
            } else {
                bf16_t* ho = F_RKV + b0 + (n0 + i16) * 64 + 4 * g;
#pragma unroll
                for (int kt = 0; kt < 4; ++kt) st8_wt(ho + 16 * kt, pack4(S[kt]));
            }
            f32x4 V[4];
            bf16_t* vo = ru + b0 + (n0 + i16) * 64 + 4 * g;
#pragma unroll
            for (int m = 0; m < 4; ++m) {
                f32x4 acc = unpack4(ui[m]);
#pragma unroll
                for (int ks = 0; ks < 2; ++ks) acc = mma16(A1[m][ks], Sb[ks], acc);
                V[m] = acc;
            }
            if (prog) {
#pragma unroll
                for (int m = 0; m < 4; ++m) *(LAS u32x2*)(Os + 32 * OUT_LD + 16 * m) = pack4(V[m]);
            } else {
#pragma unroll
                for (int m = 0; m < 4; ++m) st8_wt(vo + 16 * m, pack4(V[m]));
            }
            bf16x8 Ub[2];
#pragma unroll
            for (int cs = 0; cs < 2; ++cs) Ub[cs] = acc_frag(V[2 * cs], V[2 * cs + 1]);
#pragma unroll
            for (int kt = 0; kt < 4; ++kt) {
                f32x4 acc = S[kt] * dq[kt] + unpack4(kvi[kt]);
#pragma unroll
                for (int cs = 0; cs < 2; ++cs) acc = mma16(A2[kt][cs], Ub[cs], acc);
                S[kt] = acc;
            }
            LDS_BARRIER();
        }
        asm volatile("s_waitcnt vmcnt(0)" ::: "memory");
        if (done && lane == 0) __hip_atomic_fetch_add(done, 1u, __ATOMIC_RELAXED, __HIP_MEMORY_SCOPE_AGENT);
        float* o = F.out + (s == 0 ? O_P_RWKV + ((size_t)l * 4 + h) * 4096 : O_S_RWKV + (((size_t)l * 32 + b) * 4 + h) * 4096) + (n0 + i16) * 64 + 4 * g;
#pragma unroll
        for (int kt = 0; kt < 4; ++kt) *(f32x4*)(o + 16 * kt) = S[kt];
    }
}
__device__ __forceinline__ void post_rwkv(Frame& F, int l, int c, int h) {
    PHASE_IDS(F);
    const int tid = F.tid, lane = F.lane, w = F.wave, i16 = lane & 15, g = lane >> 4, tt = w & 3, jh = w >> 2;
    const size_t row0 = (size_t)c * 64;
    RwkvTok tk; f32x4 Zg[2];
    rwkv_tokens<true>(F, l, c, h, tk, Zg);
    LAS bf16_t* Rd = (LAS bf16_t*)(F.lds + RW_XD); LAS bf16_t* Bt = (LAS bf16_t*)(F.lds + RW_XA); LAS bf16_t* Kt = (LAS bf16_t*)(F.lds + RW_WD); LAS bf16_t* Utl = (LAS bf16_t*)(F.lds + RW_WA);
    LAS bf16_t* Rt = (LAS bf16_t*)(F.lds + RW_RT); LAS bf16_t* Htl = (LAS bf16_t*)(F.lds + RW_KX); LAS bf16_t* Vt = (LAS bf16_t*)(F.lds + RW_VT);
    LAS float* ex = (LAS float*)(F.lds + RW_EX) + 512;
    float rr[2][4];
#pragma unroll
    for (int q = 0; q < 2; ++q)
#pragma unroll
        for (int r = 0; r < 4; ++r) rr[q][r] = bf2f(Rt[(16 * tt + 4 * g + r) * RW_LD + 16 * (2 * jh + q) + i16]);
    LDS_BARRIER();
#pragma unroll
    for (int q = 0; q < 2; ++q) {
        const int j = 16 * (2 * jh + q) + i16;
#pragma unroll
        for (int r = 0; r < 4; ++r) {
            const int t = 16 * tt + 4 * g + r;
            const float cum = tk.cum[q][r], einv = __expf(-cum);
            Rd[t * RW_LD + j] = f2bf(rr[q][r] * __expf(cum));
            Bt[t * RW_LD + j] = f2bf(tk.kk[q][r] * tk.iclr[q][r] * einv);
            Kt[t * RW_LD + j] = f2bf(tk.kp[q][r] * einv);
        }
    }
    {
        const int row = tid >> 3, col8 = (tid & 7) * 8; const size_t b0 = (((size_t)c * 4 + h) * 64 + row) * 64 + col8;
        *(LAS u32x4*)(Utl + row * RW_LD + col8) = *(const u32x4*)(F_RU + b0);
        *(LAS u32x4*)(Htl + row * RW_LD + col8) = *(const u32x4*)(F_RKV + b0);
    }
    LDS_BARRIER();
    f32x4 QB[4], QK[4];
#pragma unroll
    for (int st = 0; st < 4; ++st) {
        f32x4 a = (f32x4){0.f, 0.f, 0.f, 0.f}, bq = a;
        if (st <= tt) {
#pragma unroll
            for (int ks = 0; ks < 2; ++ks) {
                const bf16x8 rf = frag_nat(Rd, RW_LD, 16 * tt, 32 * ks, i16, g);
                a = mma16(frag_nat(Bt, RW_LD, 16 * st, 32 * ks, i16, g), rf, a);
                bq = mma16(frag_nat(Kt, RW_LD, 16 * st, 32 * ks, i16, g), rf, bq);
            }
#pragma unroll
            for (int r = 0; r < 4; ++r) { const int s = 16 * st + 4 * g + r, t = 16 * tt + i16; if (!(s <= t)) { a[r] = 0.f; bq[r] = 0.f; } }
        }
        QB[st] = a; QK[st] = bq;
    }
    f32x4 Y[2]; float s1[4] = {0.f, 0.f, 0.f, 0.f}, s2[4] = {0.f, 0.f, 0.f, 0.f}, bon[4] = {0.f, 0.f, 0.f, 0.f};
#pragma unroll
    for (int q = 0; q < 2; ++q) {
        const int vt = 2 * jh + q;
        f32x4 acc = (f32x4){0.f, 0.f, 0.f, 0.f};
#pragma unroll
        for (int ks = 0; ks < 2; ++ks) acc = mma16(frag_nat(Rd, RW_LD, 16 * tt, 32 * ks, i16, g), frag_nat(Htl, RW_LD, 16 * vt, 32 * ks, i16, g), acc);
#pragma unroll
        for (int cs = 0; cs < 2; ++cs) if (2 * cs <= tt) {
            acc = mma16(acc_frag(QB[2 * cs], QB[2 * cs + 1]), frag_sig(Utl, RW_LD, 16 * vt, 32 * cs, i16, g), acc);
            acc = mma16(acc_frag(QK[2 * cs], QK[2 * cs + 1]), frag_tr_sig(Vt, RW_LD, 32 * cs, 16 * vt, i16, g), acc);
        }
        Y[q] = acc;
        const float rkw = INP(I_RRK)[l * 256 + h * 64 + 16 * vt + i16];
#pragma unroll
        for (int r = 0; r < 4; ++r) { s1[r] += acc[r]; s2[r] += acc[r] * acc[r]; bon[r] += rr[q][r] * tk.kp[q][r] * rkw; }
    }
#pragma unroll
    for (int r = 0; r < 4; ++r) {
        float a = s1[r], bq = s2[r], cq = bon[r];
#pragma unroll
        for (int o = 1; o < 16; o <<= 1) { a += __shfl_xor(a, o); bq += __shfl_xor(bq, o); cq += __shfl_xor(cq, o); }
        if (i16 == 0) { const int t = 16 * tt + 4 * g + r; ex[(0 * 2 + jh) * 64 + t] = a; ex[(1 * 2 + jh) * 64 + t] = bq; ex[(2 * 2 + jh) * 64 + t] = cq; }
    }
    LDS_BARRIER();
    bf16_t* const proj = F_PROJ;
#pragma unroll
    for (int q = 0; q < 2; ++q) {
        const int v = 16 * (2 * jh + q) + i16, vc = l * 256 + h * 64 + v;
        const float lnw = INP(I_RLNW)[vc], lnb = INP(I_RLNB)[vc];
#pragma unroll
        for (int r = 0; r < 4; ++r) {
            const int t = 16 * tt + 4 * g + r;
            const float mean = (ex[t] + ex[64 + t]) * (1.f / 64.f);
            const float var = fmaxf((ex[128 + t] + ex[192 + t]) * (1.f / 64.f) - mean * mean, 0.f);
            const float bonus = (ex[256 + t] + ex[320 + t]) * bf2f(Vt[t * RW_LD + v]);
            const float yn = (Y[q][r] - mean) * rsqrtf(var + 64e-5f) * lnw + lnb;
            proj[(row0 + t) * PW + PC_R + h * 64 + v] = f2bf((yn + bonus) * Zg[q][r]);
        }
    }
    LDS_BARRIER();
}

constexpr int SSD_LDC = 136, SSD_LDX = 72;
constexpr int SSD_BUF = 64 * SSD_LDC * 2 * 2 + 64 * SSD_LDX * 2 + 64;
__device__ __forceinline__ void scan_ssd2(Frame& F, int l, int s, int hd, int vb, int ncw, unsigned* prog, unsigned pbase, unsigned* done, int pm, const unsigned* rdy, int rstride, unsigned rneed) {
    PHASE_IDS(F);
    const int tid = F.tid, lane = F.lane, w = F.wave, i16 = lane & 15, g = lane >> 4;
    const int nch = (s == 0) ? 256 : 1, c0 = (s == 0) ? 0 : 255 + s, b = s - 1, grp = hd >> 2;
    const bf16_t* const proj = F_PROJ; const float* const scal = F_SCAL; const float* const acum = F_ACUM;
    {
        if (w == (ncw < 4 ? ncw : 0)) (void)rdy_block(F, rdy, rstride, rneed, 0, nch < RDY_SLACK ? nch : RDY_SLACK, nch);
        LDS_BARRIER();
    }
    if (w >= 4) {
        const int lt = tid - 256;
        const int umask = 128 * ncw - 1, xsh = (ncw == 4) ? 3 : (ncw == 2 ? 2 : 1);
        u32x4 rc0[4], rb0[4], rx0[2], rc1[4], rb1[4], rx1[2], rc2[4], rb2[4], rx2[2], rc3[4], rb3[4], rx3[2]; float dt0[2], ac0[2], al0, dt1[2], ac1[2], al1, dt2[2], ac2[2], al2, dt3[2], ac3[2], al3;
        const bf16_t* pC[4]; const bf16_t* pB[4]; const bf16_t* pX[2]; const float* pDt[2]; const float* pAc[2]; const float* const pAl = acum + 63 * 8 + hd;
#pragma unroll
        for (int q = 0; q < 4; ++q) { const int idx = q * 256 + lt, row = idx >> 4, col8 = (idx & 15) * 8;
            pC[q] = proj + (size_t)row * PW + PC_SC + grp * 128 + col8; pB[q] = proj + (size_t)row * PW + PC_SB + grp * 128 + col8; }
#pragma unroll
        for (int q = 0; q < 2; ++q) { const int idx = (q * 256 + lt) & umask, row = idx >> xsh, col8 = vb + (idx & ((1 << xsh) - 1)) * 8;
            pX[q] = proj + (size_t)row * PW + PC_SX + hd * 64 + col8; pDt[q] = scal + row * 16 + 8 + hd; pAc[q] = acum + row * 8 + hd; }
        const bool dupX = ncw < 4;
        if (dupX) { pX[1] = proj + PC_SX; pDt[1] = scal; pAc[1] = acum; }
#define SSD_LOAD(ch, S) do { const size_t oP_ = (size_t)(ch) * (64 * PW), oS_ = (size_t)(ch) * 1024, oA_ = (size_t)(ch) * 512; al##S = ld4_asm(pAl + oA_); \
        _Pragma("unroll") for (int q = 0; q < 4; ++q) { rc##S[q] = ld16_asm(pC[q] + oP_); rb##S[q] = ld16_asm(pB[q] + oP_); } \
        _Pragma("unroll") for (int q = 0; q < 2; ++q) { rx##S[q] = ld16_asm(pX[q] + oP_); dt##S[q] = ld4_asm(pDt[q] + oS_); ac##S[q] = ld4_asm(pAc[q] + oA_); } } while (0)
#define SSD_WAIT(S, N) asm volatile("s_waitcnt vmcnt(%15)" : "+v"(rc##S[0]), "+v"(rc##S[1]), "+v"(rc##S[2]), "+v"(rc##S[3]), "+v"(rb##S[0]), "+v"(rb##S[1]), "+v"(rb##S[2]), "+v"(rb##S[3]), \
        "+v"(rx##S[0]), "+v"(rx##S[1]), "+v"(dt##S[0]), "+v"(dt##S[1]), "+v"(ac##S[0]), "+v"(ac##S[1]), "+v"(al##S) : "n"(N))
#define SSD_WRITE(bb, S) do { LAS bf16_t* Ct_ = (LAS bf16_t*)(F.lds + (bb) * SSD_BUF); LAS bf16_t* Bt_ = Ct_ + 64 * SSD_LDC; LAS bf16_t* Xt_ = Bt_ + 64 * SSD_LDC; \
        _Pragma("unroll") for (int q = 0; q < 4; ++q) { const int idx = q * 256 + lt, row = idx >> 4, col8 = (idx & 15) * 8; \
            *(LAS u32x4*)(Ct_ + row * SSD_LDC + col8) = rc##S[q]; *(LAS u32x4*)(Bt_ + row * SSD_LDC + col8) = rb##S[q]; } \
        _Pragma("unroll") for (int q = 0; q < 2; ++q) if (q == 0 || !dupX) { const int idx = (q * 256 + lt) & umask, row = idx >> xsh, col8 = vb + (idx & ((1 << xsh) - 1)) * 8; float v_[8]; unpack8(rx##S[q], v_); \
            const float sx_ = dt##S[q] * __expf(al##S - ac##S[q]); \
            _Pragma("unroll") for (int i = 0; i < 8; ++i) v_[i] *= sx_; *(LAS u32x4*)(Xt_ + row * SSD_LDX + col8) = pack8(v_); } \
        if (lt == 0) *(LAS float*)(Xt_ + 64 * SSD_LDX) = __expf(al##S); } while (0)
        SCAN_LOADER(SSD_LOAD, SSD_WRITE, SSD_WAIT, 15);
#undef SSD_LOAD
#undef SSD_WRITE
#undef SSD_WAIT
    } else if (w >= ncw) {
        int nxt = nch < RDY_SLACK ? nch : RDY_SLACK;
        LDS_BARRIER();
#define SSD_STORE_OUT(cc) do { bf16_t* yb_ = F_YOFF + (((size_t)(c0 + (cc)) * 8 + hd) * 64 + vb) * 64; const LAS bf16_t* Os_ = (const LAS bf16_t*)(F.lds + OUT_OFF + ((cc) & 1) * OUT_BUF); \
            _Pragma("unroll") for (int it_ = 0; it_ < 4; ++it_) { const int idx_ = it_ * 64 + lane, row_ = idx_ >> 3, c8_ = (idx_ & 7) * 8; \
                st16_wt(yb_ + row_ * 64 + c8_, *(const LAS u32x4*)(Os_ + row_ * OUT_LD + c8_)); } } while (0)
        const bool storer = prog != nullptr && w == ncw + 1;
        for (int ci = 0; ci < nch; ++ci) {
            if (w == ncw && nxt < nch) { const int upto = ci + 1 + RDY_SLACK < nch ? ci + 1 + RDY_SLACK : nch; nxt = rdy_block(F, rdy, rstride, rneed, nxt, upto, nch); }
            if (storer) {
                if (ci > 0) SSD_STORE_OUT(ci - 1);
                asm volatile("s_waitcnt vmcnt(24)" ::: "memory");
                if (lane < ncw && ci >= 7) __hip_atomic_store(prog + 64 * lane, pbase + (unsigned)(ci - 7) + 1u, __ATOMIC_RELAXED, __HIP_MEMORY_SCOPE_AGENT);
            }
            LDS_BARRIER();
        }
        if (storer) {
            SSD_STORE_OUT(nch - 1);
            asm volatile("s_waitcnt vmcnt(0)" ::: "memory");
            if (lane < ncw) __hip_atomic_store(prog + 64 * lane, pbase + (unsigned)nch, __ATOMIC_RELAXED, __HIP_MEMORY_SCOPE_AGENT);
        }
#undef SSD_STORE_OUT
    } else {
        const int n0 = vb + 16 * w, head = hd;
        f32x4 H[8];
        if (s == 0) {
#pragma unroll
            for (int nt = 0; nt < 8; ++nt) H[nt] = (f32x4){0.f, 0.f, 0.f, 0.f};
        } else {
            const float* st = INP(I_SSSM) + ((((size_t)l * 32 + b) * 8 + head) * 64 + n0 + i16) * 128 + 4 * g;
#pragma unroll
            for (int nt = 0; nt < 8; ++nt) H[nt] = *(const f32x4*)(st + 16 * nt);
        }
        bf16_t* const yoff = F_YOFF;
        LDS_BARRIER();
        for (int ci = 0; ci < nch; ++ci) {
            const LAS bf16_t* Ct = (const LAS bf16_t*)(F.lds + (ci & 1) * SSD_BUF); const LAS bf16_t* Bt = Ct + 64 * SSD_LDC; const LAS bf16_t* Xt = Bt + 64 * SSD_LDC;
            const float cd = *(const LAS float*)(Xt + 64 * SSD_LDX);
            bf16x8 A1[4][4], A2[8][2], Xb[2];
#pragma unroll
            for (int m = 0; m < 4; ++m)
#pragma unroll
                for (int ks = 0; ks < 4; ++ks) A1[m][ks] = frag_sig(Ct, SSD_LDC, 16 * m, 32 * ks, i16, g);
#pragma unroll
            for (int cs = 0; cs < 2; ++cs) Xb[cs] = frag_tr_nat(Xt, SSD_LDX, 32 * cs, n0, i16, g);
#pragma unroll
            for (int nt = 0; nt < 8; ++nt)
#pragma unroll
                for (int cs = 0; cs < 2; ++cs) A2[nt][cs] = frag_tr_nat(Bt, SSD_LDC, 32 * cs, 16 * nt, i16, g);
            __builtin_amdgcn_sched_barrier(0);
            bf16x8 Hb[4];
#pragma unroll
            for (int ks = 0; ks < 4; ++ks) Hb[ks] = acc_frag(H[2 * ks], H[2 * ks + 1]);
            bf16_t* yo = yoff + (((size_t)(c0 + ci) * 8 + head) * 64 + n0 + i16) * 64 + 4 * g;
            f32x4 Yv[4];
#pragma unroll
            for (int m = 0; m < 4; ++m) {
                f32x4 acc = (f32x4){0.f, 0.f, 0.f, 0.f};
#pragma unroll
                for (int ks = 0; ks < 4; ++ks) acc = mma16(A1[m][ks], Hb[ks], acc);
                Yv[m] = acc;
            }
#pragma unroll
            for (int nt = 0; nt < 8; ++nt) {
                f32x4 acc = H[nt] * cd;
#pragma unroll
                for (int cs = 0; cs < 2; ++cs) acc = mma16(A2[nt][cs], Xb[cs], acc);
                H[nt] = acc;
            }
            if (prog) {
                LAS bf16_t* const Os = (LAS bf16_t*)(F.lds + OUT_OFF + (ci & 1) * OUT_BUF) + (16 * w + i16) * OUT_LD + 4 * g;
#pragma unroll
                for (int m = 0; m < 4; ++m) *(LAS u32x2*)(Os + 16 * m) = pack4(Yv[m]);
            } else {
#pragma unroll
                for (int m = 0; m < 4; ++m) st8_wt(yo + 16 * m, pack4(Yv[m]));
            }
            LDS_BARRIER();
        }
        asm volatile("s_waitcnt vmcnt(0)" ::: "memory");
        if (done && lane == 0) __hip_atomic_fetch_add(done, 1u, __ATOMIC_RELAXED, __HIP_MEMORY_SCOPE_AGENT);
        float* o = F.out + (s == 0 ? O_P_SSM + (((size_t)l * 8 + head) * 64 + n0 + i16) * 128 : O_S_SSM + ((((size_t)l * 32 + b) * 8 + head) * 64 + n0 + i16) * 128) + 4 * g;
#pragma unroll
        for (int nt = 0; nt < 8; ++nt) *(f32x4*)(o + 16 * nt) = H[nt];
    }
}
__device__ __forceinline__ void post_ssd(Frame& F, int l, int c, int grp) {
    PHASE_IDS(F);
    const int tid = F.tid, lane = F.lane, w = F.wave, i16 = lane & 15, g = lane >> 4;
    const size_t row0 = (size_t)c * 64;
    bf16_t* const proj = F_PROJ;
    LAS bf16_t* Ct = (LAS bf16_t*)F.lds; LAS bf16_t* Bt = Ct + 64 * SSD_LDC; LAS bf16_t* Xt = Bt + 64 * SSD_LDC;
    LAS float* acs = (LAS float*)(Xt + 4 * 64 * SSD_LDX); LAS float* dts = acs + 256; LAS float* ssn = dts + 256;
    {
#pragma unroll
        for (int q = 0; q < 2; ++q) { const int idx = q * 512 + tid, row = idx >> 4, col8 = (idx & 15) * 8;
            *(LAS u32x4*)(Ct + row * SSD_LDC + col8) = *(const u32x4*)(proj + (row0 + row) * PW + PC_SC + grp * 128 + col8);
            *(LAS u32x4*)(Bt + row * SSD_LDC + col8) = *(const u32x4*)(proj + (row0 + row) * PW + PC_SB + grp * 128 + col8); }
#pragma unroll
        for (int q = 0; q < 4; ++q) { const int idx = q * 512 + tid, row = idx >> 5, col8 = (idx & 31) * 8, hh = col8 >> 6, cc = col8 & 63;
            *(LAS u32x4*)(Xt + hh * 64 * SSD_LDX + row * SSD_LDX + cc) = *(const u32x4*)(proj + (row0 + row) * PW + PC_SX + grp * 256 + col8); }
        if (tid < 256) { const int hh = tid >> 6, t = tid & 63; acs[tid] = F_ACUM[(row0 + t) * 8 + grp * 4 + hh]; dts[tid] = F_SCAL[(row0 + t) * 16 + 8 + grp * 4 + hh]; }
    }
    LDS_BARRIER();
    const int hh = w & 3, lh = w >> 2, hd = grp * 4 + hh;
    const LAS bf16_t* Xh = Xt + hh * 64 * SSD_LDX;
    const float Dh = INP(I_SD)[l * 8 + hd];
    float ssrow[2][4];
    f32x4 Y[2][4];
#pragma unroll
    for (int li = 0; li < 2; ++li) {
        const int ltile = 2 * lh + li;
        f32x4 ST[4];
#pragma unroll
        for (int st = 0; st < 4; ++st) {
            f32x4 acc = (f32x4){0.f, 0.f, 0.f, 0.f};
            if (st <= ltile) {
#pragma unroll
                for (int ks = 0; ks < 4; ++ks) acc = mma16(frag_nat(Bt, SSD_LDC, 16 * st, 32 * ks, i16, g), frag_nat(Ct, SSD_LDC, 16 * ltile, 32 * ks, i16, g), acc);
                const int lcol = 16 * ltile + i16; const float acl = acs[hh * 64 + lcol];
#pragma unroll
                for (int r = 0; r < 4; ++r) { const int srow = 16 * st + 4 * g + r; const float f = (srow <= lcol) ? __expf(fminf(acl - acs[hh * 64 + srow], 0.f)) * dts[hh * 64 + srow] : 0.f; acc[r] *= f; }
            }
            ST[st] = acc;
        }
#pragma unroll
        for (int pt = 0; pt < 4; ++pt) {
            f32x4 acc = (f32x4){0.f, 0.f, 0.f, 0.f};
#pragma unroll
            for (int cs = 0; cs < 2; ++cs) if (2 * cs <= ltile) acc = mma16(acc_frag(ST[2 * cs], ST[2 * cs + 1]), frag_tr_sig(Xh, SSD_LDX, 32 * cs, 16 * pt, i16, g), acc);
            const int p = 16 * pt + i16, lr0 = 16 * ltile + 4 * g;
            const f32x4 yo = unpack4(*(const u32x2*)(F_YOFF + (((size_t)c * 8 + hd) * 64 + p) * 64 + lr0));
#pragma unroll
            for (int r = 0; r < 4; ++r) {
                const int lrow = lr0 + r;
                const float x = bf2f(Xh[lrow * SSD_LDX + p]);
                const float z = bf2f(proj[(row0 + lrow) * PW + PC_ZS + hd * 64 + p]);
                acc[r] = (acc[r] + __expf(acs[hh * 64 + lrow]) * yo[r] + Dh * x) * siluf_(z);
            }
            Y[li][pt] = acc;
        }
#pragma unroll
        for (int r = 0; r < 4; ++r) { float ss = 0.f;
#pragma unroll
            for (int pt = 0; pt < 4; ++pt) ss += Y[li][pt][r] * Y[li][pt][r];
            ss += __shfl_xor(ss, 1); ss += __shfl_xor(ss, 2); ss += __shfl_xor(ss, 4); ss += __shfl_xor(ss, 8);
            ssrow[li][r] = ss; }
        if (i16 == 0) {
#pragma unroll
            for (int r = 0; r < 4; ++r) ssn[(16 * ltile + 4 * g + r) * 4 + hh] = ssrow[li][r];
        }
    }
    LDS_BARRIER();
#pragma unroll
    for (int li = 0; li < 2; ++li) {
        const int ltile = 2 * lh + li;
#pragma unroll
        for (int r = 0; r < 4; ++r) {
            const int lrow = 16 * ltile + 4 * g + r;
            const f32x4 sv = *(const LAS f32x4*)(ssn + lrow * 4);
            const float sc = rsqrtf(((sv[0] + sv[1]) + (sv[2] + sv[3])) * (1.f / 256.f) + EPS);
#pragma unroll
            for (int pt = 0; pt < 4; ++pt) { const int p = 16 * pt + i16;
                proj[(row0 + lrow) * PW + PC_ZS + hd * 64 + p] = f2bf(Y[li][pt][r] * sc * INP(I_SNORMW)[l * 512 + hd * 64 + p]); }
        }
    }
    LDS_BARRIER();
}

constexpr int NSL = 2;
constexpr int CW_PROG = 8192;
constexpr int CW_SDONE = 8192 + 64 * 64;
__device__ __forceinline__ void post_wait(Frame& F, int c, int q, unsigned pbase, unsigned sneed) {
    if (F.wave == 0) {
        unsigned* const ctl = (unsigned*)(F.ws + WS_CTL);
        const int lane = F.lane;
        unsigned* wp; unsigned need; bool act;
        if (c >= 256) { wp = ctl + CW_SDONE + 64 * (c - 256); need = sneed; act = lane == 0; }
        else {
            int gq0, ng;
            if (q < 2) { gq0 = 8 + 4 * q; ng = 4; } else if (q < 4) { gq0 = 2 * (q - 2); ng = 2; } else { gq0 = 4 + (q - 4); ng = 1; }
            act = lane < 4 * ng; wp = ctl + CW_PROG + 64 * (4 * gq0 + (act ? lane : 0)); need = pbase + (unsigned)c + 1u;
        }
        unsigned sp = 0;
        for (;;) { const bool ok = !act || (int)(xb_ld(wp) - need) >= 0; if (__all(ok) || ++sp > 2000000u) break; __builtin_amdgcn_s_sleep(4); }
        __builtin_amdgcn_fence(__ATOMIC_ACQUIRE, "agent");
        asm volatile("s_waitcnt vmcnt(0)" ::: "memory");
    }
    LDS_BARRIER();
}
__device__ __forceinline__ void scan_phase(Frame& F, int l, int mode, unsigned epoch) {
    PHASE_IDS(F);
    const int xl = F.vcu >> 5, slot = F.vcu & 31;
    unsigned* const ctl = (unsigned*)(F.ws + WS_CTL);
    const unsigned pbase = 1024u * epoch, sneed = 64u * (epoch + 1u), rneed = epoch + 1u;
    const int nchain = xl < 2 ? 8 : (xl < 6 ? 4 : 0);
    const int wbase = xl < 2 ? 24 * xl : (xl < 6 ? 48 + 28 * (xl - 2) : 160 + 32 * (xl - 6));
    const bool worker = slot >= nchain;
    const int j = wbase + slot - nchain;
    if (worker) {
        for (int it = j; it < NCH * 5; it += 224) {
            int it_ = it; asm volatile("" : "+s"(it_));
            const int c = it_ / 5, q = it_ % 5;
            if (q == 0) act_chunk(F, l, c); else prep_rwkv(F, l, c, q - 1);
        }
    }
    for (int pass = 0; pass < 3; ++pass) {
        int kind, s, h, vb, ncw; unsigned* prog = nullptr; unsigned* done = nullptr;
        if (pass == 0) {
            if (worker) continue;
            kind = xl < 2 ? 2 : (xl < 4 ? 0 : 1); h = xl < 2 ? 4 * xl + (slot >> 1) : 2 * (xl & 1) + (slot >> 1);
            const int gq = kind == 0 ? h : (kind == 1 ? 4 + h : 8 + h);
            s = 0; ncw = 2; vb = 32 * (slot & 1);
            prog = ctl + CW_PROG + 64 * (4 * gq + 2 * (slot & 1));
        } else {
            const int it = F.vcu + (pass - 1) * F.G;
            if (it >= 512) continue;
            if (it < 128) { kind = 0; s = 1 + (it >> 2); h = it & 3; }
            else if (it < 256) { kind = 1; s = 1 + ((it - 128) >> 2); h = (it - 128) & 3; }
            else { kind = 2; s = 1 + ((it - 256) >> 3); h = (it - 256) & 7; }
            vb = 0; ncw = 4; done = ctl + CW_SDONE + 64 * (s - 1);
        }
        const int cfirst = (s == 0) ? 0 : 255 + s;
        if (kind == 0) scan_gdn2(F, l, s, h, vb, ncw, prog, pbase, done, mode, ctl + CW_AFLAG + cfirst, 1, rneed);
        else if (kind == 1) scan_rwkv2(F, l, s, h, vb, ncw, prog, pbase, done, mode, ctl + CW_RFLAG + 4 * cfirst + h, 4, rneed);
        else scan_ssd2(F, l, s, h, vb, ncw, prog, pbase, done, mode, ctl + CW_AFLAG + cfirst, 1, rneed);
        __syncthreads();
    }
    if (worker) {
        for (int it = j; it < NCH * 8; it += 224) {
            int it_ = it; asm volatile("" : "+s"(it_));
            const int c = it_ >> 3, q = it_ & 7;
            post_wait(F, c, q, pbase, sneed);
            if (q < 2) post_ssd(F, l, c, q); else if (q < 4) post_gdn(F, l, c, q - 2); else post_rwkv(F, l, c, q - 4);
        }
    }
}
__device__ __forceinline__ void final_norm(Frame& F) {
    PHASE_IDS(F);
    const int gw = F.vcu * 8 + F.wave, NGW = F.G * 8;
    const float* fw = INP(I_FNORM);
    float wv[16];
#pragma unroll
    for (int i = 0; i < 16; ++i) wv[i] = fw[16 * F.lane + i];
    for (int m = gw; m < T; m += NGW) {
        float s = (F.lane < 16) ? F_SSQA[(size_t)m * 16 + F.lane] : 0.f;
        s = wave_sum(s);
        const float rs = rsqrtf(s * (1.f / 1024.f) + EPS);
        const bf16_t* xr = F_R1 + (size_t)m * DM + 16 * F.lane;
        float x[16]; { float a[8], b[8]; unpack8(*(const u32x4*)xr, a); unpack8(*(const u32x4*)(xr + 8), b);
#pragma unroll
            for (int i = 0; i < 8; ++i) { x[i] = a[i]; x[8 + i] = b[i]; } }
        f32x4* o = (f32x4*)(F.out + (size_t)m * DM + 16 * F.lane);
#pragma unroll
        for (int q = 0; q < 4; ++q) o[q] = (f32x4){x[4 * q] * rs * wv[4 * q], x[4 * q + 1] * rs * wv[4 * q + 1], x[4 * q + 2] * rs * wv[4 * q + 2], x[4 * q + 3] * rs * wv[4 * q + 3]};
    }
}

constexpr int GMT = 3;
constexpr int N_PHASES = 16;
__global__ void __launch_bounds__(512, 2) mk_fwd(Args args) {
    extern __shared__ __attribute__((aligned(16))) unsigned char lds[];
    Frame F;
    F.lds = (LAS unsigned char*)lds;
    F.tid = threadIdx.x; F.lane = F.tid & 63; F.wave = __builtin_amdgcn_readfirstlane(F.tid >> 6);
    F.G = gridDim.x; { const int bx = blockIdx.x; F.vcu = (F.G % 8 == 0) ? (bx % 8) * (F.G / 8) + bx / 8 : bx; }
    F.out = args.out; F.ws = args.ws;
    volatile LAS unsigned* MISC = (volatile LAS unsigned*)(F.lds + MISC_OFF);
    for (int u = F.tid; u < (LDS_BYTES - LDSCTL_OFF) / 4; u += 512) ((LAS unsigned*)(F.lds + LDSCTL_OFF))[u] = 0u;
    __syncthreads();
    if (F.tid == 0) {
#pragma unroll
        for (int i = 0; i < 37; ++i) ((LAS unsigned long long*)(F.lds + PTRTAB_OFF))[i] = (unsigned long long)args.in[i];
    }
    __syncthreads();
    XcdBarrier bar = xcd_barrier_post((unsigned*)(args.ws + WS_CTL) + CW_BAR, MISC + 8);
    const int ns = args.nsched; unsigned nscan = 0;
    for (int si = 0; si < ns; ++si) {
        const int pe = (int)((args.sched[si >> 2] >> (8 * (si & 3))) & 0xffu); const int p = pe & 0x7f; const bool probe = (pe & 0x80) != 0;
        if (p == 0) p0_prologue(F);
        else if (p == 15) final_norm(F);
        else {
            const int l = (p - 1) / 7, sub = (p - 1) % 7;
            if (sub == 0) {
                pg8::Gemm g{F_R1, w_in(F, l), T, PW, DM, DM}; pg8::StaticOrder S; S.init(T, PW, F.G, (int)blockIdx.x);
                pg8::EpiInProj E{F_PROJ, F_SCAL, F_SSQA, F_HCONV, F_HSHIFT, F.out, l};
                pg8::gemm_phase<pg8::EpiInProj, true>(F.lds, g, S, E);
            } else if (sub == 1) { }
            else if (sub == 2) scan_phase(F, l, 0, nscan++);
            else if (sub == 3) { }
            else if (sub == 4) {
                pg8::Gemm g{F_PROJ, w_out(F, l), T, DM, DM, PW}; pg8::StaticOrder S; S.init(T, DM, F.G, (int)blockIdx.x, 64 * GMT);
                if (l == 0) { pg8::EpiResid<true, GMT> E{INP(I_XP), INP(I_XS), F_R1, F_SSQD}; pg8::gemm_phase<pg8::EpiResid<true, GMT>, true, GMT>(F.lds, g, S, E); }
                else { pg8::EpiResid<false, GMT> E{nullptr, nullptr, F_R1, F_SSQD}; pg8::gemm_phase<pg8::EpiResid<false, GMT>, true, GMT>(F.lds, g, S, E); }
            } else if (sub == 5) {
                pg8::Gemm g{F_R1, w_gu(F, l), T, NGU, DM, DM}; pg8::StaticOrder S; S.init(T, NGU, F.G, (int)blockIdx.x);
                pg8::EpiGateUp E{F_PROJ, F_SSQD};
                pg8::gemm_phase<pg8::EpiGateUp, true>(F.lds, g, S, E);
            } else {
                pg8::Gemm g{F_PROJ, w_dn(F, l), T, DM, FF, FF}; pg8::StaticOrder S; S.init(T, DM, F.G, (int)blockIdx.x, 64 * GMT);
                pg8::EpiResid<false, GMT> E{nullptr, nullptr, F_R1, F_SSQA};
                pg8::gemm_phase<pg8::EpiResid<false, GMT>, true, GMT>(F.lds, g, S, E);
            }
        }
        if (si + 1 < ns) xcd_barrier(bar);
    }
}

extern "C" void kernel_launch(void* const* d_in, const int* in_sizes, int n_in, void* d_out, int out_size, void* d_ws, size_t ws_size, hipStream_t stream) {
    static int grid = 0;
    if (grid == 0) {
        if (n_in != 37 || out_size != (int)O_END || ws_size < 268435456) { fprintf(stderr, "kernel_launch: unexpected shapes: n_in %d out %d ws %zu\n", n_in, out_size, ws_size); grid = -1; return; }
        int dev = 0, cus = 0;
        if (hipGetDevice(&dev) != hipSuccess || hipDeviceGetAttribute(&cus, hipDeviceAttributeMultiprocessorCount, dev) != hipSuccess) { grid = -1; return; }
        if (hipFuncSetAttribute((const void*)mk_fwd, hipFuncAttributeMaxDynamicSharedMemorySize, LDS_BYTES) != hipSuccess) { fprintf(stderr, "kernel_launch: hipFuncSetAttribute failed\n"); grid = -1; return; }
        int per_cu = 0;
        if (hipOccupancyMaxActiveBlocksPerMultiprocessor(&per_cu, (const void*)mk_fwd, 512, LDS_BYTES) != hipSuccess || per_cu < 1)
            fprintf(stderr, "kernel_launch: occupancy query reports %d workgroups per CU\n", per_cu);
        (void)hipGetLastError();
        grid = cus;
    }
    if (grid < 0) return;
    (void)hipMemsetAsync((char*)d_ws + WS_CTL, 0, 65536, stream);
    Args a{};
    for (int i = 0; i < 37; ++i) a.in[i] = (const float*)d_in[i];
    a.out = (float*)d_out; a.ws = (unsigned char*)d_ws;
    {
        int n = 0; unsigned char s[32];
#ifndef PROBE_K
#define PROBE_K -1
#endif
        if (PROBE_K >= 0) { s[n++] = 0x80; for (int p = 1; p <= PROBE_K; ++p) if ((p - 1) % 7 != 3 && (p - 1) % 7 != 1) s[n++] = (unsigned char)(0x80 | p); }
        for (int p = 0; p < N_PHASES; ++p) if (p == 0 || p == 15 || ((p - 1) % 7 != 3 && (p - 1) % 7 != 1)) s[n++] = (unsigned char)p;
        for (int i = 0; i < n; ++i) a.sched[i >> 2] |= (unsigned)s[i] << (8 * (i & 3));
        a.nsched = n;
#ifndef PROBE_MODE
#define PROBE_MODE 31
#endif
        a.pmode = PROBE_MODE;
    }
    hipLaunchKernelGGL(mk_fwd, dim3(grid), dim3(512), LDS_BYTES, stream, a);
}
```
